# Optimizing an MI355X kernel written in HIP

```python
import jax, jax.numpy as jnp
from jax import lax
import numpy as np

D_MODEL = 1024
BATCH = 8
SEQ = 4096
DEPTH = 2

N_A_LAYERS = DEPTH // 2
N_B_LAYERS = DEPTH - N_A_LAYERS

DN_ALPHA = (2 * DEPTH) ** 0.25
DN_BETA = (8 * DEPTH) ** -0.25
LN_EPS = 1e-5
RMS_EPS = 1e-6
NEG_INF = -1e30
Q_BLOCK = 128

NSA_HEADS = 16
NSA_KV_GROUPS = 4
NSA_GROUP_SIZE = NSA_HEADS // NSA_KV_GROUPS
NSA_HEAD_DIM = D_MODEL // NSA_HEADS
CMP_LEN = 32
CMP_STRIDE = 16
CMP_HIDDEN = 2 * NSA_HEAD_DIM
SEL_BLOCK = 64
SEL_TOPN = 16
FORCE_BONUS = 1e4
WINDOW = 512
NSA_Q_COLS = NSA_HEADS * NSA_HEAD_DIM
NSA_KV_COLS = NSA_KV_GROUPS * NSA_HEAD_DIM
NSA_IN_COLS = NSA_Q_COLS + 6 * NSA_KV_COLS + 3 * NSA_HEADS

MLA_HEADS = 16
MLA_NOPE = 64
MLA_ROPE = 32
MLA_V = 64
MLA_Q_LORA = 768
MLA_KV_LORA = 256
ROPE_THETA = 10000.0

PEER_HEADS = 8
PEER_NKEYS = 128
PEER_EXPERTS = PEER_NKEYS * PEER_NKEYS
PEER_QDIM = 256
PEER_HALF = PEER_QDIM // 2
PEER_TOPK = 16
PEER_CHUNK = 128

kernel_name = "yoco_nsa_mla_peer_deepnorm"


def layer_norm(x, g, b):
    xf = x.astype(jnp.float32)
    mu = xf.mean(-1, keepdims=True)
    var = jnp.square(xf - mu).mean(-1, keepdims=True)
    y = (xf - mu) * lax.rsqrt(var + LN_EPS)
    return (y * g.astype(jnp.float32) + b.astype(jnp.float32)).astype(x.dtype)


def rms_norm(x, g):
    xf = x.astype(jnp.float32)
    y = xf * lax.rsqrt(jnp.square(xf).mean(-1, keepdims=True) + RMS_EPS)
    return (y * g.astype(jnp.float32)).astype(x.dtype)


def masked_softmax(s, mask, axis=-1):
    s = jnp.where(mask, s.astype(jnp.float32), NEG_INF)
    p = jax.nn.softmax(s, axis=axis)
    return jnp.where(mask, p, 0.0)


def alibi_slopes(n):
    return jnp.asarray([2.0 ** (-8.0 * (h + 1) / n) for h in range(n)], jnp.float32)


def rope_cos_sin(seq, dim):
    inv = 1.0 / (ROPE_THETA ** (jnp.arange(0, dim, 2, dtype=jnp.float32) / dim))
    ang = jnp.arange(seq, dtype=jnp.float32)[:, None] * inv[None, :]
    return jnp.cos(ang), jnp.sin(ang)


def apply_rope(x, cos, sin):
    shp = (cos.shape[0],) + (1,) * (x.ndim - 3) + (cos.shape[1],)
    c, s = cos.reshape(shp), sin.reshape(shp)
    xf = x.astype(jnp.float32)
    x1, x2 = jnp.split(xf, 2, axis=-1)
    return jnp.concatenate([x1 * c - x2 * s, x2 * c + x1 * s], axis=-1).astype(x.dtype)


def cmp_to_sel_matrix(n_cmp, n_sel):
    start = np.arange(n_cmp)[:, None] * CMP_STRIDE
    bstart = np.arange(n_sel)[None, :] * SEL_BLOCK
    ov = np.clip(np.minimum(start + CMP_LEN, bstart + SEL_BLOCK) - np.maximum(start, bstart), 0, None)
    return (ov / CMP_LEN).astype(np.float32)


def nsa_compress(k, w1, w2, pe):
    B, S, G, dh = k.shape
    chunks = k.reshape(B, S // CMP_STRIDE, CMP_STRIDE, G, dh)
    w1r = w1.reshape(2, CMP_STRIDE, dh, CMP_HIDDEN)
    p_first = jnp.einsum('bnlgd,ldh->bngh', chunks, w1r[0])
    p_second = jnp.einsum('bnlgd,ldh->bngh', chunks, w1r[1])
    pe_term = jnp.einsum('ld,ldh->h', pe, w1.reshape(CMP_LEN, dh, CMP_HIDDEN))
    h = jax.nn.gelu(p_first[:, :-1] + p_second[:, 1:] + pe_term)
    return jnp.einsum('bngh,hd->bngd', h, w2)


def nsa_mixer(x, w_in, ck_w1, ck_w2, ck_pe, cv_w1, cv_w2, cv_pe, w_out):
    B, S, _ = x.shape
    G, R, dh = NSA_KV_GROUPS, NSA_GROUP_SIZE, NSA_HEAD_DIM
    proj = x @ w_in
    splits = np.cumsum([NSA_Q_COLS] + [NSA_KV_COLS] * 6).tolist()
    q, kc, vc, ks, vs, kw, vw, gates = jnp.split(proj, splits, axis=-1)
    q = q.reshape(B, S, G, R, dh)
    kc, vc, ks, vs, kw, vw = [a.reshape(B, S, G, dh) for a in (kc, vc, ks, vs, kw, vw)]
    gates = jax.nn.sigmoid(gates.astype(jnp.float32)).reshape(B, S, G, R, 3)

    kc_cmp = nsa_compress(kc, ck_w1, ck_w2, ck_pe)
    vc_cmp = nsa_compress(vc, cv_w1, cv_w2, cv_pe)
    n_cmp = S // CMP_STRIDE - 1
    cmp_end = jnp.arange(n_cmp) * CMP_STRIDE + (CMP_LEN - 1)
    n_sel = S // SEL_BLOCK
    top_n = min(SEL_TOPN, n_sel)
    sel_map = jnp.asarray(cmp_to_sel_matrix(n_cmp, n_sel))
    ks_blocks = ks.reshape(B, n_sel, SEL_BLOCK, G, dh).transpose(0, 3, 1, 2, 4)
    vs_blocks = vs.reshape(B, n_sel, SEL_BLOCK, G, dh).transpose(0, 3, 1, 2, 4)
    kw_pad = jnp.pad(kw, ((0, 0), (WINDOW, 0), (0, 0), (0, 0)))
    vw_pad = jnp.pad(vw, ((0, 0), (WINDOW, 0), (0, 0), (0, 0)))
    slopes = alibi_slopes(NSA_HEADS).reshape(G, R)
    scale = dh ** -0.5
    n_qb = S // Q_BLOCK

    def block_fn(i):
        b = i // n_qb
        q0 = (i % n_qb) * Q_BLOCK
        t = q0 + jnp.arange(Q_BLOCK)
        qb = lax.dynamic_slice(q, (b, q0, 0, 0, 0), (1, Q_BLOCK, G, R, dh))[0]
        gb = lax.dynamic_slice(gates, (b, q0, 0, 0, 0), (1, Q_BLOCK, G, R, 3))[0]
        kcb, vcb = kc_cmp[b], vc_cmp[b]
        dist_c = t[:, None] - cmp_end[None, :]
        s_c = jnp.einsum('tgrd,ngd->grtn', qb, kcb).astype(jnp.float32) * scale \
            - slopes[:, :, None, None] * dist_c.astype(jnp.float32)
        p_c = masked_softmax(s_c, dist_c >= 0)
        o_c = jnp.einsum('grtn,ngd->tgrd', p_c.astype(vcb.dtype), vcb)
        imp = jnp.einsum('grtn,nj->gtj', p_c, sel_map)
        blk_t = t // SEL_BLOCK
        j = jnp.arange(n_sel)
        eligible = j[None, :] <= blk_t[:, None]
        forced = (j[None, :] == 0) | (j[None, :] == blk_t[:, None]) | (j[None, :] == blk_t[:, None] - 1)
        imp = jnp.where(eligible, imp + jnp.where(forced, FORCE_BONUS, 0.0), NEG_INF)
        _, sel_idx = lax.top_k(imp, top_n)
        k_g = jax.vmap(lambda kk, ii: kk[ii])(ks_blocks[b], sel_idx)
        v_g = jax.vmap(lambda vv, ii: vv[ii])(vs_blocks[b], sel_idx)
        pos_s = sel_idx[..., None] * SEL_BLOCK + jnp.arange(SEL_BLOCK)
        dist_s = (t[None, :, None, None] - pos_s)[:, None]
        s_s = jnp.einsum('tgrd,gtnld->grtnl', qb, k_g).astype(jnp.float32) * scale \
            - slopes[:, :, None, None, None] * dist_s.astype(jnp.float32)
        p_s = masked_softmax(s_s, dist_s >= 0, axis=(-2, -1))
        o_s = jnp.einsum('grtnl,gtnld->tgrd', p_s.astype(v_g.dtype), v_g)
        kwb = lax.dynamic_slice(kw_pad, (b, q0, 0, 0), (1, WINDOW + Q_BLOCK, G, dh))[0]
        vwb = lax.dynamic_slice(vw_pad, (b, q0, 0, 0), (1, WINDOW + Q_BLOCK, G, dh))[0]
        s_pos = q0 - WINDOW + jnp.arange(WINDOW + Q_BLOCK)
        dist_w = t[:, None] - s_pos[None, :]
        mask_w = (dist_w >= 0) & (dist_w < WINDOW) & (s_pos[None, :] >= 0)
        s_w = jnp.einsum('tgrd,sgd->grts', qb, kwb).astype(jnp.float32) * scale \
            - slopes[:, :, None, None] * dist_w.astype(jnp.float32)
        p_w = masked_softmax(s_w, mask_w)
        o_w = jnp.einsum('grts,sgd->tgrd', p_w.astype(vwb.dtype), vwb)
        o = gb[..., 0:1] * o_c + gb[..., 1:2] * o_s + gb[..., 2:3] * o_w
        return o.reshape(Q_BLOCK, NSA_Q_COLS).astype(q.dtype)

    out = lax.map(block_fn, jnp.arange(B * n_qb)).reshape(B, S, NSA_Q_COLS)
    return out @ w_out


def mla_shared_kv(x, w_dkv, kv_norm_g, w_kr, w_uk, w_uv, cos, sin):
    c_kv = rms_norm(x @ w_dkv, kv_norm_g)
    k_rope = apply_rope(x @ w_kr, cos, sin)
    k_nope = jnp.einsum('bsc,chd->bshd', c_kv, w_uk)
    v = jnp.einsum('bsc,chd->bshd', c_kv, w_uv)
    return k_nope, k_rope, v


def mla_mixer(x, w_dq, q_norm_g, w_uq, w_out, k_nope, k_rope, v, cos, sin):
    B, S, _ = x.shape
    H = MLA_HEADS
    q = jnp.einsum('bsc,chd->bshd', rms_norm(x @ w_dq, q_norm_g), w_uq)
    q_nope = q[..., :MLA_NOPE]
    q_rope = apply_rope(q[..., MLA_NOPE:], cos, sin)
    scale = (MLA_NOPE + MLA_ROPE) ** -0.5
    n_qb = S // Q_BLOCK
    kpos = jnp.arange(S)

    def block_fn(i):
        b = i // n_qb
        q0 = (i % n_qb) * Q_BLOCK
        t = q0 + jnp.arange(Q_BLOCK)
        qn = lax.dynamic_slice(q_nope, (b, q0, 0, 0), (1, Q_BLOCK, H, MLA_NOPE))[0]
        qr = lax.dynamic_slice(q_rope, (b, q0, 0, 0), (1, Q_BLOCK, H, MLA_ROPE))[0]
        s = (jnp.einsum('thd,shd->hts', qn, k_nope[b]) + jnp.einsum('thd,sd->hts', qr, k_rope[b])).astype(jnp.float32) * scale
        p = masked_softmax(s, kpos[None, :] <= t[:, None])
        vb = v[b]
        o = jnp.einsum('hts,shd->thd', p.astype(vb.dtype), vb)
        return o.reshape(Q_BLOCK, H * MLA_V)

    out = lax.map(block_fn, jnp.arange(B * n_qb)).reshape(B, S, H * MLA_V)
    return out @ w_out


def peer_ffn(x, w_q, subkeys, u, v):
    B, S, D = x.shape
    T, K = PEER_CHUNK, PEER_TOPK
    xt = x.reshape(-1, T, D)

    def chunk_fn(xc):
        q = (xc @ w_q).reshape(T, PEER_HEADS, 2, PEER_HALF)
        s = jnp.einsum('thcd,hckd->thck', q, subkeys).astype(jnp.float32)
        sv, si = lax.top_k(s, K)
        cand = sv[:, :, 0, :, None] + sv[:, :, 1, None, :]
        cidx = si[:, :, 0, :, None] * PEER_NKEYS + si[:, :, 1, None, :]
        cs, cp = lax.top_k(cand.reshape(T, PEER_HEADS, K * K), K)
        eidx = jnp.take_along_axis(cidx.reshape(T, PEER_HEADS, K * K), cp, axis=-1)
        g = jax.nn.softmax(cs, axis=-1)
        ue, ve = u[eidx], v[eidx]
        a = jax.nn.gelu(jnp.einsum('td,thkd->thk', xc, ue).astype(jnp.float32))
        return jnp.einsum('thk,thkd->td', (g * a).astype(xc.dtype), ve)

    return lax.map(chunk_fn, xt).reshape(B, S, D)


def setup_inputs(seed: int = 0) -> dict:
    key = jax.random.key(seed)
    ks = iter(jax.random.split(key, 40))
    D = D_MODEL

    def nrm(shape, scale):
        return jax.random.normal(next(ks), shape, jnp.float32) * scale

    def gain(shape):
        return 1.0 + nrm(shape, 0.02)

    na, nb = N_A_LAYERS, N_B_LAYERS
    flat = CMP_LEN * NSA_HEAD_DIM
    return {
        "x": nrm((BATCH, SEQ, D), 1.0),
        "nsa_w_in": nrm((na, D, NSA_IN_COLS), D ** -0.5),
        "nsa_cmp_k_w1": nrm((na, flat, CMP_HIDDEN), flat ** -0.5),
        "nsa_cmp_k_w2": nrm((na, CMP_HIDDEN, NSA_HEAD_DIM), CMP_HIDDEN ** -0.5),
        "nsa_cmp_k_pe": nrm((na, CMP_LEN, NSA_HEAD_DIM), 0.1),
        "nsa_cmp_v_w1": nrm((na, flat, CMP_HIDDEN), flat ** -0.5),
        "nsa_cmp_v_w2": nrm((na, CMP_HIDDEN, NSA_HEAD_DIM), CMP_HIDDEN ** -0.5),
        "nsa_cmp_v_pe": nrm((na, CMP_LEN, NSA_HEAD_DIM), 0.1),
        "nsa_w_out": nrm((na, NSA_Q_COLS, D), DN_BETA * NSA_Q_COLS ** -0.5),
        "nsa_ln_g": gain((na, D)),
        "nsa_ln_b": nrm((na, D), 0.02),
        "mla_w_dkv": nrm((D, MLA_KV_LORA), D ** -0.5),
        "mla_kv_norm_g": gain((MLA_KV_LORA,)),
        "mla_w_kr": nrm((D, MLA_ROPE), D ** -0.5),
        "mla_w_uk": nrm((MLA_KV_LORA, MLA_HEADS, MLA_NOPE), MLA_KV_LORA ** -0.5),
        "mla_w_uv": nrm((MLA_KV_LORA, MLA_HEADS, MLA_V), MLA_KV_LORA ** -0.5),
        "mla_w_dq": nrm((nb, D, MLA_Q_LORA), D ** -0.5),
        "mla_q_norm_g": gain((nb, MLA_Q_LORA)),
        "mla_w_uq": nrm((nb, MLA_Q_LORA, MLA_HEADS, MLA_NOPE + MLA_ROPE), MLA_Q_LORA ** -0.5),
        "mla_w_out": nrm((nb, MLA_HEADS * MLA_V, D), DN_BETA * (MLA_HEADS * MLA_V) ** -0.5),
        "mla_ln_g": gain((nb, D)),
        "mla_ln_b": nrm((nb, D), 0.02),
        "peer_w_q": nrm((DEPTH, D, PEER_HEADS * PEER_QDIM), D ** -0.5),
        "peer_subkeys": nrm((DEPTH, PEER_HEADS, 2, PEER_NKEYS, PEER_HALF), PEER_HALF ** -0.5),
        "peer_u": nrm((DEPTH, PEER_EXPERTS, D), D ** -0.5),
        "peer_v": nrm((DEPTH, PEER_EXPERTS, D), DN_BETA),
        "peer_ln_g": gain((DEPTH, D)),
        "peer_ln_b": nrm((DEPTH, D), 0.02),
    }


def reference(x, nsa_w_in, nsa_cmp_k_w1, nsa_cmp_k_w2, nsa_cmp_k_pe, nsa_cmp_v_w1, nsa_cmp_v_w2,
              nsa_cmp_v_pe, nsa_w_out, nsa_ln_g, nsa_ln_b, mla_w_dkv, mla_kv_norm_g, mla_w_kr,
              mla_w_uk, mla_w_uv, mla_w_dq, mla_q_norm_g, mla_w_uq, mla_w_out, mla_ln_g, mla_ln_b,
              peer_w_q, peer_subkeys, peer_u, peer_v, peer_ln_g, peer_ln_b):
    S = x.shape[1]
    cos, sin = rope_cos_sin(S, MLA_ROPE)
    h = x
    k_nope = k_rope = v_shared = None
    for layer in range(DEPTH):
        if layer < N_A_LAYERS:
            a = layer
            mix = nsa_mixer(h, nsa_w_in[a], nsa_cmp_k_w1[a], nsa_cmp_k_w2[a], nsa_cmp_k_pe[a],
                            nsa_cmp_v_w1[a], nsa_cmp_v_w2[a], nsa_cmp_v_pe[a], nsa_w_out[a])
            h = layer_norm(DN_ALPHA * h + mix, nsa_ln_g[a], nsa_ln_b[a])
        else:
            if layer == N_A_LAYERS:
                k_nope, k_rope, v_shared = mla_shared_kv(h, mla_w_dkv, mla_kv_norm_g, mla_w_kr,
                                                         mla_w_uk, mla_w_uv, cos, sin)
            bi = layer - N_A_LAYERS
            mix = mla_mixer(h, mla_w_dq[bi], mla_q_norm_g[bi], mla_w_uq[bi], mla_w_out[bi],
                            k_nope, k_rope, v_shared, cos, sin)
            h = layer_norm(DN_ALPHA * h + mix, mla_ln_g[bi], mla_ln_b[bi])
        ffn = peer_ffn(h, peer_w_q[layer], peer_subkeys[layer], peer_u[layer], peer_v[layer])
        h = layer_norm(DN_ALPHA * h + ffn, peer_ln_g[layer], peer_ln_b[layer])
    return h
```

```cpp
#include <hip/hip_runtime.h>
#include <hip/hip_cooperative_groups.h>
#include <cstdio>
#include <cstdint>
namespace cg = cooperative_groups;

#ifndef ABL
#define ABL 0
#endif
#ifndef DBG_STAT
#define DBG_STAT 0
#endif
#ifndef MK_ONE_LAUNCH
#define MK_ONE_LAUNCH 1
#endif

#define LAS __attribute__((address_space(3)))
typedef unsigned short bf16_t;
typedef short bf16x8 __attribute__((ext_vector_type(8)));
typedef float f32x4 __attribute__((ext_vector_type(4)));
typedef float f32x2 __attribute__((ext_vector_type(2)));
typedef unsigned u32x4 __attribute__((ext_vector_type(4)));
typedef unsigned u32x2 __attribute__((ext_vector_type(2)));
typedef __bf16 bf16x2_t __attribute__((ext_vector_type(2)));

constexpr int BATCH = 8, SEQ = 4096, DM = 1024, NTOK = BATCH * SEQ;
constexpr int NSA_IN = 2608, NSA_IN_PAD = 2816;
constexpr int MLA_DOWN = 1056, MLA_DOWN_PAD = 1280;
constexpr int NEXP = 16384;
constexpr float DN_ALPHA = 1.4142135623730951f;
constexpr float LN_EPS = 1e-5f, RMS_EPS = 1e-6f;
constexpr int NWAVES = 8, NTHREADS = 512;
constexpr int LDS_BYTES = 147456;

constexpr size_t KiB = 1024, MiB = 1024 * 1024;
constexpr size_t WS_CTL = 0, CTL_BYTES = 64 * KiB;
constexpr size_t WS_W_IN_T = 1 * MiB;
constexpr size_t WS_W_NSAOUT_T = 6 * MiB + 512 * KiB;
constexpr size_t WS_W_CK1_T = 8 * MiB + 512 * KiB;
constexpr size_t WS_W_CV1_T = 9 * MiB;
constexpr size_t WS_W_MLADOWN_T = 9 * MiB + 512 * KiB;
constexpr size_t WS_W_UQ_T = 12 * MiB;
constexpr size_t WS_W_UKV_T = 14 * MiB + 256 * KiB;
constexpr size_t WS_W_MLAOUT_T = 15 * MiB + 256 * KiB;
constexpr size_t WS_W_PQ_T = 17 * MiB + 256 * KiB;
constexpr size_t WS_SUBK = 25 * MiB + 256 * KiB;
constexpr size_t WS_MISC = 27 * MiB;
constexpr size_t WS_PE = WS_MISC;
constexpr size_t WS_ROPE_COS = WS_MISC + 4 * KiB;
constexpr size_t WS_ROPE_SIN = WS_ROPE_COS + 256 * KiB;
constexpr size_t WS_RSTD_Q = WS_ROPE_SIN + 256 * KiB;
constexpr size_t WS_RSTD_KV = WS_RSTD_Q + 128 * KiB;
constexpr size_t WS_TAB = 32 * MiB;
constexpr size_t WS_HB = 160 * MiB;
constexpr size_t WS_S = 224 * MiB;
constexpr size_t S_Q = WS_S;
constexpr size_t S_KV6 = WS_S + 64 * MiB;
constexpr size_t S_AO = WS_S + 160 * MiB;
constexpr size_t S_GATES = WS_S + 224 * MiB;
constexpr size_t S_PK = WS_S + 230 * MiB;
constexpr size_t S_PV = WS_S + 238 * MiB;
constexpr size_t S_KCMP = WS_S + 246 * MiB;
constexpr size_t S_VCMP = S_KCMP + 512 * KiB;
constexpr size_t S_Z = WS_S;
constexpr size_t S_QP0 = WS_S + 64 * MiB;
constexpr size_t S_EIDX0 = WS_S + 192 * MiB;
constexpr size_t S_GW0 = WS_S + 208 * MiB;
constexpr size_t S_DQ = WS_S;
constexpr size_t S_QF = WS_S + 80 * MiB;
constexpr size_t S_V = WS_S + 176 * MiB;
constexpr size_t S_KROPE = WS_S + 240 * MiB;
constexpr size_t S_KNOPE = WS_TAB;
constexpr size_t S_AO2 = WS_S;
constexpr size_t S_Z2 = WS_S + 80 * MiB;
constexpr size_t S_QP1 = WS_S + 144 * MiB;
constexpr size_t S_EIDX1 = WS_S;
constexpr size_t S_GW1 = WS_S + 16 * MiB;
constexpr size_t WS_NEED = 512 * MiB;
static_assert(S_QP1 + 128 * MiB <= WS_NEED && S_VCMP + 512 * KiB <= WS_NEED, "workspace map");

__device__ __forceinline__ float bf_lo(unsigned u) { return __uint_as_float(u << 16); }
__device__ __forceinline__ float bf_hi(unsigned u) { return __uint_as_float(u & 0xffff0000u); }
__device__ __forceinline__ float bf2f(bf16_t v) { return __uint_as_float((unsigned)v << 16); }
__device__ __forceinline__ unsigned pk2(float lo, float hi) { f32x2 v = {lo, hi}; bf16x2_t b = __builtin_convertvector(v, bf16x2_t); return __builtin_bit_cast(unsigned, b); }
__device__ __forceinline__ bf16_t f2bf(float f) { return (bf16_t)(pk2(f, 0.f) & 0xffffu); }
__device__ __forceinline__ float wave_sum(float v) {
#pragma unroll
    for (int o = 32; o >= 1; o >>= 1) v += __shfl_xor(v, o);
    return v;
}
__device__ __forceinline__ float wave_max(float v) {
#pragma unroll
    for (int o = 32; o >= 1; o >>= 1) v = fmaxf(v, __shfl_xor(v, o));
    return v;
}
__device__ __forceinline__ float gelu_tanh(float x) {
    const float y = 0.7978845608028654f * (x + 0.044715f * x * x * x);
    const float e = __expf(2.f * y);
    const float th = 1.f - 2.f / (1.f + e);
    return 0.5f * x * (1.f + th);
}
#define LDS_FENCE() asm volatile("s_waitcnt lgkmcnt(0)" ::: "memory")

namespace pg8 {
constexpr int BM = 256, BK = 64, HALF = 128, HTB = HALF * BK * 2, STAGE_BYTES = 8 * HTB, NXCD = 8, WGM = 8;
__host__ __device__ __forceinline__ int lds_byte(int r, int c) { const int st = (r >> 4) * 2 + (c >> 5), rr = r & 15, cc = c & 31, ob = rr * 64 + cc * 2; return st * 1024 + (ob ^ (((ob >> 9) & 1) << 5)); }
__host__ __device__ __forceinline__ void stage_rc(int b, int& R, int& C) { const int st = b / 1024, sb = b % 1024, swz = sb ^ (((sb >> 9) & 1) << 5); R = (st >> 1) * 16 + swz / 64; C = (st & 1) * 32 + (swz % 64) / 2; }
__host__ __device__ __forceinline__ int perm32(int rho) { const int n = rho >> 4, i = rho & 15; return 8 * (i >> 2) + 4 * n + (i & 3); }
struct Unit { int pm, pn; };
struct Gemm { const bf16_t* A; const bf16_t* Bt; int M, N, K, lda, ldb; };
struct StaticOrder {
    int nM, nN, nwg, G, c;
    __device__ void init(int M, int N, int G_, int c_) { nM = M / BM; nN = N / BM; nwg = nM * nN; G = G_; c = c_; }
    __device__ bool next(int i, Unit& u) const {
        const long L = (long)i * G + c; if (L >= nwg) return false;
        int wgid = (int)L; { const int q = nwg / NXCD, r = nwg % NXCD, xcd = wgid % NXCD, off = wgid / NXCD; wgid = (xcd < r ? xcd * (q + 1) : r * (q + 1) + (xcd - r) * q) + off; }
        const int nig = WGM * nN, gid = wgid / nig, fm = gid * WGM, gsz = (nM - fm) < WGM ? (nM - fm) : WGM;
        u.pm = fm + ((wgid % nig) % gsz); u.pn = (wgid % nig) / gsz; return true;
    }
};
template <class F> struct EpiFn {
    static constexpr bool PERM = true;
    F f;
    __device__ __forceinline__ void operator()(const f32x4 (&acc)[2][2][4][2], const Unit& u, int wr, int wc, int fr, int fq) const {
        const int row0 = u.pm * BM + wr * 64 + fr, col0 = u.pn * BM + wc * 32 + 8 * fq;
#pragma unroll
        for (int ai = 0; ai < 2; ++ai)
#pragma unroll
            for (int m = 0; m < 4; ++m)
#pragma unroll
                for (int bj = 0; bj < 2; ++bj) f(row0 + ai * HALF + m * 16, col0 + bj * HALF, acc[ai][bj][m][0], acc[ai][bj][m][1]);
    }
};

template <class Epi, class Sched>
__device__ __forceinline__ void gemm_phase(LAS unsigned char* lds, const Gemm g, const Sched& S, const Epi& E) {
    const int tid = threadIdx.x, wid = __builtin_amdgcn_readfirstlane(tid >> 6), lane = tid & 63, wr = wid >> 2, wc = wid & 3, fr = lane & 15, fq = lane >> 4;
    const int K = g.K, nt = K / BK;
    unsigned voffA[2], voffB[2];
#pragma unroll
    for (int i = 0; i < 2; ++i) { int R, C; stage_rc(tid * 16 + i * 8192, R, C); const int Rb = Epi::PERM ? ((R & ~31) + perm32(R & 31)) : R;
        voffA[i] = (unsigned)(R * g.lda + C) * 2u; voffB[i] = (unsigned)(Rb * g.ldb + C) * 2u; }
    const size_t kstep = (size_t)(BK * 2);
    const size_t hstepA = (size_t)HALF * g.lda * 2, hstepB = (size_t)HALF * g.ldb * 2;
    const size_t tstepA = 2 * hstepA, tstepB = 2 * hstepB;
    const unsigned ldsw = (unsigned)wid * 1024u;
    const int aoff = lds_byte(wr * 64 + fr, fq * 8), boff = lds_byte(wc * 32 + fr, fq * 8);
#define PG8_SA(b, h) (((b) * 2 + (h)) * HTB)
#define PG8_SB(b, h) ((4 + (b) * 2 + (h)) * HTB)
#define PG8_STAGE(bufoff, gbase, voff) do { _Pragma("unroll") for (int _i = 0; _i < 2; ++_i) \
        __builtin_amdgcn_global_load_lds((const unsigned*)((const char*)(gbase) + (voff)[_i]), (LAS unsigned*)(lds + (bufoff) + ldsw + _i * 8192), 16, 0, 0); } while (0)
#define PG8_LDA(dst, b, h) do { _Pragma("unroll") for (int m = 0; m < 4; ++m) _Pragma("unroll") for (int k = 0; k < 2; ++k) dst[m][k] = *(const LAS bf16x8*)(lds + PG8_SA(b, h) + aoff + m * 2048 + k * 1024); } while (0)
#define PG8_LDB(dst, b, h) do { _Pragma("unroll") for (int n = 0; n < 2; ++n) _Pragma("unroll") for (int k = 0; k < 2; ++k) dst[n][k] = *(const LAS bf16x8*)(lds + PG8_SB(b, h) + boff + n * 2048 + k * 1024); } while (0)
#define PG8_MMA(ai, bj, At, Bt) do { __builtin_amdgcn_s_setprio(1); _Pragma("unroll") for (int m = 0; m < 4; ++m) _Pragma("unroll") for (int n = 0; n < 2; ++n) _Pragma("unroll") for (int k = 0; k < 2; ++k) \
        acc[ai][bj][m][n] = __builtin_amdgcn_mfma_f32_16x16x32_bf16(Bt[n][k], At[m][k], acc[ai][bj][m][n], 0, 0, 0); __builtin_amdgcn_s_setprio(0); } while (0)
#define PG8_WAIT_V(n) asm volatile("s_waitcnt vmcnt(" #n ")" ::: "memory")
#define PG8_WAIT_L(n) asm volatile("s_waitcnt lgkmcnt(" #n ")" ::: "memory")
#define PG8_BAR __builtin_amdgcn_s_barrier()
#define PG8_SCHED __builtin_amdgcn_sched_barrier(0)
    Unit cur, nxt; int ui = 0;
    if (!S.next(0, cur)) return;
    f32x4 acc[2][2][4][2];
#pragma unroll
    for (int a = 0; a < 2; ++a)
#pragma unroll
        for (int b = 0; b < 2; ++b)
#pragma unroll
            for (int m = 0; m < 4; ++m)
#pragma unroll
                for (int n = 0; n < 2; ++n) acc[a][b][m][n] = (f32x4){0.f, 0.f, 0.f, 0.f};
    bf16x8 At[4][2], B0[2][2], B1[2][2];
    const char* cA = (const char*)g.A + (size_t)cur.pm * tstepA; const char* cB = (const char*)g.Bt + (size_t)cur.pn * tstepB;
    PG8_STAGE(PG8_SB(0, 0), cB, voffB); PG8_STAGE(PG8_SB(0, 1), cB + hstepB, voffB); PG8_STAGE(PG8_SA(0, 0), cA, voffA); PG8_STAGE(PG8_SA(0, 1), cA + hstepA, voffA);
    if (wr == 1) PG8_BAR;
    PG8_WAIT_V(2); PG8_BAR;
    PG8_STAGE(PG8_SB(1, 0), cB + kstep, voffB); PG8_STAGE(PG8_SA(1, 0), cA + kstep, voffA); PG8_STAGE(PG8_SB(1, 1), cB + hstepB + kstep, voffB);
    PG8_WAIT_V(6); PG8_BAR;
    for (;;) {
        const bool has_next = S.next(ui + 1, nxt);
        const char* nA = has_next ? (const char*)g.A + (size_t)nxt.pm * tstepA : cA; const char* nB = has_next ? (const char*)g.Bt + (size_t)nxt.pn * tstepB : cB;
        for (int t = 0; t < nt; t += 2) {
            const bool last = (t == nt - 2);
            const char* a1 = cA + (size_t)(t + 1) * kstep;
            const char* a2 = last ? nA : cA + (size_t)(t + 2) * kstep; const char* b2 = last ? nB : cB + (size_t)(t + 2) * kstep;
            const char* a3 = a2 + kstep; const char* b3 = b2 + kstep;
            PG8_LDB(B0, 0, 0); PG8_LDB(B1, 0, 1); PG8_SCHED; PG8_LDA(At, 0, 0); PG8_STAGE(PG8_SA(1, 1), a1 + hstepA, voffA);
            PG8_WAIT_V(8); PG8_WAIT_L(0); PG8_BAR; PG8_MMA(0, 0, At, B0); PG8_MMA(0, 1, At, B1); PG8_BAR; PG8_SCHED;
            PG8_LDA(At, 0, 1); PG8_STAGE(PG8_SB(0, 0), b2, voffB); PG8_STAGE(PG8_SB(0, 1), b2 + hstepB, voffB); PG8_STAGE(PG8_SA(0, 0), a2, voffA);
            PG8_WAIT_V(8); PG8_WAIT_L(0); PG8_BAR; PG8_MMA(1, 0, At, B0); PG8_MMA(1, 1, At, B1); PG8_BAR; PG8_SCHED;
            PG8_LDB(B0, 1, 0); PG8_LDB(B1, 1, 1); PG8_SCHED; PG8_LDA(At, 1, 0); PG8_STAGE(PG8_SA(0, 1), a2 + hstepA, voffA);
            PG8_WAIT_V(8); PG8_WAIT_L(0); PG8_BAR; PG8_MMA(0, 0, At, B0); PG8_MMA(0, 1, At, B1); PG8_BAR; PG8_SCHED;
            PG8_LDA(At, 1, 1); PG8_STAGE(PG8_SB(1, 0), b3, voffB); PG8_STAGE(PG8_SB(1, 1), b3 + hstepB, voffB); PG8_STAGE(PG8_SA(1, 0), a3, voffA);
            PG8_WAIT_V(8); PG8_WAIT_L(0); PG8_BAR; PG8_MMA(1, 0, At, B0); PG8_MMA(1, 1, At, B1); PG8_BAR; PG8_SCHED;
        }
        if (wr == 0) PG8_BAR;
        E(acc, cur, wr, wc, fr, fq);
        if (!has_next) break;
#pragma unroll
        for (int a = 0; a < 2; ++a)
#pragma unroll
            for (int b = 0; b < 2; ++b)
#pragma unroll
                for (int m = 0; m < 4; ++m)
#pragma unroll
                    for (int n = 0; n < 2; ++n) acc[a][b][m][n] = (f32x4){0.f, 0.f, 0.f, 0.f};
        cur = nxt; cA = nA; cB = nB; ++ui;
        if (wr == 1) PG8_BAR;
    }
    PG8_WAIT_V(0);
    PG8_BAR;
#undef PG8_SA
#undef PG8_SB
#undef PG8_STAGE
#undef PG8_LDA
#undef PG8_LDB
#undef PG8_MMA
#undef PG8_WAIT_V
#undef PG8_WAIT_L
#undef PG8_BAR
#undef PG8_SCHED
}
}

template <class F>
__device__ __forceinline__ void run_gemm(LAS unsigned char* lds, const bf16_t* A, int lda, const bf16_t* Bt, int ldb, int M, int N, int K, int vblock, const F& f) {
    pg8::Gemm g{A, Bt, M, N, K, lda, ldb}; pg8::StaticOrder S; S.init(M, N, (int)gridDim.x, vblock);
    pg8::EpiFn<F> E{f};
    pg8::gemm_phase<pg8::EpiFn<F>, pg8::StaticOrder>(lds, g, S, E);
}

struct Params {
    const float* in[28];
    float* out;
    unsigned char* ws;
    int ph_lo, ph_hi;
};
enum { I_X = 0, I_NSA_WIN, I_CK_W1, I_CK_W2, I_CK_PE, I_CV_W1, I_CV_W2, I_CV_PE, I_NSA_WOUT, I_NSA_LNG, I_NSA_LNB, I_MLA_WDKV, I_MLA_KVG, I_MLA_WKR, I_MLA_WUK, I_MLA_WUV,
       I_MLA_WDQ, I_MLA_QG, I_MLA_WUQ, I_MLA_WOUT, I_MLA_LNG, I_MLA_LNB, I_PEER_WQ, I_PEER_SUBK, I_PEER_U, I_PEER_V, I_PEER_LNG, I_PEER_LNB };

__device__ __forceinline__ void p0_transpose_item(const float* W, int ldw, int n_valid, int K, bf16_t* WT, int row_off, const float* kscale, LAS float* scr, int nblk, int item, int lane) {
    const int kb = item / nblk, nb = item % nblk, k0 = 64 * kb, n0 = 32 * nb;
    const int n = n0 + (lane & 31);
#pragma unroll 8
    for (int i = 0; i < 32; ++i) { const int kk = 2 * i + (lane >> 5); float v = 0.f; if (n < n_valid) { v = W[(size_t)(k0 + kk) * ldw + n]; if (kscale) v *= kscale[k0 + kk]; } scr[kk * 33 + (lane & 31)] = v; }
    LDS_FENCE();
    const int c = lane & 7;
#pragma unroll
    for (int j = 0; j < 4; ++j) { const int nn = (lane >> 3) + 8 * j; const LAS float* s = scr + (8 * c) * 33 + nn;
        u32x4 o; o.x = pk2(s[0 * 33], s[1 * 33]); o.y = pk2(s[2 * 33], s[3 * 33]); o.z = pk2(s[4 * 33], s[5 * 33]); o.w = pk2(s[6 * 33], s[7 * 33]);
        *(u32x4*)(WT + (size_t)(row_off + n0 + nn) * K + k0 + 8 * c) = o; }
    LDS_FENCE();
}
__device__ __forceinline__ void cvt_f32_bf16(const float* src, bf16_t* dst, size_t n, size_t gtid, size_t gsz) {
    for (size_t i = gtid * 8; i < n; i += gsz * 8) { const f32x4 a = *(const f32x4*)(src + i), b = *(const f32x4*)(src + i + 4);
        u32x4 o; o.x = pk2(a.x, a.y); o.y = pk2(a.z, a.w); o.z = pk2(b.x, b.y); o.w = pk2(b.z, b.w); *(u32x4*)(dst + i) = o; }
}
__device__ __forceinline__ void phase_prologue(const Params& p, LAS unsigned char* lds) {
    const int tid = threadIdx.x, lane = tid & 63, wave = tid >> 6;
    LAS float* scr = (LAS float*)(lds + wave * 16384);
    const int gw = blockIdx.x * NWAVES + wave, NGW = gridDim.x * NWAVES;
    unsigned char* ws = p.ws;
    int base = 0;
#define TJOB(W_, ldw_, nvalid_, K_, npad_, WT_, rowoff_, ks_) do { const int nblk = (npad_) / 32, nit = ((K_) / 64) * nblk; \
        for (int it = gw - base; it < nit; it += NGW) { if (it >= 0) p0_transpose_item((W_), (ldw_), (nvalid_), (K_), (WT_), (rowoff_), (ks_), scr, nblk, it, lane); } \
        base = (base + nit) % NGW; } while (0)
    TJOB(p.in[I_NSA_WIN], NSA_IN, NSA_IN, 1024, NSA_IN_PAD, (bf16_t*)(ws + WS_W_IN_T), 0, (const float*)nullptr);
    TJOB(p.in[I_NSA_WOUT], 1024, 1024, 1024, 1024, (bf16_t*)(ws + WS_W_NSAOUT_T), 0, (const float*)nullptr);
    TJOB(p.in[I_CK_W1], 128, 128, 1024, 128, (bf16_t*)(ws + WS_W_CK1_T), 0, (const float*)nullptr);
    TJOB(p.in[I_CK_W1] + 1024 * 128, 128, 128, 1024, 128, (bf16_t*)(ws + WS_W_CK1_T), 128, (const float*)nullptr);
    TJOB(p.in[I_CV_W1], 128, 128, 1024, 128, (bf16_t*)(ws + WS_W_CV1_T), 0, (const float*)nullptr);
    TJOB(p.in[I_CV_W1] + 1024 * 128, 128, 128, 1024, 128, (bf16_t*)(ws + WS_W_CV1_T), 128, (const float*)nullptr);
    TJOB(p.in[I_MLA_WDQ], 768, 768, 1024, 768, (bf16_t*)(ws + WS_W_MLADOWN_T), 0, (const float*)nullptr);
    TJOB(p.in[I_MLA_WDKV], 256, 256, 1024, 256, (bf16_t*)(ws + WS_W_MLADOWN_T), 768, (const float*)nullptr);
    TJOB(p.in[I_MLA_WKR], 32, 32, 1024, 256, (bf16_t*)(ws + WS_W_MLADOWN_T), 1024, (const float*)nullptr);
    TJOB(p.in[I_MLA_WUQ], 1536, 1536, 768, 1536, (bf16_t*)(ws + WS_W_UQ_T), 0, p.in[I_MLA_QG]);
    TJOB(p.in[I_MLA_WUK], 1024, 1024, 256, 1024, (bf16_t*)(ws + WS_W_UKV_T), 0, p.in[I_MLA_KVG]);
    TJOB(p.in[I_MLA_WUV], 1024, 1024, 256, 1024, (bf16_t*)(ws + WS_W_UKV_T), 1024, p.in[I_MLA_KVG]);
    TJOB(p.in[I_MLA_WOUT], 1024, 1024, 1024, 1024, (bf16_t*)(ws + WS_W_MLAOUT_T), 0, (const float*)nullptr);
    TJOB(p.in[I_PEER_WQ], 2048, 2048, 1024, 2048, (bf16_t*)(ws + WS_W_PQ_T), 0, (const float*)nullptr);
    TJOB(p.in[I_PEER_WQ] + (size_t)1024 * 2048, 2048, 2048, 1024, 2048, (bf16_t*)(ws + WS_W_PQ_T) + (size_t)2048 * 1024, 0, (const float*)nullptr);
#undef TJOB
#if DBG_STAT
    if (blockIdx.x == 0 && tid == 0) ((float*)(ws + WS_CTL))[16] = 0.f;
#endif
    const size_t gtid = (size_t)blockIdx.x * NTHREADS + tid, gsz = (size_t)gridDim.x * NTHREADS;
    cvt_f32_bf16(p.in[I_X], (bf16_t*)(ws + WS_HB), (size_t)NTOK * DM, gtid, gsz);
    cvt_f32_bf16(p.in[I_PEER_SUBK], (bf16_t*)(ws + WS_SUBK), (size_t)2 * 8 * 2 * 128 * 128, gtid, gsz);
    cvt_f32_bf16(p.in[I_PEER_U], (bf16_t*)(ws + WS_TAB), (size_t)NEXP * DM, gtid, gsz);
    cvt_f32_bf16(p.in[I_PEER_V], (bf16_t*)(ws + WS_TAB + 32 * MiB), (size_t)NEXP * DM, gtid, gsz);
    cvt_f32_bf16(p.in[I_PEER_U] + (size_t)NEXP * DM, (bf16_t*)(ws + WS_TAB + 64 * MiB), (size_t)NEXP * DM, gtid, gsz);
    cvt_f32_bf16(p.in[I_PEER_V] + (size_t)NEXP * DM, (bf16_t*)(ws + WS_TAB + 96 * MiB), (size_t)NEXP * DM, gtid, gsz);
    for (int o = gw; o < 256; o += NGW) {
        const float* pe = (o < 128) ? p.in[I_CK_PE] : p.in[I_CV_PE]; const float* w1 = (o < 128) ? p.in[I_CK_W1] : p.in[I_CV_W1]; const int h = o & 127;
        float s = 0.f; for (int i = lane; i < 2048; i += 64) s += pe[i] * w1[(size_t)i * 128 + h];
        s = wave_sum(s); if (lane == 0) ((float*)(ws + WS_PE))[o] = s;
    }
    for (size_t i = gtid; i < (size_t)SEQ * 16; i += gsz) {
        const int pos = (int)(i >> 4), fi = (int)(i & 15);
        const float inv = 1.0f / powf(10000.0f, (float)(2 * fi) / 32.0f);
        const float ang = (float)pos * inv;
        const double rev = (double)ang * 0.15915494309189535; const double fr = rev - rint(rev);
        ((float*)(ws + WS_ROPE_COS))[i] = __builtin_amdgcn_cosf((float)fr); ((float*)(ws + WS_ROPE_SIN))[i] = __builtin_amdgcn_sinf((float)fr);
    }
}

__device__ __forceinline__ u32x4 pack8(const f32x4& a, const f32x4& b) { u32x4 o; o.x = pk2(a.x, a.y); o.y = pk2(a.z, a.w); o.z = pk2(b.x, b.y); o.w = pk2(b.z, b.w); return o; }
struct EpiNsaProj {
    bf16_t* q; bf16_t* kv6; float* gates;
    __device__ __forceinline__ void operator()(int row, int col, const f32x4& a, const f32x4& b) const {
        if (col < 1024) { *(u32x4*)(q + (size_t)row * 1024 + col) = pack8(a, b); }
        else if (col < 2560) {
            const int which = (col - 1024) >> 8, cc = (col - 1024) & 255;
            bf16_t* base = kv6 + (size_t)which * NTOK * 256;
            if (which < 2) { const int g = cc >> 6, d = cc & 63, bb = row >> 12, t = row & 4095, n = t >> 4, l = t & 15;
                *(u32x4*)(base + ((((size_t)(bb * 256 + n) * 4 + g) * 16 + l) * 64 + d)) = pack8(a, b); }
            else *(u32x4*)(base + (size_t)row * 256 + cc) = pack8(a, b);
        } else if (col < NSA_IN) {
            float* gp = gates + (size_t)row * 48 + (col - 2560);
            f32x4 s0, s1;
#pragma unroll
            for (int i = 0; i < 4; ++i) { s0[i] = 1.f / (1.f + __expf(-a[i])); s1[i] = 1.f / (1.f + __expf(-b[i])); }
            *(f32x4*)gp = s0; *(f32x4*)(gp + 4) = s1;
        }
    }
};
struct EpiF32 { float* O; int ldc; __device__ __forceinline__ void operator()(int row, int col, const f32x4& a, const f32x4& b) const { float* o = O + (size_t)row * ldc + col; *(f32x4*)o = a; *(f32x4*)(o + 4) = b; } };
struct EpiBf16 { bf16_t* O; int ldc; __device__ __forceinline__ void operator()(int row, int col, const f32x4& a, const f32x4& b) const { *(u32x4*)(O + (size_t)row * ldc + col) = pack8(a, b); } };
struct EpiResid {
    const bf16_t* H; bf16_t* Z; float ms;
    __device__ __forceinline__ void operator()(int row, int col, const f32x4& a_, const f32x4& b_) const {
        const f32x4 a = a_ * ms, b = b_ * ms;
        const u32x4 h = *(const u32x4*)(H + (size_t)row * 1024 + col);
        f32x4 x, y;
        x.x = DN_ALPHA * bf_lo(h.x) + a.x; x.y = DN_ALPHA * bf_hi(h.x) + a.y; x.z = DN_ALPHA * bf_lo(h.y) + a.z; x.w = DN_ALPHA * bf_hi(h.y) + a.w;
        y.x = DN_ALPHA * bf_lo(h.z) + b.x; y.y = DN_ALPHA * bf_hi(h.z) + b.y; y.z = DN_ALPHA * bf_lo(h.w) + b.z; y.w = DN_ALPHA * bf_hi(h.w) + b.w;
        *(u32x4*)(Z + (size_t)row * 1024 + col) = pack8(x, y);
    }
};
struct EpiKV {
    bf16_t* KN; bf16_t* V;
    __device__ __forceinline__ void operator()(int row, int col, const f32x4& a, const f32x4& b) const {
        bf16_t* dst = (col < 1024) ? KN + (size_t)row * 1024 + col : V + (size_t)row * 1024 + (col - 1024);
        *(u32x4*)dst = pack8(a, b);
    }
};

__device__ __forceinline__ void phase_ln(const bf16_t* Z, bf16_t* H, const float* g, const float* b) {
    const int lane = threadIdx.x & 63, wave = threadIdx.x >> 6;
    const int gw = blockIdx.x * NWAVES + wave, NGW = gridDim.x * NWAVES;
    for (int row = gw; row < NTOK; row += NGW) {
        const u32x4 a = *(const u32x4*)(Z + (size_t)row * 1024 + lane * 8), c = *(const u32x4*)(Z + (size_t)row * 1024 + 512 + lane * 8);
        float v[16] = {bf_lo(a.x), bf_hi(a.x), bf_lo(a.y), bf_hi(a.y), bf_lo(a.z), bf_hi(a.z), bf_lo(a.w), bf_hi(a.w), bf_lo(c.x), bf_hi(c.x), bf_lo(c.y), bf_hi(c.y), bf_lo(c.z), bf_hi(c.z), bf_lo(c.w), bf_hi(c.w)};
        float s = 0.f;
#pragma unroll
        for (int i = 0; i < 16; ++i) s += v[i];
        const float mean = wave_sum(s) * (1.f / 1024.f); float q = 0.f;
#pragma unroll
        for (int i = 0; i < 16; ++i) { v[i] -= mean; q += v[i] * v[i]; }
        const float rstd = rsqrtf(wave_sum(q) * (1.f / 1024.f) + LN_EPS);
        float o[16];
#pragma unroll
        for (int hh = 0; hh < 2; ++hh) { const int c0 = hh * 512 + lane * 8; const f32x4 g0 = *(const f32x4*)(g + c0), g1 = *(const f32x4*)(g + c0 + 4), b0 = *(const f32x4*)(b + c0), b1 = *(const f32x4*)(b + c0 + 4);
#pragma unroll
            for (int i = 0; i < 4; ++i) { o[hh * 8 + i] = v[hh * 8 + i] * rstd * g0[i] + b0[i]; o[hh * 8 + 4 + i] = v[hh * 8 + 4 + i] * rstd * g1[i] + b1[i]; } }
        u32x4 w0, w1; w0.x = pk2(o[0], o[1]); w0.y = pk2(o[2], o[3]); w0.z = pk2(o[4], o[5]); w0.w = pk2(o[6], o[7]); w1.x = pk2(o[8], o[9]); w1.y = pk2(o[10], o[11]); w1.z = pk2(o[12], o[13]); w1.w = pk2(o[14], o[15]);
        *(u32x4*)(H + (size_t)row * 1024 + lane * 8) = w0; *(u32x4*)(H + (size_t)row * 1024 + 512 + lane * 8) = w1;
    }
}
__device__ __forceinline__ void phase_cmp_finish(const Params& p, LAS unsigned char* lds) {
    const int lane = threadIdx.x & 63, wave = threadIdx.x >> 6;
    const int gw = blockIdx.x * NWAVES + wave, NGW = gridDim.x * NWAVES;
    LAS float* hs = (LAS float*)(lds + wave * 512);
    for (int item = gw; item < 2 * 8192; item += NGW) {
        const int kv = item >> 13, r = item & 8191, n = (r >> 2) & 255;
        const float* P = (const float*)(p.ws + (kv ? S_PV : S_PK)); const float* pe = (const float*)(p.ws + WS_PE) + kv * 128;
        const float* w2 = p.in[kv ? I_CV_W2 : I_CK_W2];
        bf16_t* out = (bf16_t*)(p.ws + (kv ? S_VCMP : S_KCMP)) + (size_t)r * 64;
        if (n == 255) { out[lane] = 0; continue; }
        const float a0 = P[(size_t)r * 256 + lane] + P[(size_t)(r + 4) * 256 + 128 + lane] + pe[lane];
        const float a1 = P[(size_t)r * 256 + 64 + lane] + P[(size_t)(r + 4) * 256 + 192 + lane] + pe[64 + lane];
        LDS_FENCE();
        hs[lane] = gelu_tanh(a0); hs[64 + lane] = gelu_tanh(a1);
        LDS_FENCE();
        float s = 0.f;
#pragma unroll 8
        for (int h = 0; h < 128; ++h) s += hs[h] * w2[h * 64 + lane];
        out[lane] = f2bf(s);
    }
}
__device__ __forceinline__ void phase_mla_rowstats(const Params& p) {
    const int lane = threadIdx.x & 63, wave = threadIdx.x >> 6;
    const int gw = blockIdx.x * NWAVES + wave, NGW = gridDim.x * NWAVES;
    bf16_t* DQ = (bf16_t*)(p.ws + S_DQ);
    const float* rc = (const float*)(p.ws + WS_ROPE_COS); const float* rs = (const float*)(p.ws + WS_ROPE_SIN);
    for (int row = gw; row < NTOK; row += NGW) {
        bf16_t* r = DQ + (size_t)row * MLA_DOWN_PAD;
        u32x2 v[4]; float sq = 0.f, skv = 0.f;
#pragma unroll
        for (int j = 0; j < 4; ++j) { v[j] = *(const u32x2*)(r + j * 256 + lane * 4); const float a = bf_lo(v[j].x), b = bf_hi(v[j].x), c = bf_lo(v[j].y), d = bf_hi(v[j].y); const float ss = (a * a + b * b) + (c * c + d * d); if (j < 3) sq += ss; else skv += ss; }
        sq = wave_sum(sq); skv = wave_sum(skv);
        const float rq = rsqrtf(sq * (1.f / 768.f) + RMS_EPS), rkv = rsqrtf(skv * (1.f / 256.f) + RMS_EPS);
#pragma unroll
        for (int j = 0; j < 4; ++j) { const float f = (j < 3) ? rq : rkv; u32x2 o; o.x = pk2(bf_lo(v[j].x) * f, bf_hi(v[j].x) * f); o.y = pk2(bf_lo(v[j].y) * f, bf_hi(v[j].y) * f); *(u32x2*)(r + j * 256 + lane * 4) = o; }
        if (lane < 16) { const int pos = row & 4095; const float x1 = bf2f(r[1024 + lane]), x2 = bf2f(r[1040 + lane]), c = rc[pos * 16 + lane], s = rs[pos * 16 + lane];
            bf16_t* kr = (bf16_t*)(p.ws + S_KROPE) + (size_t)row * 32; kr[lane] = f2bf(x1 * c - x2 * s); kr[16 + lane] = f2bf(x2 * c + x1 * s); }
    }
}

struct OnlineSt { float m[4], l[4], o[4][2]; };
__device__ __forceinline__ void nsa_attend_block(OnlineSt& st, const bf16_t* Kb, const bf16_t* Vb, int pos0, int t, const float (&slope)[4], LAS float* qs, LAS float* ps, int lane) {
    const int pos = pos0 + lane; const bool valid = pos <= t;
    const bf16_t* krow = Kb + (size_t)(valid ? pos : t) * 256;
    float acc[4] = {0.f, 0.f, 0.f, 0.f};
#pragma unroll 2
    for (int d8 = 0; d8 < 8; ++d8) { const u32x4 kv = *(const u32x4*)(krow + d8 * 8);
        const float kf[8] = {bf_lo(kv.x), bf_hi(kv.x), bf_lo(kv.y), bf_hi(kv.y), bf_lo(kv.z), bf_hi(kv.z), bf_lo(kv.w), bf_hi(kv.w)};
#pragma unroll
        for (int e = 0; e < 8; ++e) { const f32x4 qv = *(const LAS f32x4*)(qs + (d8 * 8 + e) * 4);
#pragma unroll
            for (int r = 0; r < 4; ++r) acc[r] += qv[r] * kf[e]; } }
    const float dist = (float)(t - pos);
    f32x4 pe;
#pragma unroll
    for (int r = 0; r < 4; ++r) {
        const float s = valid ? acc[r] - slope[r] * dist : -1e30f;
        const float mb = wave_max(s), mn = fmaxf(st.m[r], mb);
        const float alpha = __expf(st.m[r] - mn);
        const float e = valid ? __expf(s - mn) : 0.f;
        st.l[r] = st.l[r] * alpha + wave_sum(e); st.o[r][0] *= alpha; st.o[r][1] *= alpha; st.m[r] = mn; pe[r] = e;
    }
    LDS_FENCE();
    *(LAS f32x4*)(ps + lane * 4) = pe;
    LDS_FENCE();
    const int hf = lane >> 5, dp = lane & 31;
    const int nk = (t - pos0 + 1 < 64) ? t - pos0 + 1 : 64;
#pragma unroll 4
    for (int kk = hf; kk < nk; kk += 2) {
        const unsigned vv = *(const unsigned*)(Vb + (size_t)(pos0 + kk) * 256 + 2 * dp); const f32x4 pp = *(const LAS f32x4*)(ps + kk * 4);
        const float lo = bf_lo(vv), hi = bf_hi(vv);
#pragma unroll
        for (int r = 0; r < 4; ++r) { st.o[r][0] += pp[r] * lo; st.o[r][1] += pp[r] * hi; }
    }
}
__device__ __forceinline__ void phase_nsa_attn_ref(const Params& p, LAS unsigned char* lds) {
    const int lane = threadIdx.x & 63, wave = threadIdx.x >> 6;
    const int gw = blockIdx.x * NWAVES + wave, NGW = gridDim.x * NWAVES;
    LAS float* qs = (LAS float*)(lds + wave * 6144);
    LAS float* pc = qs + 256;
    LAS float* ptot = pc + 1024;
    const bf16_t* Q = (const bf16_t*)(p.ws + S_Q); const bf16_t* KV6 = (const bf16_t*)(p.ws + S_KV6);
    const bf16_t* KS = KV6 + (size_t)2 * NTOK * 256; const bf16_t* VS = KV6 + (size_t)3 * NTOK * 256; const bf16_t* KW = KV6 + (size_t)4 * NTOK * 256; const bf16_t* VW = KV6 + (size_t)5 * NTOK * 256;
    const bf16_t* KC = (const bf16_t*)(p.ws + S_KCMP); const bf16_t* VC = (const bf16_t*)(p.ws + S_VCMP);
    const float* GATES = (const float*)(p.ws + S_GATES); bf16_t* AO = (bf16_t*)(p.ws + S_AO);
    const int hf = lane >> 5, dp = lane & 31;
    for (int item = gw; item < NTOK * 4; item += NGW) {
        const int g = item & 3, row = item >> 2, b = row >> 12, t = row & 4095;
        float slope[4];
#pragma unroll
        for (int r = 0; r < 4; ++r) slope[r] = exp2f(-0.5f * (float)(g * 4 + r + 1));
        LDS_FENCE();
        { f32x4 qv;
#pragma unroll
          for (int r = 0; r < 4; ++r) qv[r] = bf2f(Q[(size_t)row * 1024 + (g * 4 + r) * 64 + lane]) * 0.125f;
          *(LAS f32x4*)(qs + lane * 4) = qv; }
        LDS_FENCE();
        const int nv = (t >= 31) ? (((t - 31) >> 4) + 1 < 255 ? ((t - 31) >> 4) + 1 : 255) : 0;
        float mloc[4] = {-1e30f, -1e30f, -1e30f, -1e30f};
#pragma unroll 1
        for (int c = 0; c < 4; ++c) {
            const int i = 64 * c + lane;
            f32x4 sv = (f32x4){-1e30f, -1e30f, -1e30f, -1e30f};
            if (64 * c < nv) {
                const bf16_t* krow = KC + ((size_t)(b * 256 + i) * 4 + g) * 64;
                float acc[4] = {0.f, 0.f, 0.f, 0.f};
#pragma unroll 2
                for (int d8 = 0; d8 < 8; ++d8) { const u32x4 kv = *(const u32x4*)(krow + d8 * 8);
                    const float kf[8] = {bf_lo(kv.x), bf_hi(kv.x), bf_lo(kv.y), bf_hi(kv.y), bf_lo(kv.z), bf_hi(kv.z), bf_lo(kv.w), bf_hi(kv.w)};
#pragma unroll
                    for (int e = 0; e < 8; ++e) { const f32x4 qv = *(const LAS f32x4*)(qs + (d8 * 8 + e) * 4);
#pragma unroll
                        for (int r = 0; r < 4; ++r) acc[r] += qv[r] * kf[e]; } }
                const float dist = (float)(t - (16 * i + 31));
                if (i < nv) {
#pragma unroll
                    for (int r = 0; r < 4; ++r) { sv[r] = acc[r] - slope[r] * dist; mloc[r] = fmaxf(mloc[r], sv[r]); } }
            }
            *(LAS f32x4*)(pc + i * 4) = sv;
        }
        float ssum[4] = {0.f, 0.f, 0.f, 0.f};
#pragma unroll
        for (int r = 0; r < 4; ++r) mloc[r] = wave_max(mloc[r]);
        LDS_FENCE();
#pragma unroll 1
        for (int c = 0; c < 4; ++c) {
            const int i = 64 * c + lane; f32x4 sv = *(const LAS f32x4*)(pc + i * 4);
#pragma unroll
            for (int r = 0; r < 4; ++r) { sv[r] = (sv[r] > -1e29f) ? __expf(sv[r] - mloc[r]) : 0.f; ssum[r] += sv[r]; }
            *(LAS f32x4*)(pc + i * 4) = sv;
        }
#pragma unroll
        for (int r = 0; r < 4; ++r) { const float sm = wave_sum(ssum[r]); ssum[r] = (sm > 0.f) ? 1.f / sm : 0.f; }
        LDS_FENCE();
#pragma unroll 1
        for (int c = 0; c < 4; ++c) {
            const int i = 64 * c + lane; f32x4 sv = *(const LAS f32x4*)(pc + i * 4);
#pragma unroll
            for (int r = 0; r < 4; ++r) sv[r] *= ssum[r];
            *(LAS f32x4*)(pc + i * 4) = sv; ptot[i] = (sv[0] + sv[1]) + (sv[2] + sv[3]);
        }
        LDS_FENCE();
        const int j = lane, blk = t >> 6;
        const float imp = ptot[4 * j] + ptot[4 * j + 1] + ptot[4 * j + 2] + 0.5f * ptot[4 * j + 3] + (j > 0 ? 0.5f * ptot[4 * j - 1] : 0.f);
        const bool elig = j <= blk, forced = (j == 0) || (j == blk) || (j == blk - 1);
        const float val = elig ? imp + (forced ? 1e4f : 0.f) : -1e30f;
        int rank = 0;
#pragma unroll 8
        for (int k = 0; k < 64; ++k) { const float vk = __shfl(val, k); rank += (vk > val || (vk == val && k < j)) ? 1 : 0; }
        const unsigned long long selmask = __ballot(elig && rank < 16);
        float oc[4][2] = {{0.f, 0.f}, {0.f, 0.f}, {0.f, 0.f}, {0.f, 0.f}};
        for (int i = hf; i < nv; i += 2) {
            const unsigned vv = *(const unsigned*)(VC + ((size_t)(b * 256 + i) * 4 + g) * 64 + 2 * dp); const f32x4 pp = *(const LAS f32x4*)(pc + i * 4);
            const float lo = bf_lo(vv), hi = bf_hi(vv);
#pragma unroll
            for (int r = 0; r < 4; ++r) { oc[r][0] += pp[r] * lo; oc[r][1] += pp[r] * hi; }
        }
#pragma unroll
        for (int r = 0; r < 4; ++r) { oc[r][0] += __shfl_xor(oc[r][0], 32); oc[r][1] += __shfl_xor(oc[r][1], 32); }
        OnlineSt st;
#pragma unroll
        for (int r = 0; r < 4; ++r) { st.m[r] = -1e30f; st.l[r] = 0.f; st.o[r][0] = 0.f; st.o[r][1] = 0.f; }
        const bf16_t* ksb = KS + (size_t)b * SEQ * 256 + g * 64; const bf16_t* vsb = VS + (size_t)b * SEQ * 256 + g * 64;
        for (unsigned long long mm = selmask; mm; mm &= mm - 1) { const int jj = __builtin_ctzll(mm); nsa_attend_block(st, ksb, vsb, 64 * jj, t, slope, qs, pc, lane); }
        float os[4][2];
#pragma unroll
        for (int r = 0; r < 4; ++r) { const float il = 1.f / st.l[r]; os[r][0] = (st.o[r][0] + __shfl_xor(st.o[r][0], 32)) * il; os[r][1] = (st.o[r][1] + __shfl_xor(st.o[r][1], 32)) * il; }
#pragma unroll
        for (int r = 0; r < 4; ++r) { st.m[r] = -1e30f; st.l[r] = 0.f; st.o[r][0] = 0.f; st.o[r][1] = 0.f; }
        const bf16_t* kwb = KW + (size_t)b * SEQ * 256 + g * 64; const bf16_t* vwb = VW + (size_t)b * SEQ * 256 + g * 64;
        const int lo = (t - 511 > 0) ? t - 511 : 0;
        for (int p0 = lo; p0 <= t; p0 += 64) nsa_attend_block(st, kwb, vwb, p0, t, slope, qs, pc, lane);
        const float* gp = GATES + (size_t)row * 48 + g * 12;
#pragma unroll
        for (int r = 0; r < 4; ++r) {
            const float il = 1.f / st.l[r]; const float ow0 = (st.o[r][0] + __shfl_xor(st.o[r][0], 32)) * il, ow1 = (st.o[r][1] + __shfl_xor(st.o[r][1], 32)) * il;
            const float gc = gp[r * 3 + 0], gs = gp[r * 3 + 1], gwv = gp[r * 3 + 2];
            const float o0 = gc * oc[r][0] + gs * os[r][0] + gwv * ow0, o1 = gc * oc[r][1] + gs * os[r][1] + gwv * ow1;
            if (hf == 0) *(unsigned*)(AO + (size_t)row * 1024 + (g * 4 + r) * 64 + 2 * dp) = pk2(o0, o1);
        }
    }
}

__device__ __forceinline__ void phase_mla_attn_ref(const Params& p, LAS unsigned char* lds) {
    const int lane = threadIdx.x & 63, wave = threadIdx.x >> 6;
    const int gw = blockIdx.x * NWAVES + wave, NGW = gridDim.x * NWAVES;
    LAS float* qs = (LAS float*)(lds + wave * 1024);
    LAS float* ps = qs + 128;
    const bf16_t* QF = (const bf16_t*)(p.ws + S_QF); const bf16_t* KN = (const bf16_t*)(p.ws + S_KNOPE); const bf16_t* KR = (const bf16_t*)(p.ws + S_KROPE); const bf16_t* V = (const bf16_t*)(p.ws + S_V);
    const float* rc = (const float*)(p.ws + WS_ROPE_COS); const float* rs = (const float*)(p.ws + WS_ROPE_SIN);
    bf16_t* AO = (bf16_t*)(p.ws + S_AO2);
    const float scale = 0.10206207261596577f;
    const int hf = lane >> 5, dp = lane & 31;
    for (int item = gw; item < NTOK * 16; item += NGW) {
        const int h = item & 15, row = item >> 4, b = row >> 12, t = row & 4095;
        const bf16_t* qrow = QF + (size_t)row * 1536 + h * 96; const float rq = scale;
        LDS_FENCE();
        qs[lane] = bf2f(qrow[lane]) * rq;
        if (lane < 16) { const float x1 = bf2f(qrow[64 + lane]), x2 = bf2f(qrow[80 + lane]), c = rc[t * 16 + lane], s = rs[t * 16 + lane]; qs[64 + lane] = (x1 * c - x2 * s) * rq; qs[80 + lane] = (x2 * c + x1 * s) * rq; }
        LDS_FENCE();
        float m = -1e30f, l = 0.f, o0 = 0.f, o1 = 0.f;
        for (int p0 = 0; p0 <= t; p0 += 64) {
            const int pos = p0 + lane; const bool valid = pos <= t;
            const int posc = valid ? pos : t;
            const bf16_t* kn = KN + ((size_t)(b * SEQ + posc)) * 1024 + h * 64; const bf16_t* kr = KR + ((size_t)(b * SEQ + posc)) * 32;
            float acc = 0.f;
#pragma unroll 4
            for (int d8 = 0; d8 < 12; ++d8) { const u32x4 kv = (d8 < 8) ? *(const u32x4*)(kn + d8 * 8) : *(const u32x4*)(kr + (d8 - 8) * 8);
                const f32x4 q0 = *(const LAS f32x4*)(qs + d8 * 8), q1 = *(const LAS f32x4*)(qs + d8 * 8 + 4);
                acc += q0.x * bf_lo(kv.x) + q0.y * bf_hi(kv.x) + q0.z * bf_lo(kv.y) + q0.w * bf_hi(kv.y) + q1.x * bf_lo(kv.z) + q1.y * bf_hi(kv.z) + q1.z * bf_lo(kv.w) + q1.w * bf_hi(kv.w); }
            const float s = valid ? acc : -1e30f;
            const float mn = fmaxf(m, wave_max(s)), alpha = __expf(m - mn), e = valid ? __expf(s - mn) : 0.f;
            l = l * alpha + wave_sum(e); o0 *= alpha; o1 *= alpha; m = mn;
            LDS_FENCE();
            ps[lane] = e;
            LDS_FENCE();
            const int nk = (t - p0 + 1 < 64) ? t - p0 + 1 : 64;
            for (int kk = hf; kk < nk; kk += 2) { const unsigned vv = *(const unsigned*)(V + ((size_t)(b * SEQ + p0 + kk)) * 1024 + h * 64 + 2 * dp); const float pp = ps[kk]; o0 += pp * bf_lo(vv); o1 += pp * bf_hi(vv); }
        }
        const float il = 1.f / l; o0 = (o0 + __shfl_xor(o0, 32)) * il; o1 = (o1 + __shfl_xor(o1, 32)) * il;
        if (hf == 0) *(unsigned*)(AO + (size_t)row * 1024 + h * 64 + 2 * dp) = pk2(o0, o1);
    }
}

__device__ __forceinline__ float pack_idx(float v, unsigned bits, unsigned mask) { return __uint_as_float((__float_as_uint(v) & ~mask) | bits); }
__device__ __forceinline__ void phase_peer_route_ref(const Params& p, LAS unsigned char* lds, int layer, const bf16_t* QP, int* EIDX, float* GW) {
    const int lane = threadIdx.x & 63, wave = threadIdx.x >> 6;
    const int gw = blockIdx.x * NWAVES + wave, NGW = gridDim.x * NWAVES;
    LAS float* qs = (LAS float*)(lds + wave * 1024);
    const bf16_t* SK = (const bf16_t*)(p.ws + WS_SUBK) + (size_t)layer * 8 * 2 * 128 * 128;
    for (int item = gw; item < NTOK * 8; item += NGW) {
        const int h = item & 7, t = item >> 3;
        LDS_FENCE();
        { const u32x2 qv = *(const u32x2*)(QP + (size_t)t * 2048 + h * 256 + lane * 4); *(LAS f32x4*)(qs + lane * 4) = (f32x4){bf_lo(qv.x), bf_hi(qv.x), bf_lo(qv.y), bf_hi(qv.y)}; }
        LDS_FENCE();
        float sv[2];
#pragma unroll
        for (int c = 0; c < 2; ++c) {
            float v[2];
#pragma unroll
            for (int kk = 0; kk < 2; ++kk) {
                const int key = lane + 64 * kk; const bf16_t* krow = SK + ((size_t)(h * 2 + c) * 128 + key) * 128;
                float acc = 0.f;
#pragma unroll 4
                for (int d8 = 0; d8 < 16; ++d8) { const u32x4 kv = *(const u32x4*)(krow + d8 * 8); const f32x4 q0 = *(const LAS f32x4*)(qs + c * 128 + d8 * 8), q1 = *(const LAS f32x4*)(qs + c * 128 + d8 * 8 + 4);
                    acc += q0.x * bf_lo(kv.x) + q0.y * bf_hi(kv.x) + q0.z * bf_lo(kv.y) + q0.w * bf_hi(kv.y) + q1.x * bf_lo(kv.z) + q1.y * bf_hi(kv.z) + q1.z * bf_lo(kv.w) + q1.w * bf_hi(kv.w); }
                v[kk] = pack_idx(acc, 127u - (unsigned)key, 127u);
            }
            float mine = 0.f;
#pragma unroll 1
            for (int n = 0; n < 16; ++n) { const float w = wave_max(fmaxf(v[0], v[1])); if (v[0] == w) v[0] = -INFINITY; if (v[1] == w) v[1] = -INFINITY; if (lane == n) mine = w; }
            sv[c] = mine;
        }
        const int a = lane & 15, bq = lane >> 4;
        const float s0 = __shfl(sv[0], a);
        float cv[4];
#pragma unroll
        for (int i = 0; i < 4; ++i) { const float s1 = __shfl(sv[1], 4 * bq + i); cv[i] = pack_idx(s0 + s1, 255u - (unsigned)(a * 16 + 4 * bq + i), 255u); }
        float cs = 0.f;
#pragma unroll 1
        for (int n = 0; n < 16; ++n) { const float w = wave_max(fmaxf(fmaxf(cv[0], cv[1]), fmaxf(cv[2], cv[3])));
#pragma unroll
            for (int i = 0; i < 4; ++i) if (cv[i] == w) cv[i] = -INFINITY;
            if (lane == n) cs = w; }
        const unsigned flat = 255u - (__float_as_uint(cs) & 255u);
        const int wa = (int)(flat >> 4) & 15, wb = (int)flat & 15;
        const unsigned i0 = 127u - (__float_as_uint(__shfl(sv[0], wa)) & 127u), i1 = 127u - (__float_as_uint(__shfl(sv[1], wb)) & 127u);
        const float mx = __shfl(cs, 0);
        const float ex = (lane < 16) ? __expf(cs - mx) : 0.f;
        const float sum = wave_sum(ex);
        if (lane < 16) { EIDX[(size_t)t * 128 + h * 16 + lane] = (int)(i0 * 128u + i1); GW[(size_t)t * 128 + h * 16 + lane] = ex / sum; }
    }
}

__device__ __forceinline__ float dot2bf(unsigned a, unsigned b, float acc) {
    float r; asm("v_dot2c_f32_bf16 %0, %1, %2" : "=v"(r) : "v"(a), "v"(b), "0"(acc)); return r;
}
__device__ __forceinline__ float dot8(const u32x4& a, const u32x4& b, float acc) {
    acc = dot2bf(a.x, b.x, acc); acc = dot2bf(a.y, b.y, acc); acc = dot2bf(a.z, b.z, acc); acc = dot2bf(a.w, b.w, acc);
    return acc;
}
__device__ __forceinline__ void axpy8(float* o, const u32x4& v, float w) {
    o[0] += w * bf_lo(v.x); o[1] += w * bf_hi(v.x); o[2] += w * bf_lo(v.y); o[3] += w * bf_hi(v.y); o[4] += w * bf_lo(v.z); o[5] += w * bf_hi(v.z); o[6] += w * bf_lo(v.w); o[7] += w * bf_hi(v.w);
}
__device__ __forceinline__ void phase_peer_gather(const Params& p, int layer, const int* EIDX, const float* GW, bf16_t* HB, float* OUT, float fs) {
    const int lane = threadIdx.x & 63, wave = threadIdx.x >> 6;
    const int gw = blockIdx.x * NWAVES + wave, NGW = gridDim.x * NWAVES;
    const bf16_t* U = (const bf16_t*)(p.ws + WS_TAB + (size_t)layer * 64 * MiB); const bf16_t* Vt = U + (size_t)NEXP * DM;
    const float* lg = p.in[I_PEER_LNG] + layer * 1024; const float* lb = p.in[I_PEER_LNB] + layer * 1024;
    for (int t = gw; t < NTOK; t += NGW) {
        const u32x4 x0 = *(const u32x4*)(HB + (size_t)t * 1024 + lane * 8), x1 = *(const u32x4*)(HB + (size_t)t * 1024 + 512 + lane * 8);
        const int e0 = EIDX[(size_t)t * 128 + lane], e1 = EIDX[(size_t)t * 128 + 64 + lane];
        const float g0 = GW[(size_t)t * 128 + lane], g1 = GW[(size_t)t * 128 + 64 + lane];
        float o[16];
#pragma unroll
        for (int i = 0; i < 16; ++i) o[i] = 0.f;
#if DBG_STAT
        float dstat = 0.f;
        if (DBG_STAT == 2) { int dups = 0;
            for (int sft = 1; sft < 16; ++sft) { const int src = (lane & ~15) | ((lane + sft) & 15); dups += (e0 == __shfl(e0, src)) + (e1 == __shfl(e1, src)); }
            dstat = wave_sum((float)dups) * (1.f / 8.f); }
        if (DBG_STAT == 3) dstat = wave_sum(g0 * g0 + g1 * g1) * (1.f / 8.f);
        if (DBG_STAT == 4) dstat = wave_sum(g0 + g1) * (1.f / 8.f);
        if (DBG_STAT == 5) { const int b0 = (e0 < 0 || e0 >= 16384) + (e1 < 0 || e1 >= 16384); dstat = wave_sum((float)b0); }
#endif
#pragma unroll 1
        for (int kb = 0; kb < 128; kb += 4) {
            int e[4]; float gg[4];
#pragma unroll
            for (int i = 0; i < 4; ++i) { const int k = kb + i; e[i] = (kb < 64) ? __shfl(e0, k) : __shfl(e1, k - 64); gg[i] = (kb < 64) ? __shfl(g0, k) : __shfl(g1, k - 64); }
            u32x4 ua[4], ub[4], va[4], vb[4];
#pragma unroll
            for (int i = 0; i < 4; ++i) { const bf16_t* ur = U + (size_t)e[i] * 1024 + lane * 8; const bf16_t* vr = Vt + (size_t)e[i] * 1024 + lane * 8;
                ua[i] = *(const u32x4*)ur; ub[i] = *(const u32x4*)(ur + 512); va[i] = *(const u32x4*)vr; vb[i] = *(const u32x4*)(vr + 512); }
#pragma unroll
            for (int i = 0; i < 4; ++i) {
                float d = dot8(ua[i], x0, 0.f); d = dot8(ub[i], x1, d); d = wave_sum(d);
                const float w = gg[i] * gelu_tanh(d);
#if DBG_STAT
                if (DBG_STAT == 1) dstat += gelu_tanh(d) * gelu_tanh(d) * (1.f / 128.f);
                if (DBG_STAT == 6) dstat += d * d * (1.f / 128.f);
#endif
                axpy8(o, va[i], w); axpy8(o + 8, vb[i], w);
            }
        }
#if DBG_STAT
        if (layer == 0 && lane == 0) atomicAdd((float*)(p.ws + WS_CTL) + 16, dstat * (1.f / NTOK));
#endif
        float z[16] = {bf_lo(x0.x), bf_hi(x0.x), bf_lo(x0.y), bf_hi(x0.y), bf_lo(x0.z), bf_hi(x0.z), bf_lo(x0.w), bf_hi(x0.w), bf_lo(x1.x), bf_hi(x1.x), bf_lo(x1.y), bf_hi(x1.y), bf_lo(x1.z), bf_hi(x1.z), bf_lo(x1.w), bf_hi(x1.w)};
        float s = 0.f;
#pragma unroll
        for (int i = 0; i < 16; ++i) { z[i] = DN_ALPHA * z[i] + fs * o[i]; s += z[i]; }
        const float mean = wave_sum(s) * (1.f / 1024.f); float q = 0.f;
#pragma unroll
        for (int i = 0; i < 16; ++i) { z[i] -= mean; q += z[i] * z[i]; }
        const float rstd = rsqrtf(wave_sum(q) * (1.f / 1024.f) + LN_EPS);
#pragma unroll
        for (int hh = 0; hh < 2; ++hh) { const int c0 = hh * 512 + lane * 8; const f32x4 ga = *(const f32x4*)(lg + c0), gb = *(const f32x4*)(lg + c0 + 4), ba = *(const f32x4*)(lb + c0), bb = *(const f32x4*)(lb + c0 + 4);
#pragma unroll
            for (int i = 0; i < 4; ++i) { z[hh * 8 + i] = z[hh * 8 + i] * rstd * ga[i] + ba[i]; z[hh * 8 + 4 + i] = z[hh * 8 + 4 + i] * rstd * gb[i] + bb[i]; } }
        if (OUT) {
#pragma unroll
            for (int hh = 0; hh < 2; ++hh) { float* op = OUT + (size_t)t * 1024 + hh * 512 + lane * 8; *(f32x4*)op = (f32x4){z[hh * 8], z[hh * 8 + 1], z[hh * 8 + 2], z[hh * 8 + 3]}; *(f32x4*)(op + 4) = (f32x4){z[hh * 8 + 4], z[hh * 8 + 5], z[hh * 8 + 6], z[hh * 8 + 7]}; }
        } else {
            u32x4 w0, w1; w0.x = pk2(z[0], z[1]); w0.y = pk2(z[2], z[3]); w0.z = pk2(z[4], z[5]); w0.w = pk2(z[6], z[7]); w1.x = pk2(z[8], z[9]); w1.y = pk2(z[10], z[11]); w1.z = pk2(z[12], z[13]); w1.w = pk2(z[14], z[15]);
            *(u32x4*)(HB + (size_t)t * 1024 + lane * 8) = w0; *(u32x4*)(HB + (size_t)t * 1024 + 512 + lane * 8) = w1;
        }
    }
}

constexpr int NPHASES = 19;
__global__ void __launch_bounds__(NTHREADS, 2) fwd_kernel(Params p) {
    extern __shared__ __attribute__((aligned(16))) unsigned char lds_raw[];
    LAS unsigned char* lds = (LAS unsigned char*)lds_raw;
    unsigned char* ws = p.ws;
    bf16_t* HB = (bf16_t*)(ws + WS_HB);
    const int lo = p.ph_lo, hi = p.ph_hi;
#ifndef PH_MASK
#define PH_MASK 0xFFFFFFFFu
#endif
#define IN(k) (((PH_MASK >> (k)) & 1u) && lo <= (k) && (k) < hi)
#define SEAM(k) do { if (IN(k) && IN((k) + 1)) { asm volatile("s_waitcnt vmcnt(0) lgkmcnt(0)" ::: "memory"); __builtin_amdgcn_fence(__ATOMIC_RELEASE, "agent"); asm volatile("s_waitcnt vmcnt(0)" ::: "memory"); \
        cg::this_grid().sync(); __builtin_amdgcn_fence(__ATOMIC_ACQUIRE, "agent"); asm volatile("s_waitcnt vmcnt(0)" ::: "memory"); __syncthreads(); } } while (0)
    if (IN(0)) { phase_prologue(p, lds); } SEAM(0);
    if (IN(1)) { EpiNsaProj E{(bf16_t*)(ws + S_Q), (bf16_t*)(ws + S_KV6), (float*)(ws + S_GATES)};
        run_gemm(lds, HB, 1024, (const bf16_t*)(ws + WS_W_IN_T), 1024, NTOK, NSA_IN_PAD, 1024, (int)blockIdx.x, E); } SEAM(1);
    if (IN(2)) { EpiF32 Ek{(float*)(ws + S_PK), 256}, Ev{(float*)(ws + S_PV), 256};
        run_gemm(lds, (const bf16_t*)(ws + S_KV6), 1024, (const bf16_t*)(ws + WS_W_CK1_T), 1024, 8192, 256, 1024, (int)blockIdx.x, Ek);
        run_gemm(lds, (const bf16_t*)(ws + S_KV6) + (size_t)NTOK * 256, 1024, (const bf16_t*)(ws + WS_W_CV1_T), 1024, 8192, 256, 1024, (int)((blockIdx.x + gridDim.x / 2) % gridDim.x), Ev); } SEAM(2);
    if (IN(3)) { phase_cmp_finish(p, lds); } SEAM(3);
    if (IN(4)) { phase_nsa_attn_ref(p, lds); } SEAM(4);
    if (IN(5)) { EpiResid E{HB, (bf16_t*)(ws + S_Z), (ABL & 1) ? 0.f : 1.f};
        run_gemm(lds, (const bf16_t*)(ws + S_AO), 1024, (const bf16_t*)(ws + WS_W_NSAOUT_T), 1024, NTOK, 1024, 1024, (int)blockIdx.x, E); } SEAM(5);
    if (IN(6)) { phase_ln((const bf16_t*)(ws + S_Z), HB, p.in[I_NSA_LNG], p.in[I_NSA_LNB]); } SEAM(6);
    if (IN(7)) { EpiBf16 E{(bf16_t*)(ws + S_QP0), 2048};
        run_gemm(lds, HB, 1024, (const bf16_t*)(ws + WS_W_PQ_T), 1024, NTOK, 2048, 1024, (int)blockIdx.x, E); } SEAM(7);
    if (IN(8)) { phase_peer_route_ref(p, lds, 0, (const bf16_t*)(ws + S_QP0), (int*)(ws + S_EIDX0), (float*)(ws + S_GW0)); } SEAM(8);
    if (IN(9)) { phase_peer_gather(p, 0, (const int*)(ws + S_EIDX0), (const float*)(ws + S_GW0), HB, nullptr, (ABL & 2) ? 0.f : 1.f); } SEAM(9);
    if (IN(10)) { EpiBf16 E{(bf16_t*)(ws + S_DQ), MLA_DOWN_PAD};
        run_gemm(lds, HB, 1024, (const bf16_t*)(ws + WS_W_MLADOWN_T), 1024, NTOK, MLA_DOWN_PAD, 1024, (int)blockIdx.x, E); } SEAM(10);
    if (IN(11)) { phase_mla_rowstats(p); } SEAM(11);
    if (IN(12)) { EpiBf16 Eq{(bf16_t*)(ws + S_QF), 1536}; EpiKV Ekv{(bf16_t*)(ws + S_KNOPE), (bf16_t*)(ws + S_V)};
        run_gemm(lds, (const bf16_t*)(ws + S_DQ), MLA_DOWN_PAD, (const bf16_t*)(ws + WS_W_UQ_T), 768, NTOK, 1536, 768, (int)blockIdx.x, Eq);
        run_gemm(lds, (const bf16_t*)(ws + S_DQ) + 768, MLA_DOWN_PAD, (const bf16_t*)(ws + WS_W_UKV_T), 256, NTOK, 2048, 256, (int)blockIdx.x, Ekv); } SEAM(12);
    if (IN(13)) { phase_mla_attn_ref(p, lds); } SEAM(13);
    if (IN(14)) { EpiResid E{HB, (bf16_t*)(ws + S_Z2), (ABL & 4) ? 0.f : 1.f};
        run_gemm(lds, (const bf16_t*)(ws + S_AO2), 1024, (const bf16_t*)(ws + WS_W_MLAOUT_T), 1024, NTOK, 1024, 1024, (int)blockIdx.x, E); } SEAM(14);
    if (IN(15)) { phase_ln((const bf16_t*)(ws + S_Z2), HB, p.in[I_MLA_LNG], p.in[I_MLA_LNB]); } SEAM(15);
    if (IN(16)) { EpiBf16 E{(bf16_t*)(ws + S_QP1), 2048};
        run_gemm(lds, HB, 1024, (const bf16_t*)(ws + WS_W_PQ_T) + (size_t)2048 * 1024, 1024, NTOK, 2048, 1024, (int)blockIdx.x, E); } SEAM(16);
    if (IN(17)) { phase_peer_route_ref(p, lds, 1, (const bf16_t*)(ws + S_QP1), (int*)(ws + S_EIDX1), (float*)(ws + S_GW1)); } SEAM(17);
    if (IN(18)) { phase_peer_gather(p, 1, (const int*)(ws + S_EIDX1), (const float*)(ws + S_GW1), HB, p.out, (ABL & 8) ? 0.f : 1.f); }
#if DBG_STAT
    if (IN(18)) { asm volatile("s_waitcnt vmcnt(0) lgkmcnt(0)" ::: "memory"); __builtin_amdgcn_fence(__ATOMIC_RELEASE, "agent"); cg::this_grid().sync(); __builtin_amdgcn_fence(__ATOMIC_ACQUIRE, "agent");
        const float c = 1.f + __hip_atomic_load((float*)(ws + WS_CTL) + 16, __ATOMIC_RELAXED, __HIP_MEMORY_SCOPE_AGENT);
        for (size_t i = (size_t)blockIdx.x * NTHREADS + threadIdx.x; i < (size_t)NTOK * DM; i += (size_t)gridDim.x * NTHREADS) p.out[i] = c; }
#endif
#undef IN
#undef SEAM
}

extern "C" void kernel_launch(void* const* d_in, const int* in_sizes, int n_in, void* d_out, int out_size, void* d_ws, size_t ws_size, hipStream_t stream) {
    static int grid = 0;
    if (grid == 0) {
        if (n_in != 28 || out_size != NTOK * DM || ws_size < WS_NEED) { fprintf(stderr, "kernel_launch: unexpected problem (n_in %d, out %d, ws %zu)\n", n_in, out_size, ws_size); grid = -1; return; }
        int dev = 0, cus = 0, per_cu = 0;
        (void)hipGetDevice(&dev); (void)hipDeviceGetAttribute(&cus, hipDeviceAttributeMultiprocessorCount, dev);
        if (hipFuncSetAttribute((const void*)fwd_kernel, hipFuncAttributeMaxDynamicSharedMemorySize, LDS_BYTES) != hipSuccess) { fprintf(stderr, "kernel_launch: hipFuncSetAttribute failed\n"); grid = -1; return; }
        if (hipOccupancyMaxActiveBlocksPerMultiprocessor(&per_cu, (const void*)fwd_kernel, NTHREADS, LDS_BYTES) != hipSuccess || per_cu < 1) { fprintf(stderr, "kernel_launch: occupancy query says %d blocks per CU\n", per_cu); grid = -1; return; }
        grid = cus;
    }
    if (grid < 0) return;
    Params p{};
    for (int i = 0; i < 28; ++i) p.in[i] = (const float*)d_in[i];
    p.out = (float*)d_out; p.ws = (unsigned char*)d_ws;
#if MK_ONE_LAUNCH
    p.ph_lo = 0; p.ph_hi = NPHASES;
    void* args[] = {&p};
    hipError_t e = hipLaunchCooperativeKernel((const void*)fwd_kernel, dim3(grid), dim3(NTHREADS), args, LDS_BYTES, stream);
    if (e != hipSuccess) fprintf(stderr, "kernel_launch: cooperative launch failed: %s\n", hipGetErrorString(e));
#else
    for (int k = 0; k < NPHASES; ++k) { p.ph_lo = k; p.ph_hi = k + 1; hipLaunchKernelGGL(fwd_kernel, dim3(grid), dim3(NTHREADS), LDS_BYTES, stream, p); }
#endif
}
```

```cpp
#include <hip/hip_runtime.h>
#include <hip/hip_cooperative_groups.h>
#include <cstdio>
#include <cstdint>
namespace cg = cooperative_groups;

#ifndef ABL
#define ABL 0
#endif
#ifndef PROBE_DUP
#define PROBE_DUP 0
#endif
#ifndef USE_MFMA_NSA
#define USE_MFMA_NSA 1
#endif
#ifndef USE_MFMA_MLA
#define USE_MFMA_MLA 1
#endif
#ifndef DBG_STAT
#define DBG_STAT 0
#endif
#ifndef MK_ONE_LAUNCH
#define MK_ONE_LAUNCH 1
#endif

#define LAS __attribute__((address_space(3)))
typedef unsigned short bf16_t;
typedef short bf16x8 __attribute__((ext_vector_type(8)));
typedef float f32x4 __attribute__((ext_vector_type(4)));
typedef float f32x2 __attribute__((ext_vector_type(2)));
typedef unsigned u32x4 __attribute__((ext_vector_type(4)));
typedef unsigned u32x2 __attribute__((ext_vector_type(2)));
typedef __bf16 bf16x2_t __attribute__((ext_vector_type(2)));

constexpr int BATCH = 8, SEQ = 4096, DM = 1024, NTOK = BATCH * SEQ;
constexpr int NSA_IN = 2608, NSA_IN_PAD = 2816;
constexpr int MLA_DOWN = 1056, MLA_DOWN_PAD = 1280;
constexpr int NEXP = 16384;
constexpr float DN_ALPHA = 1.4142135623730951f;
constexpr float LN_EPS = 1e-5f, RMS_EPS = 1e-6f;
constexpr int NWAVES = 8, NTHREADS = 512;
constexpr int LDS_BYTES = 147456;

constexpr size_t KiB = 1024, MiB = 1024 * 1024;
constexpr size_t WS_CTL = 0, CTL_BYTES = 64 * KiB;
constexpr size_t WS_W_IN_T = 1 * MiB;
constexpr size_t WS_W_NSAOUT_T = 6 * MiB + 512 * KiB;
constexpr size_t WS_W_CK1_T = 8 * MiB + 512 * KiB;
constexpr size_t WS_W_CV1_T = 9 * MiB;
constexpr size_t WS_W_MLADOWN_T = 9 * MiB + 512 * KiB;
constexpr size_t WS_W_UQ_T = 12 * MiB;
constexpr size_t WS_W_UKV_T = 14 * MiB + 256 * KiB;
constexpr size_t WS_W_MLAOUT_T = 15 * MiB + 256 * KiB;
constexpr size_t WS_W_PQ_T = 17 * MiB + 256 * KiB;
constexpr size_t WS_SUBK = 25 * MiB + 256 * KiB;
constexpr size_t WS_MISC = 27 * MiB;
constexpr size_t WS_PE = WS_MISC;
constexpr size_t WS_ROPE_COS = WS_MISC + 4 * KiB;
constexpr size_t WS_ROPE_SIN = WS_ROPE_COS + 256 * KiB;
constexpr size_t WS_RSTD_Q = WS_ROPE_SIN + 256 * KiB;
constexpr size_t WS_RSTD_KV = WS_RSTD_Q + 128 * KiB;
constexpr size_t WS_TAB = 32 * MiB;
constexpr size_t WS_HB = 160 * MiB;
constexpr size_t WS_S = 224 * MiB;
constexpr size_t S_Q = WS_S;
constexpr size_t S_KV6 = WS_S + 64 * MiB;
constexpr size_t S_AO = WS_S + 160 * MiB;
constexpr size_t S_GATES = WS_S + 224 * MiB;
constexpr size_t S_PK = WS_S + 230 * MiB;
constexpr size_t S_PV = WS_S + 238 * MiB;
constexpr size_t S_KCMP = WS_S + 246 * MiB;
constexpr size_t S_VCMP = S_KCMP + 512 * KiB;
constexpr size_t S_Z = WS_S;
constexpr size_t S_QP0 = WS_S + 64 * MiB;
constexpr size_t S_EIDX0 = WS_S + 192 * MiB;
constexpr size_t S_GW0 = WS_S + 208 * MiB;
constexpr size_t S_DQ = WS_S;
constexpr size_t S_QF = WS_S + 80 * MiB;
constexpr size_t S_V = WS_S + 176 * MiB;
constexpr size_t S_KROPE = WS_S + 240 * MiB;
constexpr size_t S_KNOPE = WS_TAB;
constexpr size_t S_AO2 = WS_S;
constexpr size_t S_Z2 = WS_S + 80 * MiB;
constexpr size_t S_QP1 = WS_S + 144 * MiB;
constexpr size_t S_EIDX1 = WS_S;
constexpr size_t S_GW1 = WS_S + 16 * MiB;
constexpr size_t WS_NEED = 512 * MiB;
static_assert(S_QP1 + 128 * MiB <= WS_NEED && S_VCMP + 512 * KiB <= WS_NEED, "workspace map");

__device__ __forceinline__ float bf_lo(unsigned u) { return __uint_as_float(u << 16); }
__device__ __forceinline__ float bf_hi(unsigned u) { return __uint_as_float(u & 0xffff0000u); }
__device__ __forceinline__ float bf2f(bf16_t v) { return __uint_as_float((unsigned)v << 16); }
__device__ __forceinline__ unsigned pk2(float lo, float hi) { f32x2 v = {lo, hi}; bf16x2_t b = __builtin_convertvector(v, bf16x2_t); return __builtin_bit_cast(unsigned, b); }
__device__ __forceinline__ bf16_t f2bf(float f) { return (bf16_t)(pk2(f, 0.f) & 0xffffu); }
__device__ __forceinline__ float wave_sum(float v) {
#pragma unroll
    for (int o = 32; o >= 1; o >>= 1) v += __shfl_xor(v, o);
    return v;
}
__device__ __forceinline__ float wave_max(float v) {
#pragma unroll
    for (int o = 32; o >= 1; o >>= 1) v = fmaxf(v, __shfl_xor(v, o));
    return v;
}
__device__ __forceinline__ float gelu_tanh(float x) {
    const float y = 0.7978845608028654f * (x + 0.044715f * x * x * x);
    const float e = __expf(2.f * y);
    const float th = 1.f - 2.f / (1.f + e);
    return 0.5f * x * (1.f + th);
}
#define LDS_FENCE() asm volatile("s_waitcnt lgkmcnt(0)" ::: "memory")

namespace pg8 {
constexpr int BM = 256, BK = 64, HALF = 128, HTB = HALF * BK * 2, STAGE_BYTES = 8 * HTB, NXCD = 8, WGM = 8;
__host__ __device__ __forceinline__ int lds_byte(int r, int c) { const int st = (r >> 4) * 2 + (c >> 5), rr = r & 15, cc = c & 31, ob = rr * 64 + cc * 2; return st * 1024 + (ob ^ (((ob >> 9) & 1) << 5)); }
__host__ __device__ __forceinline__ void stage_rc(int b, int& R, int& C) { const int st = b / 1024, sb = b % 1024, swz = sb ^ (((sb >> 9) & 1) << 5); R = (st >> 1) * 16 + swz / 64; C = (st & 1) * 32 + (swz % 64) / 2; }
__host__ __device__ __forceinline__ int perm32(int rho) { const int n = rho >> 4, i = rho & 15; return 8 * (i >> 2) + 4 * n + (i & 3); }
struct Unit { int pm, pn; };
struct Gemm { const bf16_t* A; const bf16_t* Bt; int M, N, K, lda, ldb; };
struct StaticOrder {
    int nM, nN, nwg, G, c;
    __device__ void init(int M, int N, int G_, int c_) { nM = M / BM; nN = N / BM; nwg = nM * nN; G = G_; c = c_; }
    __device__ bool next(int i, Unit& u) const {
        const long L = (long)i * G + c; if (L >= nwg) return false;
        int wgid = (int)L; { const int q = nwg / NXCD, r = nwg % NXCD, xcd = wgid % NXCD, off = wgid / NXCD; wgid = (xcd < r ? xcd * (q + 1) : r * (q + 1) + (xcd - r) * q) + off; }
        const int nig = WGM * nN, gid = wgid / nig, fm = gid * WGM, gsz = (nM - fm) < WGM ? (nM - fm) : WGM;
        u.pm = fm + ((wgid % nig) % gsz); u.pn = (wgid % nig) / gsz; return true;
    }
};
template <class F> struct EpiFn {
    static constexpr bool PERM = true;
    F f;
    __device__ __forceinline__ void operator()(const f32x4 (&acc)[2][2][4][2], const Unit& u, int wr, int wc, int fr, int fq) const {
        const int row0 = u.pm * BM + wr * 64 + fr, col0 = u.pn * BM + wc * 32 + 8 * fq;
#pragma unroll
        for (int ai = 0; ai < 2; ++ai)
#pragma unroll
            for (int m = 0; m < 4; ++m)
#pragma unroll
                for (int bj = 0; bj < 2; ++bj) f(row0 + ai * HALF + m * 16, col0 + bj * HALF, acc[ai][bj][m][0], acc[ai][bj][m][1]);
    }
};

template <class Epi, class Sched>
__device__ __forceinline__ void gemm_phase(LAS unsigned char* lds, const Gemm g, const Sched& S, const Epi& E) {
    const int tid = threadIdx.x, wid = __builtin_amdgcn_readfirstlane(tid >> 6), lane = tid & 63, wr = wid >> 2, wc = wid & 3, fr = lane & 15, fq = lane >> 4;
    const int K = g.K, nt = K / BK;
    unsigned voffA[2], voffB[2];
#pragma unroll
    for (int i = 0; i < 2; ++i) { int R, C; stage_rc(tid * 16 + i * 8192, R, C); const int Rb = Epi::PERM ? ((R & ~31) + perm32(R & 31)) : R;
        voffA[i] = (unsigned)(R * g.lda + C) * 2u; voffB[i] = (unsigned)(Rb * g.ldb + C) * 2u; }
    const size_t kstep = (size_t)(BK * 2);
    const size_t hstepA = (size_t)HALF * g.lda * 2, hstepB = (size_t)HALF * g.ldb * 2;
    const size_t tstepA = 2 * hstepA, tstepB = 2 * hstepB;
    const unsigned ldsw = (unsigned)wid * 1024u;
    const int aoff = lds_byte(wr * 64 + fr, fq * 8), boff = lds_byte(wc * 32 + fr, fq * 8);
#define PG8_SA(b, h) (((b) * 2 + (h)) * HTB)
#define PG8_SB(b, h) ((4 + (b) * 2 + (h)) * HTB)
#define PG8_STAGE(bufoff, gbase, voff) do { _Pragma("unroll") for (int _i = 0; _i < 2; ++_i) \
        __builtin_amdgcn_global_load_lds((const unsigned*)((const char*)(gbase) + (voff)[_i]), (LAS unsigned*)(lds + (bufoff) + ldsw + _i * 8192), 16, 0, 0); } while (0)
#define PG8_LDA(dst, b, h) do { _Pragma("unroll") for (int m = 0; m < 4; ++m) _Pragma("unroll") for (int k = 0; k < 2; ++k) dst[m][k] = *(const LAS bf16x8*)(lds + PG8_SA(b, h) + aoff + m * 2048 + k * 1024); } while (0)
#define PG8_LDB(dst, b, h) do { _Pragma("unroll") for (int n = 0; n < 2; ++n) _Pragma("unroll") for (int k = 0; k < 2; ++k) dst[n][k] = *(const LAS bf16x8*)(lds + PG8_SB(b, h) + boff + n * 2048 + k * 1024); } while (0)
#define PG8_MMA(ai, bj, At, Bt) do { __builtin_amdgcn_s_setprio(1); _Pragma("unroll") for (int m = 0; m < 4; ++m) _Pragma("unroll") for (int n = 0; n < 2; ++n) _Pragma("unroll") for (int k = 0; k < 2; ++k) \
        acc[ai][bj][m][n] = __builtin_amdgcn_mfma_f32_16x16x32_bf16(Bt[n][k], At[m][k], acc[ai][bj][m][n], 0, 0, 0); __builtin_amdgcn_s_setprio(0); } while (0)
#define PG8_WAIT_V(n) asm volatile("s_waitcnt vmcnt(" #n ")" ::: "memory")
#define PG8_WAIT_L(n) asm volatile("s_waitcnt lgkmcnt(" #n ")" ::: "memory")
#define PG8_BAR __builtin_amdgcn_s_barrier()
#define PG8_SCHED __builtin_amdgcn_sched_barrier(0)
    Unit cur, nxt; int ui = 0;
    if (!S.next(0, cur)) return;
    f32x4 acc[2][2][4][2];
#pragma unroll
    for (int a = 0; a < 2; ++a)
#pragma unroll
        for (int b = 0; b < 2; ++b)
#pragma unroll
            for (int m = 0; m < 4; ++m)
#pragma unroll
                for (int n = 0; n < 2; ++n) acc[a][b][m][n] = (f32x4){0.f, 0.f, 0.f, 0.f};
    bf16x8 At[4][2], B0[2][2], B1[2][2];
    const char* cA = (const char*)g.A + (size_t)cur.pm * tstepA; const char* cB = (const char*)g.Bt + (size_t)cur.pn * tstepB;
    PG8_STAGE(PG8_SB(0, 0), cB, voffB); PG8_STAGE(PG8_SB(0, 1), cB + hstepB, voffB); PG8_STAGE(PG8_SA(0, 0), cA, voffA); PG8_STAGE(PG8_SA(0, 1), cA + hstepA, voffA);
    if (wr == 1) PG8_BAR;
    PG8_WAIT_V(2); PG8_BAR;
    PG8_STAGE(PG8_SB(1, 0), cB + kstep, voffB); PG8_STAGE(PG8_SA(1, 0), cA + kstep, voffA); PG8_STAGE(PG8_SB(1, 1), cB + hstepB + kstep, voffB);
    PG8_WAIT_V(6); PG8_BAR;
    for (;;) {
        const bool has_next = S.next(ui + 1, nxt);
        const char* nA = has_next ? (const char*)g.A + (size_t)nxt.pm * tstepA : cA; const char* nB = has_next ? (const char*)g.Bt + (size_t)nxt.pn * tstepB : cB;
        for (int t = 0; t < nt; t += 2) {
            const bool last = (t == nt - 2);
            const char* a1 = cA + (size_t)(t + 1) * kstep;
            const char* a2 = last ? nA : cA + (size_t)(t + 2) * kstep; const char* b2 = last ? nB : cB + (size_t)(t + 2) * kstep;
            const char* a3 = a2 + kstep; const char* b3 = b2 + kstep;
            PG8_LDB(B0, 0, 0); PG8_LDB(B1, 0, 1); PG8_SCHED; PG8_LDA(At, 0, 0); PG8_STAGE(PG8_SA(1, 1), a1 + hstepA, voffA);
            PG8_WAIT_V(8); PG8_WAIT_L(0); PG8_BAR; PG8_MMA(0, 0, At, B0); PG8_MMA(0, 1, At, B1); PG8_BAR; PG8_SCHED;
            PG8_LDA(At, 0, 1); PG8_STAGE(PG8_SB(0, 0), b2, voffB); PG8_STAGE(PG8_SB(0, 1), b2 + hstepB, voffB); PG8_STAGE(PG8_SA(0, 0), a2, voffA);
            PG8_WAIT_V(8); PG8_WAIT_L(0); PG8_BAR; PG8_MMA(1, 0, At, B0); PG8_MMA(1, 1, At, B1); PG8_BAR; PG8_SCHED;
            PG8_LDB(B0, 1, 0); PG8_LDB(B1, 1, 1); PG8_SCHED; PG8_LDA(At, 1, 0); PG8_STAGE(PG8_SA(0, 1), a2 + hstepA, voffA);
            PG8_WAIT_V(8); PG8_WAIT_L(0); PG8_BAR; PG8_MMA(0, 0, At, B0); PG8_MMA(0, 1, At, B1); PG8_BAR; PG8_SCHED;
            PG8_LDA(At, 1, 1); PG8_STAGE(PG8_SB(1, 0), b3, voffB); PG8_STAGE(PG8_SB(1, 1), b3 + hstepB, voffB); PG8_STAGE(PG8_SA(1, 0), a3, voffA);
            PG8_WAIT_V(8); PG8_WAIT_L(0); PG8_BAR; PG8_MMA(1, 0, At, B0); PG8_MMA(1, 1, At, B1); PG8_BAR; PG8_SCHED;
        }
        if (wr == 0) PG8_BAR;
        E(acc, cur, wr, wc, fr, fq);
        if (!has_next) break;
#pragma unroll
        for (int a = 0; a < 2; ++a)
#pragma unroll
            for (int b = 0; b < 2; ++b)
#pragma unroll
                for (int m = 0; m < 4; ++m)
#pragma unroll
                    for (int n = 0; n < 2; ++n) acc[a][b][m][n] = (f32x4){0.f, 0.f, 0.f, 0.f};
        cur = nxt; cA = nA; cB = nB; ++ui;
        if (wr == 1) PG8_BAR;
    }
    PG8_WAIT_V(0);
    PG8_BAR;
#undef PG8_SA
#undef PG8_SB
#undef PG8_STAGE
#undef PG8_LDA
#undef PG8_LDB
#undef PG8_MMA
#undef PG8_WAIT_V
#undef PG8_WAIT_L
#undef PG8_BAR
#undef PG8_SCHED
}
}

template <class F>
__device__ __forceinline__ void run_gemm(LAS unsigned char* lds, const bf16_t* A, int lda, const bf16_t* Bt, int ldb, int M, int N, int K, int vblock, const F& f) {
    pg8::Gemm g{A, Bt, M, N, K, lda, ldb}; pg8::StaticOrder S; S.init(M, N, (int)gridDim.x, vblock);
    pg8::EpiFn<F> E{f};
    pg8::gemm_phase<pg8::EpiFn<F>, pg8::StaticOrder>(lds, g, S, E);
}

struct Params {
    const float* in[28];
    float* out;
    unsigned char* ws;
    int ph_lo, ph_hi;
};
enum { I_X = 0, I_NSA_WIN, I_CK_W1, I_CK_W2, I_CK_PE, I_CV_W1, I_CV_W2, I_CV_PE, I_NSA_WOUT, I_NSA_LNG, I_NSA_LNB, I_MLA_WDKV, I_MLA_KVG, I_MLA_WKR, I_MLA_WUK, I_MLA_WUV,
       I_MLA_WDQ, I_MLA_QG, I_MLA_WUQ, I_MLA_WOUT, I_MLA_LNG, I_MLA_LNB, I_PEER_WQ, I_PEER_SUBK, I_PEER_U, I_PEER_V, I_PEER_LNG, I_PEER_LNB };

__device__ __forceinline__ void p0_transpose_item(const float* W, int ldw, int n_valid, int K, bf16_t* WT, int row_off, const float* kscale, LAS float* scr, int nblk, int item, int lane) {
    const int kb = item / nblk, nb = item % nblk, k0 = 64 * kb, n0 = 32 * nb;
    const int n = n0 + (lane & 31);
#pragma unroll 8
    for (int i = 0; i < 32; ++i) { const int kk = 2 * i + (lane >> 5); float v = 0.f; if (n < n_valid) { v = W[(size_t)(k0 + kk) * ldw + n]; if (kscale) v *= kscale[k0 + kk]; } scr[kk * 33 + (lane & 31)] = v; }
    LDS_FENCE();
    const int c = lane & 7;
#pragma unroll
    for (int j = 0; j < 4; ++j) { const int nn = (lane >> 3) + 8 * j; const LAS float* s = scr + (8 * c) * 33 + nn;
        u32x4 o; o.x = pk2(s[0 * 33], s[1 * 33]); o.y = pk2(s[2 * 33], s[3 * 33]); o.z = pk2(s[4 * 33], s[5 * 33]); o.w = pk2(s[6 * 33], s[7 * 33]);
        *(u32x4*)(WT + (size_t)(row_off + n0 + nn) * K + k0 + 8 * c) = o; }
    LDS_FENCE();
}
__device__ __forceinline__ void cvt_f32_bf16(const float* src, bf16_t* dst, size_t n, size_t gtid, size_t gsz) {
    for (size_t i = gtid * 8; i < n; i += gsz * 8) { const f32x4 a = *(const f32x4*)(src + i), b = *(const f32x4*)(src + i + 4);
        u32x4 o; o.x = pk2(a.x, a.y); o.y = pk2(a.z, a.w); o.z = pk2(b.x, b.y); o.w = pk2(b.z, b.w); *(u32x4*)(dst + i) = o; }
}
__device__ __forceinline__ void phase_prologue(const Params& p, LAS unsigned char* lds) {
    const int tid = threadIdx.x, lane = tid & 63, wave = tid >> 6;
    LAS float* scr = (LAS float*)(lds + wave * 16384);
    const int gw = blockIdx.x * NWAVES + wave, NGW = gridDim.x * NWAVES;
    unsigned char* ws = p.ws;
    int base = 0;
#define TJOB(W_, ldw_, nvalid_, K_, npad_, WT_, rowoff_, ks_) do { const int nblk = (npad_) / 32, nit = ((K_) / 64) * nblk; \
        for (int it = gw - base; it < nit; it += NGW) { if (it >= 0) p0_transpose_item((W_), (ldw_), (nvalid_), (K_), (WT_), (rowoff_), (ks_), scr, nblk, it, lane); } \
        base = (base + nit) % NGW; } while (0)
    TJOB(p.in[I_NSA_WIN], NSA_IN, NSA_IN, 1024, NSA_IN_PAD, (bf16_t*)(ws + WS_W_IN_T), 0, (const float*)nullptr);
    TJOB(p.in[I_NSA_WOUT], 1024, 1024, 1024, 1024, (bf16_t*)(ws + WS_W_NSAOUT_T), 0, (const float*)nullptr);
    TJOB(p.in[I_CK_W1], 128, 128, 1024, 128, (bf16_t*)(ws + WS_W_CK1_T), 0, (const float*)nullptr);
    TJOB(p.in[I_CK_W1] + 1024 * 128, 128, 128, 1024, 128, (bf16_t*)(ws + WS_W_CK1_T), 128, (const float*)nullptr);
    TJOB(p.in[I_CV_W1], 128, 128, 1024, 128, (bf16_t*)(ws + WS_W_CV1_T), 0, (const float*)nullptr);
    TJOB(p.in[I_CV_W1] + 1024 * 128, 128, 128, 1024, 128, (bf16_t*)(ws + WS_W_CV1_T), 128, (const float*)nullptr);
    TJOB(p.in[I_MLA_WDQ], 768, 768, 1024, 768, (bf16_t*)(ws + WS_W_MLADOWN_T), 0, (const float*)nullptr);
    TJOB(p.in[I_MLA_WDKV], 256, 256, 1024, 256, (bf16_t*)(ws + WS_W_MLADOWN_T), 768, (const float*)nullptr);
    TJOB(p.in[I_MLA_WKR], 32, 32, 1024, 256, (bf16_t*)(ws + WS_W_MLADOWN_T), 1024, (const float*)nullptr);
    TJOB(p.in[I_MLA_WUQ], 1536, 1536, 768, 1536, (bf16_t*)(ws + WS_W_UQ_T), 0, p.in[I_MLA_QG]);
    TJOB(p.in[I_MLA_WUK], 1024, 1024, 256, 1024, (bf16_t*)(ws + WS_W_UKV_T), 0, p.in[I_MLA_KVG]);
    TJOB(p.in[I_MLA_WUV], 1024, 1024, 256, 1024, (bf16_t*)(ws + WS_W_UKV_T), 1024, p.in[I_MLA_KVG]);
    TJOB(p.in[I_MLA_WOUT], 1024, 1024, 1024, 1024, (bf16_t*)(ws + WS_W_MLAOUT_T), 0, (const float*)nullptr);
    TJOB(p.in[I_PEER_WQ], 2048, 2048, 1024, 2048, (bf16_t*)(ws + WS_W_PQ_T), 0, (const float*)nullptr);
    TJOB(p.in[I_PEER_WQ] + (size_t)1024 * 2048, 2048, 2048, 1024, 2048, (bf16_t*)(ws + WS_W_PQ_T) + (size_t)2048 * 1024, 0, (const float*)nullptr);
#undef TJOB
#if DBG_STAT
    if (blockIdx.x == 0 && tid == 0) ((float*)(ws + WS_CTL))[16] = 0.f;
#endif
    const size_t gtid = (size_t)blockIdx.x * NTHREADS + tid, gsz = (size_t)gridDim.x * NTHREADS;
    cvt_f32_bf16(p.in[I_X], (bf16_t*)(ws + WS_HB), (size_t)NTOK * DM, gtid, gsz);
    cvt_f32_bf16(p.in[I_PEER_SUBK], (bf16_t*)(ws + WS_SUBK), (size_t)2 * 8 * 2 * 128 * 128, gtid, gsz);
    cvt_f32_bf16(p.in[I_PEER_U], (bf16_t*)(ws + WS_TAB), (size_t)NEXP * DM, gtid, gsz);
    cvt_f32_bf16(p.in[I_PEER_V], (bf16_t*)(ws + WS_TAB + 32 * MiB), (size_t)NEXP * DM, gtid, gsz);
    cvt_f32_bf16(p.in[I_PEER_U] + (size_t)NEXP * DM, (bf16_t*)(ws + WS_TAB + 64 * MiB), (size_t)NEXP * DM, gtid, gsz);
    cvt_f32_bf16(p.in[I_PEER_V] + (size_t)NEXP * DM, (bf16_t*)(ws + WS_TAB + 96 * MiB), (size_t)NEXP * DM, gtid, gsz);
    for (int o = gw; o < 256; o += NGW) {
        const float* pe = (o < 128) ? p.in[I_CK_PE] : p.in[I_CV_PE]; const float* w1 = (o < 128) ? p.in[I_CK_W1] : p.in[I_CV_W1]; const int h = o & 127;
        float s = 0.f; for (int i = lane; i < 2048; i += 64) s += pe[i] * w1[(size_t)i * 128 + h];
        s = wave_sum(s); if (lane == 0) ((float*)(ws + WS_PE))[o] = s;
    }
    for (size_t i = gtid; i < (size_t)SEQ * 16; i += gsz) {
        const int pos = (int)(i >> 4), fi = (int)(i & 15);
        const float inv = 1.0f / powf(10000.0f, (float)(2 * fi) / 32.0f);
        const float ang = (float)pos * inv;
        const double rev = (double)ang * 0.15915494309189535; const double fr = rev - rint(rev);
        ((float*)(ws + WS_ROPE_COS))[i] = __builtin_amdgcn_cosf((float)fr); ((float*)(ws + WS_ROPE_SIN))[i] = __builtin_amdgcn_sinf((float)fr);
    }
}

__device__ __forceinline__ u32x4 pack8(const f32x4& a, const f32x4& b) { u32x4 o; o.x = pk2(a.x, a.y); o.y = pk2(a.z, a.w); o.z = pk2(b.x, b.y); o.w = pk2(b.z, b.w); return o; }
struct EpiNsaProj {
    bf16_t* q; bf16_t* kv6; float* gates;
    __device__ __forceinline__ void operator()(int row, int col, const f32x4& a, const f32x4& b) const {
        if (col < 1024) { *(u32x4*)(q + (size_t)row * 1024 + col) = pack8(a, b); }
        else if (col < 2560) {
            const int which = (col - 1024) >> 8, cc = (col - 1024) & 255;
            bf16_t* base = kv6 + (size_t)which * NTOK * 256;
            if (which < 2) { const int g = cc >> 6, d = cc & 63, bb = row >> 12, t = row & 4095, n = t >> 4, l = t & 15;
                *(u32x4*)(base + ((((size_t)(bb * 256 + n) * 4 + g) * 16 + l) * 64 + d)) = pack8(a, b); }
            else *(u32x4*)(base + (size_t)row * 256 + cc) = pack8(a, b);
        } else if (col < NSA_IN) {
            float* gp = gates + (size_t)row * 48 + (col - 2560);
            f32x4 s0, s1;
#pragma unroll
            for (int i = 0; i < 4; ++i) { s0[i] = 1.f / (1.f + __expf(-a[i])); s1[i] = 1.f / (1.f + __expf(-b[i])); }
            *(f32x4*)gp = s0; *(f32x4*)(gp + 4) = s1;
        }
    }
};
struct EpiF32 { float* O; int ldc; __device__ __forceinline__ void operator()(int row, int col, const f32x4& a, const f32x4& b) const { float* o = O + (size_t)row * ldc + col; *(f32x4*)o = a; *(f32x4*)(o + 4) = b; } };
struct EpiBf16 { bf16_t* O; int ldc; __device__ __forceinline__ void operator()(int row, int col, const f32x4& a, const f32x4& b) const { *(u32x4*)(O + (size_t)row * ldc + col) = pack8(a, b); } };
struct EpiResid {
    const bf16_t* H; bf16_t* Z; float ms;
    __device__ __forceinline__ void operator()(int row, int col, const f32x4& a_, const f32x4& b_) const {
        const f32x4 a = a_ * ms, b = b_ * ms;
        const u32x4 h = *(const u32x4*)(H + (size_t)row * 1024 + col);
        f32x4 x, y;
        x.x = DN_ALPHA * bf_lo(h.x) + a.x; x.y = DN_ALPHA * bf_hi(h.x) + a.y; x.z = DN_ALPHA * bf_lo(h.y) + a.z; x.w = DN_ALPHA * bf_hi(h.y) + a.w;
        y.x = DN_ALPHA * bf_lo(h.z) + b.x; y.y = DN_ALPHA * bf_hi(h.z) + b.y; y.z = DN_ALPHA * bf_lo(h.w) + b.z; y.w = DN_ALPHA * bf_hi(h.w) + b.w;
        *(u32x4*)(Z + (size_t)row * 1024 + col) = pack8(x, y);
    }
};
struct EpiKV {
    bf16_t* KN; bf16_t* V;
    __device__ __forceinline__ void operator()(int row, int col, const f32x4& a, const f32x4& b) const {
        bf16_t* dst = (col < 1024) ? KN + (size_t)row * 1024 + col : V + (size_t)row * 1024 + (col - 1024);
        *(u32x4*)dst = pack8(a, b);
    }
};

__device__ __forceinline__ void phase_ln(const bf16_t* Z, bf16_t* H, const float* g, const float* b) {
    const int lane = threadIdx.x & 63, wave = threadIdx.x >> 6;
    const int gw = blockIdx.x * NWAVES + wave, NGW = gridDim.x * NWAVES;
    for (int row = gw; row < NTOK; row += NGW) {
        const u32x4 a = *(const u32x4*)(Z + (size_t)row * 1024 + lane * 8), c = *(const u32x4*)(Z + (size_t)row * 1024 + 512 + lane * 8);
        float v[16] = {bf_lo(a.x), bf_hi(a.x), bf_lo(a.y), bf_hi(a.y), bf_lo(a.z), bf_hi(a.z), bf_lo(a.w), bf_hi(a.w), bf_lo(c.x), bf_hi(c.x), bf_lo(c.y), bf_hi(c.y), bf_lo(c.z), bf_hi(c.z), bf_lo(c.w), bf_hi(c.w)};
        float s = 0.f;
#pragma unroll
        for (int i = 0; i < 16; ++i) s += v[i];
        const float mean = wave_sum(s) * (1.f / 1024.f); float q = 0.f;
#pragma unroll
        for (int i = 0; i < 16; ++i) { v[i] -= mean; q += v[i] * v[i]; }
        const float rstd = rsqrtf(wave_sum(q) * (1.f / 1024.f) + LN_EPS);
        float o[16];
#pragma unroll
        for (int hh = 0; hh < 2; ++hh) { const int c0 = hh * 512 + lane * 8; const f32x4 g0 = *(const f32x4*)(g + c0), g1 = *(const f32x4*)(g + c0 + 4), b0 = *(const f32x4*)(b + c0), b1 = *(const f32x4*)(b + c0 + 4);
#pragma unroll
            for (int i = 0; i < 4; ++i) { o[hh * 8 + i] = v[hh * 8 + i] * rstd * g0[i] + b0[i]; o[hh * 8 + 4 + i] = v[hh * 8 + 4 + i] * rstd * g1[i] + b1[i]; } }
        u32x4 w0, w1; w0.x = pk2(o[0], o[1]); w0.y = pk2(o[2], o[3]); w0.z = pk2(o[4], o[5]); w0.w = pk2(o[6], o[7]); w1.x = pk2(o[8], o[9]); w1.y = pk2(o[10], o[11]); w1.z = pk2(o[12], o[13]); w1.w = pk2(o[14], o[15]);
        *(u32x4*)(H + (size_t)row * 1024 + lane * 8) = w0; *(u32x4*)(H + (size_t)row * 1024 + 512 + lane * 8) = w1;
    }
}
__device__ __forceinline__ void phase_cmp_finish(const Params& p, LAS unsigned char* lds) {
    const int lane = threadIdx.x & 63, wave = threadIdx.x >> 6;
    const int gw = blockIdx.x * NWAVES + wave, NGW = gridDim.x * NWAVES;
    LAS float* hs = (LAS float*)(lds + wave * 512);
    for (int item = gw; item < 2 * 8192; item += NGW) {
        const int kv = item >> 13, r = item & 8191, n = (r >> 2) & 255;
        const float* P = (const float*)(p.ws + (kv ? S_PV : S_PK)); const float* pe = (const float*)(p.ws + WS_PE) + kv * 128;
        const float* w2 = p.in[kv ? I_CV_W2 : I_CK_W2];
        bf16_t* out = (bf16_t*)(p.ws + (kv ? S_VCMP : S_KCMP)) + (size_t)r * 64;
        if (n == 255) { out[lane] = 0; continue; }
        const float a0 = P[(size_t)r * 256 + lane] + P[(size_t)(r + 4) * 256 + 128 + lane] + pe[lane];
        const float a1 = P[(size_t)r * 256 + 64 + lane] + P[(size_t)(r + 4) * 256 + 192 + lane] + pe[64 + lane];
        LDS_FENCE();
        hs[lane] = gelu_tanh(a0); hs[64 + lane] = gelu_tanh(a1);
        LDS_FENCE();
        float s = 0.f;
#pragma unroll 8
        for (int h = 0; h < 128; ++h) s += hs[h] * w2[h * 64 + lane];
        out[lane] = f2bf(s);
    }
}
__device__ __forceinline__ void phase_mla_rowstats(const Params& p) {
    const int lane = threadIdx.x & 63, wave = threadIdx.x >> 6;
    const int gw = blockIdx.x * NWAVES + wave, NGW = gridDim.x * NWAVES;
    bf16_t* DQ = (bf16_t*)(p.ws + S_DQ);
    const float* rc = (const float*)(p.ws + WS_ROPE_COS); const float* rs = (const float*)(p.ws + WS_ROPE_SIN);
    for (int row = gw; row < NTOK; row += NGW) {
        bf16_t* r = DQ + (size_t)row * MLA_DOWN_PAD;
        u32x2 v[4]; float sq = 0.f, skv = 0.f;
#pragma unroll
        for (int j = 0; j < 4; ++j) { v[j] = *(const u32x2*)(r + j * 256 + lane * 4); const float a = bf_lo(v[j].x), b = bf_hi(v[j].x), c = bf_lo(v[j].y), d = bf_hi(v[j].y); const float ss = (a * a + b * b) + (c * c + d * d); if (j < 3) sq += ss; else skv += ss; }
        sq = wave_sum(sq); skv = wave_sum(skv);
        const float rq = rsqrtf(sq * (1.f / 768.f) + RMS_EPS), rkv = rsqrtf(skv * (1.f / 256.f) + RMS_EPS);
#pragma unroll
        for (int j = 0; j < 4; ++j) { const float f = (j < 3) ? rq : rkv; u32x2 o; o.x = pk2(bf_lo(v[j].x) * f, bf_hi(v[j].x) * f); o.y = pk2(bf_lo(v[j].y) * f, bf_hi(v[j].y) * f); *(u32x2*)(r + j * 256 + lane * 4) = o; }
        if (lane < 16) { const int pos = row & 4095; const float x1 = bf2f(r[1024 + lane]), x2 = bf2f(r[1040 + lane]), c = rc[pos * 16 + lane], s = rs[pos * 16 + lane];
            bf16_t* kr = (bf16_t*)(p.ws + S_KROPE) + (size_t)row * 32; kr[lane] = f2bf(x1 * c - x2 * s); kr[16 + lane] = f2bf(x2 * c + x1 * s); }
    }
}

struct OnlineSt { float m[4], l[4], o[4][2]; };
__device__ __forceinline__ void nsa_attend_block(OnlineSt& st, const bf16_t* Kb, const bf16_t* Vb, int pos0, int t, const float (&slope)[4], LAS float* qs, LAS float* ps, int lane) {
    const int pos = pos0 + lane; const bool valid = pos <= t;
    const bf16_t* krow = Kb + (size_t)(valid ? pos : t) * 256;
    float acc[4] = {0.f, 0.f, 0.f, 0.f};
#pragma unroll 2
    for (int d8 = 0; d8 < 8; ++d8) { const u32x4 kv = *(const u32x4*)(krow + d8 * 8);
        const float kf[8] = {bf_lo(kv.x), bf_hi(kv.x), bf_lo(kv.y), bf_hi(kv.y), bf_lo(kv.z), bf_hi(kv.z), bf_lo(kv.w), bf_hi(kv.w)};
#pragma unroll
        for (int e = 0; e < 8; ++e) { const f32x4 qv = *(const LAS f32x4*)(qs + (d8 * 8 + e) * 4);
#pragma unroll
            for (int r = 0; r < 4; ++r) acc[r] += qv[r] * kf[e]; } }
    const float dist = (float)(t - pos);
    f32x4 pe;
#pragma unroll
    for (int r = 0; r < 4; ++r) {
        const float s = valid ? acc[r] - slope[r] * dist : -1e30f;
        const float mb = wave_max(s), mn = fmaxf(st.m[r], mb);
        const float alpha = __expf(st.m[r] - mn);
        const float e = valid ? __expf(s - mn) : 0.f;
        st.l[r] = st.l[r] * alpha + wave_sum(e); st.o[r][0] *= alpha; st.o[r][1] *= alpha; st.m[r] = mn; pe[r] = e;
    }
    LDS_FENCE();
    *(LAS f32x4*)(ps + lane * 4) = pe;
    LDS_FENCE();
    const int hf = lane >> 5, dp = lane & 31;
    const int nk = (t - pos0 + 1 < 64) ? t - pos0 + 1 : 64;
#pragma unroll 4
    for (int kk = hf; kk < nk; kk += 2) {
        const unsigned vv = *(const unsigned*)(Vb + (size_t)(pos0 + kk) * 256 + 2 * dp); const f32x4 pp = *(const LAS f32x4*)(ps + kk * 4);
        const float lo = bf_lo(vv), hi = bf_hi(vv);
#pragma unroll
        for (int r = 0; r < 4; ++r) { st.o[r][0] += pp[r] * lo; st.o[r][1] += pp[r] * hi; }
    }
}
__device__ __forceinline__ void phase_nsa_attn_ref(const Params& p, LAS unsigned char* lds) {
    const int lane = threadIdx.x & 63, wave = threadIdx.x >> 6;
    const int gw = blockIdx.x * NWAVES + wave, NGW = gridDim.x * NWAVES;
    LAS float* qs = (LAS float*)(lds + wave * 6144);
    LAS float* pc = qs + 256;
    LAS float* ptot = pc + 1024;
    const bf16_t* Q = (const bf16_t*)(p.ws + S_Q); const bf16_t* KV6 = (const bf16_t*)(p.ws + S_KV6);
    const bf16_t* KS = KV6 + (size_t)2 * NTOK * 256; const bf16_t* VS = KV6 + (size_t)3 * NTOK * 256; const bf16_t* KW = KV6 + (size_t)4 * NTOK * 256; const bf16_t* VW = KV6 + (size_t)5 * NTOK * 256;
    const bf16_t* KC = (const bf16_t*)(p.ws + S_KCMP); const bf16_t* VC = (const bf16_t*)(p.ws + S_VCMP);
    const float* GATES = (const float*)(p.ws + S_GATES); bf16_t* AO = (bf16_t*)(p.ws + S_AO);
    const int hf = lane >> 5, dp = lane & 31;
    for (int item = gw; item < NTOK * 4; item += NGW) {
        const int g = item & 3, row = item >> 2, b = row >> 12, t = row & 4095;
        float slope[4];
#pragma unroll
        for (int r = 0; r < 4; ++r) slope[r] = exp2f(-0.5f * (float)(g * 4 + r + 1));
        LDS_FENCE();
        { f32x4 qv;
#pragma unroll
          for (int r = 0; r < 4; ++r) qv[r] = bf2f(Q[(size_t)row * 1024 + (g * 4 + r) * 64 + lane]) * 0.125f;
          *(LAS f32x4*)(qs + lane * 4) = qv; }
        LDS_FENCE();
        const int nv = (t >= 31) ? (((t - 31) >> 4) + 1 < 255 ? ((t - 31) >> 4) + 1 : 255) : 0;
        float mloc[4] = {-1e30f, -1e30f, -1e30f, -1e30f};
#pragma unroll 1
        for (int c = 0; c < 4; ++c) {
            const int i = 64 * c + lane;
            f32x4 sv = (f32x4){-1e30f, -1e30f, -1e30f, -1e30f};
            if (64 * c < nv) {
                const bf16_t* krow = KC + ((size_t)(b * 256 + i) * 4 + g) * 64;
                float acc[4] = {0.f, 0.f, 0.f, 0.f};
#pragma unroll 2
                for (int d8 = 0; d8 < 8; ++d8) { const u32x4 kv = *(const u32x4*)(krow + d8 * 8);
                    const float kf[8] = {bf_lo(kv.x), bf_hi(kv.x), bf_lo(kv.y), bf_hi(kv.y), bf_lo(kv.z), bf_hi(kv.z), bf_lo(kv.w), bf_hi(kv.w)};
#pragma unroll
                    for (int e = 0; e < 8; ++e) { const f32x4 qv = *(const LAS f32x4*)(qs + (d8 * 8 + e) * 4);
#pragma unroll
                        for (int r = 0; r < 4; ++r) acc[r] += qv[r] * kf[e]; } }
                const float dist = (float)(t - (16 * i + 31));
                if (i < nv) {
#pragma unroll
                    for (int r = 0; r < 4; ++r) { sv[r] = acc[r] - slope[r] * dist; mloc[r] = fmaxf(mloc[r], sv[r]); } }
            }
            *(LAS f32x4*)(pc + i * 4) = sv;
        }
        float ssum[4] = {0.f, 0.f, 0.f, 0.f};
#pragma unroll
        for (int r = 0; r < 4; ++r) mloc[r] = wave_max(mloc[r]);
        LDS_FENCE();
#pragma unroll 1
        for (int c = 0; c < 4; ++c) {
            const int i = 64 * c + lane; f32x4 sv = *(const LAS f32x4*)(pc + i * 4);
#pragma unroll
            for (int r = 0; r < 4; ++r) { sv[r] = (sv[r] > -1e29f) ? __expf(sv[r] - mloc[r]) : 0.f; ssum[r] += sv[r]; }
            *(LAS f32x4*)(pc + i * 4) = sv;
        }
#pragma unroll
        for (int r = 0; r < 4; ++r) { const float sm = wave_sum(ssum[r]); ssum[r] = (sm > 0.f) ? 1.f / sm : 0.f; }
        LDS_FENCE();
#pragma unroll 1
        for (int c = 0; c < 4; ++c) {
            const int i = 64 * c + lane; f32x4 sv = *(const LAS f32x4*)(pc + i * 4);
#pragma unroll
            for (int r = 0; r < 4; ++r) sv[r] *= ssum[r];
            *(LAS f32x4*)(pc + i * 4) = sv; ptot[i] = (sv[0] + sv[1]) + (sv[2] + sv[3]);
        }
        LDS_FENCE();
        const int j = lane, blk = t >> 6;
        const float imp = ptot[4 * j] + ptot[4 * j + 1] + ptot[4 * j + 2] + 0.5f * ptot[4 * j + 3] + (j > 0 ? 0.5f * ptot[4 * j - 1] : 0.f);
        const bool elig = j <= blk, forced = (j == 0) || (j == blk) || (j == blk - 1);
        const float val = elig ? imp + (forced ? 1e4f : 0.f) : -1e30f;
        int rank = 0;
#pragma unroll 8
        for (int k = 0; k < 64; ++k) { const float vk = __shfl(val, k); rank += (vk > val || (vk == val && k < j)) ? 1 : 0; }
        const unsigned long long selmask = __ballot(elig && rank < 16);
        float oc[4][2] = {{0.f, 0.f}, {0.f, 0.f}, {0.f, 0.f}, {0.f, 0.f}};
        for (int i = hf; i < nv; i += 2) {
            const unsigned vv = *(const unsigned*)(VC + ((size_t)(b * 256 + i) * 4 + g) * 64 + 2 * dp); const f32x4 pp = *(const LAS f32x4*)(pc + i * 4);
            const float lo = bf_lo(vv), hi = bf_hi(vv);
#pragma unroll
            for (int r = 0; r < 4; ++r) { oc[r][0] += pp[r] * lo; oc[r][1] += pp[r] * hi; }
        }
#pragma unroll
        for (int r = 0; r < 4; ++r) { oc[r][0] += __shfl_xor(oc[r][0], 32); oc[r][1] += __shfl_xor(oc[r][1], 32); }
        OnlineSt st;
#pragma unroll
        for (int r = 0; r < 4; ++r) { st.m[r] = -1e30f; st.l[r] = 0.f; st.o[r][0] = 0.f; st.o[r][1] = 0.f; }
        const bf16_t* ksb = KS + (size_t)b * SEQ * 256 + g * 64; const bf16_t* vsb = VS + (size_t)b * SEQ * 256 + g * 64;
        for (unsigned long long mm = selmask; mm; mm &= mm - 1) { const int jj = __builtin_ctzll(mm); nsa_attend_block(st, ksb, vsb, 64 * jj, t, slope, qs, pc, lane); }
        float os[4][2];
#pragma unroll
        for (int r = 0; r < 4; ++r) { const float il = 1.f / st.l[r]; os[r][0] = (st.o[r][0] + __shfl_xor(st.o[r][0], 32)) * il; os[r][1] = (st.o[r][1] + __shfl_xor(st.o[r][1], 32)) * il; }
#pragma unroll
        for (int r = 0; r < 4; ++r) { st.m[r] = -1e30f; st.l[r] = 0.f; st.o[r][0] = 0.f; st.o[r][1] = 0.f; }
        const bf16_t* kwb = KW + (size_t)b * SEQ * 256 + g * 64; const bf16_t* vwb = VW + (size_t)b * SEQ * 256 + g * 64;
        const int lo = (t - 511 > 0) ? t - 511 : 0;
        for (int p0 = lo; p0 <= t; p0 += 64) nsa_attend_block(st, kwb, vwb, p0, t, slope, qs, pc, lane);
        const float* gp = GATES + (size_t)row * 48 + g * 12;
#pragma unroll
        for (int r = 0; r < 4; ++r) {
            const float il = 1.f / st.l[r]; const float ow0 = (st.o[r][0] + __shfl_xor(st.o[r][0], 32)) * il, ow1 = (st.o[r][1] + __shfl_xor(st.o[r][1], 32)) * il;
            const float gc = gp[r * 3 + 0], gs = gp[r * 3 + 1], gwv = gp[r * 3 + 2];
            const float o0 = gc * oc[r][0] + gs * os[r][0] + gwv * ow0, o1 = gc * oc[r][1] + gs * os[r][1] + gwv * ow1;
            if (hf == 0) *(unsigned*)(AO + (size_t)row * 1024 + (g * 4 + r) * 64 + 2 * dp) = pk2(o0, o1);
        }
    }
}

__device__ __forceinline__ void phase_mla_attn_ref(const Params& p, LAS unsigned char* lds) {
    const int lane = threadIdx.x & 63, wave = threadIdx.x >> 6;
    const int gw = blockIdx.x * NWAVES + wave, NGW = gridDim.x * NWAVES;
    LAS float* qs = (LAS float*)(lds + wave * 1024);
    LAS float* ps = qs + 128;
    const bf16_t* QF = (const bf16_t*)(p.ws + S_QF); const bf16_t* KN = (const bf16_t*)(p.ws + S_KNOPE); const bf16_t* KR = (const bf16_t*)(p.ws + S_KROPE); const bf16_t* V = (const bf16_t*)(p.ws + S_V);
    const float* rc = (const float*)(p.ws + WS_ROPE_COS); const float* rs = (const float*)(p.ws + WS_ROPE_SIN);
    bf16_t* AO = (bf16_t*)(p.ws + S_AO2);
    const float scale = 0.10206207261596577f;
    const int hf = lane >> 5, dp = lane & 31;
    for (int item = gw; item < NTOK * 16; item += NGW) {
        const int h = item & 15, row = item >> 4, b = row >> 12, t = row & 4095;
        const bf16_t* qrow = QF + (size_t)row * 1536 + h * 96; const float rq = scale;
        LDS_FENCE();
        qs[lane] = bf2f(qrow[lane]) * rq;
        if (lane < 16) { const float x1 = bf2f(qrow[64 + lane]), x2 = bf2f(qrow[80 + lane]), c = rc[t * 16 + lane], s = rs[t * 16 + lane]; qs[64 + lane] = (x1 * c - x2 * s) * rq; qs[80 + lane] = (x2 * c + x1 * s) * rq; }
        LDS_FENCE();
        float m = -1e30f, l = 0.f, o0 = 0.f, o1 = 0.f;
        for (int p0 = 0; p0 <= t; p0 += 64) {
            const int pos = p0 + lane; const bool valid = pos <= t;
            const int posc = valid ? pos : t;
            const bf16_t* kn = KN + ((size_t)(b * SEQ + posc)) * 1024 + h * 64; const bf16_t* kr = KR + ((size_t)(b * SEQ + posc)) * 32;
            float acc = 0.f;
#pragma unroll 4
            for (int d8 = 0; d8 < 12; ++d8) { const u32x4 kv = (d8 < 8) ? *(const u32x4*)(kn + d8 * 8) : *(const u32x4*)(kr + (d8 - 8) * 8);
                const f32x4 q0 = *(const LAS f32x4*)(qs + d8 * 8), q1 = *(const LAS f32x4*)(qs + d8 * 8 + 4);
                acc += q0.x * bf_lo(kv.x) + q0.y * bf_hi(kv.x) + q0.z * bf_lo(kv.y) + q0.w * bf_hi(kv.y) + q1.x * bf_lo(kv.z) + q1.y * bf_hi(kv.z) + q1.z * bf_lo(kv.w) + q1.w * bf_hi(kv.w); }
            const float s = valid ? acc : -1e30f;
            const float mn = fmaxf(m, wave_max(s)), alpha = __expf(m - mn), e = valid ? __expf(s - mn) : 0.f;
            l = l * alpha + wave_sum(e); o0 *= alpha; o1 *= alpha; m = mn;
            LDS_FENCE();
            ps[lane] = e;
            LDS_FENCE();
            const int nk = (t - p0 + 1 < 64) ? t - p0 + 1 : 64;
            for (int kk = hf; kk < nk; kk += 2) { const unsigned vv = *(const unsigned*)(V + ((size_t)(b * SEQ + p0 + kk)) * 1024 + h * 64 + 2 * dp); const float pp = ps[kk]; o0 += pp * bf_lo(vv); o1 += pp * bf_hi(vv); }
        }
        const float il = 1.f / l; o0 = (o0 + __shfl_xor(o0, 32)) * il; o1 = (o1 + __shfl_xor(o1, 32)) * il;
        if (hf == 0) *(unsigned*)(AO + (size_t)row * 1024 + h * 64 + 2 * dp) = pk2(o0, o1);
    }
}

namespace att {
typedef float f32x16 __attribute__((ext_vector_type(16)));
typedef short s16x4 __attribute__((ext_vector_type(4)));
constexpr int KSTR64 = 144, KSTR96 = 208;
constexpr int KBUF = 64 * KSTR96, VBUF = 8192;
constexpr int OFF_K = 0, OFF_V = 2 * KBUF, OFF_IMPM = OFF_V + 2 * VBUF, OFF_IMPS = OFF_IMPM + 8 * 8 * 64 * 4, OFF_SELB = OFF_IMPS + 8 * 8 * 72 * 4, OFF_UNION = OFF_SELB + 8 * 8 * 8, OFF_FIN = OFF_UNION + 16, LDS_END = OFF_FIN + 8 * 32 * 64 * 4;
static_assert(LDS_END <= 147456, "attention LDS map");
constexpr float LOG2E = 1.4426950408889634f;
__device__ __forceinline__ int crow(int r, int hi) { return (r & 3) + 8 * (r >> 2) + 4 * hi; }
__device__ __forceinline__ float xhalf(float v) { return __shfl_xor(v, 32); }

struct TileRegs { u32x4 k0, k1, v; };
__device__ __forceinline__ const char* uni_ptr(const void* p) {
    const unsigned long long v = (unsigned long long)p; const unsigned lo = __builtin_amdgcn_readfirstlane((unsigned)v), hh = __builtin_amdgcn_readfirstlane((unsigned)(v >> 32));
    return (const char*)(((unsigned long long)hh << 32) | lo);
}
template <bool MLA>
__device__ __forceinline__ void tile_load(TileRegs& R, const bf16_t* Kg, const bf16_t* KRg, const bf16_t* Vg, unsigned koff, unsigned voff, unsigned roff, int tid) {
    R.k0 = *(const u32x4*)(uni_ptr(Kg) + koff);
    R.v = *(const u32x4*)(uni_ptr(Vg) + voff);
    if (MLA) { if (tid < 256) R.k1 = *(const u32x4*)(uni_ptr(KRg) + roff); }
}
template <bool MLA, int KSTR>
__device__ __forceinline__ void tile_store(const TileRegs& R, LAS unsigned char* Kb, LAS unsigned char* Vb, int tid) {
    const int key = tid >> 3, c = tid & 7;
    *(LAS u32x4*)(Kb + key * KSTR + c * 16) = R.k0;
    if (MLA) { if (tid < 256) *(LAS u32x4*)(Kb + (tid >> 2) * KSTR + 128 + (tid & 3) * 16) = R.k1; }
    *(LAS u32x4*)(Vb + (c >> 2) * 4096 + key * 64 + (c & 3) * 16) = R.v;
}
template <int NKS, int KSTR>
__device__ __forceinline__ void qk(f32x16& p0, f32x16& p1, const LAS unsigned char* Kb, const bf16x8 (&qf)[NKS], int lane) {
    const LAS unsigned char* kp = Kb + (lane & 31) * KSTR + (lane >> 5) * 16;
#pragma unroll
    for (int r = 0; r < 16; ++r) { p0[r] = 0.f; p1[r] = 0.f; }
#pragma unroll
    for (int ks = 0; ks < NKS; ++ks) {
        const bf16x8 a0 = *(const LAS bf16x8*)(kp + ks * 32), a1 = *(const LAS bf16x8*)(kp + 32 * KSTR + ks * 32);
        p0 = __builtin_amdgcn_mfma_f32_32x32x16_bf16(a0, qf[ks], p0, 0, 0, 0);
        p1 = __builtin_amdgcn_mfma_f32_32x32x16_bf16(a1, qf[ks], p1, 0, 0, 0);
    }
}
__device__ __forceinline__ s16x4 vtr(const LAS unsigned char* p) { return __builtin_bit_cast(s16x4, __builtin_amdgcn_ds_read_tr16_b64_v4i16((LAS s16x4*)p)); }
__device__ __forceinline__ void pv(f32x16& o0, f32x16& o1, const f32x16& p0, const f32x16& p1, const LAS unsigned char* Vb, int lane) {
    const int hi = lane >> 5;
    const LAS unsigned char* vp = Vb + ((lane >> 4) & 1) * 32 + (lane & 3) * 8 + (4 * hi + ((lane & 15) >> 2)) * 64;
#pragma unroll
    for (int S = 0; S < 4; ++S) {
        u32x4 pw;
#pragma unroll
        for (int jj = 0; jj < 4; ++jj) { const int r = 8 * (S & 1) + 2 * jj; pw[jj] = (S < 2) ? pk2(p0[r], p0[r + 1]) : pk2(p1[r], p1[r + 1]); }
        const bf16x8 pf = __builtin_bit_cast(bf16x8, pw);
#pragma unroll
        for (int dh = 0; dh < 2; ++dh) {
            const s16x4 lo = vtr(vp + dh * 4096 + S * 1024), hh = vtr(vp + dh * 4096 + S * 1024 + 512);
            const bf16x8 vf = (bf16x8){lo[0], lo[1], lo[2], lo[3], hh[0], hh[1], hh[2], hh[3]};
            if (dh == 0) o0 = __builtin_amdgcn_mfma_f32_32x32x16_bf16(vf, pf, o0, 0, 0, 0); else o1 = __builtin_amdgcn_mfma_f32_32x32x16_bf16(vf, pf, o1, 0, 0, 0);
        }
    }
}
template <int PS, bool ALIBI, bool CAUS, bool WLOW, bool ROWEN>
__device__ __forceinline__ void transform(f32x16& p0, f32x16& p1, float c1, float c2, float tbf, bool en) {
#pragma unroll
    for (int r = 0; r < 16; ++r) {
        const float k0 = (float)(PS * ((r & 3) + 8 * (r >> 2))), k1 = (float)(PS * (32 + (r & 3) + 8 * (r >> 2)));
        const float d0 = tbf - k0, d1 = tbf - k1;
        float s0 = p0[r] * c1, s1 = p1[r] * c1;
        if (ALIBI) { s0 -= c2 * d0; s1 -= c2 * d1; }
        bool v0 = true, v1 = true;
        if (CAUS) { v0 = v0 && (d0 >= 0.f); v1 = v1 && (d1 >= 0.f); }
        if (WLOW) { v0 = v0 && (d0 < 512.f); v1 = v1 && (d1 < 512.f); }
        if (ROWEN) { v0 = v0 && en; v1 = v1 && en; }
        p0[r] = v0 ? s0 : -1e30f; p1[r] = v1 ? s1 : -1e30f;
    }
}
__device__ __forceinline__ float tile_max(const f32x16& p0, const f32x16& p1) {
    float a = fmaxf(p0[0], p1[0]);
#pragma unroll
    for (int r = 1; r < 16; ++r) a = fmaxf(a, fmaxf(p0[r], p1[r]));
    return fmaxf(a, xhalf(a));
}
__device__ __forceinline__ void softmax_pv(f32x16& p0, f32x16& p1, float& m, float& l, f32x16& o0, f32x16& o1, const LAS unsigned char* Vb, int lane) {
    const float mn = fmaxf(m, tile_max(p0, p1));
    if (__any(mn > m)) { const float alpha = __builtin_amdgcn_exp2f(m - mn); l *= alpha; o0 *= alpha; o1 *= alpha; m = mn; }
    const float mu = fmaxf(m, -1e20f);
    float s = 0.f;
#pragma unroll
    for (int r = 0; r < 16; ++r) { p0[r] = __builtin_amdgcn_exp2f(p0[r] - mu); p1[r] = __builtin_amdgcn_exp2f(p1[r] - mu); s += p0[r] + p1[r]; }
    l += s;
    pv(o0, o1, p0, p1, Vb, lane);
}
template <bool FIRST> __device__ __forceinline__ void fold(LAS float* fb, const f32x16& o0, const f32x16& o1, float sc, int lane) {
#pragma unroll
    for (int r = 0; r < 16; ++r) { const float a = o0[r] * sc, b = o1[r] * sc; if (FIRST) { fb[r * 64 + lane] = a; fb[(16 + r) * 64 + lane] = b; } else { fb[r * 64 + lane] += a; fb[(16 + r) * 64 + lane] += b; } }
}
__device__ __forceinline__ void store_o(bf16_t* dst  , const f32x16& f0, const f32x16& f1, int hi) {
#pragma unroll
    for (int dh = 0; dh < 2; ++dh)
#pragma unroll
        for (int a = 0; a < 4; ++a) { const f32x16& f = dh ? f1 : f0; u32x2 w; w.x = pk2(f[4 * a], f[4 * a + 1]); w.y = pk2(f[4 * a + 2], f[4 * a + 3]); *(u32x2*)(dst + 32 * dh + 8 * a + 4 * hi) = w; }
}
}

__device__ __forceinline__ void phase_nsa_attn(const Params& p, LAS unsigned char* lds) {
    using namespace att;
    const int tid0 = threadIdx.x, wave = __builtin_amdgcn_readfirstlane(tid0 >> 6);
    const bf16_t* Q = (const bf16_t*)(p.ws + S_Q); const bf16_t* KV6 = (const bf16_t*)(p.ws + S_KV6);
    const bf16_t* KS = KV6 + (size_t)2 * NTOK * 256; const bf16_t* VS = KV6 + (size_t)3 * NTOK * 256; const bf16_t* KW = KV6 + (size_t)4 * NTOK * 256; const bf16_t* VW = KV6 + (size_t)5 * NTOK * 256;
    const bf16_t* KC = (const bf16_t*)(p.ws + S_KCMP); const bf16_t* VC = (const bf16_t*)(p.ws + S_VCMP);
    const float* GATES = (const float*)(p.ws + S_GATES); bf16_t* AO = (bf16_t*)(p.ws + S_AO);
    LAS unsigned char* Kb0 = lds + OFF_K; LAS unsigned char* Vb0 = lds + OFF_V;
    LAS float* impM = (LAS float*)(lds + OFF_IMPM) + wave * 512; LAS float* impS = (LAS float*)(lds + OFF_IMPS) + wave * 576;
    LAS unsigned char* selb = lds + OFF_SELB + wave * 64; LAS unsigned long long* uni = (LAS unsigned long long*)(lds + OFF_UNION);
    const float c1 = 0.125f * LOG2E;
    const int vcu = blockIdx.x;
#pragma unroll 1
    for (int ui = 0; ui < 8; ++ui) {
        int tid = tid0; asm volatile("" : "+v"(tid));
        const int lane = tid & 63, q = lane & 31, hi = lane >> 5, tl = q & 7, rh = q >> 3;
        const unsigned koff = (unsigned)((tid >> 3) * 256 + (tid & 7) * 8) * 2u;
        const int pair = vcu >> 3, kk = vcu & 7, b = pair >> 2, g = pair & 3;
        const int tile = (ui >> 1) * 16 + ((ui & 1) ? 15 - kk : kk);
        const int q0 = tile * 64, t = q0 + 8 * wave + tl, head = 4 * g + rh;
        const size_t row = (size_t)b * SEQ + t;
        const float c2 = exp2f(-0.5f * (float)(head + 1)) * LOG2E;
        bf16x8 qf[4];
#pragma unroll
        for (int ks = 0; ks < 4; ++ks) qf[ks] = *(const bf16x8*)(Q + row * 1024 + head * 64 + ks * 16 + hi * 8);
        const float gc = GATES[row * 48 + head * 3 + 0], gs = GATES[row * 48 + head * 3 + 1], gwd = GATES[row * 48 + head * 3 + 2];
        LAS float* fb = (LAS float*)(lds + OFF_FIN) + wave * 2048;
        TileRegs R;
        for (int i = lane; i < 512; i += 64) impM[i] = 0.f;
        for (int i = lane; i < 576; i += 64) impS[i] = 0.f;
        if (tid0 == 0) *uni = 0ull;
        const int nc = (4 * tile + 3 < 255) ? 4 * tile + 3 : 255, ntc = (nc + 63) >> 6;
        const bf16_t* kcb = KC + ((size_t)b * 256 * 4 + g) * 64; const bf16_t* vcb = VC + ((size_t)b * 256 * 4 + g) * 64;
        float m = -1e30f, l = 0.f;
#pragma unroll 1
        for (int pass = 0; pass < 2; ++pass) {
            f32x16 o0, o1;
#pragma unroll
            for (int r = 0; r < 16; ++r) { o0[r] = 0.f; o1[r] = 0.f; }
            const float ltc = l + xhalf(l); const float invl = (ltc > 0.f) ? 1.f / ltc : 0.f;
            tile_load<false>(R, kcb, nullptr, vcb, koff, koff, 0u, tid);
#pragma unroll 1
            for (int T = 0; T < ntc; ++T) {
                LAS unsigned char* Kb = Kb0 + (T & 1) * KBUF; LAS unsigned char* Vb = Vb0 + (T & 1) * VBUF;
                tile_store<false, KSTR64>(R, Kb, Vb, tid);
                __syncthreads();
                if (T + 1 < ntc) tile_load<false>(R, kcb + (size_t)(T + 1) * 64 * 256, nullptr, vcb + (size_t)(T + 1) * 64 * 256, koff, koff, 0u, tid);
                f32x16 p0, p1;
                qk<4, KSTR64>(p0, p1, Kb, qf, lane);
                const float tbf = (float)(t - (16 * 64 * T + 31) - 64 * hi);
                transform<16, true, true, false, false>(p0, p1, c1, c2, tbf, true);
                if (pass == 0) {
                    const float mn = fmaxf(m, tile_max(p0, p1)); const float alpha = __builtin_amdgcn_exp2f(m - mn); const float mu = fmaxf(mn, -1e20f);
                    float s = 0.f;
#pragma unroll
                    for (int r = 0; r < 16; ++r) s += __builtin_amdgcn_exp2f(p0[r] - mu) + __builtin_amdgcn_exp2f(p1[r] - mu);
                    l = l * alpha + s; m = mn;
                } else {
                    const float mu = fmaxf(m, -1e20f);
#pragma unroll
                    for (int r = 0; r < 16; ++r) { p0[r] = __builtin_amdgcn_exp2f(p0[r] - mu); p1[r] = __builtin_amdgcn_exp2f(p1[r] - mu); }
#pragma unroll
                    for (int kbk = 0; kbk < 2; ++kbk)
#pragma unroll
                        for (int a = 0; a < 4; ++a) {
                            const f32x16& pp = kbk ? p1 : p0;
                            float mainv = (pp[4 * a] + pp[4 * a + 1] + pp[4 * a + 2] + 0.5f * pp[4 * a + 3]) * invl, spill = 0.5f * pp[4 * a + 3] * invl;
                            mainv += __shfl_xor(mainv, 8); mainv += __shfl_xor(mainv, 16); spill += __shfl_xor(spill, 8); spill += __shfl_xor(spill, 16);
                            const int jb = 16 * T + 8 * kbk + 2 * a + hi;
                            if (rh == 0) { impM[tl * 64 + jb] = mainv; impS[tl * 72 + jb + 1] = spill; }
                            __builtin_amdgcn_sched_barrier(0);
                        }
                    pv(o0, o1, p0, p1, Vb, lane);
                }
            }
            if (pass == 1) fold<true>(fb, o0, o1, gc * invl, lane);
            __syncthreads();
        }
        const int blk = tile;
        unsigned long long mymask;
        if (blk < 16) { mymask = (2ull << blk) - 1ull; }
        else {
            LDS_FENCE();
            const int stl = lane >> 3, sub = lane & 7;
            float mv[8]; int rk[8];
#pragma unroll
            for (int i = 0; i < 8; ++i) { const int j = sub * 8 + i; mv[i] = impM[stl * 64 + j] + impS[stl * 72 + j]; rk[i] = 0; }
#pragma unroll 1
            for (int j2 = 1; j2 < blk - 1; ++j2) {
                const float v2 = impM[stl * 64 + j2] + impS[stl * 72 + j2];
#pragma unroll
                for (int i = 0; i < 8; ++i) { const int j = sub * 8 + i; rk[i] += (v2 > mv[i] || (v2 == mv[i] && j2 < j)) ? 1 : 0; }
            }
            unsigned bits = 0;
#pragma unroll
            for (int i = 0; i < 8; ++i) { const int j = sub * 8 + i; const bool forced = (j == 0) || (j == blk) || (j == blk - 1); const bool sel = (j <= blk) && (forced || rk[i] < 13); bits |= sel ? (1u << i) : 0u; }
            selb[stl * 8 + sub] = (unsigned char)bits;
            LDS_FENCE();
            mymask = *(const LAS unsigned long long*)(selb + tl * 8);
        }
        { unsigned long long um = mymask;
#pragma unroll
          for (int o = 1; o < 8; o <<= 1) { const unsigned lo = __shfl_xor((unsigned)um, o), hh = __shfl_xor((unsigned)(um >> 32), o); um |= ((unsigned long long)hh << 32) | lo; }
          if (lane == 0) atomicOr((unsigned long long*)uni, um); }
        __syncthreads();
        const unsigned long long umask = *uni;
        {
            f32x16 o0, o1;
#pragma unroll
            for (int r = 0; r < 16; ++r) { o0[r] = 0.f; o1[r] = 0.f; }
            m = -1e30f; l = 0.f;
            const bf16_t* kb_ = KS + ((size_t)b * SEQ) * 256 + g * 64; const bf16_t* vb_ = VS + ((size_t)b * SEQ) * 256 + g * 64;
            unsigned long long rem = umask; int it = 0;
            int j = 63 - __builtin_clzll(rem); rem &= ~(1ull << j);
            tile_load<false>(R, kb_ + (size_t)j * 64 * 256, nullptr, vb_ + (size_t)j * 64 * 256, koff, koff, 0u, tid);
#pragma unroll 1
            for (;;) {
                LAS unsigned char* Kb = Kb0 + (it & 1) * KBUF; LAS unsigned char* Vb = Vb0 + (it & 1) * VBUF;
                tile_store<false, KSTR64>(R, Kb, Vb, tid);
                __syncthreads();
                const int jn = rem ? 63 - __builtin_clzll(rem) : -1;
                if (jn >= 0) { rem &= ~(1ull << jn); tile_load<false>(R, kb_ + (size_t)jn * 64 * 256, nullptr, vb_ + (size_t)jn * 64 * 256, koff, koff, 0u, tid); }
                const bool en = (mymask >> j) & 1ull;
                if (__any(en)) {
                    f32x16 p0, p1;
                    qk<4, KSTR64>(p0, p1, Kb, qf, lane);
                    const float tbf = (float)(t - 64 * j - 4 * hi);
                    if (j == blk) transform<1, true, true, false, true>(p0, p1, c1, c2, tbf, en); else transform<1, true, false, false, true>(p0, p1, c1, c2, tbf, en);
                    softmax_pv(p0, p1, m, l, o0, o1, Vb, lane);
                }
                if (jn < 0) break;
                j = jn; ++it;
            }
            const float lt = l + xhalf(l);
            fold<false>(fb, o0, o1, (lt > 0.f) ? gs / lt : 0.f, lane);
            __syncthreads();
        }
        {
            f32x16 o0, o1;
#pragma unroll
            for (int r = 0; r < 16; ++r) { o0[r] = 0.f; o1[r] = 0.f; }
            m = -1e30f; l = 0.f;
            const bf16_t* kb_ = KW + ((size_t)b * SEQ) * 256 + g * 64; const bf16_t* vb_ = VW + ((size_t)b * SEQ) * 256 + g * 64;
            const int jlo = (blk - 8 > 0) ? blk - 8 : 0;
            tile_load<false>(R, kb_ + (size_t)blk * 64 * 256, nullptr, vb_ + (size_t)blk * 64 * 256, koff, koff, 0u, tid);
#pragma unroll 1
            for (int j = blk, it = 0; j >= jlo; --j, ++it) {
                LAS unsigned char* Kb = Kb0 + (it & 1) * KBUF; LAS unsigned char* Vb = Vb0 + (it & 1) * VBUF;
                tile_store<false, KSTR64>(R, Kb, Vb, tid);
                __syncthreads();
                if (j > jlo) tile_load<false>(R, kb_ + (size_t)(j - 1) * 64 * 256, nullptr, vb_ + (size_t)(j - 1) * 64 * 256, koff, koff, 0u, tid);
                f32x16 p0, p1;
                qk<4, KSTR64>(p0, p1, Kb, qf, lane);
                const float tbf = (float)(t - 64 * j - 4 * hi);
                if (j == blk) transform<1, true, true, false, false>(p0, p1, c1, c2, tbf, true);
                else if (j == blk - 8) transform<1, true, false, true, false>(p0, p1, c1, c2, tbf, true);
                else transform<1, true, false, false, false>(p0, p1, c1, c2, tbf, true);
                softmax_pv(p0, p1, m, l, o0, o1, Vb, lane);
            }
            const float lt = l + xhalf(l);
            const float scw = (lt > 0.f) ? gwd / lt : 0.f;
#pragma unroll
            for (int r = 0; r < 16; ++r) { o0[r] = o0[r] * scw + fb[r * 64 + lane]; o1[r] = o1[r] * scw + fb[(16 + r) * 64 + lane]; }
            store_o(AO + row * 1024 + head * 64, o0, o1, hi);
            __syncthreads();
        }
    }
}

__device__ __forceinline__ void phase_mla_attn(const Params& p, LAS unsigned char* lds) {
    using namespace att;
    const int tid0 = threadIdx.x, wave = __builtin_amdgcn_readfirstlane(tid0 >> 6);
    const bf16_t* QF = (const bf16_t*)(p.ws + S_QF); const bf16_t* KN = (const bf16_t*)(p.ws + S_KNOPE); const bf16_t* KR = (const bf16_t*)(p.ws + S_KROPE); const bf16_t* V = (const bf16_t*)(p.ws + S_V);
    const float* rc = (const float*)(p.ws + WS_ROPE_COS); const float* rs = (const float*)(p.ws + WS_ROPE_SIN);
    bf16_t* AO = (bf16_t*)(p.ws + S_AO2);
    LAS unsigned char* Kb0 = lds + OFF_K; LAS unsigned char* Vb0 = lds + OFF_V;
    const float c1 = 0.10206207261596577f * LOG2E;
    const int vcu = blockIdx.x;
#pragma unroll 1
    for (int ui = 0; ui < 8; ++ui) {
        int tid = tid0; asm volatile("" : "+v"(tid));
        const int lane = tid & 63, q = lane & 31, hi = lane >> 5;
        const unsigned koff = (unsigned)((tid >> 3) * 1024 + (tid & 7) * 8) * 2u, roff = (unsigned)((tid >> 2) * 32 + (tid & 3) * 8) * 2u;
        const int bh = vcu >> 1, b = bh >> 4, h = bh & 15, par = vcu & 1;
        const int qb = (ui & 1) ? 15 - (ui - 1) - par : ui + par;
        const int t = 256 * qb + 32 * wave + q; const size_t row = (size_t)b * SEQ + t;
        bf16x8 qf[6];
        { const bf16_t* qrow = QF + row * 1536 + h * 96;
#pragma unroll
          for (int ks = 0; ks < 4; ++ks) qf[ks] = *(const bf16x8*)(qrow + ks * 16 + hi * 8);
          const u32x4 x1 = *(const u32x4*)(qrow + 64 + hi * 8), x2 = *(const u32x4*)(qrow + 80 + hi * 8);
          const f32x4 ca = *(const f32x4*)(rc + t * 16 + hi * 8), cb = *(const f32x4*)(rc + t * 16 + hi * 8 + 4), sa = *(const f32x4*)(rs + t * 16 + hi * 8), sb = *(const f32x4*)(rs + t * 16 + hi * 8 + 4);
          const float a1[8] = {bf_lo(x1.x), bf_hi(x1.x), bf_lo(x1.y), bf_hi(x1.y), bf_lo(x1.z), bf_hi(x1.z), bf_lo(x1.w), bf_hi(x1.w)};
          const float a2[8] = {bf_lo(x2.x), bf_hi(x2.x), bf_lo(x2.y), bf_hi(x2.y), bf_lo(x2.z), bf_hi(x2.z), bf_lo(x2.w), bf_hi(x2.w)};
          const float cc[8] = {ca.x, ca.y, ca.z, ca.w, cb.x, cb.y, cb.z, cb.w}, ss[8] = {sa.x, sa.y, sa.z, sa.w, sb.x, sb.y, sb.z, sb.w};
          u32x4 w1, w2;
#pragma unroll
          for (int jj = 0; jj < 4; ++jj) { const int e = 2 * jj;
              w1[jj] = pk2(a1[e] * cc[e] - a2[e] * ss[e], a1[e + 1] * cc[e + 1] - a2[e + 1] * ss[e + 1]);
              w2[jj] = pk2(a2[e] * cc[e] + a1[e] * ss[e], a2[e + 1] * cc[e + 1] + a1[e + 1] * ss[e + 1]); }
          qf[4] = __builtin_bit_cast(bf16x8, w1); qf[5] = __builtin_bit_cast(bf16x8, w2); }
        f32x16 o0, o1;
#pragma unroll
        for (int r = 0; r < 16; ++r) { o0[r] = 0.f; o1[r] = 0.f; }
        float m = -1e30f, l = 0.f;
        const bf16_t* knb = KN + ((size_t)b * SEQ) * 1024 + h * 64; const bf16_t* krb = KR + ((size_t)b * SEQ) * 32; const bf16_t* vb_ = V + ((size_t)b * SEQ) * 1024 + h * 64;
        const int nt = 4 * qb + 4; const int tmin = 256 * qb + 32 * wave;
        TileRegs R;
        tile_load<true>(R, knb, krb, vb_, koff, koff, roff, tid);
#pragma unroll 1
        for (int j = 0; j < nt; ++j) {
            LAS unsigned char* Kb = Kb0 + (j & 1) * KBUF; LAS unsigned char* Vb = Vb0 + (j & 1) * VBUF;
            tile_store<true, KSTR96>(R, Kb, Vb, tid);
            __syncthreads();
            if (j + 1 < nt) tile_load<true>(R, knb + (size_t)(j + 1) * 64 * 1024, krb + (size_t)(j + 1) * 64 * 32, vb_ + (size_t)(j + 1) * 64 * 1024, koff, koff, roff, tid);
            if (64 * j <= tmin + 31) {
                f32x16 p0, p1;
                qk<6, KSTR96>(p0, p1, Kb, qf, lane);
                const float tbf = (float)(t - 64 * j - 4 * hi);
                if (64 * j + 63 > tmin) transform<1, false, true, false, false>(p0, p1, c1, 0.f, tbf, true); else transform<1, false, false, false, false>(p0, p1, c1, 0.f, tbf, true);
                softmax_pv(p0, p1, m, l, o0, o1, Vb, lane);
            }
        }
        const float lt = l + xhalf(l); const float il = 1.f / lt;
        o0 *= il; o1 *= il;
        store_o(AO + row * 1024 + h * 64, o0, o1, hi);
        __syncthreads();
    }
}

__device__ __forceinline__ float pack_idx(float v, unsigned bits, unsigned mask) { return __uint_as_float((__float_as_uint(v) & ~mask) | bits); }
__device__ __forceinline__ void phase_peer_route_ref(const Params& p, LAS unsigned char* lds, int layer, const bf16_t* QP, int* EIDX, float* GW) {
    const int lane = threadIdx.x & 63, wave = threadIdx.x >> 6;
    const int gw = blockIdx.x * NWAVES + wave, NGW = gridDim.x * NWAVES;
    LAS float* qs = (LAS float*)(lds + wave * 1024);
    const bf16_t* SK = (const bf16_t*)(p.ws + WS_SUBK) + (size_t)layer * 8 * 2 * 128 * 128;
    for (int item = gw; item < NTOK * 8; item += NGW) {
        const int h = item & 7, t = item >> 3;
        LDS_FENCE();
        { const u32x2 qv = *(const u32x2*)(QP + (size_t)t * 2048 + h * 256 + lane * 4); *(LAS f32x4*)(qs + lane * 4) = (f32x4){bf_lo(qv.x), bf_hi(qv.x), bf_lo(qv.y), bf_hi(qv.y)}; }
        LDS_FENCE();
        float sv[2];
#pragma unroll
        for (int c = 0; c < 2; ++c) {
            float v[2];
#pragma unroll
            for (int kk = 0; kk < 2; ++kk) {
                const int key = lane + 64 * kk; const bf16_t* krow = SK + ((size_t)(h * 2 + c) * 128 + key) * 128;
                float acc = 0.f;
#pragma unroll 4
                for (int d8 = 0; d8 < 16; ++d8) { const u32x4 kv = *(const u32x4*)(krow + d8 * 8); const f32x4 q0 = *(const LAS f32x4*)(qs + c * 128 + d8 * 8), q1 = *(const LAS f32x4*)(qs + c * 128 + d8 * 8 + 4);
                    acc += q0.x * bf_lo(kv.x) + q0.y * bf_hi(kv.x) + q0.z * bf_lo(kv.y) + q0.w * bf_hi(kv.y) + q1.x * bf_lo(kv.z) + q1.y * bf_hi(kv.z) + q1.z * bf_lo(kv.w) + q1.w * bf_hi(kv.w); }
                v[kk] = pack_idx(acc, 127u - (unsigned)key, 127u);
            }
            float mine = 0.f;
#pragma unroll 1
            for (int n = 0; n < 16; ++n) { const float w = wave_max(fmaxf(v[0], v[1])); if (v[0] == w) v[0] = -INFINITY; if (v[1] == w) v[1] = -INFINITY; if (lane == n) mine = w; }
            sv[c] = mine;
        }
        const int a = lane & 15, bq = lane >> 4;
        const float s0 = __shfl(sv[0], a);
        float cv[4];
#pragma unroll
        for (int i = 0; i < 4; ++i) { const float s1 = __shfl(sv[1], 4 * bq + i); cv[i] = pack_idx(s0 + s1, 255u - (unsigned)(a * 16 + 4 * bq + i), 255u); }
        float cs = 0.f;
#pragma unroll 1
        for (int n = 0; n < 16; ++n) { const float w = wave_max(fmaxf(fmaxf(cv[0], cv[1]), fmaxf(cv[2], cv[3])));
#pragma unroll
            for (int i = 0; i < 4; ++i) if (cv[i] == w) cv[i] = -INFINITY;
            if (lane == n) cs = w; }
        const unsigned flat = 255u - (__float_as_uint(cs) & 255u);
        const int wa = (int)(flat >> 4) & 15, wb = (int)flat & 15;
        const unsigned i0 = 127u - (__float_as_uint(__shfl(sv[0], wa)) & 127u), i1 = 127u - (__float_as_uint(__shfl(sv[1], wb)) & 127u);
        const float mx = __shfl(cs, 0);
        const float ex = (lane < 16) ? __expf(cs - mx) : 0.f;
        const float sum = wave_sum(ex);
        if (lane < 16) { EIDX[(size_t)t * 128 + h * 16 + lane] = (int)(i0 * 128u + i1); GW[(size_t)t * 128 + h * 16 + lane] = ex / sum; }
    }
}

__device__ __forceinline__ float dot2bf(unsigned a, unsigned b, float acc) {
    float r; asm("v_dot2c_f32_bf16 %0, %1, %2" : "=v"(r) : "v"(a), "v"(b), "0"(acc)); return r;
}
__device__ __forceinline__ float dot8(const u32x4& a, const u32x4& b, float acc) {
    acc = dot2bf(a.x, b.x, acc); acc = dot2bf(a.y, b.y, acc); acc = dot2bf(a.z, b.z, acc); acc = dot2bf(a.w, b.w, acc);
    return acc;
}
__device__ __forceinline__ void axpy8(float* o, const u32x4& v, float w) {
    o[0] += w * bf_lo(v.x); o[1] += w * bf_hi(v.x); o[2] += w * bf_lo(v.y); o[3] += w * bf_hi(v.y); o[4] += w * bf_lo(v.z); o[5] += w * bf_hi(v.z); o[6] += w * bf_lo(v.w); o[7] += w * bf_hi(v.w);
}
__device__ __forceinline__ void phase_peer_gather(const Params& p, int layer, const int* EIDX, const float* GW, const bf16_t* HB, bf16_t* HBO, float* OUT, float fs) {
    const int lane = threadIdx.x & 63, wave = threadIdx.x >> 6;
    const int gw = blockIdx.x * NWAVES + wave, NGW = gridDim.x * NWAVES;
    const bf16_t* U = (const bf16_t*)(p.ws + WS_TAB + (size_t)layer * 64 * MiB); const bf16_t* Vt = U + (size_t)NEXP * DM;
    const float* lg = p.in[I_PEER_LNG] + layer * 1024; const float* lb = p.in[I_PEER_LNB] + layer * 1024;
    for (int t = gw; t < NTOK; t += NGW) {
        const u32x4 x0 = *(const u32x4*)(HB + (size_t)t * 1024 + lane * 8), x1 = *(const u32x4*)(HB + (size_t)t * 1024 + 512 + lane * 8);
        const int e0 = EIDX[(size_t)t * 128 + lane], e1 = EIDX[(size_t)t * 128 + 64 + lane];
        const float g0 = GW[(size_t)t * 128 + lane], g1 = GW[(size_t)t * 128 + 64 + lane];
        float o[16];
#pragma unroll
        for (int i = 0; i < 16; ++i) o[i] = 0.f;
#if DBG_STAT
        float dstat = 0.f;
        if (DBG_STAT == 2) { int dups = 0;
            for (int sft = 1; sft < 16; ++sft) { const int src = (lane & ~15) | ((lane + sft) & 15); dups += (e0 == __shfl(e0, src)) + (e1 == __shfl(e1, src)); }
            dstat = wave_sum((float)dups) * (1.f / 8.f); }
        if (DBG_STAT == 3) dstat = wave_sum(g0 * g0 + g1 * g1) * (1.f / 8.f);
        if (DBG_STAT == 4) dstat = wave_sum(g0 + g1) * (1.f / 8.f);
        if (DBG_STAT == 5) { const int b0 = (e0 < 0 || e0 >= 16384) + (e1 < 0 || e1 >= 16384); dstat = wave_sum((float)b0); }
#endif
#pragma unroll 1
        for (int kb = 0; kb < 128; kb += 4) {
            int e[4]; float gg[4];
#pragma unroll
            for (int i = 0; i < 4; ++i) { const int k = kb + i; e[i] = (kb < 64) ? __shfl(e0, k) : __shfl(e1, k - 64); gg[i] = (kb < 64) ? __shfl(g0, k) : __shfl(g1, k - 64); }
            u32x4 ua[4], ub[4], va[4], vb[4];
#pragma unroll
            for (int i = 0; i < 4; ++i) { const bf16_t* ur = U + (size_t)e[i] * 1024 + lane * 8; const bf16_t* vr = Vt + (size_t)e[i] * 1024 + lane * 8;
                ua[i] = *(const u32x4*)ur; ub[i] = *(const u32x4*)(ur + 512); va[i] = *(const u32x4*)vr; vb[i] = *(const u32x4*)(vr + 512); }
#pragma unroll
            for (int i = 0; i < 4; ++i) {
                float d = dot8(ua[i], x0, 0.f); d = dot8(ub[i], x1, d); d = wave_sum(d);
                const float w = gg[i] * gelu_tanh(d);
#if DBG_STAT
                if (DBG_STAT == 1) dstat += gelu_tanh(d) * gelu_tanh(d) * (1.f / 128.f);
                if (DBG_STAT == 6) dstat += d * d * (1.f / 128.f);
#endif
                axpy8(o, va[i], w); axpy8(o + 8, vb[i], w);
            }
        }
#if DBG_STAT
        if (layer == 0 && lane == 0) atomicAdd((float*)(p.ws + WS_CTL) + 16, dstat * (1.f / NTOK));
#endif
        float z[16] = {bf_lo(x0.x), bf_hi(x0.x), bf_lo(x0.y), bf_hi(x0.y), bf_lo(x0.z), bf_hi(x0.z), bf_lo(x0.w), bf_hi(x0.w), bf_lo(x1.x), bf_hi(x1.x), bf_lo(x1.y), bf_hi(x1.y), bf_lo(x1.z), bf_hi(x1.z), bf_lo(x1.w), bf_hi(x1.w)};
        float s = 0.f;
#pragma unroll
        for (int i = 0; i < 16; ++i) { z[i] = DN_ALPHA * z[i] + fs * o[i]; s += z[i]; }
        const float mean = wave_sum(s) * (1.f / 1024.f); float q = 0.f;
#pragma unroll
        for (int i = 0; i < 16; ++i) { z[i] -= mean; q += z[i] * z[i]; }
        const float rstd = rsqrtf(wave_sum(q) * (1.f / 1024.f) + LN_EPS);
#pragma unroll
        for (int hh = 0; hh < 2; ++hh) { const int c0 = hh * 512 + lane * 8; const f32x4 ga = *(const f32x4*)(lg + c0), gb = *(const f32x4*)(lg + c0 + 4), ba = *(const f32x4*)(lb + c0), bb = *(const f32x4*)(lb + c0 + 4);
#pragma unroll
            for (int i = 0; i < 4; ++i) { z[hh * 8 + i] = z[hh * 8 + i] * rstd * ga[i] + ba[i]; z[hh * 8 + 4 + i] = z[hh * 8 + 4 + i] * rstd * gb[i] + bb[i]; } }
        if (OUT) {
#pragma unroll
            for (int hh = 0; hh < 2; ++hh) { float* op = OUT + (size_t)t * 1024 + hh * 512 + lane * 8; *(f32x4*)op = (f32x4){z[hh * 8], z[hh * 8 + 1], z[hh * 8 + 2], z[hh * 8 + 3]}; *(f32x4*)(op + 4) = (f32x4){z[hh * 8 + 4], z[hh * 8 + 5], z[hh * 8 + 6], z[hh * 8 + 7]}; }
        } else {
            u32x4 w0, w1; w0.x = pk2(z[0], z[1]); w0.y = pk2(z[2], z[3]); w0.z = pk2(z[4], z[5]); w0.w = pk2(z[6], z[7]); w1.x = pk2(z[8], z[9]); w1.y = pk2(z[10], z[11]); w1.z = pk2(z[12], z[13]); w1.w = pk2(z[14], z[15]);
            *(u32x4*)(HBO + (size_t)t * 1024 + lane * 8) = w0; *(u32x4*)(HBO + (size_t)t * 1024 + 512 + lane * 8) = w1;
        }
    }
}

constexpr int NPHASES = 19;
__global__ void __launch_bounds__(NTHREADS, 2) fwd_kernel(Params p) {
    extern __shared__ __attribute__((aligned(16))) unsigned char lds_raw[];
    LAS unsigned char* lds = (LAS unsigned char*)lds_raw;
    unsigned char* ws = p.ws;
    bf16_t* HB = (bf16_t*)(ws + WS_HB);
    const int lo = p.ph_lo, hi = p.ph_hi;
#ifndef PH_MASK
#define PH_MASK 0xFFFFFFFFu
#endif
#define IN(k) (((PH_MASK >> (k)) & 1u) && lo <= (k) && (k) < hi)
#define SEAM(k) do { if (IN(k) && IN((k) + 1)) { asm volatile("s_waitcnt vmcnt(0) lgkmcnt(0)" ::: "memory"); __builtin_amdgcn_fence(__ATOMIC_RELEASE, "agent"); asm volatile("s_waitcnt vmcnt(0)" ::: "memory"); \
        cg::this_grid().sync(); __builtin_amdgcn_fence(__ATOMIC_ACQUIRE, "agent"); asm volatile("s_waitcnt vmcnt(0)" ::: "memory"); __syncthreads(); } } while (0)
    if (IN(0)) { phase_prologue(p, lds); } SEAM(0);
    if (IN(1)) { EpiNsaProj E{(bf16_t*)(ws + S_Q), (bf16_t*)(ws + S_KV6), (float*)(ws + S_GATES)};
        run_gemm(lds, HB, 1024, (const bf16_t*)(ws + WS_W_IN_T), 1024, NTOK, NSA_IN_PAD, 1024, (int)blockIdx.x, E); } SEAM(1);
    if (IN(2)) { EpiF32 Ek{(float*)(ws + S_PK), 256}, Ev{(float*)(ws + S_PV), 256};
        run_gemm(lds, (const bf16_t*)(ws + S_KV6), 1024, (const bf16_t*)(ws + WS_W_CK1_T), 1024, 8192, 256, 1024, (int)blockIdx.x, Ek);
        run_gemm(lds, (const bf16_t*)(ws + S_KV6) + (size_t)NTOK * 256, 1024, (const bf16_t*)(ws + WS_W_CV1_T), 1024, 8192, 256, 1024, (int)((blockIdx.x + gridDim.x / 2) % gridDim.x), Ev); } SEAM(2);
    if (IN(3)) { phase_cmp_finish(p, lds); } SEAM(3);
    if (IN(4)) { if (USE_MFMA_NSA) phase_nsa_attn(p, lds); else phase_nsa_attn_ref(p, lds); } SEAM(4);
    if (IN(5)) { EpiResid E{HB, (bf16_t*)(ws + S_Z), (ABL & 1) ? 0.f : 1.f};
        run_gemm(lds, (const bf16_t*)(ws + S_AO), 1024, (const bf16_t*)(ws + WS_W_NSAOUT_T), 1024, NTOK, 1024, 1024, (int)blockIdx.x, E); } SEAM(5);
    if (IN(6)) { phase_ln((const bf16_t*)(ws + S_Z), HB, p.in[I_NSA_LNG], p.in[I_NSA_LNB]); } SEAM(6);
    if (IN(7)) { EpiBf16 E{(bf16_t*)(ws + S_QP0), 2048};
        run_gemm(lds, HB, 1024, (const bf16_t*)(ws + WS_W_PQ_T), 1024, NTOK, 2048, 1024, (int)blockIdx.x, E); } SEAM(7);
    if (IN(8) && (PROBE_DUP & 1)) { phase_peer_route_ref(p, lds, 0, (const bf16_t*)(ws + S_QP0), (int*)(ws + S_EIDX0), (float*)(ws + S_GW0)); }
    if (IN(8)) { phase_peer_route_ref(p, lds, 0, (const bf16_t*)(ws + S_QP0), (int*)(ws + S_EIDX0), (float*)(ws + S_GW0)); } SEAM(8);
    if (IN(9) && (PROBE_DUP & 2)) { phase_peer_gather(p, 0, (const int*)(ws + S_EIDX0), (const float*)(ws + S_GW0), HB, (bf16_t*)(ws + S_Z), nullptr, 1.f); }
    if (IN(9)) { phase_peer_gather(p, 0, (const int*)(ws + S_EIDX0), (const float*)(ws + S_GW0), HB, HB, nullptr, (ABL & 2) ? 0.f : 1.f); } SEAM(9);
    if (IN(10)) { EpiBf16 E{(bf16_t*)(ws + S_DQ), MLA_DOWN_PAD};
        run_gemm(lds, HB, 1024, (const bf16_t*)(ws + WS_W_MLADOWN_T), 1024, NTOK, MLA_DOWN_PAD, 1024, (int)blockIdx.x, E); } SEAM(10);
    if (IN(11)) { phase_mla_rowstats(p); } SEAM(11);
    if (IN(12)) { EpiBf16 Eq{(bf16_t*)(ws + S_QF), 1536}; EpiKV Ekv{(bf16_t*)(ws + S_KNOPE), (bf16_t*)(ws + S_V)};
        run_gemm(lds, (const bf16_t*)(ws + S_DQ), MLA_DOWN_PAD, (const bf16_t*)(ws + WS_W_UQ_T), 768, NTOK, 1536, 768, (int)blockIdx.x, Eq);
        run_gemm(lds, (const bf16_t*)(ws + S_DQ) + 768, MLA_DOWN_PAD, (const bf16_t*)(ws + WS_W_UKV_T), 256, NTOK, 2048, 256, (int)blockIdx.x, Ekv); } SEAM(12);
    if (IN(13)) { if (USE_MFMA_MLA) phase_mla_attn(p, lds); else phase_mla_attn_ref(p, lds); } SEAM(13);
    if (IN(14)) { EpiResid E{HB, (bf16_t*)(ws + S_Z2), (ABL & 4) ? 0.f : 1.f};
        run_gemm(lds, (const bf16_t*)(ws + S_AO2), 1024, (const bf16_t*)(ws + WS_W_MLAOUT_T), 1024, NTOK, 1024, 1024, (int)blockIdx.x, E); } SEAM(14);
    if (IN(15)) { phase_ln((const bf16_t*)(ws + S_Z2), HB, p.in[I_MLA_LNG], p.in[I_MLA_LNB]); } SEAM(15);
    if (IN(16)) { EpiBf16 E{(bf16_t*)(ws + S_QP1), 2048};
        run_gemm(lds, HB, 1024, (const bf16_t*)(ws + WS_W_PQ_T) + (size_t)2048 * 1024, 1024, NTOK, 2048, 1024, (int)blockIdx.x, E); } SEAM(16);
    if (IN(17) && (PROBE_DUP & 1)) { phase_peer_route_ref(p, lds, 1, (const bf16_t*)(ws + S_QP1), (int*)(ws + S_EIDX1), (float*)(ws + S_GW1)); }
    if (IN(17)) { phase_peer_route_ref(p, lds, 1, (const bf16_t*)(ws + S_QP1), (int*)(ws + S_EIDX1), (float*)(ws + S_GW1)); } SEAM(17);
    if (IN(18) && (PROBE_DUP & 2)) { phase_peer_gather(p, 1, (const int*)(ws + S_EIDX1), (const float*)(ws + S_GW1), HB, (bf16_t*)(ws + S_Z2), nullptr, 1.f); }
    if (IN(18)) { phase_peer_gather(p, 1, (const int*)(ws + S_EIDX1), (const float*)(ws + S_GW1), HB, HB, p.out, (ABL & 8) ? 0.f : 1.f); }
#if DBG_STAT
    if (IN(18)) { asm volatile("s_waitcnt vmcnt(0) lgkmcnt(0)" ::: "memory"); __builtin_amdgcn_fence(__ATOMIC_RELEASE, "agent"); cg::this_grid().sync(); __builtin_amdgcn_fence(__ATOMIC_ACQUIRE, "agent");
        const float c = 1.f + __hip_atomic_load((float*)(ws + WS_CTL) + 16, __ATOMIC_RELAXED, __HIP_MEMORY_SCOPE_AGENT);
        for (size_t i = (size_t)blockIdx.x * NTHREADS + threadIdx.x; i < (size_t)NTOK * DM; i += (size_t)gridDim.x * NTHREADS) p.out[i] = c; }
#endif
#undef IN
#undef SEAM
}

extern "C" void kernel_launch(void* const* d_in, const int* in_sizes, int n_in, void* d_out, int out_size, void* d_ws, size_t ws_size, hipStream_t stream) {
    static int grid = 0;
    if (grid == 0) {
        if (n_in != 28 || out_size != NTOK * DM || ws_size < WS_NEED) { fprintf(stderr, "kernel_launch: unexpected problem (n_in %d, out %d, ws %zu)\n", n_in, out_size, ws_size); grid = -1; return; }
        int dev = 0, cus = 0, per_cu = 0;
        (void)hipGetDevice(&dev); (void)hipDeviceGetAttribute(&cus, hipDeviceAttributeMultiprocessorCount, dev);
        if (hipFuncSetAttribute((const void*)fwd_kernel, hipFuncAttributeMaxDynamicSharedMemorySize, LDS_BYTES) != hipSuccess) { fprintf(stderr, "kernel_launch: hipFuncSetAttribute failed\n"); grid = -1; return; }
        if (hipOccupancyMaxActiveBlocksPerMultiprocessor(&per_cu, (const void*)fwd_kernel, NTHREADS, LDS_BYTES) != hipSuccess || per_cu < 1) { fprintf(stderr, "kernel_launch: occupancy query says %d blocks per CU\n", per_cu); grid = -1; return; }
        grid = cus;
    }
    if (grid < 0) return;
    Params p{};
    for (int i = 0; i < 28; ++i) p.in[i] = (const float*)d_in[i];
    p.out = (float*)d_out; p.ws = (unsigned char*)d_ws;
#if MK_ONE_LAUNCH
    p.ph_lo = 0; p.ph_hi = NPHASES;
    void* args[] = {&p};
    hipError_t e = hipLaunchCooperativeKernel((const void*)fwd_kernel, dim3(grid), dim3(NTHREADS), args, LDS_BYTES, stream);
    if (e != hipSuccess) fprintf(stderr, "kernel_launch: cooperative launch failed: %s\n", hipGetErrorString(e));
#else
    for (int k = 0; k < NPHASES; ++k) { p.ph_lo = k; p.ph_hi = k + 1; hipLaunchKernelGGL(fwd_kernel, dim3(grid), dim3(NTHREADS), LDS_BYTES, stream, p); }
#endif
}
#ifdef REGTEST
__global__ void __launch_bounds__(256) regtest_nsa(Params p) { extern __shared__ __attribute__((aligned(16))) unsigned char l2[]; phase_nsa_attn(p, (LAS unsigned char*)l2); }
__global__ void __launch_bounds__(256) regtest_mla(Params p) { extern __shared__ __attribute__((aligned(16))) unsigned char l2[]; phase_mla_attn(p, (LAS unsigned char*)l2); }
#endif
```

```cpp
#include <hip/hip_runtime.h>
#include <hip/hip_cooperative_groups.h>
#include <cstdio>
#include <cstdint>
namespace cg = cooperative_groups;

#ifndef ABL
#define ABL 0
#endif
#ifndef PROBE_DUP
#define PROBE_DUP 0
#endif
#ifndef PROBE_REP
#define PROBE_REP -1
#endif
#ifndef PROBE_N
#define PROBE_N 2
#endif
#ifndef USE_MFMA_ROUTE
#define USE_MFMA_ROUTE 1
#endif
#ifndef USE_MFMA_NSA
#define USE_MFMA_NSA 1
#endif
#ifndef USE_MFMA_MLA
#define USE_MFMA_MLA 1
#endif
#ifndef DBG_STAT
#define DBG_STAT 0
#endif
#ifndef MK_ONE_LAUNCH
#define MK_ONE_LAUNCH 1
#endif

#define LAS __attribute__((address_space(3)))
typedef unsigned short bf16_t;
typedef short bf16x8 __attribute__((ext_vector_type(8)));
typedef float f32x4 __attribute__((ext_vector_type(4)));
typedef float f32x2 __attribute__((ext_vector_type(2)));
typedef unsigned u32x4 __attribute__((ext_vector_type(4)));
typedef unsigned u32x2 __attribute__((ext_vector_type(2)));
typedef __bf16 bf16x2_t __attribute__((ext_vector_type(2)));

constexpr int BATCH = 8, SEQ = 4096, DM = 1024, NTOK = BATCH * SEQ;
constexpr int NSA_IN = 2608, NSA_IN_PAD = 2816;
constexpr int MLA_DOWN = 1056, MLA_DOWN_PAD = 1280;
constexpr int NEXP = 16384;
constexpr float DN_ALPHA = 1.4142135623730951f;
constexpr float LN_EPS = 1e-5f, RMS_EPS = 1e-6f;
constexpr int NWAVES = 8, NTHREADS = 512;
constexpr int LDS_BYTES = 147456;

constexpr size_t KiB = 1024, MiB = 1024 * 1024;
constexpr size_t WS_CTL = 0, CTL_BYTES = 64 * KiB;
constexpr size_t WS_W_IN_T = 1 * MiB;
constexpr size_t WS_W_NSAOUT_T = 6 * MiB + 512 * KiB;
constexpr size_t WS_W_CK1_T = 8 * MiB + 512 * KiB;
constexpr size_t WS_W_CV1_T = 9 * MiB;
constexpr size_t WS_W_MLADOWN_T = 9 * MiB + 512 * KiB;
constexpr size_t WS_W_UQ_T = 12 * MiB;
constexpr size_t WS_W_UKV_T = 14 * MiB + 256 * KiB;
constexpr size_t WS_W_MLAOUT_T = 15 * MiB + 256 * KiB;
constexpr size_t WS_W_PQ_T = 17 * MiB + 256 * KiB;
constexpr size_t WS_SUBK = 25 * MiB + 256 * KiB;
constexpr size_t WS_MISC = 27 * MiB;
constexpr size_t WS_PE = WS_MISC;
constexpr size_t WS_ROPE_COS = WS_MISC + 4 * KiB;
constexpr size_t WS_ROPE_SIN = WS_ROPE_COS + 256 * KiB;
constexpr size_t WS_RSTD_Q = WS_ROPE_SIN + 256 * KiB;
constexpr size_t WS_RSTD_KV = WS_RSTD_Q + 128 * KiB;
constexpr size_t WS_TAB = 32 * MiB;
constexpr size_t WS_HB = 160 * MiB;
constexpr size_t WS_S = 224 * MiB;
constexpr size_t S_Q = WS_S;
constexpr size_t S_KV6 = WS_S + 64 * MiB;
constexpr size_t S_AO = WS_S + 160 * MiB;
constexpr size_t S_GATES = WS_S + 224 * MiB;
constexpr size_t S_PK = WS_S + 230 * MiB;
constexpr size_t S_PV = WS_S + 238 * MiB;
constexpr size_t S_KCMP = WS_S + 246 * MiB;
constexpr size_t S_VCMP = S_KCMP + 512 * KiB;
constexpr size_t S_Z = WS_S;
constexpr size_t S_QP0 = WS_S + 64 * MiB;
constexpr size_t S_EIDX0 = WS_S + 192 * MiB;
constexpr size_t S_GW0 = WS_S + 208 * MiB;
constexpr size_t S_DQ = WS_S;
constexpr size_t S_QF = WS_S + 80 * MiB;
constexpr size_t S_V = WS_S + 176 * MiB;
constexpr size_t S_KROPE = WS_S + 240 * MiB;
constexpr size_t S_KNOPE = WS_TAB;
constexpr size_t S_AO2 = WS_S;
constexpr size_t S_Z2 = WS_S + 80 * MiB;
constexpr size_t S_QP1 = WS_S + 144 * MiB;
constexpr size_t S_EIDX1 = WS_S;
constexpr size_t S_GW1 = WS_S + 16 * MiB;
constexpr size_t WS_NEED = 512 * MiB;
static_assert(S_QP1 + 128 * MiB <= WS_NEED && S_VCMP + 512 * KiB <= WS_NEED, "workspace map");

__device__ __forceinline__ float bf_lo(unsigned u) { return __uint_as_float(u << 16); }
__device__ __forceinline__ float bf_hi(unsigned u) { return __uint_as_float(u & 0xffff0000u); }
__device__ __forceinline__ float bf2f(bf16_t v) { return __uint_as_float((unsigned)v << 16); }
__device__ __forceinline__ unsigned pk2(float lo, float hi) { f32x2 v = {lo, hi}; bf16x2_t b = __builtin_convertvector(v, bf16x2_t); return __builtin_bit_cast(unsigned, b); }
__device__ __forceinline__ bf16_t f2bf(float f) { return (bf16_t)(pk2(f, 0.f) & 0xffffu); }
__device__ __forceinline__ float wave_sum(float v) {
#pragma unroll
    for (int o = 32; o >= 1; o >>= 1) v += __shfl_xor(v, o);
    return v;
}
__device__ __forceinline__ float wave_max(float v) {
#pragma unroll
    for (int o = 32; o >= 1; o >>= 1) v = fmaxf(v, __shfl_xor(v, o));
    return v;
}
__device__ __forceinline__ float gelu_tanh(float x) {
    const float y = 0.7978845608028654f * (x + 0.044715f * x * x * x);
    const float e = __expf(2.f * y);
    const float th = 1.f - 2.f / (1.f + e);
    return 0.5f * x * (1.f + th);
}
#define LDS_FENCE() asm volatile("s_waitcnt lgkmcnt(0)" ::: "memory")

namespace pg8 {
constexpr int BM = 256, BK = 64, HALF = 128, HTB = HALF * BK * 2, STAGE_BYTES = 8 * HTB, NXCD = 8, WGM = 8;
__host__ __device__ __forceinline__ int lds_byte(int r, int c) { const int st = (r >> 4) * 2 + (c >> 5), rr = r & 15, cc = c & 31, ob = rr * 64 + cc * 2; return st * 1024 + (ob ^ (((ob >> 9) & 1) << 5)); }
__host__ __device__ __forceinline__ void stage_rc(int b, int& R, int& C) { const int st = b / 1024, sb = b % 1024, swz = sb ^ (((sb >> 9) & 1) << 5); R = (st >> 1) * 16 + swz / 64; C = (st & 1) * 32 + (swz % 64) / 2; }
__host__ __device__ __forceinline__ int perm32(int rho) { const int n = rho >> 4, i = rho & 15; return 8 * (i >> 2) + 4 * n + (i & 3); }
struct Unit { int pm, pn; };
struct Gemm { const bf16_t* A; const bf16_t* Bt; int M, N, K, lda, ldb; };
struct StaticOrder {
    int nM, nN, nwg, G, c;
    __device__ void init(int M, int N, int G_, int c_) { nM = M / BM; nN = N / BM; nwg = nM * nN; G = G_; c = c_; }
    __device__ bool next(int i, Unit& u) const {
        const long L = (long)i * G + c; if (L >= nwg) return false;
        int wgid = (int)L; { const int q = nwg / NXCD, r = nwg % NXCD, xcd = wgid % NXCD, off = wgid / NXCD; wgid = (xcd < r ? xcd * (q + 1) : r * (q + 1) + (xcd - r) * q) + off; }
        const int nig = WGM * nN, gid = wgid / nig, fm = gid * WGM, gsz = (nM - fm) < WGM ? (nM - fm) : WGM;
        u.pm = fm + ((wgid % nig) % gsz); u.pn = (wgid % nig) / gsz; return true;
    }
};
template <class F> struct EpiFn {
    static constexpr bool PERM = true;
    F f;
    __device__ __forceinline__ void operator()(const f32x4 (&acc)[2][2][4][2], const Unit& u, int wr, int wc, int fr, int fq) const {
        const int row0 = u.pm * BM + wr * 64 + fr, col0 = u.pn * BM + wc * 32 + 8 * fq;
#pragma unroll
        for (int ai = 0; ai < 2; ++ai)
#pragma unroll
            for (int m = 0; m < 4; ++m)
#pragma unroll
                for (int bj = 0; bj < 2; ++bj) f(row0 + ai * HALF + m * 16, col0 + bj * HALF, acc[ai][bj][m][0], acc[ai][bj][m][1]);
    }
};

template <class Epi, class Sched>
__device__ __forceinline__ void gemm_phase(LAS unsigned char* lds, const Gemm g, const Sched& S, const Epi& E) {
    const int tid = threadIdx.x, wid = __builtin_amdgcn_readfirstlane(tid >> 6), lane = tid & 63, wr = wid >> 2, wc = wid & 3, fr = lane & 15, fq = lane >> 4;
    const int K = g.K, nt = K / BK;
    unsigned voffA[2], voffB[2];
#pragma unroll
    for (int i = 0; i < 2; ++i) { int R, C; stage_rc(tid * 16 + i * 8192, R, C); const int Rb = Epi::PERM ? ((R & ~31) + perm32(R & 31)) : R;
        voffA[i] = (unsigned)(R * g.lda + C) * 2u; voffB[i] = (unsigned)(Rb * g.ldb + C) * 2u; }
    const size_t kstep = (size_t)(BK * 2);
    const size_t hstepA = (size_t)HALF * g.lda * 2, hstepB = (size_t)HALF * g.ldb * 2;
    const size_t tstepA = 2 * hstepA, tstepB = 2 * hstepB;
    const unsigned ldsw = (unsigned)wid * 1024u;
    const int aoff = lds_byte(wr * 64 + fr, fq * 8), boff = lds_byte(wc * 32 + fr, fq * 8);
#define PG8_SA(b, h) (((b) * 2 + (h)) * HTB)
#define PG8_SB(b, h) ((4 + (b) * 2 + (h)) * HTB)
#define PG8_STAGE(bufoff, gbase, voff) do { _Pragma("unroll") for (int _i = 0; _i < 2; ++_i) \
        __builtin_amdgcn_global_load_lds((const unsigned*)((const char*)(gbase) + (voff)[_i]), (LAS unsigned*)(lds + (bufoff) + ldsw + _i * 8192), 16, 0, 0); } while (0)
#define PG8_LDA(dst, b, h) do { _Pragma("unroll") for (int m = 0; m < 4; ++m) _Pragma("unroll") for (int k = 0; k < 2; ++k) dst[m][k] = *(const LAS bf16x8*)(lds + PG8_SA(b, h) + aoff + m * 2048 + k * 1024); } while (0)
#define PG8_LDB(dst, b, h) do { _Pragma("unroll") for (int n = 0; n < 2; ++n) _Pragma("unroll") for (int k = 0; k < 2; ++k) dst[n][k] = *(const LAS bf16x8*)(lds + PG8_SB(b, h) + boff + n * 2048 + k * 1024); } while (0)
#define PG8_MMA(ai, bj, At, Bt) do { __builtin_amdgcn_s_setprio(1); _Pragma("unroll") for (int m = 0; m < 4; ++m) _Pragma("unroll") for (int n = 0; n < 2; ++n) _Pragma("unroll") for (int k = 0; k < 2; ++k) \
        acc[ai][bj][m][n] = __builtin_amdgcn_mfma_f32_16x16x32_bf16(Bt[n][k], At[m][k], acc[ai][bj][m][n], 0, 0, 0); __builtin_amdgcn_s_setprio(0); } while (0)
#define PG8_WAIT_V(n) asm volatile("s_waitcnt vmcnt(" #n ")" ::: "memory")
#define PG8_WAIT_L(n) asm volatile("s_waitcnt lgkmcnt(" #n ")" ::: "memory")
#define PG8_BAR __builtin_amdgcn_s_barrier()
#define PG8_SCHED __builtin_amdgcn_sched_barrier(0)
    Unit cur, nxt; int ui = 0;
    if (!S.next(0, cur)) return;
    f32x4 acc[2][2][4][2];
#pragma unroll
    for (int a = 0; a < 2; ++a)
#pragma unroll
        for (int b = 0; b < 2; ++b)
#pragma unroll
            for (int m = 0; m < 4; ++m)
#pragma unroll
                for (int n = 0; n < 2; ++n) acc[a][b][m][n] = (f32x4){0.f, 0.f, 0.f, 0.f};
    bf16x8 At[4][2], B0[2][2], B1[2][2];
    const char* cA = (const char*)g.A + (size_t)cur.pm * tstepA; const char* cB = (const char*)g.Bt + (size_t)cur.pn * tstepB;
    PG8_STAGE(PG8_SB(0, 0), cB, voffB); PG8_STAGE(PG8_SB(0, 1), cB + hstepB, voffB); PG8_STAGE(PG8_SA(0, 0), cA, voffA); PG8_STAGE(PG8_SA(0, 1), cA + hstepA, voffA);
    if (wr == 1) PG8_BAR;
    PG8_WAIT_V(2); PG8_BAR;
    PG8_STAGE(PG8_SB(1, 0), cB + kstep, voffB); PG8_STAGE(PG8_SA(1, 0), cA + kstep, voffA); PG8_STAGE(PG8_SB(1, 1), cB + hstepB + kstep, voffB);
    PG8_WAIT_V(6); PG8_BAR;
    for (;;) {
        const bool has_next = S.next(ui + 1, nxt);
        const char* nA = has_next ? (const char*)g.A + (size_t)nxt.pm * tstepA : cA; const char* nB = has_next ? (const char*)g.Bt + (size_t)nxt.pn * tstepB : cB;
        for (int t = 0; t < nt; t += 2) {
            const bool last = (t == nt - 2);
            const char* a1 = cA + (size_t)(t + 1) * kstep;
            const char* a2 = last ? nA : cA + (size_t)(t + 2) * kstep; const char* b2 = last ? nB : cB + (size_t)(t + 2) * kstep;
            const char* a3 = a2 + kstep; const char* b3 = b2 + kstep;
            PG8_LDB(B0, 0, 0); PG8_LDB(B1, 0, 1); PG8_SCHED; PG8_LDA(At, 0, 0); PG8_STAGE(PG8_SA(1, 1), a1 + hstepA, voffA);
            PG8_WAIT_V(8); PG8_WAIT_L(0); PG8_BAR; PG8_MMA(0, 0, At, B0); PG8_MMA(0, 1, At, B1); PG8_BAR; PG8_SCHED;
            PG8_LDA(At, 0, 1); PG8_STAGE(PG8_SB(0, 0), b2, voffB); PG8_STAGE(PG8_SB(0, 1), b2 + hstepB, voffB); PG8_STAGE(PG8_SA(0, 0), a2, voffA);
            PG8_WAIT_V(8); PG8_WAIT_L(0); PG8_BAR; PG8_MMA(1, 0, At, B0); PG8_MMA(1, 1, At, B1); PG8_BAR; PG8_SCHED;
            PG8_LDB(B0, 1, 0); PG8_LDB(B1, 1, 1); PG8_SCHED; PG8_LDA(At, 1, 0); PG8_STAGE(PG8_SA(0, 1), a2 + hstepA, voffA);
            PG8_WAIT_V(8); PG8_WAIT_L(0); PG8_BAR; PG8_MMA(0, 0, At, B0); PG8_MMA(0, 1, At, B1); PG8_BAR; PG8_SCHED;
            PG8_LDA(At, 1, 1); PG8_STAGE(PG8_SB(1, 0), b3, voffB); PG8_STAGE(PG8_SB(1, 1), b3 + hstepB, voffB); PG8_STAGE(PG8_SA(1, 0), a3, voffA);
            PG8_WAIT_V(8); PG8_WAIT_L(0); PG8_BAR; PG8_MMA(1, 0, At, B0); PG8_MMA(1, 1, At, B1); PG8_BAR; PG8_SCHED;
        }
        if (wr == 0) PG8_BAR;
        E(acc, cur, wr, wc, fr, fq);
        if (!has_next) break;
#pragma unroll
        for (int a = 0; a < 2; ++a)
#pragma unroll
            for (int b = 0; b < 2; ++b)
#pragma unroll
                for (int m = 0; m < 4; ++m)
#pragma unroll
                    for (int n = 0; n < 2; ++n) acc[a][b][m][n] = (f32x4){0.f, 0.f, 0.f, 0.f};
        cur = nxt; cA = nA; cB = nB; ++ui;
        if (wr == 1) PG8_BAR;
    }
    PG8_WAIT_V(0);
    PG8_BAR;
#undef PG8_SA
#undef PG8_SB
#undef PG8_STAGE
#undef PG8_LDA
#undef PG8_LDB
#undef PG8_MMA
#undef PG8_WAIT_V
#undef PG8_WAIT_L
#undef PG8_BAR
#undef PG8_SCHED
}
}

template <class F>
__device__ __forceinline__ void run_gemm(LAS unsigned char* lds, const bf16_t* A, int lda, const bf16_t* Bt, int ldb, int M, int N, int K, int vblock, const F& f) {
    pg8::Gemm g{A, Bt, M, N, K, lda, ldb}; pg8::StaticOrder S; S.init(M, N, (int)gridDim.x, vblock);
    pg8::EpiFn<F> E{f};
    pg8::gemm_phase<pg8::EpiFn<F>, pg8::StaticOrder>(lds, g, S, E);
}

struct Params {
    const float* in[28];
    float* out;
    unsigned char* ws;
    int ph_lo, ph_hi;
};
enum { I_X = 0, I_NSA_WIN, I_CK_W1, I_CK_W2, I_CK_PE, I_CV_W1, I_CV_W2, I_CV_PE, I_NSA_WOUT, I_NSA_LNG, I_NSA_LNB, I_MLA_WDKV, I_MLA_KVG, I_MLA_WKR, I_MLA_WUK, I_MLA_WUV,
       I_MLA_WDQ, I_MLA_QG, I_MLA_WUQ, I_MLA_WOUT, I_MLA_LNG, I_MLA_LNB, I_PEER_WQ, I_PEER_SUBK, I_PEER_U, I_PEER_V, I_PEER_LNG, I_PEER_LNB };

__device__ __forceinline__ void p0_transpose_item(const float* W, int ldw, int n_valid, int K, bf16_t* WT, int row_off, const float* kscale, LAS float* scr, int nblk, int item, int lane) {
    const int kb = item / nblk, nb = item % nblk, k0 = 64 * kb, n0 = 32 * nb;
    const int n = n0 + (lane & 31);
#pragma unroll 8
    for (int i = 0; i < 32; ++i) { const int kk = 2 * i + (lane >> 5); float v = 0.f; if (n < n_valid) { v = W[(size_t)(k0 + kk) * ldw + n]; if (kscale) v *= kscale[k0 + kk]; } scr[kk * 33 + (lane & 31)] = v; }
    LDS_FENCE();
    const int c = lane & 7;
#pragma unroll
    for (int j = 0; j < 4; ++j) { const int nn = (lane >> 3) + 8 * j; const LAS float* s = scr + (8 * c) * 33 + nn;
        u32x4 o; o.x = pk2(s[0 * 33], s[1 * 33]); o.y = pk2(s[2 * 33], s[3 * 33]); o.z = pk2(s[4 * 33], s[5 * 33]); o.w = pk2(s[6 * 33], s[7 * 33]);
        *(u32x4*)(WT + (size_t)(row_off + n0 + nn) * K + k0 + 8 * c) = o; }
    LDS_FENCE();
}
__device__ __forceinline__ void cvt_f32_bf16(const float* src, bf16_t* dst, size_t n, size_t gtid, size_t gsz) {
    for (size_t i = gtid * 8; i < n; i += gsz * 8) { const f32x4 a = *(const f32x4*)(src + i), b = *(const f32x4*)(src + i + 4);
        u32x4 o; o.x = pk2(a.x, a.y); o.y = pk2(a.z, a.w); o.z = pk2(b.x, b.y); o.w = pk2(b.z, b.w); *(u32x4*)(dst + i) = o; }
}
__device__ __forceinline__ void phase_prologue(const Params& p, LAS unsigned char* lds) {
    const int tid = threadIdx.x, lane = tid & 63, wave = tid >> 6;
    LAS float* scr = (LAS float*)(lds + wave * 16384);
    const int gw = blockIdx.x * NWAVES + wave, NGW = gridDim.x * NWAVES;
    unsigned char* ws = p.ws;
    int base = 0;
#define TJOB(W_, ldw_, nvalid_, K_, npad_, WT_, rowoff_, ks_) do { const int nblk = (npad_) / 32, nit = ((K_) / 64) * nblk; \
        for (int it = gw - base; it < nit; it += NGW) { if (it >= 0) p0_transpose_item((W_), (ldw_), (nvalid_), (K_), (WT_), (rowoff_), (ks_), scr, nblk, it, lane); } \
        base = (base + nit) % NGW; } while (0)
    TJOB(p.in[I_NSA_WIN], NSA_IN, NSA_IN, 1024, NSA_IN_PAD, (bf16_t*)(ws + WS_W_IN_T), 0, (const float*)nullptr);
    TJOB(p.in[I_NSA_WOUT], 1024, 1024, 1024, 1024, (bf16_t*)(ws + WS_W_NSAOUT_T), 0, (const float*)nullptr);
    TJOB(p.in[I_CK_W1], 128, 128, 1024, 128, (bf16_t*)(ws + WS_W_CK1_T), 0, (const float*)nullptr);
    TJOB(p.in[I_CK_W1] + 1024 * 128, 128, 128, 1024, 128, (bf16_t*)(ws + WS_W_CK1_T), 128, (const float*)nullptr);
    TJOB(p.in[I_CV_W1], 128, 128, 1024, 128, (bf16_t*)(ws + WS_W_CV1_T), 0, (const float*)nullptr);
    TJOB(p.in[I_CV_W1] + 1024 * 128, 128, 128, 1024, 128, (bf16_t*)(ws + WS_W_CV1_T), 128, (const float*)nullptr);
    TJOB(p.in[I_MLA_WDQ], 768, 768, 1024, 768, (bf16_t*)(ws + WS_W_MLADOWN_T), 0, (const float*)nullptr);
    TJOB(p.in[I_MLA_WDKV], 256, 256, 1024, 256, (bf16_t*)(ws + WS_W_MLADOWN_T), 768, (const float*)nullptr);
    TJOB(p.in[I_MLA_WKR], 32, 32, 1024, 256, (bf16_t*)(ws + WS_W_MLADOWN_T), 1024, (const float*)nullptr);
    TJOB(p.in[I_MLA_WUQ], 1536, 1536, 768, 1536, (bf16_t*)(ws + WS_W_UQ_T), 0, p.in[I_MLA_QG]);
    TJOB(p.in[I_MLA_WUK], 1024, 1024, 256, 1024, (bf16_t*)(ws + WS_W_UKV_T), 0, p.in[I_MLA_KVG]);
    TJOB(p.in[I_MLA_WUV], 1024, 1024, 256, 1024, (bf16_t*)(ws + WS_W_UKV_T), 1024, p.in[I_MLA_KVG]);
    TJOB(p.in[I_MLA_WOUT], 1024, 1024, 1024, 1024, (bf16_t*)(ws + WS_W_MLAOUT_T), 0, (const float*)nullptr);
    TJOB(p.in[I_PEER_WQ], 2048, 2048, 1024, 2048, (bf16_t*)(ws + WS_W_PQ_T), 0, (const float*)nullptr);
    TJOB(p.in[I_PEER_WQ] + (size_t)1024 * 2048, 2048, 2048, 1024, 2048, (bf16_t*)(ws + WS_W_PQ_T) + (size_t)2048 * 1024, 0, (const float*)nullptr);
#undef TJOB
#if DBG_STAT
    if (blockIdx.x == 0 && tid == 0) ((float*)(ws + WS_CTL))[16] = 0.f;
#endif
    const size_t gtid = (size_t)blockIdx.x * NTHREADS + tid, gsz = (size_t)gridDim.x * NTHREADS;
    cvt_f32_bf16(p.in[I_X], (bf16_t*)(ws + WS_HB), (size_t)NTOK * DM, gtid, gsz);
    cvt_f32_bf16(p.in[I_PEER_SUBK], (bf16_t*)(ws + WS_SUBK), (size_t)2 * 8 * 2 * 128 * 128, gtid, gsz);
    cvt_f32_bf16(p.in[I_PEER_U], (bf16_t*)(ws + WS_TAB), (size_t)NEXP * DM, gtid, gsz);
    cvt_f32_bf16(p.in[I_PEER_V], (bf16_t*)(ws + WS_TAB + 32 * MiB), (size_t)NEXP * DM, gtid, gsz);
    cvt_f32_bf16(p.in[I_PEER_U] + (size_t)NEXP * DM, (bf16_t*)(ws + WS_TAB + 64 * MiB), (size_t)NEXP * DM, gtid, gsz);
    cvt_f32_bf16(p.in[I_PEER_V] + (size_t)NEXP * DM, (bf16_t*)(ws + WS_TAB + 96 * MiB), (size_t)NEXP * DM, gtid, gsz);
    for (int o = gw; o < 256; o += NGW) {
        const float* pe = (o < 128) ? p.in[I_CK_PE] : p.in[I_CV_PE]; const float* w1 = (o < 128) ? p.in[I_CK_W1] : p.in[I_CV_W1]; const int h = o & 127;
        float s = 0.f; for (int i = lane; i < 2048; i += 64) s += pe[i] * w1[(size_t)i * 128 + h];
        s = wave_sum(s); if (lane == 0) ((float*)(ws + WS_PE))[o] = s;
    }
    for (size_t i = gtid; i < (size_t)SEQ * 16; i += gsz) {
        const int pos = (int)(i >> 4), fi = (int)(i & 15);
        const float inv = 1.0f / powf(10000.0f, (float)(2 * fi) / 32.0f);
        const float ang = (float)pos * inv;
        const double rev = (double)ang * 0.15915494309189535; const double fr = rev - rint(rev);
        ((float*)(ws + WS_ROPE_COS))[i] = __builtin_amdgcn_cosf((float)fr); ((float*)(ws + WS_ROPE_SIN))[i] = __builtin_amdgcn_sinf((float)fr);
    }
}

__device__ __forceinline__ u32x4 pack8(const f32x4& a, const f32x4& b) { u32x4 o; o.x = pk2(a.x, a.y); o.y = pk2(a.z, a.w); o.z = pk2(b.x, b.y); o.w = pk2(b.z, b.w); return o; }
struct EpiNsaProj {
    bf16_t* q; bf16_t* kv6; float* gates;
    __device__ __forceinline__ void operator()(int row, int col, const f32x4& a, const f32x4& b) const {
        if (col < 1024) { *(u32x4*)(q + (size_t)row * 1024 + col) = pack8(a, b); }
        else if (col < 2560) {
            const int which = (col - 1024) >> 8, cc = (col - 1024) & 255;
            bf16_t* base = kv6 + (size_t)which * NTOK * 256;
            if (which < 2) { const int g = cc >> 6, d = cc & 63, bb = row >> 12, t = row & 4095, n = t >> 4, l = t & 15;
                *(u32x4*)(base + ((((size_t)(bb * 256 + n) * 4 + g) * 16 + l) * 64 + d)) = pack8(a, b); }
            else *(u32x4*)(base + (size_t)row * 256 + cc) = pack8(a, b);
        } else if (col < NSA_IN) {
            float* gp = gates + (size_t)row * 48 + (col - 2560);
            f32x4 s0, s1;
#pragma unroll
            for (int i = 0; i < 4; ++i) { s0[i] = 1.f / (1.f + __expf(-a[i])); s1[i] = 1.f / (1.f + __expf(-b[i])); }
            *(f32x4*)gp = s0; *(f32x4*)(gp + 4) = s1;
        }
    }
};
struct EpiF32 { float* O; int ldc; __device__ __forceinline__ void operator()(int row, int col, const f32x4& a, const f32x4& b) const { float* o = O + (size_t)row * ldc + col; *(f32x4*)o = a; *(f32x4*)(o + 4) = b; } };
struct EpiBf16 { bf16_t* O; int ldc; __device__ __forceinline__ void operator()(int row, int col, const f32x4& a, const f32x4& b) const { *(u32x4*)(O + (size_t)row * ldc + col) = pack8(a, b); } };
struct EpiResid {
    const bf16_t* H; bf16_t* Z; float ms;
    __device__ __forceinline__ void operator()(int row, int col, const f32x4& a_, const f32x4& b_) const {
        const f32x4 a = a_ * ms, b = b_ * ms;
        const u32x4 h = *(const u32x4*)(H + (size_t)row * 1024 + col);
        f32x4 x, y;
        x.x = DN_ALPHA * bf_lo(h.x) + a.x; x.y = DN_ALPHA * bf_hi(h.x) + a.y; x.z = DN_ALPHA * bf_lo(h.y) + a.z; x.w = DN_ALPHA * bf_hi(h.y) + a.w;
        y.x = DN_ALPHA * bf_lo(h.z) + b.x; y.y = DN_ALPHA * bf_hi(h.z) + b.y; y.z = DN_ALPHA * bf_lo(h.w) + b.z; y.w = DN_ALPHA * bf_hi(h.w) + b.w;
        *(u32x4*)(Z + (size_t)row * 1024 + col) = pack8(x, y);
    }
};
struct EpiKV {
    bf16_t* KN; bf16_t* V;
    __device__ __forceinline__ void operator()(int row, int col, const f32x4& a, const f32x4& b) const {
        bf16_t* dst = (col < 1024) ? KN + (size_t)row * 1024 + col : V + (size_t)row * 1024 + (col - 1024);
        *(u32x4*)dst = pack8(a, b);
    }
};

__device__ __forceinline__ void phase_ln(const bf16_t* Z, bf16_t* H, const float* g, const float* b) {
    const int lane = threadIdx.x & 63, wave = threadIdx.x >> 6;
    const int gw = blockIdx.x * NWAVES + wave, NGW = gridDim.x * NWAVES;
    for (int row = gw; row < NTOK; row += NGW) {
        const u32x4 a = *(const u32x4*)(Z + (size_t)row * 1024 + lane * 8), c = *(const u32x4*)(Z + (size_t)row * 1024 + 512 + lane * 8);
        float v[16] = {bf_lo(a.x), bf_hi(a.x), bf_lo(a.y), bf_hi(a.y), bf_lo(a.z), bf_hi(a.z), bf_lo(a.w), bf_hi(a.w), bf_lo(c.x), bf_hi(c.x), bf_lo(c.y), bf_hi(c.y), bf_lo(c.z), bf_hi(c.z), bf_lo(c.w), bf_hi(c.w)};
        float s = 0.f;
#pragma unroll
        for (int i = 0; i < 16; ++i) s += v[i];
        const float mean = wave_sum(s) * (1.f / 1024.f); float q = 0.f;
#pragma unroll
        for (int i = 0; i < 16; ++i) { v[i] -= mean; q += v[i] * v[i]; }
        const float rstd = rsqrtf(wave_sum(q) * (1.f / 1024.f) + LN_EPS);
        float o[16];
#pragma unroll
        for (int hh = 0; hh < 2; ++hh) { const int c0 = hh * 512 + lane * 8; const f32x4 g0 = *(const f32x4*)(g + c0), g1 = *(const f32x4*)(g + c0 + 4), b0 = *(const f32x4*)(b + c0), b1 = *(const f32x4*)(b + c0 + 4);
#pragma unroll
            for (int i = 0; i < 4; ++i) { o[hh * 8 + i] = v[hh * 8 + i] * rstd * g0[i] + b0[i]; o[hh * 8 + 4 + i] = v[hh * 8 + 4 + i] * rstd * g1[i] + b1[i]; } }
        u32x4 w0, w1; w0.x = pk2(o[0], o[1]); w0.y = pk2(o[2], o[3]); w0.z = pk2(o[4], o[5]); w0.w = pk2(o[6], o[7]); w1.x = pk2(o[8], o[9]); w1.y = pk2(o[10], o[11]); w1.z = pk2(o[12], o[13]); w1.w = pk2(o[14], o[15]);
        *(u32x4*)(H + (size_t)row * 1024 + lane * 8) = w0; *(u32x4*)(H + (size_t)row * 1024 + 512 + lane * 8) = w1;
    }
}
__device__ __forceinline__ void phase_cmp_finish(const Params& p, LAS unsigned char* lds) {
    const int lane = threadIdx.x & 63, wave = threadIdx.x >> 6;
    const int gw = blockIdx.x * NWAVES + wave, NGW = gridDim.x * NWAVES;
    LAS float* hs = (LAS float*)(lds + wave * 512);
    for (int item = gw; item < 2 * 8192; item += NGW) {
        const int kv = item >> 13, r = item & 8191, n = (r >> 2) & 255;
        const float* P = (const float*)(p.ws + (kv ? S_PV : S_PK)); const float* pe = (const float*)(p.ws + WS_PE) + kv * 128;
        const float* w2 = p.in[kv ? I_CV_W2 : I_CK_W2];
        bf16_t* out = (bf16_t*)(p.ws + (kv ? S_VCMP : S_KCMP)) + (size_t)r * 64;
        if (n == 255) { out[lane] = 0; continue; }
        const float a0 = P[(size_t)r * 256 + lane] + P[(size_t)(r + 4) * 256 + 128 + lane] + pe[lane];
        const float a1 = P[(size_t)r * 256 + 64 + lane] + P[(size_t)(r + 4) * 256 + 192 + lane] + pe[64 + lane];
        LDS_FENCE();
        hs[lane] = gelu_tanh(a0); hs[64 + lane] = gelu_tanh(a1);
        LDS_FENCE();
        float s = 0.f;
#pragma unroll 8
        for (int h = 0; h < 128; ++h) s += hs[h] * w2[h * 64 + lane];
        out[lane] = f2bf(s);
    }
}
__device__ __forceinline__ void phase_mla_rowstats(const Params& p) {
    const int lane = threadIdx.x & 63, wave = threadIdx.x >> 6;
    const int gw = blockIdx.x * NWAVES + wave, NGW = gridDim.x * NWAVES;
    bf16_t* DQ = (bf16_t*)(p.ws + S_DQ);
    const float* rc = (const float*)(p.ws + WS_ROPE_COS); const float* rs = (const float*)(p.ws + WS_ROPE_SIN);
    for (int row = gw; row < NTOK; row += NGW) {
        bf16_t* r = DQ + (size_t)row * MLA_DOWN_PAD;
        u32x2 v[4]; float sq = 0.f, skv = 0.f;
#pragma unroll
        for (int j = 0; j < 4; ++j) { v[j] = *(const u32x2*)(r + j * 256 + lane * 4); const float a = bf_lo(v[j].x), b = bf_hi(v[j].x), c = bf_lo(v[j].y), d = bf_hi(v[j].y); const float ss = (a * a + b * b) + (c * c + d * d); if (j < 3) sq += ss; else skv += ss; }
        sq = wave_sum(sq); skv = wave_sum(skv);
        const float rq = rsqrtf(sq * (1.f / 768.f) + RMS_EPS), rkv = rsqrtf(skv * (1.f / 256.f) + RMS_EPS);
#pragma unroll
        for (int j = 0; j < 4; ++j) { const float f = (j < 3) ? rq : rkv; u32x2 o; o.x = pk2(bf_lo(v[j].x) * f, bf_hi(v[j].x) * f); o.y = pk2(bf_lo(v[j].y) * f, bf_hi(v[j].y) * f); *(u32x2*)(r + j * 256 + lane * 4) = o; }
        if (lane < 16) { const int pos = row & 4095; const float x1 = bf2f(r[1024 + lane]), x2 = bf2f(r[1040 + lane]), c = rc[pos * 16 + lane], s = rs[pos * 16 + lane];
            bf16_t* kr = (bf16_t*)(p.ws + S_KROPE) + (size_t)row * 32; kr[lane] = f2bf(x1 * c - x2 * s); kr[16 + lane] = f2bf(x2 * c + x1 * s); }
    }
}

struct OnlineSt { float m[4], l[4], o[4][2]; };
__device__ __forceinline__ void nsa_attend_block(OnlineSt& st, const bf16_t* Kb, const bf16_t* Vb, int pos0, int t, const float (&slope)[4], LAS float* qs, LAS float* ps, int lane) {
    const int pos = pos0 + lane; const bool valid = pos <= t;
    const bf16_t* krow = Kb + (size_t)(valid ? pos : t) * 256;
    float acc[4] = {0.f, 0.f, 0.f, 0.f};
#pragma unroll 2
    for (int d8 = 0; d8 < 8; ++d8) { const u32x4 kv = *(const u32x4*)(krow + d8 * 8);
        const float kf[8] = {bf_lo(kv.x), bf_hi(kv.x), bf_lo(kv.y), bf_hi(kv.y), bf_lo(kv.z), bf_hi(kv.z), bf_lo(kv.w), bf_hi(kv.w)};
#pragma unroll
        for (int e = 0; e < 8; ++e) { const f32x4 qv = *(const LAS f32x4*)(qs + (d8 * 8 + e) * 4);
#pragma unroll
            for (int r = 0; r < 4; ++r) acc[r] += qv[r] * kf[e]; } }
    const float dist = (float)(t - pos);
    f32x4 pe;
#pragma unroll
    for (int r = 0; r < 4; ++r) {
        const float s = valid ? acc[r] - slope[r] * dist : -1e30f;
        const float mb = wave_max(s), mn = fmaxf(st.m[r], mb);
        const float alpha = __expf(st.m[r] - mn);
        const float e = valid ? __expf(s - mn) : 0.f;
        st.l[r] = st.l[r] * alpha + wave_sum(e); st.o[r][0] *= alpha; st.o[r][1] *= alpha; st.m[r] = mn; pe[r] = e;
    }
    LDS_FENCE();
    *(LAS f32x4*)(ps + lane * 4) = pe;
    LDS_FENCE();
    const int hf = lane >> 5, dp = lane & 31;
    const int nk = (t - pos0 + 1 < 64) ? t - pos0 + 1 : 64;
#pragma unroll 4
    for (int kk = hf; kk < nk; kk += 2) {
        const unsigned vv = *(const unsigned*)(Vb + (size_t)(pos0 + kk) * 256 + 2 * dp); const f32x4 pp = *(const LAS f32x4*)(ps + kk * 4);
        const float lo = bf_lo(vv), hi = bf_hi(vv);
#pragma unroll
        for (int r = 0; r < 4; ++r) { st.o[r][0] += pp[r] * lo; st.o[r][1] += pp[r] * hi; }
    }
}
__device__ __forceinline__ void phase_nsa_attn_ref(const Params& p, LAS unsigned char* lds) {
    const int lane = threadIdx.x & 63, wave = threadIdx.x >> 6;
    const int gw = blockIdx.x * NWAVES + wave, NGW = gridDim.x * NWAVES;
    LAS float* qs = (LAS float*)(lds + wave * 6144);
    LAS float* pc = qs + 256;
    LAS float* ptot = pc + 1024;
    const bf16_t* Q = (const bf16_t*)(p.ws + S_Q); const bf16_t* KV6 = (const bf16_t*)(p.ws + S_KV6);
    const bf16_t* KS = KV6 + (size_t)2 * NTOK * 256; const bf16_t* VS = KV6 + (size_t)3 * NTOK * 256; const bf16_t* KW = KV6 + (size_t)4 * NTOK * 256; const bf16_t* VW = KV6 + (size_t)5 * NTOK * 256;
    const bf16_t* KC = (const bf16_t*)(p.ws + S_KCMP); const bf16_t* VC = (const bf16_t*)(p.ws + S_VCMP);
    const float* GATES = (const float*)(p.ws + S_GATES); bf16_t* AO = (bf16_t*)(p.ws + S_AO);
    const int hf = lane >> 5, dp = lane & 31;
    for (int item = gw; item < NTOK * 4; item += NGW) {
        const int g = item & 3, row = item >> 2, b = row >> 12, t = row & 4095;
        float slope[4];
#pragma unroll
        for (int r = 0; r < 4; ++r) slope[r] = exp2f(-0.5f * (float)(g * 4 + r + 1));
        LDS_FENCE();
        { f32x4 qv;
#pragma unroll
          for (int r = 0; r < 4; ++r) qv[r] = bf2f(Q[(size_t)row * 1024 + (g * 4 + r) * 64 + lane]) * 0.125f;
          *(LAS f32x4*)(qs + lane * 4) = qv; }
        LDS_FENCE();
        const int nv = (t >= 31) ? (((t - 31) >> 4) + 1 < 255 ? ((t - 31) >> 4) + 1 : 255) : 0;
        float mloc[4] = {-1e30f, -1e30f, -1e30f, -1e30f};
#pragma unroll 1
        for (int c = 0; c < 4; ++c) {
            const int i = 64 * c + lane;
            f32x4 sv = (f32x4){-1e30f, -1e30f, -1e30f, -1e30f};
            if (64 * c < nv) {
                const bf16_t* krow = KC + ((size_t)(b * 256 + i) * 4 + g) * 64;
                float acc[4] = {0.f, 0.f, 0.f, 0.f};
#pragma unroll 2
                for (int d8 = 0; d8 < 8; ++d8) { const u32x4 kv = *(const u32x4*)(krow + d8 * 8);
                    const float kf[8] = {bf_lo(kv.x), bf_hi(kv.x), bf_lo(kv.y), bf_hi(kv.y), bf_lo(kv.z), bf_hi(kv.z), bf_lo(kv.w), bf_hi(kv.w)};
#pragma unroll
                    for (int e = 0; e < 8; ++e) { const f32x4 qv = *(const LAS f32x4*)(qs + (d8 * 8 + e) * 4);
#pragma unroll
                        for (int r = 0; r < 4; ++r) acc[r] += qv[r] * kf[e]; } }
                const float dist = (float)(t - (16 * i + 31));
                if (i < nv) {
#pragma unroll
                    for (int r = 0; r < 4; ++r) { sv[r] = acc[r] - slope[r] * dist; mloc[r] = fmaxf(mloc[r], sv[r]); } }
            }
            *(LAS f32x4*)(pc + i * 4) = sv;
        }
        float ssum[4] = {0.f, 0.f, 0.f, 0.f};
#pragma unroll
        for (int r = 0; r < 4; ++r) mloc[r] = wave_max(mloc[r]);
        LDS_FENCE();
#pragma unroll 1
        for (int c = 0; c < 4; ++c) {
            const int i = 64 * c + lane; f32x4 sv = *(const LAS f32x4*)(pc + i * 4);
#pragma unroll
            for (int r = 0; r < 4; ++r) { sv[r] = (sv[r] > -1e29f) ? __expf(sv[r] - mloc[r]) : 0.f; ssum[r] += sv[r]; }
            *(LAS f32x4*)(pc + i * 4) = sv;
        }
#pragma unroll
        for (int r = 0; r < 4; ++r) { const float sm = wave_sum(ssum[r]); ssum[r] = (sm > 0.f) ? 1.f / sm : 0.f; }
        LDS_FENCE();
#pragma unroll 1
        for (int c = 0; c < 4; ++c) {
            const int i = 64 * c + lane; f32x4 sv = *(const LAS f32x4*)(pc + i * 4);
#pragma unroll
            for (int r = 0; r < 4; ++r) sv[r] *= ssum[r];
            *(LAS f32x4*)(pc + i * 4) = sv; ptot[i] = (sv[0] + sv[1]) + (sv[2] + sv[3]);
        }
        LDS_FENCE();
        const int j = lane, blk = t >> 6;
        const float imp = ptot[4 * j] + ptot[4 * j + 1] + ptot[4 * j + 2] + 0.5f * ptot[4 * j + 3] + (j > 0 ? 0.5f * ptot[4 * j - 1] : 0.f);
        const bool elig = j <= blk, forced = (j == 0) || (j == blk) || (j == blk - 1);
        const float val = elig ? imp + (forced ? 1e4f : 0.f) : -1e30f;
        int rank = 0;
#pragma unroll 8
        for (int k = 0; k < 64; ++k) { const float vk = __shfl(val, k); rank += (vk > val || (vk == val && k < j)) ? 1 : 0; }
        const unsigned long long selmask = __ballot(elig && rank < 16);
        float oc[4][2] = {{0.f, 0.f}, {0.f, 0.f}, {0.f, 0.f}, {0.f, 0.f}};
        for (int i = hf; i < nv; i += 2) {
            const unsigned vv = *(const unsigned*)(VC + ((size_t)(b * 256 + i) * 4 + g) * 64 + 2 * dp); const f32x4 pp = *(const LAS f32x4*)(pc + i * 4);
            const float lo = bf_lo(vv), hi = bf_hi(vv);
#pragma unroll
            for (int r = 0; r < 4; ++r) { oc[r][0] += pp[r] * lo; oc[r][1] += pp[r] * hi; }
        }
#pragma unroll
        for (int r = 0; r < 4; ++r) { oc[r][0] += __shfl_xor(oc[r][0], 32); oc[r][1] += __shfl_xor(oc[r][1], 32); }
        OnlineSt st;
#pragma unroll
        for (int r = 0; r < 4; ++r) { st.m[r] = -1e30f; st.l[r] = 0.f; st.o[r][0] = 0.f; st.o[r][1] = 0.f; }
        const bf16_t* ksb = KS + (size_t)b * SEQ * 256 + g * 64; const bf16_t* vsb = VS + (size_t)b * SEQ * 256 + g * 64;
        for (unsigned long long mm = selmask; mm; mm &= mm - 1) { const int jj = __builtin_ctzll(mm); nsa_attend_block(st, ksb, vsb, 64 * jj, t, slope, qs, pc, lane); }
        float os[4][2];
#pragma unroll
        for (int r = 0; r < 4; ++r) { const float il = 1.f / st.l[r]; os[r][0] = (st.o[r][0] + __shfl_xor(st.o[r][0], 32)) * il; os[r][1] = (st.o[r][1] + __shfl_xor(st.o[r][1], 32)) * il; }
#pragma unroll
        for (int r = 0; r < 4; ++r) { st.m[r] = -1e30f; st.l[r] = 0.f; st.o[r][0] = 0.f; st.o[r][1] = 0.f; }
        const bf16_t* kwb = KW + (size_t)b * SEQ * 256 + g * 64; const bf16_t* vwb = VW + (size_t)b * SEQ * 256 + g * 64;
        const int lo = (t - 511 > 0) ? t - 511 : 0;
        for (int p0 = lo; p0 <= t; p0 += 64) nsa_attend_block(st, kwb, vwb, p0, t, slope, qs, pc, lane);
        const float* gp = GATES + (size_t)row * 48 + g * 12;
#pragma unroll
        for (int r = 0; r < 4; ++r) {
            const float il = 1.f / st.l[r]; const float ow0 = (st.o[r][0] + __shfl_xor(st.o[r][0], 32)) * il, ow1 = (st.o[r][1] + __shfl_xor(st.o[r][1], 32)) * il;
            const float gc = gp[r * 3 + 0], gs = gp[r * 3 + 1], gwv = gp[r * 3 + 2];
            const float o0 = gc * oc[r][0] + gs * os[r][0] + gwv * ow0, o1 = gc * oc[r][1] + gs * os[r][1] + gwv * ow1;
            if (hf == 0) *(unsigned*)(AO + (size_t)row * 1024 + (g * 4 + r) * 64 + 2 * dp) = pk2(o0, o1);
        }
    }
}

__device__ __forceinline__ void phase_mla_attn_ref(const Params& p, LAS unsigned char* lds) {
    const int lane = threadIdx.x & 63, wave = threadIdx.x >> 6;
    const int gw = blockIdx.x * NWAVES + wave, NGW = gridDim.x * NWAVES;
    LAS float* qs = (LAS float*)(lds + wave * 1024);
    LAS float* ps = qs + 128;
    const bf16_t* QF = (const bf16_t*)(p.ws + S_QF); const bf16_t* KN = (const bf16_t*)(p.ws + S_KNOPE); const bf16_t* KR = (const bf16_t*)(p.ws + S_KROPE); const bf16_t* V = (const bf16_t*)(p.ws + S_V);
    const float* rc = (const float*)(p.ws + WS_ROPE_COS); const float* rs = (const float*)(p.ws + WS_ROPE_SIN);
    bf16_t* AO = (bf16_t*)(p.ws + S_AO2);
    const float scale = 0.10206207261596577f;
    const int hf = lane >> 5, dp = lane & 31;
    for (int item = gw; item < NTOK * 16; item += NGW) {
        const int h = item & 15, row = item >> 4, b = row >> 12, t = row & 4095;
        const bf16_t* qrow = QF + (size_t)row * 1536 + h * 96; const float rq = scale;
        LDS_FENCE();
        qs[lane] = bf2f(qrow[lane]) * rq;
        if (lane < 16) { const float x1 = bf2f(qrow[64 + lane]), x2 = bf2f(qrow[80 + lane]), c = rc[t * 16 + lane], s = rs[t * 16 + lane]; qs[64 + lane] = (x1 * c - x2 * s) * rq; qs[80 + lane] = (x2 * c + x1 * s) * rq; }
        LDS_FENCE();
        float m = -1e30f, l = 0.f, o0 = 0.f, o1 = 0.f;
        for (int p0 = 0; p0 <= t; p0 += 64) {
            const int pos = p0 + lane; const bool valid = pos <= t;
            const int posc = valid ? pos : t;
            const bf16_t* kn = KN + ((size_t)(b * SEQ + posc)) * 1024 + h * 64; const bf16_t* kr = KR + ((size_t)(b * SEQ + posc)) * 32;
            float acc = 0.f;
#pragma unroll 4
            for (int d8 = 0; d8 < 12; ++d8) { const u32x4 kv = (d8 < 8) ? *(const u32x4*)(kn + d8 * 8) : *(const u32x4*)(kr + (d8 - 8) * 8);
                const f32x4 q0 = *(const LAS f32x4*)(qs + d8 * 8), q1 = *(const LAS f32x4*)(qs + d8 * 8 + 4);
                acc += q0.x * bf_lo(kv.x) + q0.y * bf_hi(kv.x) + q0.z * bf_lo(kv.y) + q0.w * bf_hi(kv.y) + q1.x * bf_lo(kv.z) + q1.y * bf_hi(kv.z) + q1.z * bf_lo(kv.w) + q1.w * bf_hi(kv.w); }
            const float s = valid ? acc : -1e30f;
            const float mn = fmaxf(m, wave_max(s)), alpha = __expf(m - mn), e = valid ? __expf(s - mn) : 0.f;
            l = l * alpha + wave_sum(e); o0 *= alpha; o1 *= alpha; m = mn;
            LDS_FENCE();
            ps[lane] = e;
            LDS_FENCE();
            const int nk = (t - p0 + 1 < 64) ? t - p0 + 1 : 64;
            for (int kk = hf; kk < nk; kk += 2) { const unsigned vv = *(const unsigned*)(V + ((size_t)(b * SEQ + p0 + kk)) * 1024 + h * 64 + 2 * dp); const float pp = ps[kk]; o0 += pp * bf_lo(vv); o1 += pp * bf_hi(vv); }
        }
        const float il = 1.f / l; o0 = (o0 + __shfl_xor(o0, 32)) * il; o1 = (o1 + __shfl_xor(o1, 32)) * il;
        if (hf == 0) *(unsigned*)(AO + (size_t)row * 1024 + h * 64 + 2 * dp) = pk2(o0, o1);
    }
}

namespace att {
typedef float f32x16 __attribute__((ext_vector_type(16)));
typedef short s16x4 __attribute__((ext_vector_type(4)));
constexpr int KSTR64 = 144, KSTR96 = 208;
constexpr int KBUF = 64 * KSTR96, VBUF = 8192;
constexpr int OFF_K = 0, OFF_V = 2 * KBUF, OFF_IMPM = OFF_V + 2 * VBUF, OFF_IMPS = OFF_IMPM + 8 * 8 * 64 * 4, OFF_SELB = OFF_IMPS + 8 * 8 * 72 * 4, OFF_UNION = OFF_SELB + 8 * 8 * 8, OFF_FIN = OFF_UNION + 16, LDS_END = OFF_FIN + 8 * 32 * 64 * 4;
static_assert(LDS_END <= 147456, "attention LDS map");
constexpr float LOG2E = 1.4426950408889634f;
__device__ __forceinline__ int crow(int r, int hi) { return (r & 3) + 8 * (r >> 2) + 4 * hi; }
__device__ __forceinline__ float xhalf(float v) { return __shfl_xor(v, 32); }

struct TileRegs { u32x4 k0, k1, v; };
__device__ __forceinline__ const char* uni_ptr(const void* p) {
    const unsigned long long v = (unsigned long long)p; const unsigned lo = __builtin_amdgcn_readfirstlane((unsigned)v), hh = __builtin_amdgcn_readfirstlane((unsigned)(v >> 32));
    return (const char*)(((unsigned long long)hh << 32) | lo);
}
template <bool MLA>
__device__ __forceinline__ void tile_load(TileRegs& R, const bf16_t* Kg, const bf16_t* KRg, const bf16_t* Vg, unsigned koff, unsigned voff, unsigned roff, int tid) {
    R.k0 = *(const u32x4*)(uni_ptr(Kg) + koff);
    R.v = *(const u32x4*)(uni_ptr(Vg) + voff);
    if (MLA) { if (tid < 256) R.k1 = *(const u32x4*)(uni_ptr(KRg) + roff); }
}
template <bool MLA, int KSTR>
__device__ __forceinline__ void tile_store(const TileRegs& R, LAS unsigned char* Kb, LAS unsigned char* Vb, int tid) {
    const int key = tid >> 3, c = tid & 7;
    *(LAS u32x4*)(Kb + key * KSTR + c * 16) = R.k0;
    if (MLA) { if (tid < 256) *(LAS u32x4*)(Kb + (tid >> 2) * KSTR + 128 + (tid & 3) * 16) = R.k1; }
    *(LAS u32x4*)(Vb + (c >> 2) * 4096 + key * 64 + (c & 3) * 16) = R.v;
}
template <int NKS, int KSTR>
__device__ __forceinline__ void qk(f32x16& p0, f32x16& p1, const LAS unsigned char* Kb, const bf16x8 (&qf)[NKS], int lane) {
    const LAS unsigned char* kp = Kb + (lane & 31) * KSTR + (lane >> 5) * 16;
#pragma unroll
    for (int r = 0; r < 16; ++r) { p0[r] = 0.f; p1[r] = 0.f; }
#pragma unroll
    for (int ks = 0; ks < NKS; ++ks) {
        const bf16x8 a0 = *(const LAS bf16x8*)(kp + ks * 32), a1 = *(const LAS bf16x8*)(kp + 32 * KSTR + ks * 32);
        p0 = __builtin_amdgcn_mfma_f32_32x32x16_bf16(a0, qf[ks], p0, 0, 0, 0);
        p1 = __builtin_amdgcn_mfma_f32_32x32x16_bf16(a1, qf[ks], p1, 0, 0, 0);
    }
}
__device__ __forceinline__ s16x4 vtr(const LAS unsigned char* p) { return __builtin_bit_cast(s16x4, __builtin_amdgcn_ds_read_tr16_b64_v4i16((LAS s16x4*)p)); }
__device__ __forceinline__ void pv(f32x16& o0, f32x16& o1, const f32x16& p0, const f32x16& p1, const LAS unsigned char* Vb, int lane) {
    const int hi = lane >> 5;
    const LAS unsigned char* vp = Vb + ((lane >> 4) & 1) * 32 + (lane & 3) * 8 + (4 * hi + ((lane & 15) >> 2)) * 64;
#pragma unroll
    for (int S = 0; S < 4; ++S) {
        u32x4 pw;
#pragma unroll
        for (int jj = 0; jj < 4; ++jj) { const int r = 8 * (S & 1) + 2 * jj; pw[jj] = (S < 2) ? pk2(p0[r], p0[r + 1]) : pk2(p1[r], p1[r + 1]); }
        const bf16x8 pf = __builtin_bit_cast(bf16x8, pw);
#pragma unroll
        for (int dh = 0; dh < 2; ++dh) {
            const s16x4 lo = vtr(vp + dh * 4096 + S * 1024), hh = vtr(vp + dh * 4096 + S * 1024 + 512);
            const bf16x8 vf = (bf16x8){lo[0], lo[1], lo[2], lo[3], hh[0], hh[1], hh[2], hh[3]};
            if (dh == 0) o0 = __builtin_amdgcn_mfma_f32_32x32x16_bf16(vf, pf, o0, 0, 0, 0); else o1 = __builtin_amdgcn_mfma_f32_32x32x16_bf16(vf, pf, o1, 0, 0, 0);
        }
    }
}
template <int PS, bool ALIBI, bool CAUS, bool WLOW, bool ROWEN>
__device__ __forceinline__ void transform(f32x16& p0, f32x16& p1, float c1, float c2, float tbf, bool en) {
#pragma unroll
    for (int r = 0; r < 16; ++r) {
        const float k0 = (float)(PS * ((r & 3) + 8 * (r >> 2))), k1 = (float)(PS * (32 + (r & 3) + 8 * (r >> 2)));
        const float d0 = tbf - k0, d1 = tbf - k1;
        float s0 = p0[r] * c1, s1 = p1[r] * c1;
        if (ALIBI) { s0 -= c2 * d0; s1 -= c2 * d1; }
        bool v0 = true, v1 = true;
        if (CAUS) { v0 = v0 && (d0 >= 0.f); v1 = v1 && (d1 >= 0.f); }
        if (WLOW) { v0 = v0 && (d0 < 512.f); v1 = v1 && (d1 < 512.f); }
        if (ROWEN) { v0 = v0 && en; v1 = v1 && en; }
        p0[r] = v0 ? s0 : -1e30f; p1[r] = v1 ? s1 : -1e30f;
    }
}
__device__ __forceinline__ float tile_max(const f32x16& p0, const f32x16& p1) {
    float a = fmaxf(p0[0], p1[0]);
#pragma unroll
    for (int r = 1; r < 16; ++r) a = fmaxf(a, fmaxf(p0[r], p1[r]));
    return fmaxf(a, xhalf(a));
}
__device__ __forceinline__ void softmax_pv(f32x16& p0, f32x16& p1, float& m, float& l, f32x16& o0, f32x16& o1, const LAS unsigned char* Vb, int lane) {
    const float mn = fmaxf(m, tile_max(p0, p1));
    if (__any(mn > m)) { const float alpha = __builtin_amdgcn_exp2f(m - mn); l *= alpha; o0 *= alpha; o1 *= alpha; m = mn; }
    const float mu = fmaxf(m, -1e20f);
    float s = 0.f;
#pragma unroll
    for (int r = 0; r < 16; ++r) { p0[r] = __builtin_amdgcn_exp2f(p0[r] - mu); p1[r] = __builtin_amdgcn_exp2f(p1[r] - mu); s += p0[r] + p1[r]; }
    l += s;
    pv(o0, o1, p0, p1, Vb, lane);
}
template <bool FIRST> __device__ __forceinline__ void fold(LAS float* fb, const f32x16& o0, const f32x16& o1, float sc, int lane) {
#pragma unroll
    for (int r = 0; r < 16; ++r) { const float a = o0[r] * sc, b = o1[r] * sc; if (FIRST) { fb[r * 64 + lane] = a; fb[(16 + r) * 64 + lane] = b; } else { fb[r * 64 + lane] += a; fb[(16 + r) * 64 + lane] += b; } }
}
__device__ __forceinline__ void store_o(bf16_t* dst  , const f32x16& f0, const f32x16& f1, int hi) {
#pragma unroll
    for (int dh = 0; dh < 2; ++dh)
#pragma unroll
        for (int a = 0; a < 4; ++a) { const f32x16& f = dh ? f1 : f0; u32x2 w; w.x = pk2(f[4 * a], f[4 * a + 1]); w.y = pk2(f[4 * a + 2], f[4 * a + 3]); *(u32x2*)(dst + 32 * dh + 8 * a + 4 * hi) = w; }
}
}

__device__ __forceinline__ void phase_nsa_attn(const Params& p, LAS unsigned char* lds) {
    using namespace att;
    const int tid0 = threadIdx.x, wave = __builtin_amdgcn_readfirstlane(tid0 >> 6);
    const bf16_t* Q = (const bf16_t*)(p.ws + S_Q); const bf16_t* KV6 = (const bf16_t*)(p.ws + S_KV6);
    const bf16_t* KS = KV6 + (size_t)2 * NTOK * 256; const bf16_t* VS = KV6 + (size_t)3 * NTOK * 256; const bf16_t* KW = KV6 + (size_t)4 * NTOK * 256; const bf16_t* VW = KV6 + (size_t)5 * NTOK * 256;
    const bf16_t* KC = (const bf16_t*)(p.ws + S_KCMP); const bf16_t* VC = (const bf16_t*)(p.ws + S_VCMP);
    const float* GATES = (const float*)(p.ws + S_GATES); bf16_t* AO = (bf16_t*)(p.ws + S_AO);
    LAS unsigned char* Kb0 = lds + OFF_K; LAS unsigned char* Vb0 = lds + OFF_V;
    LAS float* impM = (LAS float*)(lds + OFF_IMPM) + wave * 512; LAS float* impS = (LAS float*)(lds + OFF_IMPS) + wave * 576;
    LAS unsigned char* selb = lds + OFF_SELB + wave * 64; LAS unsigned long long* uni = (LAS unsigned long long*)(lds + OFF_UNION);
    const float c1 = 0.125f * LOG2E;
    const int vcu = blockIdx.x;
#pragma unroll 1
    for (int ui = 0; ui < 8; ++ui) {
        int tid = tid0; asm volatile("" : "+v"(tid));
        const int lane = tid & 63, q = lane & 31, hi = lane >> 5, tl = q & 7, rh = q >> 3;
        const unsigned koff = (unsigned)((tid >> 3) * 256 + (tid & 7) * 8) * 2u;
        const int pair = vcu >> 3, kk = vcu & 7, b = pair >> 2, g = pair & 3;
        const int tile = (ui >> 1) * 16 + ((ui & 1) ? 15 - kk : kk);
        const int q0 = tile * 64, t = q0 + 8 * wave + tl, head = 4 * g + rh;
        const size_t row = (size_t)b * SEQ + t;
        const float c2 = exp2f(-0.5f * (float)(head + 1)) * LOG2E;
        bf16x8 qf[4];
#pragma unroll
        for (int ks = 0; ks < 4; ++ks) qf[ks] = *(const bf16x8*)(Q + row * 1024 + head * 64 + ks * 16 + hi * 8);
        const float gc = GATES[row * 48 + head * 3 + 0], gs = GATES[row * 48 + head * 3 + 1], gwd = GATES[row * 48 + head * 3 + 2];
        LAS float* fb = (LAS float*)(lds + OFF_FIN) + wave * 2048;
        TileRegs R;
        for (int i = lane; i < 512; i += 64) impM[i] = 0.f;
        for (int i = lane; i < 576; i += 64) impS[i] = 0.f;
        if (tid0 == 0) *uni = 0ull;
        const int nc = (4 * tile + 3 < 255) ? 4 * tile + 3 : 255, ntc = (nc + 63) >> 6;
        const bf16_t* kcb = KC + ((size_t)b * 256 * 4 + g) * 64; const bf16_t* vcb = VC + ((size_t)b * 256 * 4 + g) * 64;
        float m = -1e30f, l = 0.f;
#pragma unroll 1
        for (int pass = 0; pass < 2; ++pass) {
            f32x16 o0, o1;
#pragma unroll
            for (int r = 0; r < 16; ++r) { o0[r] = 0.f; o1[r] = 0.f; }
            const float ltc = l + xhalf(l); const float invl = (ltc > 0.f) ? 1.f / ltc : 0.f;
            tile_load<false>(R, kcb, nullptr, vcb, koff, koff, 0u, tid);
#pragma unroll 1
            for (int T = 0; T < ntc; ++T) {
                LAS unsigned char* Kb = Kb0 + (T & 1) * KBUF; LAS unsigned char* Vb = Vb0 + (T & 1) * VBUF;
                tile_store<false, KSTR64>(R, Kb, Vb, tid);
                __syncthreads();
                if (T + 1 < ntc) tile_load<false>(R, kcb + (size_t)(T + 1) * 64 * 256, nullptr, vcb + (size_t)(T + 1) * 64 * 256, koff, koff, 0u, tid);
                f32x16 p0, p1;
                qk<4, KSTR64>(p0, p1, Kb, qf, lane);
                const float tbf = (float)(t - (16 * 64 * T + 31) - 64 * hi);
                transform<16, true, true, false, false>(p0, p1, c1, c2, tbf, true);
                if (pass == 0) {
                    const float mn = fmaxf(m, tile_max(p0, p1)); const float alpha = __builtin_amdgcn_exp2f(m - mn); const float mu = fmaxf(mn, -1e20f);
                    float s = 0.f;
#pragma unroll
                    for (int r = 0; r < 16; ++r) s += __builtin_amdgcn_exp2f(p0[r] - mu) + __builtin_amdgcn_exp2f(p1[r] - mu);
                    l = l * alpha + s; m = mn;
                } else {
                    const float mu = fmaxf(m, -1e20f);
#pragma unroll
                    for (int r = 0; r < 16; ++r) { p0[r] = __builtin_amdgcn_exp2f(p0[r] - mu); p1[r] = __builtin_amdgcn_exp2f(p1[r] - mu); }
#pragma unroll
                    for (int kbk = 0; kbk < 2; ++kbk)
#pragma unroll
                        for (int a = 0; a < 4; ++a) {
                            const f32x16& pp = kbk ? p1 : p0;
                            float mainv = (pp[4 * a] + pp[4 * a + 1] + pp[4 * a + 2] + 0.5f * pp[4 * a + 3]) * invl, spill = 0.5f * pp[4 * a + 3] * invl;
                            mainv += __shfl_xor(mainv, 8); mainv += __shfl_xor(mainv, 16); spill += __shfl_xor(spill, 8); spill += __shfl_xor(spill, 16);
                            const int jb = 16 * T + 8 * kbk + 2 * a + hi;
                            if (rh == 0) { impM[tl * 64 + jb] = mainv; impS[tl * 72 + jb + 1] = spill; }
                            __builtin_amdgcn_sched_barrier(0);
                        }
                    pv(o0, o1, p0, p1, Vb, lane);
                }
            }
            if (pass == 1) fold<true>(fb, o0, o1, gc * invl, lane);
            __syncthreads();
        }
        const int blk = tile;
        unsigned long long mymask;
        if (blk < 16) { mymask = (2ull << blk) - 1ull; }
        else {
            LDS_FENCE();
            const int stl = lane >> 3, sub = lane & 7;
            float mv[8]; int rk[8];
#pragma unroll
            for (int i = 0; i < 8; ++i) { const int j = sub * 8 + i; mv[i] = impM[stl * 64 + j] + impS[stl * 72 + j]; rk[i] = 0; }
#pragma unroll 1
            for (int j2 = 1; j2 < blk - 1; ++j2) {
                const float v2 = impM[stl * 64 + j2] + impS[stl * 72 + j2];
#pragma unroll
                for (int i = 0; i < 8; ++i) { const int j = sub * 8 + i; rk[i] += (v2 > mv[i] || (v2 == mv[i] && j2 < j)) ? 1 : 0; }
            }
            unsigned bits = 0;
#pragma unroll
            for (int i = 0; i < 8; ++i) { const int j = sub * 8 + i; const bool forced = (j == 0) || (j == blk) || (j == blk - 1); const bool sel = (j <= blk) && (forced || rk[i] < 13); bits |= sel ? (1u << i) : 0u; }
            selb[stl * 8 + sub] = (unsigned char)bits;
            LDS_FENCE();
            mymask = *(const LAS unsigned long long*)(selb + tl * 8);
        }
        { unsigned long long um = mymask;
#pragma unroll
          for (int o = 1; o < 8; o <<= 1) { const unsigned lo = __shfl_xor((unsigned)um, o), hh = __shfl_xor((unsigned)(um >> 32), o); um |= ((unsigned long long)hh << 32) | lo; }
          if (lane == 0) atomicOr((unsigned long long*)uni, um); }
        __syncthreads();
        const unsigned long long umask = *uni;
        {
            f32x16 o0, o1;
#pragma unroll
            for (int r = 0; r < 16; ++r) { o0[r] = 0.f; o1[r] = 0.f; }
            m = -1e30f; l = 0.f;
            const bf16_t* kb_ = KS + ((size_t)b * SEQ) * 256 + g * 64; const bf16_t* vb_ = VS + ((size_t)b * SEQ) * 256 + g * 64;
            unsigned long long rem = umask; int it = 0;
            int j = 63 - __builtin_clzll(rem); rem &= ~(1ull << j);
            tile_load<false>(R, kb_ + (size_t)j * 64 * 256, nullptr, vb_ + (size_t)j * 64 * 256, koff, koff, 0u, tid);
#pragma unroll 1
            for (;;) {
                LAS unsigned char* Kb = Kb0 + (it & 1) * KBUF; LAS unsigned char* Vb = Vb0 + (it & 1) * VBUF;
                tile_store<false, KSTR64>(R, Kb, Vb, tid);
                __syncthreads();
                const int jn = rem ? 63 - __builtin_clzll(rem) : -1;
                if (jn >= 0) { rem &= ~(1ull << jn); tile_load<false>(R, kb_ + (size_t)jn * 64 * 256, nullptr, vb_ + (size_t)jn * 64 * 256, koff, koff, 0u, tid); }
                const bool en = (mymask >> j) & 1ull;
                if (__any(en)) {
                    f32x16 p0, p1;
                    qk<4, KSTR64>(p0, p1, Kb, qf, lane);
                    const float tbf = (float)(t - 64 * j - 4 * hi);
                    if (j == blk) transform<1, true, true, false, true>(p0, p1, c1, c2, tbf, en); else transform<1, true, false, false, true>(p0, p1, c1, c2, tbf, en);
                    softmax_pv(p0, p1, m, l, o0, o1, Vb, lane);
                }
                if (jn < 0) break;
                j = jn; ++it;
            }
            const float lt = l + xhalf(l);
            fold<false>(fb, o0, o1, (lt > 0.f) ? gs / lt : 0.f, lane);
            __syncthreads();
        }
        {
            f32x16 o0, o1;
#pragma unroll
            for (int r = 0; r < 16; ++r) { o0[r] = 0.f; o1[r] = 0.f; }
            m = -1e30f; l = 0.f;
            const bf16_t* kb_ = KW + ((size_t)b * SEQ) * 256 + g * 64; const bf16_t* vb_ = VW + ((size_t)b * SEQ) * 256 + g * 64;
            const int jlo = (blk - 8 > 0) ? blk - 8 : 0;
            tile_load<false>(R, kb_ + (size_t)blk * 64 * 256, nullptr, vb_ + (size_t)blk * 64 * 256, koff, koff, 0u, tid);
#pragma unroll 1
            for (int j = blk, it = 0; j >= jlo; --j, ++it) {
                LAS unsigned char* Kb = Kb0 + (it & 1) * KBUF; LAS unsigned char* Vb = Vb0 + (it & 1) * VBUF;
                tile_store<false, KSTR64>(R, Kb, Vb, tid);
                __syncthreads();
                if (j > jlo) tile_load<false>(R, kb_ + (size_t)(j - 1) * 64 * 256, nullptr, vb_ + (size_t)(j - 1) * 64 * 256, koff, koff, 0u, tid);
                f32x16 p0, p1;
                qk<4, KSTR64>(p0, p1, Kb, qf, lane);
                const float tbf = (float)(t - 64 * j - 4 * hi);
                if (j == blk) transform<1, true, true, false, false>(p0, p1, c1, c2, tbf, true);
                else if (j == blk - 8) transform<1, true, false, true, false>(p0, p1, c1, c2, tbf, true);
                else transform<1, true, false, false, false>(p0, p1, c1, c2, tbf, true);
                softmax_pv(p0, p1, m, l, o0, o1, Vb, lane);
            }
            const float lt = l + xhalf(l);
            const float scw = (lt > 0.f) ? gwd / lt : 0.f;
#pragma unroll
            for (int r = 0; r < 16; ++r) { o0[r] = o0[r] * scw + fb[r * 64 + lane]; o1[r] = o1[r] * scw + fb[(16 + r) * 64 + lane]; }
            store_o(AO + row * 1024 + head * 64, o0, o1, hi);
            __syncthreads();
        }
    }
}

__device__ __forceinline__ void phase_mla_attn(const Params& p, LAS unsigned char* lds) {
    using namespace att;
    const int tid0 = threadIdx.x, wave = __builtin_amdgcn_readfirstlane(tid0 >> 6);
    const bf16_t* QF = (const bf16_t*)(p.ws + S_QF); const bf16_t* KN = (const bf16_t*)(p.ws + S_KNOPE); const bf16_t* KR = (const bf16_t*)(p.ws + S_KROPE); const bf16_t* V = (const bf16_t*)(p.ws + S_V);
    const float* rc = (const float*)(p.ws + WS_ROPE_COS); const float* rs = (const float*)(p.ws + WS_ROPE_SIN);
    bf16_t* AO = (bf16_t*)(p.ws + S_AO2);
    LAS unsigned char* Kb0 = lds + OFF_K; LAS unsigned char* Vb0 = lds + OFF_V;
    const float c1 = 0.10206207261596577f * LOG2E;
    const int vcu = blockIdx.x;
#pragma unroll 1
    for (int ui = 0; ui < 8; ++ui) {
        int tid = tid0; asm volatile("" : "+v"(tid));
        const int lane = tid & 63, q = lane & 31, hi = lane >> 5;
        const unsigned koff = (unsigned)((tid >> 3) * 1024 + (tid & 7) * 8) * 2u, roff = (unsigned)((tid >> 2) * 32 + (tid & 3) * 8) * 2u;
        const int bh = vcu >> 1, b = bh >> 4, h = bh & 15, par = vcu & 1;
        const int qb = (ui & 1) ? 15 - (ui - 1) - par : ui + par;
        const int t = 256 * qb + 32 * wave + q; const size_t row = (size_t)b * SEQ + t;
        bf16x8 qf[6];
        { const bf16_t* qrow = QF + row * 1536 + h * 96;
#pragma unroll
          for (int ks = 0; ks < 4; ++ks) qf[ks] = *(const bf16x8*)(qrow + ks * 16 + hi * 8);
          const u32x4 x1 = *(const u32x4*)(qrow + 64 + hi * 8), x2 = *(const u32x4*)(qrow + 80 + hi * 8);
          const f32x4 ca = *(const f32x4*)(rc + t * 16 + hi * 8), cb = *(const f32x4*)(rc + t * 16 + hi * 8 + 4), sa = *(const f32x4*)(rs + t * 16 + hi * 8), sb = *(const f32x4*)(rs + t * 16 + hi * 8 + 4);
          const float a1[8] = {bf_lo(x1.x), bf_hi(x1.x), bf_lo(x1.y), bf_hi(x1.y), bf_lo(x1.z), bf_hi(x1.z), bf_lo(x1.w), bf_hi(x1.w)};
          const float a2[8] = {bf_lo(x2.x), bf_hi(x2.x), bf_lo(x2.y), bf_hi(x2.y), bf_lo(x2.z), bf_hi(x2.z), bf_lo(x2.w), bf_hi(x2.w)};
          const float cc[8] = {ca.x, ca.y, ca.z, ca.w, cb.x, cb.y, cb.z, cb.w}, ss[8] = {sa.x, sa.y, sa.z, sa.w, sb.x, sb.y, sb.z, sb.w};
          u32x4 w1, w2;
#pragma unroll
          for (int jj = 0; jj < 4; ++jj) { const int e = 2 * jj;
              w1[jj] = pk2(a1[e] * cc[e] - a2[e] * ss[e], a1[e + 1] * cc[e + 1] - a2[e + 1] * ss[e + 1]);
              w2[jj] = pk2(a2[e] * cc[e] + a1[e] * ss[e], a2[e + 1] * cc[e + 1] + a1[e + 1] * ss[e + 1]); }
          qf[4] = __builtin_bit_cast(bf16x8, w1); qf[5] = __builtin_bit_cast(bf16x8, w2); }
        f32x16 o0, o1;
#pragma unroll
        for (int r = 0; r < 16; ++r) { o0[r] = 0.f; o1[r] = 0.f; }
        float m = -1e30f, l = 0.f;
        const bf16_t* knb = KN + ((size_t)b * SEQ) * 1024 + h * 64; const bf16_t* krb = KR + ((size_t)b * SEQ) * 32; const bf16_t* vb_ = V + ((size_t)b * SEQ) * 1024 + h * 64;
        const int nt = 4 * qb + 4; const int tmin = 256 * qb + 32 * wave;
        TileRegs R;
        tile_load<true>(R, knb, krb, vb_, koff, koff, roff, tid);
#pragma unroll 1
        for (int j = 0; j < nt; ++j) {
            LAS unsigned char* Kb = Kb0 + (j & 1) * KBUF; LAS unsigned char* Vb = Vb0 + (j & 1) * VBUF;
            tile_store<true, KSTR96>(R, Kb, Vb, tid);
            __syncthreads();
            if (j + 1 < nt) tile_load<true>(R, knb + (size_t)(j + 1) * 64 * 1024, krb + (size_t)(j + 1) * 64 * 32, vb_ + (size_t)(j + 1) * 64 * 1024, koff, koff, roff, tid);
            if (64 * j <= tmin + 31) {
                f32x16 p0, p1;
                qk<6, KSTR96>(p0, p1, Kb, qf, lane);
                const float tbf = (float)(t - 64 * j - 4 * hi);
                if (64 * j + 63 > tmin) transform<1, false, true, false, false>(p0, p1, c1, 0.f, tbf, true); else transform<1, false, false, false, false>(p0, p1, c1, 0.f, tbf, true);
                softmax_pv(p0, p1, m, l, o0, o1, Vb, lane);
            }
        }
        const float lt = l + xhalf(l); const float il = 1.f / lt;
        o0 *= il; o1 *= il;
        store_o(AO + row * 1024 + h * 64, o0, o1, hi);
        __syncthreads();
    }
}

__device__ __forceinline__ float pack_idx(float v, unsigned bits, unsigned mask) { return __uint_as_float((__float_as_uint(v) & ~mask) | bits); }
__device__ __forceinline__ void phase_peer_route_ref(const Params& p, LAS unsigned char* lds, int layer, const bf16_t* QP, int* EIDX, float* GW) {
    const int lane = threadIdx.x & 63, wave = threadIdx.x >> 6;
    const int gw = blockIdx.x * NWAVES + wave, NGW = gridDim.x * NWAVES;
    LAS float* qs = (LAS float*)(lds + wave * 1024);
    const bf16_t* SK = (const bf16_t*)(p.ws + WS_SUBK) + (size_t)layer * 8 * 2 * 128 * 128;
    for (int item = gw; item < NTOK * 8; item += NGW) {
        const int h = item & 7, t = item >> 3;
        LDS_FENCE();
        { const u32x2 qv = *(const u32x2*)(QP + (size_t)t * 2048 + h * 256 + lane * 4); *(LAS f32x4*)(qs + lane * 4) = (f32x4){bf_lo(qv.x), bf_hi(qv.x), bf_lo(qv.y), bf_hi(qv.y)}; }
        LDS_FENCE();
        float sv[2];
#pragma unroll
        for (int c = 0; c < 2; ++c) {
            float v[2];
#pragma unroll
            for (int kk = 0; kk < 2; ++kk) {
                const int key = lane + 64 * kk; const bf16_t* krow = SK + ((size_t)(h * 2 + c) * 128 + key) * 128;
                float acc = 0.f;
#pragma unroll 4
                for (int d8 = 0; d8 < 16; ++d8) { const u32x4 kv = *(const u32x4*)(krow + d8 * 8); const f32x4 q0 = *(const LAS f32x4*)(qs + c * 128 + d8 * 8), q1 = *(const LAS f32x4*)(qs + c * 128 + d8 * 8 + 4);
                    acc += q0.x * bf_lo(kv.x) + q0.y * bf_hi(kv.x) + q0.z * bf_lo(kv.y) + q0.w * bf_hi(kv.y) + q1.x * bf_lo(kv.z) + q1.y * bf_hi(kv.z) + q1.z * bf_lo(kv.w) + q1.w * bf_hi(kv.w); }
                v[kk] = pack_idx(acc, 127u - (unsigned)key, 127u);
            }
            float mine = 0.f;
#pragma unroll 1
            for (int n = 0; n < 16; ++n) { const float w = wave_max(fmaxf(v[0], v[1])); if (v[0] == w) v[0] = -INFINITY; if (v[1] == w) v[1] = -INFINITY; if (lane == n) mine = w; }
            sv[c] = mine;
        }
        const int a = lane & 15, bq = lane >> 4;
        const float s0 = __shfl(sv[0], a);
        float cv[4];
#pragma unroll
        for (int i = 0; i < 4; ++i) { const float s1 = __shfl(sv[1], 4 * bq + i); cv[i] = pack_idx(s0 + s1, 255u - (unsigned)(a * 16 + 4 * bq + i), 255u); }
        float cs = 0.f;
#pragma unroll 1
        for (int n = 0; n < 16; ++n) { const float w = wave_max(fmaxf(fmaxf(cv[0], cv[1]), fmaxf(cv[2], cv[3])));
#pragma unroll
            for (int i = 0; i < 4; ++i) if (cv[i] == w) cv[i] = -INFINITY;
            if (lane == n) cs = w; }
        const unsigned flat = 255u - (__float_as_uint(cs) & 255u);
        const int wa = (int)(flat >> 4) & 15, wb = (int)flat & 15;
        const unsigned i0 = 127u - (__float_as_uint(__shfl(sv[0], wa)) & 127u), i1 = 127u - (__float_as_uint(__shfl(sv[1], wb)) & 127u);
        const float mx = __shfl(cs, 0);
        const float ex = (lane < 16) ? __expf(cs - mx) : 0.f;
        const float sum = wave_sum(ex);
        if (lane < 16) { EIDX[(size_t)t * 128 + h * 16 + lane] = (int)(i0 * 128u + i1); GW[(size_t)t * 128 + h * 16 + lane] = ex / sum; }
    }
}

namespace rt {
typedef float f32x16 __attribute__((ext_vector_type(16)));
constexpr int SKSTR = 272;
constexpr int OFF_SK = 0, OFF_IDX = 2 * 128 * SKSTR, LDS_END = OFF_IDX + 8 * 64 * 32;
__device__ __forceinline__ void ce_desc(float& a, float& b) { const float hi = fmaxf(a, b), lo = fminf(a, b); a = hi; b = lo; }
__device__ __forceinline__ void sort16_desc(float (&v)[16]) {
#pragma unroll
    for (int k = 2; k <= 16; k <<= 1)
#pragma unroll
        for (int j = k >> 1; j > 0; j >>= 1)
#pragma unroll
            for (int i = 0; i < 16; ++i) { const int l = i ^ j; if (l > i) { if ((i & k) == 0) ce_desc(v[i], v[l]); else ce_desc(v[l], v[i]); } }
}
__device__ __forceinline__ void merge16_desc(float (&v)[16]) {
#pragma unroll
    for (int j = 8; j > 0; j >>= 1)
#pragma unroll
        for (int i = 0; i < 16; ++i) { const int l = i ^ j; if (l > i) ce_desc(v[i], v[l]); }
}
__device__ __forceinline__ void top16_merge(float (&a)[16], const float (&b)[16]) {
#pragma unroll
    for (int i = 0; i < 16; ++i) a[i] = fmaxf(a[i], b[15 - i]);
    merge16_desc(a);
}
}
__device__ __forceinline__ void phase_peer_route(const Params& p, LAS unsigned char* lds, int layer, const bf16_t* QP, int* EIDX, float* GW) {
    using namespace rt;
    const int tid = threadIdx.x, lane = tid & 63, wave = __builtin_amdgcn_readfirstlane(tid >> 6), tok = lane & 31, hi = lane >> 5;
    const bf16_t* SK = (const bf16_t*)(p.ws + WS_SUBK) + (size_t)layer * 8 * 2 * 128 * 128;
    LAS unsigned char* idxs = lds + OFF_IDX + wave * 2048 + lane * 32;
    const int nbpi = NTOK / 1024;
    for (int bi = blockIdx.x; bi < 8 * nbpi; bi += gridDim.x) {
        const int h = bi & 7, tb = bi >> 3;
        __syncthreads();
        for (int i = tid; i < 256 * 16; i += NTHREADS) { const int r = i >> 4, c = i & 15; *(LAS u32x4*)(lds + OFF_SK + r * SKSTR + c * 16) = *(const u32x4*)(SK + ((size_t)h * 256 + r) * 128 + c * 8); }
        __syncthreads();
#pragma unroll 1
        for (int gi = 0; gi < 4; ++gi) {
            const int t = tb * 1024 + wave * 128 + gi * 32 + tok;
            float top[2][16];
#pragma unroll
            for (int c = 0; c < 2; ++c) {
                bf16x8 qf[8];
#pragma unroll
                for (int ks = 0; ks < 8; ++ks) qf[ks] = *(const bf16x8*)(QP + (size_t)t * 2048 + h * 256 + c * 128 + ks * 16 + hi * 8);
                float cur[16];
#pragma unroll
                for (int kb = 0; kb < 4; ++kb) {
                    f32x16 acc;
#pragma unroll
                    for (int r = 0; r < 16; ++r) acc[r] = 0.f;
                    const LAS unsigned char* kp = lds + OFF_SK + (c * 128 + kb * 32 + tok) * SKSTR + hi * 16;
#pragma unroll
                    for (int ks = 0; ks < 8; ++ks) acc = __builtin_amdgcn_mfma_f32_32x32x16_bf16(*(const LAS bf16x8*)(kp + ks * 32), qf[ks], acc, 0, 0, 0);
                    float v[16];
#pragma unroll
                    for (int r = 0; r < 16; ++r) { const unsigned key = (unsigned)(32 * kb + (r & 3) + 8 * (r >> 2)) + 4u * (unsigned)hi; v[r] = __uint_as_float((__float_as_uint(acc[r]) & ~127u) | (127u - key)); }
                    sort16_desc(v);
                    if (kb == 0) {
#pragma unroll
                        for (int r = 0; r < 16; ++r) cur[r] = v[r];
                    } else top16_merge(cur, v);
                }
                float oth[16];
#pragma unroll
                for (int r = 0; r < 16; ++r) oth[r] = __shfl_xor(cur[r], 32);
                top16_merge(cur, oth);
#pragma unroll
                for (int r = 0; r < 16; ++r) top[c][r] = cur[r];
            }
            { u32x4 w0, w1;
#pragma unroll
              for (int c = 0; c < 2; ++c) {
                  u32x4 w;
#pragma unroll
                  for (int jj = 0; jj < 4; ++jj) { unsigned x = 0;
#pragma unroll
                      for (int e = 0; e < 4; ++e) x |= (127u - (__float_as_uint(top[c][4 * jj + e]) & 127u)) << (8 * e);
                      w[jj] = x; }
                  if (c == 0) w0 = w; else w1 = w; }
              *(LAS u32x4*)idxs = w0; *(LAS u32x4*)(idxs + 16) = w1; }
#define CAND(a, b) __uint_as_float((__float_as_uint(top[0][a] + top[1][b]) & ~255u) | (255u - (unsigned)(16 * (a) + (b))))
            float A[16], B[16], X[16], Y[16];
#pragma unroll
            for (int b = 0; b < 16; ++b) A[b] = CAND(0, b);
#pragma unroll
            for (int b = 0; b < 8; ++b) B[b] = CAND(1, b);
#pragma unroll
            for (int b = 8; b < 16; ++b) B[b] = -INFINITY;
            top16_merge(A, B);
            X[0] = CAND(2, 0); X[1] = CAND(2, 1); X[2] = CAND(2, 2); X[3] = CAND(2, 3); X[4] = CAND(2, 4); X[5] = CAND(3, 0); X[6] = CAND(3, 1); X[7] = CAND(3, 2); X[8] = CAND(3, 3);
            X[9] = CAND(4, 0); X[10] = CAND(4, 1); X[11] = CAND(4, 2); X[12] = CAND(5, 0); X[13] = CAND(5, 1); X[14] = CAND(6, 0); X[15] = CAND(6, 1);
            Y[0] = CAND(7, 0); Y[1] = CAND(7, 1); Y[2] = CAND(8, 0); Y[3] = CAND(9, 0); Y[4] = CAND(10, 0); Y[5] = CAND(11, 0); Y[6] = CAND(12, 0); Y[7] = CAND(13, 0); Y[8] = CAND(14, 0); Y[9] = CAND(15, 0);
#pragma unroll
            for (int i = 10; i < 16; ++i) Y[i] = -INFINITY;
#undef CAND
            sort16_desc(X); sort16_desc(Y);
            top16_merge(A, X); top16_merge(A, Y);
            float ex[16], sum = 0.f;
#pragma unroll
            for (int n = 0; n < 16; ++n) { ex[n] = __expf(A[n] - A[0]); sum += ex[n]; }
            const float inv = 1.f / sum;
            LDS_FENCE();
            if (hi == 0) {
                int* ep = EIDX + (size_t)t * 128 + h * 16;
#pragma unroll
                for (int jj = 0; jj < 4; ++jj) { u32x4 w;
#pragma unroll
                    for (int e = 0; e < 4; ++e) { const unsigned flat = 255u - (__float_as_uint(A[4 * jj + e]) & 255u); const unsigned i0 = idxs[flat >> 4], i1 = idxs[16 + (flat & 15u)]; w[e] = i0 * 128u + i1; }
                    *(u32x4*)(ep + 4 * jj) = w; }
            } else {
                float* gp = GW + (size_t)t * 128 + h * 16;
#pragma unroll
                for (int jj = 0; jj < 4; ++jj) *(f32x4*)(gp + 4 * jj) = (f32x4){ex[4 * jj] * inv, ex[4 * jj + 1] * inv, ex[4 * jj + 2] * inv, ex[4 * jj + 3] * inv};
            }
            LDS_FENCE();
        }
    }
}

__device__ __forceinline__ float dot2bf(unsigned a, unsigned b, float acc) {
    float r; asm("v_dot2c_f32_bf16 %0, %1, %2" : "=v"(r) : "v"(a), "v"(b), "0"(acc)); return r;
}
__device__ __forceinline__ float dot8(const u32x4& a, const u32x4& b, float acc) {
    acc = dot2bf(a.x, b.x, acc); acc = dot2bf(a.y, b.y, acc); acc = dot2bf(a.z, b.z, acc); acc = dot2bf(a.w, b.w, acc);
    return acc;
}
__device__ __forceinline__ void axpy8(float* o, const u32x4& v, float w) {
    o[0] += w * bf_lo(v.x); o[1] += w * bf_hi(v.x); o[2] += w * bf_lo(v.y); o[3] += w * bf_hi(v.y); o[4] += w * bf_lo(v.z); o[5] += w * bf_hi(v.z); o[6] += w * bf_lo(v.w); o[7] += w * bf_hi(v.w);
}
__device__ __forceinline__ void phase_peer_gather(const Params& p, int layer, const int* EIDX, const float* GW, const bf16_t* HB, bf16_t* HBO, float* OUT, float fs) {
    const int lane = threadIdx.x & 63, wave = threadIdx.x >> 6;
    const int gw = blockIdx.x * NWAVES + wave, NGW = gridDim.x * NWAVES;
    const bf16_t* U = (const bf16_t*)(p.ws + WS_TAB + (size_t)layer * 64 * MiB); const bf16_t* Vt = U + (size_t)NEXP * DM;
    const float* lg = p.in[I_PEER_LNG] + layer * 1024; const float* lb = p.in[I_PEER_LNB] + layer * 1024;
    for (int t = gw; t < NTOK; t += NGW) {
        const u32x4 x0 = *(const u32x4*)(HB + (size_t)t * 1024 + lane * 8), x1 = *(const u32x4*)(HB + (size_t)t * 1024 + 512 + lane * 8);
        const int e0 = EIDX[(size_t)t * 128 + lane], e1 = EIDX[(size_t)t * 128 + 64 + lane];
        const float g0 = GW[(size_t)t * 128 + lane], g1 = GW[(size_t)t * 128 + 64 + lane];
        float o[16];
#pragma unroll
        for (int i = 0; i < 16; ++i) o[i] = 0.f;
#if DBG_STAT
        float dstat = 0.f;
        if (DBG_STAT == 2) { int dups = 0;
            for (int sft = 1; sft < 16; ++sft) { const int src = (lane & ~15) | ((lane + sft) & 15); dups += (e0 == __shfl(e0, src)) + (e1 == __shfl(e1, src)); }
            dstat = wave_sum((float)dups) * (1.f / 8.f); }
        if (DBG_STAT == 3) dstat = wave_sum(g0 * g0 + g1 * g1) * (1.f / 8.f);
        if (DBG_STAT == 4) dstat = wave_sum(g0 + g1) * (1.f / 8.f);
        if (DBG_STAT == 5) { const int b0 = (e0 < 0 || e0 >= 16384) + (e1 < 0 || e1 >= 16384); dstat = wave_sum((float)b0); }
#endif
#pragma unroll 1
        for (int kb = 0; kb < 128; kb += 4) {
            int e[4]; float gg[4];
#pragma unroll
            for (int i = 0; i < 4; ++i) { const int k = kb + i; e[i] = (kb < 64) ? __shfl(e0, k) : __shfl(e1, k - 64); gg[i] = (kb < 64) ? __shfl(g0, k) : __shfl(g1, k - 64); }
            u32x4 ua[4], ub[4], va[4], vb[4];
#pragma unroll
            for (int i = 0; i < 4; ++i) { const bf16_t* ur = U + (size_t)e[i] * 1024 + lane * 8; const bf16_t* vr = Vt + (size_t)e[i] * 1024 + lane * 8;
                ua[i] = *(const u32x4*)ur; ub[i] = *(const u32x4*)(ur + 512); va[i] = *(const u32x4*)vr; vb[i] = *(const u32x4*)(vr + 512); }
#pragma unroll
            for (int i = 0; i < 4; ++i) {
                float d = dot8(ua[i], x0, 0.f); d = dot8(ub[i], x1, d); d = wave_sum(d);
                const float w = gg[i] * gelu_tanh(d);
#if DBG_STAT
                if (DBG_STAT == 1) dstat += gelu_tanh(d) * gelu_tanh(d) * (1.f / 128.f);
                if (DBG_STAT == 6) dstat += d * d * (1.f / 128.f);
#endif
                axpy8(o, va[i], w); axpy8(o + 8, vb[i], w);
            }
        }
#if DBG_STAT
        if (layer == 0 && lane == 0) atomicAdd((float*)(p.ws + WS_CTL) + 16, dstat * (1.f / NTOK));
#endif
        float z[16] = {bf_lo(x0.x), bf_hi(x0.x), bf_lo(x0.y), bf_hi(x0.y), bf_lo(x0.z), bf_hi(x0.z), bf_lo(x0.w), bf_hi(x0.w), bf_lo(x1.x), bf_hi(x1.x), bf_lo(x1.y), bf_hi(x1.y), bf_lo(x1.z), bf_hi(x1.z), bf_lo(x1.w), bf_hi(x1.w)};
        float s = 0.f;
#pragma unroll
        for (int i = 0; i < 16; ++i) { z[i] = DN_ALPHA * z[i] + fs * o[i]; s += z[i]; }
        const float mean = wave_sum(s) * (1.f / 1024.f); float q = 0.f;
#pragma unroll
        for (int i = 0; i < 16; ++i) { z[i] -= mean; q += z[i] * z[i]; }
        const float rstd = rsqrtf(wave_sum(q) * (1.f / 1024.f) + LN_EPS);
#pragma unroll
        for (int hh = 0; hh < 2; ++hh) { const int c0 = hh * 512 + lane * 8; const f32x4 ga = *(const f32x4*)(lg + c0), gb = *(const f32x4*)(lg + c0 + 4), ba = *(const f32x4*)(lb + c0), bb = *(const f32x4*)(lb + c0 + 4);
#pragma unroll
            for (int i = 0; i < 4; ++i) { z[hh * 8 + i] = z[hh * 8 + i] * rstd * ga[i] + ba[i]; z[hh * 8 + 4 + i] = z[hh * 8 + 4 + i] * rstd * gb[i] + bb[i]; } }
        if (OUT) {
#pragma unroll
            for (int hh = 0; hh < 2; ++hh) { float* op = OUT + (size_t)t * 1024 + hh * 512 + lane * 8; *(f32x4*)op = (f32x4){z[hh * 8], z[hh * 8 + 1], z[hh * 8 + 2], z[hh * 8 + 3]}; *(f32x4*)(op + 4) = (f32x4){z[hh * 8 + 4], z[hh * 8 + 5], z[hh * 8 + 6], z[hh * 8 + 7]}; }
        } else {
            u32x4 w0, w1; w0.x = pk2(z[0], z[1]); w0.y = pk2(z[2], z[3]); w0.z = pk2(z[4], z[5]); w0.w = pk2(z[6], z[7]); w1.x = pk2(z[8], z[9]); w1.y = pk2(z[10], z[11]); w1.z = pk2(z[12], z[13]); w1.w = pk2(z[14], z[15]);
            *(u32x4*)(HBO + (size_t)t * 1024 + lane * 8) = w0; *(u32x4*)(HBO + (size_t)t * 1024 + 512 + lane * 8) = w1;
        }
    }
}

constexpr int NPHASES = 19;
__global__ void __launch_bounds__(NTHREADS, 2) fwd_kernel(Params p) {
    extern __shared__ __attribute__((aligned(16))) unsigned char lds_raw[];
    LAS unsigned char* lds = (LAS unsigned char*)lds_raw;
    unsigned char* ws = p.ws;
    bf16_t* HB = (bf16_t*)(ws + WS_HB);
    const int lo = p.ph_lo, hi = p.ph_hi;
#ifndef PH_MASK
#define PH_MASK 0xFFFFFFFFu
#endif
#define IN(k) (((PH_MASK >> (k)) & 1u) && lo <= (k) && (k) < hi)
#define SEAM(k) do { if (IN(k) && IN((k) + 1)) { asm volatile("s_waitcnt vmcnt(0) lgkmcnt(0)" ::: "memory"); __builtin_amdgcn_fence(__ATOMIC_RELEASE, "agent"); asm volatile("s_waitcnt vmcnt(0)" ::: "memory"); \
        cg::this_grid().sync(); __builtin_amdgcn_fence(__ATOMIC_ACQUIRE, "agent"); asm volatile("s_waitcnt vmcnt(0)" ::: "memory"); __syncthreads(); } } while (0)
    if (IN(0)) for (int rep_ = 0; rep_ < ((PROBE_REP == 0) ? 1 + PROBE_N : 1); ++rep_) { phase_prologue(p, lds); } SEAM(0);
    if (IN(1)) for (int rep_ = 0; rep_ < ((PROBE_REP == 1) ? 1 + PROBE_N : 1); ++rep_) { EpiNsaProj E{(bf16_t*)(ws + S_Q), (bf16_t*)(ws + S_KV6), (float*)(ws + S_GATES)};
        run_gemm(lds, HB, 1024, (const bf16_t*)(ws + WS_W_IN_T), 1024, NTOK, NSA_IN_PAD, 1024, (int)blockIdx.x, E); } SEAM(1);
    if (IN(2)) for (int rep_ = 0; rep_ < ((PROBE_REP == 2) ? 1 + PROBE_N : 1); ++rep_) { EpiF32 Ek{(float*)(ws + S_PK), 256}, Ev{(float*)(ws + S_PV), 256};
        run_gemm(lds, (const bf16_t*)(ws + S_KV6), 1024, (const bf16_t*)(ws + WS_W_CK1_T), 1024, 8192, 256, 1024, (int)blockIdx.x, Ek);
        run_gemm(lds, (const bf16_t*)(ws + S_KV6) + (size_t)NTOK * 256, 1024, (const bf16_t*)(ws + WS_W_CV1_T), 1024, 8192, 256, 1024, (int)((blockIdx.x + gridDim.x / 2) % gridDim.x), Ev); } SEAM(2);
    if (IN(3)) for (int rep_ = 0; rep_ < ((PROBE_REP == 3) ? 1 + PROBE_N : 1); ++rep_) { phase_cmp_finish(p, lds); } SEAM(3);
    if (IN(4)) for (int rep_ = 0; rep_ < ((PROBE_REP == 4) ? 1 + PROBE_N : 1); ++rep_) { if (USE_MFMA_NSA) phase_nsa_attn(p, lds); else phase_nsa_attn_ref(p, lds); } SEAM(4);
    if (IN(5)) for (int rep_ = 0; rep_ < ((PROBE_REP == 5) ? 1 + PROBE_N : 1); ++rep_) { EpiResid E{HB, (bf16_t*)(ws + S_Z), (ABL & 1) ? 0.f : 1.f};
        run_gemm(lds, (const bf16_t*)(ws + S_AO), 1024, (const bf16_t*)(ws + WS_W_NSAOUT_T), 1024, NTOK, 1024, 1024, (int)blockIdx.x, E); } SEAM(5);
    if (IN(6)) for (int rep_ = 0; rep_ < ((PROBE_REP == 6) ? 1 + PROBE_N : 1); ++rep_) { phase_ln((const bf16_t*)(ws + S_Z), HB, p.in[I_NSA_LNG], p.in[I_NSA_LNB]); } SEAM(6);
    if (IN(7)) for (int rep_ = 0; rep_ < ((PROBE_REP == 7) ? 1 + PROBE_N : 1); ++rep_) { EpiBf16 E{(bf16_t*)(ws + S_QP0), 2048};
        run_gemm(lds, HB, 1024, (const bf16_t*)(ws + WS_W_PQ_T), 1024, NTOK, 2048, 1024, (int)blockIdx.x, E); } SEAM(7);
    if (IN(8) && ((PROBE_DUP & 1) || PROBE_REP == 8)) for (int rep_ = 0; rep_ < PROBE_N; ++rep_) { phase_peer_route_ref(p, lds, 0, (const bf16_t*)(ws + S_QP0), (int*)(ws + S_EIDX0), (float*)(ws + S_GW0)); }
    if (IN(8)) { if (USE_MFMA_ROUTE) phase_peer_route(p, lds, 0, (const bf16_t*)(ws + S_QP0), (int*)(ws + S_EIDX0), (float*)(ws + S_GW0)); else phase_peer_route_ref(p, lds, 0, (const bf16_t*)(ws + S_QP0), (int*)(ws + S_EIDX0), (float*)(ws + S_GW0)); } SEAM(8);
    if (IN(9) && ((PROBE_DUP & 2) || PROBE_REP == 9)) for (int rep_ = 0; rep_ < PROBE_N; ++rep_) { phase_peer_gather(p, 0, (const int*)(ws + S_EIDX0), (const float*)(ws + S_GW0), HB, (bf16_t*)(ws + S_Z), nullptr, 1.f); }
    if (IN(9)) { phase_peer_gather(p, 0, (const int*)(ws + S_EIDX0), (const float*)(ws + S_GW0), HB, HB, nullptr, (ABL & 2) ? 0.f : 1.f); } SEAM(9);
    if (IN(10)) for (int rep_ = 0; rep_ < ((PROBE_REP == 10) ? 1 + PROBE_N : 1); ++rep_) { EpiBf16 E{(bf16_t*)(ws + S_DQ), MLA_DOWN_PAD};
        run_gemm(lds, HB, 1024, (const bf16_t*)(ws + WS_W_MLADOWN_T), 1024, NTOK, MLA_DOWN_PAD, 1024, (int)blockIdx.x, E); } SEAM(10);
    if (IN(11)) for (int rep_ = 0; rep_ < ((PROBE_REP == 11) ? 1 + PROBE_N : 1); ++rep_) { phase_mla_rowstats(p); } SEAM(11);
    if (IN(12)) for (int rep_ = 0; rep_ < ((PROBE_REP == 12) ? 1 + PROBE_N : 1); ++rep_) { EpiBf16 Eq{(bf16_t*)(ws + S_QF), 1536}; EpiKV Ekv{(bf16_t*)(ws + S_KNOPE), (bf16_t*)(ws + S_V)};
        run_gemm(lds, (const bf16_t*)(ws + S_DQ), MLA_DOWN_PAD, (const bf16_t*)(ws + WS_W_UQ_T), 768, NTOK, 1536, 768, (int)blockIdx.x, Eq);
        run_gemm(lds, (const bf16_t*)(ws + S_DQ) + 768, MLA_DOWN_PAD, (const bf16_t*)(ws + WS_W_UKV_T), 256, NTOK, 2048, 256, (int)blockIdx.x, Ekv); } SEAM(12);
    if (IN(13)) for (int rep_ = 0; rep_ < ((PROBE_REP == 13) ? 1 + PROBE_N : 1); ++rep_) { if (USE_MFMA_MLA) phase_mla_attn(p, lds); else phase_mla_attn_ref(p, lds); } SEAM(13);
    if (IN(14)) for (int rep_ = 0; rep_ < ((PROBE_REP == 14) ? 1 + PROBE_N : 1); ++rep_) { EpiResid E{HB, (bf16_t*)(ws + S_Z2), (ABL & 4) ? 0.f : 1.f};
        run_gemm(lds, (const bf16_t*)(ws + S_AO2), 1024, (const bf16_t*)(ws + WS_W_MLAOUT_T), 1024, NTOK, 1024, 1024, (int)blockIdx.x, E); } SEAM(14);
    if (IN(15)) for (int rep_ = 0; rep_ < ((PROBE_REP == 15) ? 1 + PROBE_N : 1); ++rep_) { phase_ln((const bf16_t*)(ws + S_Z2), HB, p.in[I_MLA_LNG], p.in[I_MLA_LNB]); } SEAM(15);
    if (IN(16)) for (int rep_ = 0; rep_ < ((PROBE_REP == 16) ? 1 + PROBE_N : 1); ++rep_) { EpiBf16 E{(bf16_t*)(ws + S_QP1), 2048};
        run_gemm(lds, HB, 1024, (const bf16_t*)(ws + WS_W_PQ_T) + (size_t)2048 * 1024, 1024, NTOK, 2048, 1024, (int)blockIdx.x, E); } SEAM(16);
    if (IN(17) && ((PROBE_DUP & 1) || PROBE_REP == 17)) for (int rep_ = 0; rep_ < PROBE_N; ++rep_) { phase_peer_route_ref(p, lds, 1, (const bf16_t*)(ws + S_QP1), (int*)(ws + S_EIDX1), (float*)(ws + S_GW1)); }
    if (IN(17)) { if (USE_MFMA_ROUTE) phase_peer_route(p, lds, 1, (const bf16_t*)(ws + S_QP1), (int*)(ws + S_EIDX1), (float*)(ws + S_GW1)); else phase_peer_route_ref(p, lds, 1, (const bf16_t*)(ws + S_QP1), (int*)(ws + S_EIDX1), (float*)(ws + S_GW1)); } SEAM(17);
    if (IN(18) && ((PROBE_DUP & 2) || PROBE_REP == 18)) for (int rep_ = 0; rep_ < PROBE_N; ++rep_) { phase_peer_gather(p, 1, (const int*)(ws + S_EIDX1), (const float*)(ws + S_GW1), HB, (bf16_t*)(ws + S_Z2), nullptr, 1.f); }
    if (IN(18)) { phase_peer_gather(p, 1, (const int*)(ws + S_EIDX1), (const float*)(ws + S_GW1), HB, HB, p.out, (ABL & 8) ? 0.f : 1.f); }
#if DBG_STAT
    if (IN(18)) { asm volatile("s_waitcnt vmcnt(0) lgkmcnt(0)" ::: "memory"); __builtin_amdgcn_fence(__ATOMIC_RELEASE, "agent"); cg::this_grid().sync(); __builtin_amdgcn_fence(__ATOMIC_ACQUIRE, "agent");
        const float c = 1.f + __hip_atomic_load((float*)(ws + WS_CTL) + 16, __ATOMIC_RELAXED, __HIP_MEMORY_SCOPE_AGENT);
        for (size_t i = (size_t)blockIdx.x * NTHREADS + threadIdx.x; i < (size_t)NTOK * DM; i += (size_t)gridDim.x * NTHREADS) p.out[i] = c; }
#endif
#undef IN
#undef SEAM
}

extern "C" void kernel_launch(void* const* d_in, const int* in_sizes, int n_in, void* d_out, int out_size, void* d_ws, size_t ws_size, hipStream_t stream) {
    static int grid = 0;
    if (grid == 0) {
        if (n_in != 28 || out_size != NTOK * DM || ws_size < WS_NEED) { fprintf(stderr, "kernel_launch: unexpected problem (n_in %d, out %d, ws %zu)\n", n_in, out_size, ws_size); grid = -1; return; }
        int dev = 0, cus = 0, per_cu = 0;
        (void)hipGetDevice(&dev); (void)hipDeviceGetAttribute(&cus, hipDeviceAttributeMultiprocessorCount, dev);
        if (hipFuncSetAttribute((const void*)fwd_kernel, hipFuncAttributeMaxDynamicSharedMemorySize, LDS_BYTES) != hipSuccess) { fprintf(stderr, "kernel_launch: hipFuncSetAttribute failed\n"); grid = -1; return; }
        if (hipOccupancyMaxActiveBlocksPerMultiprocessor(&per_cu, (const void*)fwd_kernel, NTHREADS, LDS_BYTES) != hipSuccess || per_cu < 1) { fprintf(stderr, "kernel_launch: occupancy query says %d blocks per CU\n", per_cu); grid = -1; return; }
        grid = cus;
    }
    if (grid < 0) return;
    Params p{};
    for (int i = 0; i < 28; ++i) p.in[i] = (const float*)d_in[i];
    p.out = (float*)d_out; p.ws = (unsigned char*)d_ws;
#if MK_ONE_LAUNCH
    p.ph_lo = 0; p.ph_hi = NPHASES;
    void* args[] = {&p};
    hipError_t e = hipLaunchCooperativeKernel((const void*)fwd_kernel, dim3(grid), dim3(NTHREADS), args, LDS_BYTES, stream);
    if (e != hipSuccess) fprintf(stderr, "kernel_launch: cooperative launch failed: %s\n", hipGetErrorString(e));
#else
    for (int k = 0; k < NPHASES; ++k) { p.ph_lo = k; p.ph_hi = k + 1; hipLaunchKernelGGL(fwd_kernel, dim3(grid), dim3(NTHREADS), LDS_BYTES, stream, p); }
#endif
}
#ifdef REGTEST
__global__ void __launch_bounds__(256) regtest_nsa(Params p) { extern __shared__ __attribute__((aligned(16))) unsigned char l2[]; phase_nsa_attn(p, (LAS unsigned char*)l2); }
__global__ void __launch_bounds__(256) regtest_mla(Params p) { extern __shared__ __attribute__((aligned(16))) unsigned char l2[]; phase_mla_attn(p, (LAS unsigned char*)l2); }
#endif
```

```cpp
#include <hip/hip_runtime.h>
#include <hip/hip_cooperative_groups.h>
#include <cstdio>
#include <cstdint>
namespace cg = cooperative_groups;

#ifndef ABL
#define ABL 0
#endif
#ifndef PROBE_DUP
#define PROBE_DUP 0
#endif
#ifndef PROBE_REP
#define PROBE_REP -1
#endif
#ifndef PROBE_N
#define PROBE_N 2
#endif
#ifndef USE_MFMA_ROUTE
#define USE_MFMA_ROUTE 1
#endif
#ifndef USE_MFMA_NSA
#define USE_MFMA_NSA 1
#endif
#ifndef USE_MFMA_MLA
#define USE_MFMA_MLA 1
#endif
#ifndef DBG_STAT
#define DBG_STAT 0
#endif
#ifndef MK_ONE_LAUNCH
#define MK_ONE_LAUNCH 1
#endif

#define LAS __attribute__((address_space(3)))
typedef unsigned short bf16_t;
typedef short bf16x8 __attribute__((ext_vector_type(8)));
typedef float f32x4 __attribute__((ext_vector_type(4)));
typedef float f32x2 __attribute__((ext_vector_type(2)));
typedef unsigned u32x4 __attribute__((ext_vector_type(4)));
typedef unsigned u32x2 __attribute__((ext_vector_type(2)));
typedef __bf16 bf16x2_t __attribute__((ext_vector_type(2)));

constexpr int BATCH = 8, SEQ = 4096, DM = 1024, NTOK = BATCH * SEQ;
constexpr int NSA_IN = 2608, NSA_IN_PAD = 2816;
constexpr int MLA_DOWN = 1056, MLA_DOWN_PAD = 1280;
constexpr int NEXP = 16384;
constexpr float DN_ALPHA = 1.4142135623730951f;
constexpr float LN_EPS = 1e-5f, RMS_EPS = 1e-6f;
constexpr float U_SCALE = 1024.f, V_SCALE = 64.f;
constexpr int NWAVES = 8, NTHREADS = 512;
constexpr int LDS_BYTES = 147456;

constexpr size_t KiB = 1024, MiB = 1024 * 1024;
constexpr size_t WS_CTL = 0, CTL_BYTES = 64 * KiB;
constexpr size_t WS_W_IN_T = 1 * MiB;
constexpr size_t WS_W_NSAOUT_T = 6 * MiB + 512 * KiB;
constexpr size_t WS_W_CK1_T = 8 * MiB + 512 * KiB;
constexpr size_t WS_W_CV1_T = 9 * MiB;
constexpr size_t WS_W_MLADOWN_T = 9 * MiB + 512 * KiB;
constexpr size_t WS_W_UQ_T = 12 * MiB;
constexpr size_t WS_W_UKV_T = 14 * MiB + 256 * KiB;
constexpr size_t WS_W_MLAOUT_T = 15 * MiB + 256 * KiB;
constexpr size_t WS_W_PQ_T = 17 * MiB + 256 * KiB;
constexpr size_t WS_SUBK = 25 * MiB + 256 * KiB;
constexpr size_t WS_MISC = 27 * MiB;
constexpr size_t WS_PE = WS_MISC;
constexpr size_t WS_ROPE_COS = WS_MISC + 4 * KiB;
constexpr size_t WS_ROPE_SIN = WS_ROPE_COS + 256 * KiB;
constexpr size_t WS_RSTD_Q = WS_ROPE_SIN + 256 * KiB;
constexpr size_t WS_RSTD_KV = WS_RSTD_Q + 128 * KiB;
constexpr size_t WS_TAB = 32 * MiB;
constexpr size_t WS_HB = 160 * MiB;
constexpr size_t WS_S = 224 * MiB;
constexpr size_t S_Q = WS_S;
constexpr size_t S_KV6 = WS_S + 64 * MiB;
constexpr size_t S_AO = WS_S + 160 * MiB;
constexpr size_t S_GATES = WS_S + 224 * MiB;
constexpr size_t S_PK = WS_S + 230 * MiB;
constexpr size_t S_PV = WS_S + 238 * MiB;
constexpr size_t S_KCMP = WS_S + 246 * MiB;
constexpr size_t S_VCMP = S_KCMP + 512 * KiB;
constexpr size_t S_Z = WS_S;
constexpr size_t S_QP0 = WS_S + 64 * MiB;
constexpr size_t S_EIDX0 = WS_S + 192 * MiB;
constexpr size_t S_GW0 = WS_S + 208 * MiB;
constexpr size_t S_DQ = WS_S;
constexpr size_t S_QF = WS_S + 80 * MiB;
constexpr size_t S_V = WS_S + 176 * MiB;
constexpr size_t S_KROPE = WS_S + 240 * MiB;
constexpr size_t S_KNOPE = WS_TAB + 64 * MiB;
constexpr size_t S_AO2 = WS_S;
constexpr size_t S_Z2 = WS_S + 80 * MiB;
constexpr size_t S_QP1 = WS_S + 144 * MiB;
constexpr size_t S_EIDX1 = WS_S;
constexpr size_t S_GW1 = WS_S + 16 * MiB;
constexpr size_t WS_NEED = 512 * MiB;
static_assert(S_QP1 + 128 * MiB <= WS_NEED && S_VCMP + 512 * KiB <= WS_NEED, "workspace map");

__device__ __forceinline__ float bf_lo(unsigned u) { return __uint_as_float(u << 16); }
__device__ __forceinline__ float bf_hi(unsigned u) { return __uint_as_float(u & 0xffff0000u); }
__device__ __forceinline__ float bf2f(bf16_t v) { return __uint_as_float((unsigned)v << 16); }
__device__ __forceinline__ unsigned pk2(float lo, float hi) { f32x2 v = {lo, hi}; bf16x2_t b = __builtin_convertvector(v, bf16x2_t); return __builtin_bit_cast(unsigned, b); }
__device__ __forceinline__ bf16_t f2bf(float f) { return (bf16_t)(pk2(f, 0.f) & 0xffffu); }
__device__ __forceinline__ float wave_sum(float v) {
#pragma unroll
    for (int o = 32; o >= 1; o >>= 1) v += __shfl_xor(v, o);
    return v;
}
__device__ __forceinline__ float wave_max(float v) {
#pragma unroll
    for (int o = 32; o >= 1; o >>= 1) v = fmaxf(v, __shfl_xor(v, o));
    return v;
}
__device__ __forceinline__ float gelu_tanh(float x) {
    const float y = 0.7978845608028654f * (x + 0.044715f * x * x * x);
    const float e = __expf(2.f * y);
    const float th = 1.f - 2.f / (1.f + e);
    return 0.5f * x * (1.f + th);
}
#define LDS_FENCE() asm volatile("s_waitcnt lgkmcnt(0)" ::: "memory")

namespace pg8 {
constexpr int BM = 256, BK = 64, HALF = 128, HTB = HALF * BK * 2, STAGE_BYTES = 8 * HTB, NXCD = 8, WGM = 8;
__host__ __device__ __forceinline__ int lds_byte(int r, int c) { const int st = (r >> 4) * 2 + (c >> 5), rr = r & 15, cc = c & 31, ob = rr * 64 + cc * 2; return st * 1024 + (ob ^ (((ob >> 9) & 1) << 5)); }
__host__ __device__ __forceinline__ void stage_rc(int b, int& R, int& C) { const int st = b / 1024, sb = b % 1024, swz = sb ^ (((sb >> 9) & 1) << 5); R = (st >> 1) * 16 + swz / 64; C = (st & 1) * 32 + (swz % 64) / 2; }
__host__ __device__ __forceinline__ int perm32(int rho) { const int n = rho >> 4, i = rho & 15; return 8 * (i >> 2) + 4 * n + (i & 3); }
struct Unit { int pm, pn; };
struct Gemm { const bf16_t* A; const bf16_t* Bt; int M, N, K, lda, ldb; };
struct StaticOrder {
    int nM, nN, nwg, G, c;
    __device__ void init(int M, int N, int G_, int c_) { nM = M / BM; nN = N / BM; nwg = nM * nN; G = G_; c = c_; }
    __device__ bool next(int i, Unit& u) const {
        const long L = (long)i * G + c; if (L >= nwg) return false;
        int wgid = (int)L; { const int q = nwg / NXCD, r = nwg % NXCD, xcd = wgid % NXCD, off = wgid / NXCD; wgid = (xcd < r ? xcd * (q + 1) : r * (q + 1) + (xcd - r) * q) + off; }
        const int nig = WGM * nN, gid = wgid / nig, fm = gid * WGM, gsz = (nM - fm) < WGM ? (nM - fm) : WGM;
        u.pm = fm + ((wgid % nig) % gsz); u.pn = (wgid % nig) / gsz; return true;
    }
};
template <class F> struct EpiFn {
    static constexpr bool PERM = true;
    F f;
    __device__ __forceinline__ void operator()(const f32x4 (&acc)[2][2][4][2], const Unit& u, int wr, int wc, int fr, int fq) const {
        const int row0 = u.pm * BM + wr * 64 + fr, col0 = u.pn * BM + wc * 32 + 8 * fq;
#pragma unroll
        for (int ai = 0; ai < 2; ++ai)
#pragma unroll
            for (int m = 0; m < 4; ++m)
#pragma unroll
                for (int bj = 0; bj < 2; ++bj) f(row0 + ai * HALF + m * 16, col0 + bj * HALF, acc[ai][bj][m][0], acc[ai][bj][m][1]);
    }
};

template <class Epi, class Sched>
__device__ __forceinline__ void gemm_phase(LAS unsigned char* lds, const Gemm g, const Sched& S, const Epi& E) {
    const int tid = threadIdx.x, wid = __builtin_amdgcn_readfirstlane(tid >> 6), lane = tid & 63, wr = wid >> 2, wc = wid & 3, fr = lane & 15, fq = lane >> 4;
    const int K = g.K, nt = K / BK;
    unsigned voffA[2], voffB[2];
#pragma unroll
    for (int i = 0; i < 2; ++i) { int R, C; stage_rc(tid * 16 + i * 8192, R, C); const int Rb = Epi::PERM ? ((R & ~31) + perm32(R & 31)) : R;
        voffA[i] = (unsigned)(R * g.lda + C) * 2u; voffB[i] = (unsigned)(Rb * g.ldb + C) * 2u; }
    const size_t kstep = (size_t)(BK * 2);
    const size_t hstepA = (size_t)HALF * g.lda * 2, hstepB = (size_t)HALF * g.ldb * 2;
    const size_t tstepA = 2 * hstepA, tstepB = 2 * hstepB;
    const unsigned ldsw = (unsigned)wid * 1024u;
    const int aoff = lds_byte(wr * 64 + fr, fq * 8), boff = lds_byte(wc * 32 + fr, fq * 8);
#define PG8_SA(b, h) (((b) * 2 + (h)) * HTB)
#define PG8_SB(b, h) ((4 + (b) * 2 + (h)) * HTB)
#define PG8_STAGE(bufoff, gbase, voff) do { _Pragma("unroll") for (int _i = 0; _i < 2; ++_i) \
        __builtin_amdgcn_global_load_lds((const unsigned*)((const char*)(gbase) + (voff)[_i]), (LAS unsigned*)(lds + (bufoff) + ldsw + _i * 8192), 16, 0, 0); } while (0)
#define PG8_LDA(dst, b, h) do { _Pragma("unroll") for (int m = 0; m < 4; ++m) _Pragma("unroll") for (int k = 0; k < 2; ++k) dst[m][k] = *(const LAS bf16x8*)(lds + PG8_SA(b, h) + aoff + m * 2048 + k * 1024); } while (0)
#define PG8_LDB(dst, b, h) do { _Pragma("unroll") for (int n = 0; n < 2; ++n) _Pragma("unroll") for (int k = 0; k < 2; ++k) dst[n][k] = *(const LAS bf16x8*)(lds + PG8_SB(b, h) + boff + n * 2048 + k * 1024); } while (0)
#define PG8_MMA(ai, bj, At, Bt) do { __builtin_amdgcn_s_setprio(1); _Pragma("unroll") for (int m = 0; m < 4; ++m) _Pragma("unroll") for (int n = 0; n < 2; ++n) _Pragma("unroll") for (int k = 0; k < 2; ++k) \
        acc[ai][bj][m][n] = __builtin_amdgcn_mfma_f32_16x16x32_bf16(Bt[n][k], At[m][k], acc[ai][bj][m][n], 0, 0, 0); __builtin_amdgcn_s_setprio(0); } while (0)
#define PG8_WAIT_V(n) asm volatile("s_waitcnt vmcnt(" #n ")" ::: "memory")
#define PG8_WAIT_L(n) asm volatile("s_waitcnt lgkmcnt(" #n ")" ::: "memory")
#define PG8_BAR __builtin_amdgcn_s_barrier()
#define PG8_SCHED __builtin_amdgcn_sched_barrier(0)
    Unit cur, nxt; int ui = 0;
    if (!S.next(0, cur)) return;
    f32x4 acc[2][2][4][2];
#pragma unroll
    for (int a = 0; a < 2; ++a)
#pragma unroll
        for (int b = 0; b < 2; ++b)
#pragma unroll
            for (int m = 0; m < 4; ++m)
#pragma unroll
                for (int n = 0; n < 2; ++n) acc[a][b][m][n] = (f32x4){0.f, 0.f, 0.f, 0.f};
    bf16x8 At[4][2], B0[2][2], B1[2][2];
    const char* cA = (const char*)g.A + (size_t)cur.pm * tstepA; const char* cB = (const char*)g.Bt + (size_t)cur.pn * tstepB;
    PG8_STAGE(PG8_SB(0, 0), cB, voffB); PG8_STAGE(PG8_SB(0, 1), cB + hstepB, voffB); PG8_STAGE(PG8_SA(0, 0), cA, voffA); PG8_STAGE(PG8_SA(0, 1), cA + hstepA, voffA);
    if (wr == 1) PG8_BAR;
    PG8_WAIT_V(2); PG8_BAR;
    PG8_STAGE(PG8_SB(1, 0), cB + kstep, voffB); PG8_STAGE(PG8_SA(1, 0), cA + kstep, voffA); PG8_STAGE(PG8_SB(1, 1), cB + hstepB + kstep, voffB);
    PG8_WAIT_V(6); PG8_BAR;
    for (;;) {
        const bool has_next = S.next(ui + 1, nxt);
        const char* nA = has_next ? (const char*)g.A + (size_t)nxt.pm * tstepA : cA; const char* nB = has_next ? (const char*)g.Bt + (size_t)nxt.pn * tstepB : cB;
        for (int t = 0; t < nt; t += 2) {
            const bool last = (t == nt - 2);
            const char* a1 = cA + (size_t)(t + 1) * kstep;
            const char* a2 = last ? nA : cA + (size_t)(t + 2) * kstep; const char* b2 = last ? nB : cB + (size_t)(t + 2) * kstep;
            const char* a3 = a2 + kstep; const char* b3 = b2 + kstep;
            PG8_LDB(B0, 0, 0); PG8_LDB(B1, 0, 1); PG8_SCHED; PG8_LDA(At, 0, 0); PG8_STAGE(PG8_SA(1, 1), a1 + hstepA, voffA);
            PG8_WAIT_V(8); PG8_WAIT_L(0); PG8_BAR; PG8_MMA(0, 0, At, B0); PG8_MMA(0, 1, At, B1); PG8_BAR; PG8_SCHED;
            PG8_LDA(At, 0, 1); PG8_STAGE(PG8_SB(0, 0), b2, voffB); PG8_STAGE(PG8_SB(0, 1), b2 + hstepB, voffB); PG8_STAGE(PG8_SA(0, 0), a2, voffA);
            PG8_WAIT_V(8); PG8_WAIT_L(0); PG8_BAR; PG8_MMA(1, 0, At, B0); PG8_MMA(1, 1, At, B1); PG8_BAR; PG8_SCHED;
            PG8_LDB(B0, 1, 0); PG8_LDB(B1, 1, 1); PG8_SCHED; PG8_LDA(At, 1, 0); PG8_STAGE(PG8_SA(0, 1), a2 + hstepA, voffA);
            PG8_WAIT_V(8); PG8_WAIT_L(0); PG8_BAR; PG8_MMA(0, 0, At, B0); PG8_MMA(0, 1, At, B1); PG8_BAR; PG8_SCHED;
            PG8_LDA(At, 1, 1); PG8_STAGE(PG8_SB(1, 0), b3, voffB); PG8_STAGE(PG8_SB(1, 1), b3 + hstepB, voffB); PG8_STAGE(PG8_SA(1, 0), a3, voffA);
            PG8_WAIT_V(8); PG8_WAIT_L(0); PG8_BAR; PG8_MMA(1, 0, At, B0); PG8_MMA(1, 1, At, B1); PG8_BAR; PG8_SCHED;
        }
        if (wr == 0) PG8_BAR;
        E(acc, cur, wr, wc, fr, fq);
        if (!has_next) break;
#pragma unroll
        for (int a = 0; a < 2; ++a)
#pragma unroll
            for (int b = 0; b < 2; ++b)
#pragma unroll
                for (int m = 0; m < 4; ++m)
#pragma unroll
                    for (int n = 0; n < 2; ++n) acc[a][b][m][n] = (f32x4){0.f, 0.f, 0.f, 0.f};
        cur = nxt; cA = nA; cB = nB; ++ui;
        if (wr == 1) PG8_BAR;
    }
    PG8_WAIT_V(0);
    PG8_BAR;
#undef PG8_SA
#undef PG8_SB
#undef PG8_STAGE
#undef PG8_LDA
#undef PG8_LDB
#undef PG8_MMA
#undef PG8_WAIT_V
#undef PG8_WAIT_L
#undef PG8_BAR
#undef PG8_SCHED
}
}

template <class F>
__device__ __forceinline__ void run_gemm(LAS unsigned char* lds, const bf16_t* A, int lda, const bf16_t* Bt, int ldb, int M, int N, int K, int vblock, const F& f) {
    pg8::Gemm g{A, Bt, M, N, K, lda, ldb}; pg8::StaticOrder S; S.init(M, N, (int)gridDim.x, vblock);
    pg8::EpiFn<F> E{f};
    pg8::gemm_phase<pg8::EpiFn<F>, pg8::StaticOrder>(lds, g, S, E);
}

struct Params {
    const float* in[28];
    float* out;
    unsigned char* ws;
    int ph_lo, ph_hi;
};
enum { I_X = 0, I_NSA_WIN, I_CK_W1, I_CK_W2, I_CK_PE, I_CV_W1, I_CV_W2, I_CV_PE, I_NSA_WOUT, I_NSA_LNG, I_NSA_LNB, I_MLA_WDKV, I_MLA_KVG, I_MLA_WKR, I_MLA_WUK, I_MLA_WUV,
       I_MLA_WDQ, I_MLA_QG, I_MLA_WUQ, I_MLA_WOUT, I_MLA_LNG, I_MLA_LNB, I_PEER_WQ, I_PEER_SUBK, I_PEER_U, I_PEER_V, I_PEER_LNG, I_PEER_LNB };

__device__ __forceinline__ void p0_transpose_item(const float* W, int ldw, int n_valid, int K, bf16_t* WT, int row_off, const float* kscale, LAS float* scr, int nblk, int item, int lane) {
    const int kb = item / nblk, nb = item % nblk, k0 = 64 * kb, n0 = 32 * nb;
    const int n = n0 + (lane & 31);
#pragma unroll 8
    for (int i = 0; i < 32; ++i) { const int kk = 2 * i + (lane >> 5); float v = 0.f; if (n < n_valid) { v = W[(size_t)(k0 + kk) * ldw + n]; if (kscale) v *= kscale[k0 + kk]; } scr[kk * 33 + (lane & 31)] = v; }
    LDS_FENCE();
    const int c = lane & 7;
#pragma unroll
    for (int j = 0; j < 4; ++j) { const int nn = (lane >> 3) + 8 * j; const LAS float* s = scr + (8 * c) * 33 + nn;
        u32x4 o; o.x = pk2(s[0 * 33], s[1 * 33]); o.y = pk2(s[2 * 33], s[3 * 33]); o.z = pk2(s[4 * 33], s[5 * 33]); o.w = pk2(s[6 * 33], s[7 * 33]);
        *(u32x4*)(WT + (size_t)(row_off + n0 + nn) * K + k0 + 8 * c) = o; }
    LDS_FENCE();
}
__device__ __forceinline__ void cvt_f32_bf16(const float* src, bf16_t* dst, size_t n, size_t gtid, size_t gsz) {
    for (size_t i = gtid * 8; i < n; i += gsz * 8) { const f32x4 a = *(const f32x4*)(src + i), b = *(const f32x4*)(src + i + 4);
        u32x4 o; o.x = pk2(a.x, a.y); o.y = pk2(a.z, a.w); o.z = pk2(b.x, b.y); o.w = pk2(b.z, b.w); *(u32x4*)(dst + i) = o; }
}
__device__ __forceinline__ void cvt_f32_fp8(const float* src, unsigned char* dst, size_t n, float scale, size_t gtid, size_t gsz) {
    for (size_t i = gtid * 16; i < n; i += gsz * 16) {
        u32x4 o;
#pragma unroll
        for (int j = 0; j < 4; ++j) { f32x4 a = *(const f32x4*)(src + i + 4 * j) * scale;
#pragma unroll
            for (int e = 0; e < 4; ++e) a[e] = fminf(fmaxf(a[e], -448.f), 448.f);
            int pk = 0; pk = __builtin_amdgcn_cvt_pk_fp8_f32(a.x, a.y, pk, false); pk = __builtin_amdgcn_cvt_pk_fp8_f32(a.z, a.w, pk, true); o[j] = (unsigned)pk; }
        *(u32x4*)(dst + i) = o;
    }
}
__device__ __forceinline__ void phase_prologue(const Params& p, LAS unsigned char* lds) {
    const int tid = threadIdx.x, lane = tid & 63, wave = tid >> 6;
    LAS float* scr = (LAS float*)(lds + wave * 16384);
    const int gw = blockIdx.x * NWAVES + wave, NGW = gridDim.x * NWAVES;
    unsigned char* ws = p.ws;
    int base = 0;
#define TJOB(W_, ldw_, nvalid_, K_, npad_, WT_, rowoff_, ks_) do { const int nblk = (npad_) / 32, nit = ((K_) / 64) * nblk; \
        for (int it = gw - base; it < nit; it += NGW) { if (it >= 0) p0_transpose_item((W_), (ldw_), (nvalid_), (K_), (WT_), (rowoff_), (ks_), scr, nblk, it, lane); } \
        base = (base + nit) % NGW; } while (0)
    TJOB(p.in[I_NSA_WIN], NSA_IN, NSA_IN, 1024, NSA_IN_PAD, (bf16_t*)(ws + WS_W_IN_T), 0, (const float*)nullptr);
    TJOB(p.in[I_NSA_WOUT], 1024, 1024, 1024, 1024, (bf16_t*)(ws + WS_W_NSAOUT_T), 0, (const float*)nullptr);
    TJOB(p.in[I_CK_W1], 128, 128, 1024, 128, (bf16_t*)(ws + WS_W_CK1_T), 0, (const float*)nullptr);
    TJOB(p.in[I_CK_W1] + 1024 * 128, 128, 128, 1024, 128, (bf16_t*)(ws + WS_W_CK1_T), 128, (const float*)nullptr);
    TJOB(p.in[I_CV_W1], 128, 128, 1024, 128, (bf16_t*)(ws + WS_W_CV1_T), 0, (const float*)nullptr);
    TJOB(p.in[I_CV_W1] + 1024 * 128, 128, 128, 1024, 128, (bf16_t*)(ws + WS_W_CV1_T), 128, (const float*)nullptr);
    TJOB(p.in[I_MLA_WDQ], 768, 768, 1024, 768, (bf16_t*)(ws + WS_W_MLADOWN_T), 0, (const float*)nullptr);
    TJOB(p.in[I_MLA_WDKV], 256, 256, 1024, 256, (bf16_t*)(ws + WS_W_MLADOWN_T), 768, (const float*)nullptr);
    TJOB(p.in[I_MLA_WKR], 32, 32, 1024, 256, (bf16_t*)(ws + WS_W_MLADOWN_T), 1024, (const float*)nullptr);
    TJOB(p.in[I_MLA_WUQ], 1536, 1536, 768, 1536, (bf16_t*)(ws + WS_W_UQ_T), 0, p.in[I_MLA_QG]);
    TJOB(p.in[I_MLA_WUK], 1024, 1024, 256, 1024, (bf16_t*)(ws + WS_W_UKV_T), 0, p.in[I_MLA_KVG]);
    TJOB(p.in[I_MLA_WUV], 1024, 1024, 256, 1024, (bf16_t*)(ws + WS_W_UKV_T), 1024, p.in[I_MLA_KVG]);
    TJOB(p.in[I_MLA_WOUT], 1024, 1024, 1024, 1024, (bf16_t*)(ws + WS_W_MLAOUT_T), 0, (const float*)nullptr);
    TJOB(p.in[I_PEER_WQ], 2048, 2048, 1024, 2048, (bf16_t*)(ws + WS_W_PQ_T), 0, (const float*)nullptr);
    TJOB(p.in[I_PEER_WQ] + (size_t)1024 * 2048, 2048, 2048, 1024, 2048, (bf16_t*)(ws + WS_W_PQ_T) + (size_t)2048 * 1024, 0, (const float*)nullptr);
#undef TJOB
#if DBG_STAT
    if (blockIdx.x == 0 && tid == 0) ((float*)(ws + WS_CTL))[16] = 0.f;
#endif
    const size_t gtid = (size_t)blockIdx.x * NTHREADS + tid, gsz = (size_t)gridDim.x * NTHREADS;
    cvt_f32_bf16(p.in[I_X], (bf16_t*)(ws + WS_HB), (size_t)NTOK * DM, gtid, gsz);
    cvt_f32_bf16(p.in[I_PEER_SUBK], (bf16_t*)(ws + WS_SUBK), (size_t)2 * 8 * 2 * 128 * 128, gtid, gsz);
    cvt_f32_fp8(p.in[I_PEER_U], ws + WS_TAB, (size_t)NEXP * DM, U_SCALE, gtid, gsz);
    cvt_f32_fp8(p.in[I_PEER_V], ws + WS_TAB + 16 * MiB, (size_t)NEXP * DM, V_SCALE, gtid, gsz);
    cvt_f32_fp8(p.in[I_PEER_U] + (size_t)NEXP * DM, ws + WS_TAB + 32 * MiB, (size_t)NEXP * DM, U_SCALE, gtid, gsz);
    cvt_f32_fp8(p.in[I_PEER_V] + (size_t)NEXP * DM, ws + WS_TAB + 48 * MiB, (size_t)NEXP * DM, V_SCALE, gtid, gsz);
    for (int o = gw; o < 256; o += NGW) {
        const float* pe = (o < 128) ? p.in[I_CK_PE] : p.in[I_CV_PE]; const float* w1 = (o < 128) ? p.in[I_CK_W1] : p.in[I_CV_W1]; const int h = o & 127;
        float s = 0.f; for (int i = lane; i < 2048; i += 64) s += pe[i] * w1[(size_t)i * 128 + h];
        s = wave_sum(s); if (lane == 0) ((float*)(ws + WS_PE))[o] = s;
    }
    for (size_t i = gtid; i < (size_t)SEQ * 16; i += gsz) {
        const int pos = (int)(i >> 4), fi = (int)(i & 15);
        const float inv = 1.0f / powf(10000.0f, (float)(2 * fi) / 32.0f);
        const float ang = (float)pos * inv;
        const double rev = (double)ang * 0.15915494309189535; const double fr = rev - rint(rev);
        ((float*)(ws + WS_ROPE_COS))[i] = __builtin_amdgcn_cosf((float)fr); ((float*)(ws + WS_ROPE_SIN))[i] = __builtin_amdgcn_sinf((float)fr);
    }
}

__device__ __forceinline__ u32x4 pack8(const f32x4& a, const f32x4& b) { u32x4 o; o.x = pk2(a.x, a.y); o.y = pk2(a.z, a.w); o.z = pk2(b.x, b.y); o.w = pk2(b.z, b.w); return o; }
struct EpiNsaProj {
    bf16_t* q; bf16_t* kv6; float* gates;
    __device__ __forceinline__ void operator()(int row, int col, const f32x4& a, const f32x4& b) const {
        if (col < 1024) { *(u32x4*)(q + (size_t)row * 1024 + col) = pack8(a, b); }
        else if (col < 2560) {
            const int which = (col - 1024) >> 8, cc = (col - 1024) & 255;
            bf16_t* base = kv6 + (size_t)which * NTOK * 256;
            if (which < 2) { const int g = cc >> 6, d = cc & 63, bb = row >> 12, t = row & 4095, n = t >> 4, l = t & 15;
                *(u32x4*)(base + ((((size_t)(bb * 256 + n) * 4 + g) * 16 + l) * 64 + d)) = pack8(a, b); }
            else *(u32x4*)(base + (size_t)row * 256 + cc) = pack8(a, b);
        } else if (col < NSA_IN) {
            float* gp = gates + (size_t)row * 48 + (col - 2560);
            f32x4 s0, s1;
#pragma unroll
            for (int i = 0; i < 4; ++i) { s0[i] = 1.f / (1.f + __expf(-a[i])); s1[i] = 1.f / (1.f + __expf(-b[i])); }
            *(f32x4*)gp = s0; *(f32x4*)(gp + 4) = s1;
        }
    }
};
struct EpiF32 { float* O; int ldc; __device__ __forceinline__ void operator()(int row, int col, const f32x4& a, const f32x4& b) const { float* o = O + (size_t)row * ldc + col; *(f32x4*)o = a; *(f32x4*)(o + 4) = b; } };
struct EpiBf16 { bf16_t* O; int ldc; __device__ __forceinline__ void operator()(int row, int col, const f32x4& a, const f32x4& b) const { *(u32x4*)(O + (size_t)row * ldc + col) = pack8(a, b); } };
struct EpiResid {
    const bf16_t* H; bf16_t* Z; float ms;
    __device__ __forceinline__ void operator()(int row, int col, const f32x4& a_, const f32x4& b_) const {
        const f32x4 a = a_ * ms, b = b_ * ms;
        const u32x4 h = *(const u32x4*)(H + (size_t)row * 1024 + col);
        f32x4 x, y;
        x.x = DN_ALPHA * bf_lo(h.x) + a.x; x.y = DN_ALPHA * bf_hi(h.x) + a.y; x.z = DN_ALPHA * bf_lo(h.y) + a.z; x.w = DN_ALPHA * bf_hi(h.y) + a.w;
        y.x = DN_ALPHA * bf_lo(h.z) + b.x; y.y = DN_ALPHA * bf_hi(h.z) + b.y; y.z = DN_ALPHA * bf_lo(h.w) + b.z; y.w = DN_ALPHA * bf_hi(h.w) + b.w;
        *(u32x4*)(Z + (size_t)row * 1024 + col) = pack8(x, y);
    }
};
struct EpiKV {
    bf16_t* KN; bf16_t* V;
    __device__ __forceinline__ void operator()(int row, int col, const f32x4& a, const f32x4& b) const {
        bf16_t* dst = (col < 1024) ? KN + (size_t)row * 1024 + col : V + (size_t)row * 1024 + (col - 1024);
        *(u32x4*)dst = pack8(a, b);
    }
};

__device__ __forceinline__ void phase_ln(const bf16_t* Z, bf16_t* H, const float* g, const float* b) {
    const int lane = threadIdx.x & 63, wave = threadIdx.x >> 6;
    const int gw = blockIdx.x * NWAVES + wave, NGW = gridDim.x * NWAVES;
    for (int row = gw; row < NTOK; row += NGW) {
        const u32x4 a = *(const u32x4*)(Z + (size_t)row * 1024 + lane * 8), c = *(const u32x4*)(Z + (size_t)row * 1024 + 512 + lane * 8);
        float v[16] = {bf_lo(a.x), bf_hi(a.x), bf_lo(a.y), bf_hi(a.y), bf_lo(a.z), bf_hi(a.z), bf_lo(a.w), bf_hi(a.w), bf_lo(c.x), bf_hi(c.x), bf_lo(c.y), bf_hi(c.y), bf_lo(c.z), bf_hi(c.z), bf_lo(c.w), bf_hi(c.w)};
        float s = 0.f;
#pragma unroll
        for (int i = 0; i < 16; ++i) s += v[i];
        const float mean = wave_sum(s) * (1.f / 1024.f); float q = 0.f;
#pragma unroll
        for (int i = 0; i < 16; ++i) { v[i] -= mean; q += v[i] * v[i]; }
        const float rstd = rsqrtf(wave_sum(q) * (1.f / 1024.f) + LN_EPS);
        float o[16];
#pragma unroll
        for (int hh = 0; hh < 2; ++hh) { const int c0 = hh * 512 + lane * 8; const f32x4 g0 = *(const f32x4*)(g + c0), g1 = *(const f32x4*)(g + c0 + 4), b0 = *(const f32x4*)(b + c0), b1 = *(const f32x4*)(b + c0 + 4);
#pragma unroll
            for (int i = 0; i < 4; ++i) { o[hh * 8 + i] = v[hh * 8 + i] * rstd * g0[i] + b0[i]; o[hh * 8 + 4 + i] = v[hh * 8 + 4 + i] * rstd * g1[i] + b1[i]; } }
        u32x4 w0, w1; w0.x = pk2(o[0], o[1]); w0.y = pk2(o[2], o[3]); w0.z = pk2(o[4], o[5]); w0.w = pk2(o[6], o[7]); w1.x = pk2(o[8], o[9]); w1.y = pk2(o[10], o[11]); w1.z = pk2(o[12], o[13]); w1.w = pk2(o[14], o[15]);
        *(u32x4*)(H + (size_t)row * 1024 + lane * 8) = w0; *(u32x4*)(H + (size_t)row * 1024 + 512 + lane * 8) = w1;
    }
}
__device__ __forceinline__ void phase_cmp_finish(const Params& p, LAS unsigned char* lds) {
    const int lane = threadIdx.x & 63, wave = threadIdx.x >> 6;
    const int gw = blockIdx.x * NWAVES + wave, NGW = gridDim.x * NWAVES;
    LAS float* hs = (LAS float*)(lds + wave * 512);
    for (int item = gw; item < 2 * 8192; item += NGW) {
        const int kv = item >> 13, r = item & 8191, n = (r >> 2) & 255;
        const float* P = (const float*)(p.ws + (kv ? S_PV : S_PK)); const float* pe = (const float*)(p.ws + WS_PE) + kv * 128;
        const float* w2 = p.in[kv ? I_CV_W2 : I_CK_W2];
        bf16_t* out = (bf16_t*)(p.ws + (kv ? S_VCMP : S_KCMP)) + (size_t)r * 64;
        if (n == 255) { out[lane] = 0; continue; }
        const float a0 = P[(size_t)r * 256 + lane] + P[(size_t)(r + 4) * 256 + 128 + lane] + pe[lane];
        const float a1 = P[(size_t)r * 256 + 64 + lane] + P[(size_t)(r + 4) * 256 + 192 + lane] + pe[64 + lane];
        LDS_FENCE();
        hs[lane] = gelu_tanh(a0); hs[64 + lane] = gelu_tanh(a1);
        LDS_FENCE();
        float s = 0.f;
#pragma unroll 8
        for (int h = 0; h < 128; ++h) s += hs[h] * w2[h * 64 + lane];
        out[lane] = f2bf(s);
    }
}
__device__ __forceinline__ void phase_mla_rowstats(const Params& p) {
    const int lane = threadIdx.x & 63, wave = threadIdx.x >> 6;
    const int gw = blockIdx.x * NWAVES + wave, NGW = gridDim.x * NWAVES;
    bf16_t* DQ = (bf16_t*)(p.ws + S_DQ);
    const float* rc = (const float*)(p.ws + WS_ROPE_COS); const float* rs = (const float*)(p.ws + WS_ROPE_SIN);
    for (int row = gw; row < NTOK; row += NGW) {
        bf16_t* r = DQ + (size_t)row * MLA_DOWN_PAD;
        u32x2 v[4]; float sq = 0.f, skv = 0.f;
#pragma unroll
        for (int j = 0; j < 4; ++j) { v[j] = *(const u32x2*)(r + j * 256 + lane * 4); const float a = bf_lo(v[j].x), b = bf_hi(v[j].x), c = bf_lo(v[j].y), d = bf_hi(v[j].y); const float ss = (a * a + b * b) + (c * c + d * d); if (j < 3) sq += ss; else skv += ss; }
        sq = wave_sum(sq); skv = wave_sum(skv);
        const float rq = rsqrtf(sq * (1.f / 768.f) + RMS_EPS), rkv = rsqrtf(skv * (1.f / 256.f) + RMS_EPS);
#pragma unroll
        for (int j = 0; j < 4; ++j) { const float f = (j < 3) ? rq : rkv; u32x2 o; o.x = pk2(bf_lo(v[j].x) * f, bf_hi(v[j].x) * f); o.y = pk2(bf_lo(v[j].y) * f, bf_hi(v[j].y) * f); *(u32x2*)(r + j * 256 + lane * 4) = o; }
        if (lane < 16) { const int pos = row & 4095; const float x1 = bf2f(r[1024 + lane]), x2 = bf2f(r[1040 + lane]), c = rc[pos * 16 + lane], s = rs[pos * 16 + lane];
            bf16_t* kr = (bf16_t*)(p.ws + S_KROPE) + (size_t)row * 32; kr[lane] = f2bf(x1 * c - x2 * s); kr[16 + lane] = f2bf(x2 * c + x1 * s); }
    }
}

struct OnlineSt { float m[4], l[4], o[4][2]; };
__device__ __forceinline__ void nsa_attend_block(OnlineSt& st, const bf16_t* Kb, const bf16_t* Vb, int pos0, int t, const float (&slope)[4], LAS float* qs, LAS float* ps, int lane) {
    const int pos = pos0 + lane; const bool valid = pos <= t;
    const bf16_t* krow = Kb + (size_t)(valid ? pos : t) * 256;
    float acc[4] = {0.f, 0.f, 0.f, 0.f};
#pragma unroll 2
    for (int d8 = 0; d8 < 8; ++d8) { const u32x4 kv = *(const u32x4*)(krow + d8 * 8);
        const float kf[8] = {bf_lo(kv.x), bf_hi(kv.x), bf_lo(kv.y), bf_hi(kv.y), bf_lo(kv.z), bf_hi(kv.z), bf_lo(kv.w), bf_hi(kv.w)};
#pragma unroll
        for (int e = 0; e < 8; ++e) { const f32x4 qv = *(const LAS f32x4*)(qs + (d8 * 8 + e) * 4);
#pragma unroll
            for (int r = 0; r < 4; ++r) acc[r] += qv[r] * kf[e]; } }
    const float dist = (float)(t - pos);
    f32x4 pe;
#pragma unroll
    for (int r = 0; r < 4; ++r) {
        const float s = valid ? acc[r] - slope[r] * dist : -1e30f;
        const float mb = wave_max(s), mn = fmaxf(st.m[r], mb);
        const float alpha = __expf(st.m[r] - mn);
        const float e = valid ? __expf(s - mn) : 0.f;
        st.l[r] = st.l[r] * alpha + wave_sum(e); st.o[r][0] *= alpha; st.o[r][1] *= alpha; st.m[r] = mn; pe[r] = e;
    }
    LDS_FENCE();
    *(LAS f32x4*)(ps + lane * 4) = pe;
    LDS_FENCE();
    const int hf = lane >> 5, dp = lane & 31;
    const int nk = (t - pos0 + 1 < 64) ? t - pos0 + 1 : 64;
#pragma unroll 4
    for (int kk = hf; kk < nk; kk += 2) {
        const unsigned vv = *(const unsigned*)(Vb + (size_t)(pos0 + kk) * 256 + 2 * dp); const f32x4 pp = *(const LAS f32x4*)(ps + kk * 4);
        const float lo = bf_lo(vv), hi = bf_hi(vv);
#pragma unroll
        for (int r = 0; r < 4; ++r) { st.o[r][0] += pp[r] * lo; st.o[r][1] += pp[r] * hi; }
    }
}
__device__ __forceinline__ void phase_nsa_attn_ref(const Params& p, LAS unsigned char* lds) {
    const int lane = threadIdx.x & 63, wave = threadIdx.x >> 6;
    const int gw = blockIdx.x * NWAVES + wave, NGW = gridDim.x * NWAVES;
    LAS float* qs = (LAS float*)(lds + wave * 6144);
    LAS float* pc = qs + 256;
    LAS float* ptot = pc + 1024;
    const bf16_t* Q = (const bf16_t*)(p.ws + S_Q); const bf16_t* KV6 = (const bf16_t*)(p.ws + S_KV6);
    const bf16_t* KS = KV6 + (size_t)2 * NTOK * 256; const bf16_t* VS = KV6 + (size_t)3 * NTOK * 256; const bf16_t* KW = KV6 + (size_t)4 * NTOK * 256; const bf16_t* VW = KV6 + (size_t)5 * NTOK * 256;
    const bf16_t* KC = (const bf16_t*)(p.ws + S_KCMP); const bf16_t* VC = (const bf16_t*)(p.ws + S_VCMP);
    const float* GATES = (const float*)(p.ws + S_GATES); bf16_t* AO = (bf16_t*)(p.ws + S_AO);
    const int hf = lane >> 5, dp = lane & 31;
    for (int item = gw; item < NTOK * 4; item += NGW) {
        const int g = item & 3, row = item >> 2, b = row >> 12, t = row & 4095;
        float slope[4];
#pragma unroll
        for (int r = 0; r < 4; ++r) slope[r] = exp2f(-0.5f * (float)(g * 4 + r + 1));
        LDS_FENCE();
        { f32x4 qv;
#pragma unroll
          for (int r = 0; r < 4; ++r) qv[r] = bf2f(Q[(size_t)row * 1024 + (g * 4 + r) * 64 + lane]) * 0.125f;
          *(LAS f32x4*)(qs + lane * 4) = qv; }
        LDS_FENCE();
        const int nv = (t >= 31) ? (((t - 31) >> 4) + 1 < 255 ? ((t - 31) >> 4) + 1 : 255) : 0;
        float mloc[4] = {-1e30f, -1e30f, -1e30f, -1e30f};
#pragma unroll 1
        for (int c = 0; c < 4; ++c) {
            const int i = 64 * c + lane;
            f32x4 sv = (f32x4){-1e30f, -1e30f, -1e30f, -1e30f};
            if (64 * c < nv) {
                const bf16_t* krow = KC + ((size_t)(b * 256 + i) * 4 + g) * 64;
                float acc[4] = {0.f, 0.f, 0.f, 0.f};
#pragma unroll 2
                for (int d8 = 0; d8 < 8; ++d8) { const u32x4 kv = *(const u32x4*)(krow + d8 * 8);
                    const float kf[8] = {bf_lo(kv.x), bf_hi(kv.x), bf_lo(kv.y), bf_hi(kv.y), bf_lo(kv.z), bf_hi(kv.z), bf_lo(kv.w), bf_hi(kv.w)};
#pragma unroll
                    for (int e = 0; e < 8; ++e) { const f32x4 qv = *(const LAS f32x4*)(qs + (d8 * 8 + e) * 4);
#pragma unroll
                        for (int r = 0; r < 4; ++r) acc[r] += qv[r] * kf[e]; } }
                const float dist = (float)(t - (16 * i + 31));
                if (i < nv) {
#pragma unroll
                    for (int r = 0; r < 4; ++r) { sv[r] = acc[r] - slope[r] * dist; mloc[r] = fmaxf(mloc[r], sv[r]); } }
            }
            *(LAS f32x4*)(pc + i * 4) = sv;
        }
        float ssum[4] = {0.f, 0.f, 0.f, 0.f};
#pragma unroll
        for (int r = 0; r < 4; ++r) mloc[r] = wave_max(mloc[r]);
        LDS_FENCE();
#pragma unroll 1
        for (int c = 0; c < 4; ++c) {
            const int i = 64 * c + lane; f32x4 sv = *(const LAS f32x4*)(pc + i * 4);
#pragma unroll
            for (int r = 0; r < 4; ++r) { sv[r] = (sv[r] > -1e29f) ? __expf(sv[r] - mloc[r]) : 0.f; ssum[r] += sv[r]; }
            *(LAS f32x4*)(pc + i * 4) = sv;
        }
#pragma unroll
        for (int r = 0; r < 4; ++r) { const float sm = wave_sum(ssum[r]); ssum[r] = (sm > 0.f) ? 1.f / sm : 0.f; }
        LDS_FENCE();
#pragma unroll 1
        for (int c = 0; c < 4; ++c) {
            const int i = 64 * c + lane; f32x4 sv = *(const LAS f32x4*)(pc + i * 4);
#pragma unroll
            for (int r = 0; r < 4; ++r) sv[r] *= ssum[r];
            *(LAS f32x4*)(pc + i * 4) = sv; ptot[i] = (sv[0] + sv[1]) + (sv[2] + sv[3]);
        }
        LDS_FENCE();
        const int j = lane, blk = t >> 6;
        const float imp = ptot[4 * j] + ptot[4 * j + 1] + ptot[4 * j + 2] + 0.5f * ptot[4 * j + 3] + (j > 0 ? 0.5f * ptot[4 * j - 1] : 0.f);
        const bool elig = j <= blk, forced = (j == 0) || (j == blk) || (j == blk - 1);
        const float val = elig ? imp + (forced ? 1e4f : 0.f) : -1e30f;
        int rank = 0;
#pragma unroll 8
        for (int k = 0; k < 64; ++k) { const float vk = __shfl(val, k); rank += (vk > val || (vk == val && k < j)) ? 1 : 0; }
        const unsigned long long selmask = __ballot(elig && rank < 16);
        float oc[4][2] = {{0.f, 0.f}, {0.f, 0.f}, {0.f, 0.f}, {0.f, 0.f}};
        for (int i = hf; i < nv; i += 2) {
            const unsigned vv = *(const unsigned*)(VC + ((size_t)(b * 256 + i) * 4 + g) * 64 + 2 * dp); const f32x4 pp = *(const LAS f32x4*)(pc + i * 4);
            const float lo = bf_lo(vv), hi = bf_hi(vv);
#pragma unroll
            for (int r = 0; r < 4; ++r) { oc[r][0] += pp[r] * lo; oc[r][1] += pp[r] * hi; }
        }
#pragma unroll
        for (int r = 0; r < 4; ++r) { oc[r][0] += __shfl_xor(oc[r][0], 32); oc[r][1] += __shfl_xor(oc[r][1], 32); }
        OnlineSt st;
#pragma unroll
        for (int r = 0; r < 4; ++r) { st.m[r] = -1e30f; st.l[r] = 0.f; st.o[r][0] = 0.f; st.o[r][1] = 0.f; }
        const bf16_t* ksb = KS + (size_t)b * SEQ * 256 + g * 64; const bf16_t* vsb = VS + (size_t)b * SEQ * 256 + g * 64;
        for (unsigned long long mm = selmask; mm; mm &= mm - 1) { const int jj = __builtin_ctzll(mm); nsa_attend_block(st, ksb, vsb, 64 * jj, t, slope, qs, pc, lane); }
        float os[4][2];
#pragma unroll
        for (int r = 0; r < 4; ++r) { const float il = 1.f / st.l[r]; os[r][0] = (st.o[r][0] + __shfl_xor(st.o[r][0], 32)) * il; os[r][1] = (st.o[r][1] + __shfl_xor(st.o[r][1], 32)) * il; }
#pragma unroll
        for (int r = 0; r < 4; ++r) { st.m[r] = -1e30f; st.l[r] = 0.f; st.o[r][0] = 0.f; st.o[r][1] = 0.f; }
        const bf16_t* kwb = KW + (size_t)b * SEQ * 256 + g * 64; const bf16_t* vwb = VW + (size_t)b * SEQ * 256 + g * 64;
        const int lo = (t - 511 > 0) ? t - 511 : 0;
        for (int p0 = lo; p0 <= t; p0 += 64) nsa_attend_block(st, kwb, vwb, p0, t, slope, qs, pc, lane);
        const float* gp = GATES + (size_t)row * 48 + g * 12;
#pragma unroll
        for (int r = 0; r < 4; ++r) {
            const float il = 1.f / st.l[r]; const float ow0 = (st.o[r][0] + __shfl_xor(st.o[r][0], 32)) * il, ow1 = (st.o[r][1] + __shfl_xor(st.o[r][1], 32)) * il;
            const float gc = gp[r * 3 + 0], gs = gp[r * 3 + 1], gwv = gp[r * 3 + 2];
            const float o0 = gc * oc[r][0] + gs * os[r][0] + gwv * ow0, o1 = gc * oc[r][1] + gs * os[r][1] + gwv * ow1;
            if (hf == 0) *(unsigned*)(AO + (size_t)row * 1024 + (g * 4 + r) * 64 + 2 * dp) = pk2(o0, o1);
        }
    }
}

__device__ __forceinline__ void phase_mla_attn_ref(const Params& p, LAS unsigned char* lds) {
    const int lane = threadIdx.x & 63, wave = threadIdx.x >> 6;
    const int gw = blockIdx.x * NWAVES + wave, NGW = gridDim.x * NWAVES;
    LAS float* qs = (LAS float*)(lds + wave * 1024);
    LAS float* ps = qs + 128;
    const bf16_t* QF = (const bf16_t*)(p.ws + S_QF); const bf16_t* KN = (const bf16_t*)(p.ws + S_KNOPE); const bf16_t* KR = (const bf16_t*)(p.ws + S_KROPE); const bf16_t* V = (const bf16_t*)(p.ws + S_V);
    const float* rc = (const float*)(p.ws + WS_ROPE_COS); const float* rs = (const float*)(p.ws + WS_ROPE_SIN);
    bf16_t* AO = (bf16_t*)(p.ws + S_AO2);
    const float scale = 0.10206207261596577f;
    const int hf = lane >> 5, dp = lane & 31;
    for (int item = gw; item < NTOK * 16; item += NGW) {
        const int h = item & 15, row = item >> 4, b = row >> 12, t = row & 4095;
        const bf16_t* qrow = QF + (size_t)row * 1536 + h * 96; const float rq = scale;
        LDS_FENCE();
        qs[lane] = bf2f(qrow[lane]) * rq;
        if (lane < 16) { const float x1 = bf2f(qrow[64 + lane]), x2 = bf2f(qrow[80 + lane]), c = rc[t * 16 + lane], s = rs[t * 16 + lane]; qs[64 + lane] = (x1 * c - x2 * s) * rq; qs[80 + lane] = (x2 * c + x1 * s) * rq; }
        LDS_FENCE();
        float m = -1e30f, l = 0.f, o0 = 0.f, o1 = 0.f;
        for (int p0 = 0; p0 <= t; p0 += 64) {
            const int pos = p0 + lane; const bool valid = pos <= t;
            const int posc = valid ? pos : t;
            const bf16_t* kn = KN + ((size_t)(b * SEQ + posc)) * 1024 + h * 64; const bf16_t* kr = KR + ((size_t)(b * SEQ + posc)) * 32;
            float acc = 0.f;
#pragma unroll 4
            for (int d8 = 0; d8 < 12; ++d8) { const u32x4 kv = (d8 < 8) ? *(const u32x4*)(kn + d8 * 8) : *(const u32x4*)(kr + (d8 - 8) * 8);
                const f32x4 q0 = *(const LAS f32x4*)(qs + d8 * 8), q1 = *(const LAS f32x4*)(qs + d8 * 8 + 4);
                acc += q0.x * bf_lo(kv.x) + q0.y * bf_hi(kv.x) + q0.z * bf_lo(kv.y) + q0.w * bf_hi(kv.y) + q1.x * bf_lo(kv.z) + q1.y * bf_hi(kv.z) + q1.z * bf_lo(kv.w) + q1.w * bf_hi(kv.w); }
            const float s = valid ? acc : -1e30f;
            const float mn = fmaxf(m, wave_max(s)), alpha = __expf(m - mn), e = valid ? __expf(s - mn) : 0.f;
            l = l * alpha + wave_sum(e); o0 *= alpha; o1 *= alpha; m = mn;
            LDS_FENCE();
            ps[lane] = e;
            LDS_FENCE();
            const int nk = (t - p0 + 1 < 64) ? t - p0 + 1 : 64;
            for (int kk = hf; kk < nk; kk += 2) { const unsigned vv = *(const unsigned*)(V + ((size_t)(b * SEQ + p0 + kk)) * 1024 + h * 64 + 2 * dp); const float pp = ps[kk]; o0 += pp * bf_lo(vv); o1 += pp * bf_hi(vv); }
        }
        const float il = 1.f / l; o0 = (o0 + __shfl_xor(o0, 32)) * il; o1 = (o1 + __shfl_xor(o1, 32)) * il;
        if (hf == 0) *(unsigned*)(AO + (size_t)row * 1024 + h * 64 + 2 * dp) = pk2(o0, o1);
    }
}

namespace att {
typedef float f32x16 __attribute__((ext_vector_type(16)));
typedef short s16x4 __attribute__((ext_vector_type(4)));
constexpr int KSTR64 = 144, KSTR96 = 208;
constexpr int KBUF = 64 * KSTR96, VBUF = 8192;
constexpr int OFF_K = 0, OFF_V = 2 * KBUF, OFF_IMPM = OFF_V + 2 * VBUF, OFF_IMPS = OFF_IMPM + 8 * 8 * 64 * 4, OFF_SELB = OFF_IMPS + 8 * 8 * 72 * 4, OFF_UNION = OFF_SELB + 8 * 8 * 8, OFF_FIN = OFF_UNION + 16, LDS_END = OFF_FIN + 8 * 32 * 64 * 4;
static_assert(LDS_END <= 147456, "attention LDS map");
constexpr float LOG2E = 1.4426950408889634f;
__device__ __forceinline__ int crow(int r, int hi) { return (r & 3) + 8 * (r >> 2) + 4 * hi; }
__device__ __forceinline__ float xhalf(float v) { return __shfl_xor(v, 32); }

struct TileRegs { u32x4 k0, k1, v; };
__device__ __forceinline__ const char* uni_ptr(const void* p) {
    const unsigned long long v = (unsigned long long)p; const unsigned lo = __builtin_amdgcn_readfirstlane((unsigned)v), hh = __builtin_amdgcn_readfirstlane((unsigned)(v >> 32));
    return (const char*)(((unsigned long long)hh << 32) | lo);
}
template <bool MLA>
__device__ __forceinline__ void tile_load(TileRegs& R, const bf16_t* Kg, const bf16_t* KRg, const bf16_t* Vg, unsigned koff, unsigned voff, unsigned roff, int tid) {
    R.k0 = *(const u32x4*)(uni_ptr(Kg) + koff);
    R.v = *(const u32x4*)(uni_ptr(Vg) + voff);
    if (MLA) { if (tid < 256) R.k1 = *(const u32x4*)(uni_ptr(KRg) + roff); }
}
template <bool MLA, int KSTR>
__device__ __forceinline__ void tile_store(const TileRegs& R, LAS unsigned char* Kb, LAS unsigned char* Vb, int tid) {
    const int key = tid >> 3, c = tid & 7;
    *(LAS u32x4*)(Kb + key * KSTR + c * 16) = R.k0;
    if (MLA) { if (tid < 256) *(LAS u32x4*)(Kb + (tid >> 2) * KSTR + 128 + (tid & 3) * 16) = R.k1; }
    *(LAS u32x4*)(Vb + (c >> 2) * 4096 + key * 64 + (c & 3) * 16) = R.v;
}
template <int NKS, int KSTR>
__device__ __forceinline__ void qk(f32x16& p0, f32x16& p1, const LAS unsigned char* Kb, const bf16x8 (&qf)[NKS], int lane) {
    const LAS unsigned char* kp = Kb + (lane & 31) * KSTR + (lane >> 5) * 16;
#pragma unroll
    for (int r = 0; r < 16; ++r) { p0[r] = 0.f; p1[r] = 0.f; }
#pragma unroll
    for (int ks = 0; ks < NKS; ++ks) {
        const bf16x8 a0 = *(const LAS bf16x8*)(kp + ks * 32), a1 = *(const LAS bf16x8*)(kp + 32 * KSTR + ks * 32);
        p0 = __builtin_amdgcn_mfma_f32_32x32x16_bf16(a0, qf[ks], p0, 0, 0, 0);
        p1 = __builtin_amdgcn_mfma_f32_32x32x16_bf16(a1, qf[ks], p1, 0, 0, 0);
    }
}
__device__ __forceinline__ s16x4 vtr(const LAS unsigned char* p) { return __builtin_bit_cast(s16x4, __builtin_amdgcn_ds_read_tr16_b64_v4i16((LAS s16x4*)p)); }
__device__ __forceinline__ void pv(f32x16& o0, f32x16& o1, const f32x16& p0, const f32x16& p1, const LAS unsigned char* Vb, int lane) {
    const int hi = lane >> 5;
    const LAS unsigned char* vp = Vb + ((lane >> 4) & 1) * 32 + (lane & 3) * 8 + (4 * hi + ((lane & 15) >> 2)) * 64;
#pragma unroll
    for (int S = 0; S < 4; ++S) {
        u32x4 pw;
#pragma unroll
        for (int jj = 0; jj < 4; ++jj) { const int r = 8 * (S & 1) + 2 * jj; pw[jj] = (S < 2) ? pk2(p0[r], p0[r + 1]) : pk2(p1[r], p1[r + 1]); }
        const bf16x8 pf = __builtin_bit_cast(bf16x8, pw);
#pragma unroll
        for (int dh = 0; dh < 2; ++dh) {
            const s16x4 lo = vtr(vp + dh * 4096 + S * 1024), hh = vtr(vp + dh * 4096 + S * 1024 + 512);
            const bf16x8 vf = (bf16x8){lo[0], lo[1], lo[2], lo[3], hh[0], hh[1], hh[2], hh[3]};
            if (dh == 0) o0 = __builtin_amdgcn_mfma_f32_32x32x16_bf16(vf, pf, o0, 0, 0, 0); else o1 = __builtin_amdgcn_mfma_f32_32x32x16_bf16(vf, pf, o1, 0, 0, 0);
        }
    }
}
template <int PS, bool ALIBI, bool CAUS, bool WLOW, bool ROWEN>
__device__ __forceinline__ void transform(f32x16& p0, f32x16& p1, float c1, float c2, float tbf, bool en) {
#pragma unroll
    for (int r = 0; r < 16; ++r) {
        const float k0 = (float)(PS * ((r & 3) + 8 * (r >> 2))), k1 = (float)(PS * (32 + (r & 3) + 8 * (r >> 2)));
        const float d0 = tbf - k0, d1 = tbf - k1;
        float s0 = p0[r] * c1, s1 = p1[r] * c1;
        if (ALIBI) { s0 -= c2 * d0; s1 -= c2 * d1; }
        bool v0 = true, v1 = true;
        if (CAUS) { v0 = v0 && (d0 >= 0.f); v1 = v1 && (d1 >= 0.f); }
        if (WLOW) { v0 = v0 && (d0 < 512.f); v1 = v1 && (d1 < 512.f); }
        if (ROWEN) { v0 = v0 && en; v1 = v1 && en; }
        p0[r] = v0 ? s0 : -1e30f; p1[r] = v1 ? s1 : -1e30f;
    }
}
__device__ __forceinline__ float tile_max(const f32x16& p0, const f32x16& p1) {
    float a = fmaxf(p0[0], p1[0]);
#pragma unroll
    for (int r = 1; r < 16; ++r) a = fmaxf(a, fmaxf(p0[r], p1[r]));
    return fmaxf(a, xhalf(a));
}
__device__ __forceinline__ void softmax_pv(f32x16& p0, f32x16& p1, float& m, float& l, f32x16& o0, f32x16& o1, const LAS unsigned char* Vb, int lane) {
    const float mn = fmaxf(m, tile_max(p0, p1));
    if (__any(mn > m)) { const float alpha = __builtin_amdgcn_exp2f(m - mn); l *= alpha; o0 *= alpha; o1 *= alpha; m = mn; }
    const float mu = fmaxf(m, -1e20f);
    float s = 0.f;
#pragma unroll
    for (int r = 0; r < 16; ++r) { p0[r] = __builtin_amdgcn_exp2f(p0[r] - mu); p1[r] = __builtin_amdgcn_exp2f(p1[r] - mu); s += p0[r] + p1[r]; }
    l += s;
    pv(o0, o1, p0, p1, Vb, lane);
}
template <bool FIRST> __device__ __forceinline__ void fold(LAS float* fb, const f32x16& o0, const f32x16& o1, float sc, int lane) {
#pragma unroll
    for (int r = 0; r < 16; ++r) { const float a = o0[r] * sc, b = o1[r] * sc; if (FIRST) { fb[r * 64 + lane] = a; fb[(16 + r) * 64 + lane] = b; } else { fb[r * 64 + lane] += a; fb[(16 + r) * 64 + lane] += b; } }
}
__device__ __forceinline__ void store_o(bf16_t* dst  , const f32x16& f0, const f32x16& f1, int hi) {
#pragma unroll
    for (int dh = 0; dh < 2; ++dh)
#pragma unroll
        for (int a = 0; a < 4; ++a) { const f32x16& f = dh ? f1 : f0; u32x2 w; w.x = pk2(f[4 * a], f[4 * a + 1]); w.y = pk2(f[4 * a + 2], f[4 * a + 3]); *(u32x2*)(dst + 32 * dh + 8 * a + 4 * hi) = w; }
}
}

__device__ __forceinline__ void phase_nsa_attn(const Params& p, LAS unsigned char* lds) {
    using namespace att;
    const int tid0 = threadIdx.x, wave = __builtin_amdgcn_readfirstlane(tid0 >> 6);
    const bf16_t* Q = (const bf16_t*)(p.ws + S_Q); const bf16_t* KV6 = (const bf16_t*)(p.ws + S_KV6);
    const bf16_t* KS = KV6 + (size_t)2 * NTOK * 256; const bf16_t* VS = KV6 + (size_t)3 * NTOK * 256; const bf16_t* KW = KV6 + (size_t)4 * NTOK * 256; const bf16_t* VW = KV6 + (size_t)5 * NTOK * 256;
    const bf16_t* KC = (const bf16_t*)(p.ws + S_KCMP); const bf16_t* VC = (const bf16_t*)(p.ws + S_VCMP);
    const float* GATES = (const float*)(p.ws + S_GATES); bf16_t* AO = (bf16_t*)(p.ws + S_AO);
    LAS unsigned char* Kb0 = lds + OFF_K; LAS unsigned char* Vb0 = lds + OFF_V;
    LAS float* impM = (LAS float*)(lds + OFF_IMPM) + wave * 512; LAS float* impS = (LAS float*)(lds + OFF_IMPS) + wave * 576;
    LAS unsigned char* selb = lds + OFF_SELB + wave * 64; LAS unsigned long long* uni = (LAS unsigned long long*)(lds + OFF_UNION);
    const float c1 = 0.125f * LOG2E;
    const int vcu = blockIdx.x;
#pragma unroll 1
    for (int ui = 0; ui < 8; ++ui) {
        int tid = tid0; asm volatile("" : "+v"(tid));
        const int lane = tid & 63, q = lane & 31, hi = lane >> 5, tl = q & 7, rh = q >> 3;
        const unsigned koff = (unsigned)((tid >> 3) * 256 + (tid & 7) * 8) * 2u;
        const int pair = vcu >> 3, kk = vcu & 7, b = pair >> 2, g = pair & 3;
        const int tile = (ui >> 1) * 16 + ((ui & 1) ? 15 - kk : kk);
        const int q0 = tile * 64, t = q0 + 8 * wave + tl, head = 4 * g + rh;
        const size_t row = (size_t)b * SEQ + t;
        const float c2 = exp2f(-0.5f * (float)(head + 1)) * LOG2E;
        bf16x8 qf[4];
#pragma unroll
        for (int ks = 0; ks < 4; ++ks) qf[ks] = *(const bf16x8*)(Q + row * 1024 + head * 64 + ks * 16 + hi * 8);
        const float gc = GATES[row * 48 + head * 3 + 0], gs = GATES[row * 48 + head * 3 + 1], gwd = GATES[row * 48 + head * 3 + 2];
        LAS float* fb = (LAS float*)(lds + OFF_FIN) + wave * 2048;
        TileRegs R;
        for (int i = lane; i < 512; i += 64) impM[i] = 0.f;
        for (int i = lane; i < 576; i += 64) impS[i] = 0.f;
        if (tid0 == 0) *uni = 0ull;
        const int nc = (4 * tile + 3 < 255) ? 4 * tile + 3 : 255, ntc = (nc + 63) >> 6;
        const bf16_t* kcb = KC + ((size_t)b * 256 * 4 + g) * 64; const bf16_t* vcb = VC + ((size_t)b * 256 * 4 + g) * 64;
        float m = -1e30f, l = 0.f;
#pragma unroll 1
        for (int pass = 0; pass < 2; ++pass) {
            f32x16 o0, o1;
#pragma unroll
            for (int r = 0; r < 16; ++r) { o0[r] = 0.f; o1[r] = 0.f; }
            const float ltc = l + xhalf(l); const float invl = (ltc > 0.f) ? 1.f / ltc : 0.f;
            tile_load<false>(R, kcb, nullptr, vcb, koff, koff, 0u, tid);
#pragma unroll 1
            for (int T = 0; T < ntc; ++T) {
                LAS unsigned char* Kb = Kb0 + (T & 1) * KBUF; LAS unsigned char* Vb = Vb0 + (T & 1) * VBUF;
                tile_store<false, KSTR64>(R, Kb, Vb, tid);
                __syncthreads();
                if (T + 1 < ntc) tile_load<false>(R, kcb + (size_t)(T + 1) * 64 * 256, nullptr, vcb + (size_t)(T + 1) * 64 * 256, koff, koff, 0u, tid);
                f32x16 p0, p1;
                qk<4, KSTR64>(p0, p1, Kb, qf, lane);
                const float tbf = (float)(t - (16 * 64 * T + 31) - 64 * hi);
                transform<16, true, true, false, false>(p0, p1, c1, c2, tbf, true);
                if (pass == 0) {
                    const float mn = fmaxf(m, tile_max(p0, p1)); const float alpha = __builtin_amdgcn_exp2f(m - mn); const float mu = fmaxf(mn, -1e20f);
                    float s = 0.f;
#pragma unroll
                    for (int r = 0; r < 16; ++r) s += __builtin_amdgcn_exp2f(p0[r] - mu) + __builtin_amdgcn_exp2f(p1[r] - mu);
                    l = l * alpha + s; m = mn;
                } else {
                    const float mu = fmaxf(m, -1e20f);
#pragma unroll
                    for (int r = 0; r < 16; ++r) { p0[r] = __builtin_amdgcn_exp2f(p0[r] - mu); p1[r] = __builtin_amdgcn_exp2f(p1[r] - mu); }
#pragma unroll
                    for (int kbk = 0; kbk < 2; ++kbk)
#pragma unroll
                        for (int a = 0; a < 4; ++a) {
                            const f32x16& pp = kbk ? p1 : p0;
                            float mainv = (pp[4 * a] + pp[4 * a + 1] + pp[4 * a + 2] + 0.5f * pp[4 * a + 3]) * invl, spill = 0.5f * pp[4 * a + 3] * invl;
                            mainv += __shfl_xor(mainv, 8); mainv += __shfl_xor(mainv, 16); spill += __shfl_xor(spill, 8); spill += __shfl_xor(spill, 16);
                            const int jb = 16 * T + 8 * kbk + 2 * a + hi;
                            if (rh == 0) { impM[tl * 64 + jb] = mainv; impS[tl * 72 + jb + 1] = spill; }
                            __builtin_amdgcn_sched_barrier(0);
                        }
                    pv(o0, o1, p0, p1, Vb, lane);
                }
            }
            if (pass == 1) fold<true>(fb, o0, o1, gc * invl, lane);
            __syncthreads();
        }
        const int blk = tile;
        unsigned long long mymask;
        if (blk < 16) { mymask = (2ull << blk) - 1ull; }
        else {
            LDS_FENCE();
            const int stl = lane >> 3, sub = lane & 7;
            float mv[8]; int rk[8];
#pragma unroll
            for (int i = 0; i < 8; ++i) { const int j = sub * 8 + i; mv[i] = impM[stl * 64 + j] + impS[stl * 72 + j]; rk[i] = 0; }
#pragma unroll 1
            for (int j2 = 1; j2 < blk - 1; ++j2) {
                const float v2 = impM[stl * 64 + j2] + impS[stl * 72 + j2];
#pragma unroll
                for (int i = 0; i < 8; ++i) { const int j = sub * 8 + i; rk[i] += (v2 > mv[i] || (v2 == mv[i] && j2 < j)) ? 1 : 0; }
            }
            unsigned bits = 0;
#pragma unroll
            for (int i = 0; i < 8; ++i) { const int j = sub * 8 + i; const bool forced = (j == 0) || (j == blk) || (j == blk - 1); const bool sel = (j <= blk) && (forced || rk[i] < 13); bits |= sel ? (1u << i) : 0u; }
            selb[stl * 8 + sub] = (unsigned char)bits;
            LDS_FENCE();
            mymask = *(const LAS unsigned long long*)(selb + tl * 8);
        }
        { unsigned long long um = mymask;
#pragma unroll
          for (int o = 1; o < 8; o <<= 1) { const unsigned lo = __shfl_xor((unsigned)um, o), hh = __shfl_xor((unsigned)(um >> 32), o); um |= ((unsigned long long)hh << 32) | lo; }
          if (lane == 0) atomicOr((unsigned long long*)uni, um); }
        __syncthreads();
        const unsigned long long umask = *uni;
        {
            f32x16 o0, o1;
#pragma unroll
            for (int r = 0; r < 16; ++r) { o0[r] = 0.f; o1[r] = 0.f; }
            m = -1e30f; l = 0.f;
            const bf16_t* kb_ = KS + ((size_t)b * SEQ) * 256 + g * 64; const bf16_t* vb_ = VS + ((size_t)b * SEQ) * 256 + g * 64;
            unsigned long long rem = umask; int it = 0;
            int j = 63 - __builtin_clzll(rem); rem &= ~(1ull << j);
            tile_load<false>(R, kb_ + (size_t)j * 64 * 256, nullptr, vb_ + (size_t)j * 64 * 256, koff, koff, 0u, tid);
#pragma unroll 1
            for (;;) {
                LAS unsigned char* Kb = Kb0 + (it & 1) * KBUF; LAS unsigned char* Vb = Vb0 + (it & 1) * VBUF;
                tile_store<false, KSTR64>(R, Kb, Vb, tid);
                __syncthreads();
                const int jn = rem ? 63 - __builtin_clzll(rem) : -1;
                if (jn >= 0) { rem &= ~(1ull << jn); tile_load<false>(R, kb_ + (size_t)jn * 64 * 256, nullptr, vb_ + (size_t)jn * 64 * 256, koff, koff, 0u, tid); }
                const bool en = (mymask >> j) & 1ull;
                if (__any(en)) {
                    f32x16 p0, p1;
                    qk<4, KSTR64>(p0, p1, Kb, qf, lane);
                    const float tbf = (float)(t - 64 * j - 4 * hi);
                    if (j == blk) transform<1, true, true, false, true>(p0, p1, c1, c2, tbf, en); else transform<1, true, false, false, true>(p0, p1, c1, c2, tbf, en);
                    softmax_pv(p0, p1, m, l, o0, o1, Vb, lane);
                }
                if (jn < 0) break;
                j = jn; ++it;
            }
            const float lt = l + xhalf(l);
            fold<false>(fb, o0, o1, (lt > 0.f) ? gs / lt : 0.f, lane);
            __syncthreads();
        }
        {
            f32x16 o0, o1;
#pragma unroll
            for (int r = 0; r < 16; ++r) { o0[r] = 0.f; o1[r] = 0.f; }
            m = -1e30f; l = 0.f;
            const bf16_t* kb_ = KW + ((size_t)b * SEQ) * 256 + g * 64; const bf16_t* vb_ = VW + ((size_t)b * SEQ) * 256 + g * 64;
            const int jlo = (blk - 8 > 0) ? blk - 8 : 0;
            tile_load<false>(R, kb_ + (size_t)blk * 64 * 256, nullptr, vb_ + (size_t)blk * 64 * 256, koff, koff, 0u, tid);
#pragma unroll 1
            for (int j = blk, it = 0; j >= jlo; --j, ++it) {
                LAS unsigned char* Kb = Kb0 + (it & 1) * KBUF; LAS unsigned char* Vb = Vb0 + (it & 1) * VBUF;
                tile_store<false, KSTR64>(R, Kb, Vb, tid);
                __syncthreads();
                if (j > jlo) tile_load<false>(R, kb_ + (size_t)(j - 1) * 64 * 256, nullptr, vb_ + (size_t)(j - 1) * 64 * 256, koff, koff, 0u, tid);
                f32x16 p0, p1;
                qk<4, KSTR64>(p0, p1, Kb, qf, lane);
                const float tbf = (float)(t - 64 * j - 4 * hi);
                if (j == blk) transform<1, true, true, false, false>(p0, p1, c1, c2, tbf, true);
                else if (j == blk - 8) transform<1, true, false, true, false>(p0, p1, c1, c2, tbf, true);
                else transform<1, true, false, false, false>(p0, p1, c1, c2, tbf, true);
                softmax_pv(p0, p1, m, l, o0, o1, Vb, lane);
            }
            const float lt = l + xhalf(l);
            const float scw = (lt > 0.f) ? gwd / lt : 0.f;
#pragma unroll
            for (int r = 0; r < 16; ++r) { o0[r] = o0[r] * scw + fb[r * 64 + lane]; o1[r] = o1[r] * scw + fb[(16 + r) * 64 + lane]; }
            store_o(AO + row * 1024 + head * 64, o0, o1, hi);
            __syncthreads();
        }
    }
}

__device__ __forceinline__ void phase_mla_attn(const Params& p, LAS unsigned char* lds) {
    using namespace att;
    const int tid0 = threadIdx.x, wave = __builtin_amdgcn_readfirstlane(tid0 >> 6);
    const bf16_t* QF = (const bf16_t*)(p.ws + S_QF); const bf16_t* KN = (const bf16_t*)(p.ws + S_KNOPE); const bf16_t* KR = (const bf16_t*)(p.ws + S_KROPE); const bf16_t* V = (const bf16_t*)(p.ws + S_V);
    const float* rc = (const float*)(p.ws + WS_ROPE_COS); const float* rs = (const float*)(p.ws + WS_ROPE_SIN);
    bf16_t* AO = (bf16_t*)(p.ws + S_AO2);
    LAS unsigned char* Kb0 = lds + OFF_K; LAS unsigned char* Vb0 = lds + OFF_V;
    const float c1 = 0.10206207261596577f * LOG2E;
    const int vcu = blockIdx.x;
#pragma unroll 1
    for (int ui = 0; ui < 8; ++ui) {
        int tid = tid0; asm volatile("" : "+v"(tid));
        const int lane = tid & 63, q = lane & 31, hi = lane >> 5;
        const unsigned koff = (unsigned)((tid >> 3) * 1024 + (tid & 7) * 8) * 2u, roff = (unsigned)((tid >> 2) * 32 + (tid & 3) * 8) * 2u;
        const int bh = vcu >> 1, b = bh >> 4, h = bh & 15, par = vcu & 1;
        const int qb = (ui & 1) ? 15 - (ui - 1) - par : ui + par;
        const int t = 256 * qb + 32 * wave + q; const size_t row = (size_t)b * SEQ + t;
        bf16x8 qf[6];
        { const bf16_t* qrow = QF + row * 1536 + h * 96;
#pragma unroll
          for (int ks = 0; ks < 4; ++ks) qf[ks] = *(const bf16x8*)(qrow + ks * 16 + hi * 8);
          const u32x4 x1 = *(const u32x4*)(qrow + 64 + hi * 8), x2 = *(const u32x4*)(qrow + 80 + hi * 8);
          const f32x4 ca = *(const f32x4*)(rc + t * 16 + hi * 8), cb = *(const f32x4*)(rc + t * 16 + hi * 8 + 4), sa = *(const f32x4*)(rs + t * 16 + hi * 8), sb = *(const f32x4*)(rs + t * 16 + hi * 8 + 4);
          const float a1[8] = {bf_lo(x1.x), bf_hi(x1.x), bf_lo(x1.y), bf_hi(x1.y), bf_lo(x1.z), bf_hi(x1.z), bf_lo(x1.w), bf_hi(x1.w)};
          const float a2[8] = {bf_lo(x2.x), bf_hi(x2.x), bf_lo(x2.y), bf_hi(x2.y), bf_lo(x2.z), bf_hi(x2.z), bf_lo(x2.w), bf_hi(x2.w)};
          const float cc[8] = {ca.x, ca.y, ca.z, ca.w, cb.x, cb.y, cb.z, cb.w}, ss[8] = {sa.x, sa.y, sa.z, sa.w, sb.x, sb.y, sb.z, sb.w};
          u32x4 w1, w2;
#pragma unroll
          for (int jj = 0; jj < 4; ++jj) { const int e = 2 * jj;
              w1[jj] = pk2(a1[e] * cc[e] - a2[e] * ss[e], a1[e + 1] * cc[e + 1] - a2[e + 1] * ss[e + 1]);
              w2[jj] = pk2(a2[e] * cc[e] + a1[e] * ss[e], a2[e + 1] * cc[e + 1] + a1[e + 1] * ss[e + 1]); }
          qf[4] = __builtin_bit_cast(bf16x8, w1); qf[5] = __builtin_bit_cast(bf16x8, w2); }
        f32x16 o0, o1;
#pragma unroll
        for (int r = 0; r < 16; ++r) { o0[r] = 0.f; o1[r] = 0.f; }
        float m = -1e30f, l = 0.f;
        const bf16_t* knb = KN + ((size_t)b * SEQ) * 1024 + h * 64; const bf16_t* krb = KR + ((size_t)b * SEQ) * 32; const bf16_t* vb_ = V + ((size_t)b * SEQ) * 1024 + h * 64;
        const int nt = 4 * qb + 4; const int tmin = 256 * qb + 32 * wave;
        TileRegs R;
        tile_load<true>(R, knb, krb, vb_, koff, koff, roff, tid);
#pragma unroll 1
        for (int j = 0; j < nt; ++j) {
            LAS unsigned char* Kb = Kb0 + (j & 1) * KBUF; LAS unsigned char* Vb = Vb0 + (j & 1) * VBUF;
            tile_store<true, KSTR96>(R, Kb, Vb, tid);
            __syncthreads();
            if (j + 1 < nt) tile_load<true>(R, knb + (size_t)(j + 1) * 64 * 1024, krb + (size_t)(j + 1) * 64 * 32, vb_ + (size_t)(j + 1) * 64 * 1024, koff, koff, roff, tid);
            if (64 * j <= tmin + 31) {
                f32x16 p0, p1;
                qk<6, KSTR96>(p0, p1, Kb, qf, lane);
                const float tbf = (float)(t - 64 * j - 4 * hi);
                if (64 * j + 63 > tmin) transform<1, false, true, false, false>(p0, p1, c1, 0.f, tbf, true); else transform<1, false, false, false, false>(p0, p1, c1, 0.f, tbf, true);
                softmax_pv(p0, p1, m, l, o0, o1, Vb, lane);
            }
        }
        const float lt = l + xhalf(l); const float il = 1.f / lt;
        o0 *= il; o1 *= il;
        store_o(AO + row * 1024 + h * 64, o0, o1, hi);
        __syncthreads();
    }
}

__device__ __forceinline__ float pack_idx(float v, unsigned bits, unsigned mask) { return __uint_as_float((__float_as_uint(v) & ~mask) | bits); }
__device__ __forceinline__ void phase_peer_route_ref(const Params& p, LAS unsigned char* lds, int layer, const bf16_t* QP, int* EIDX, float* GW) {
    const int lane = threadIdx.x & 63, wave = threadIdx.x >> 6;
    const int gw = blockIdx.x * NWAVES + wave, NGW = gridDim.x * NWAVES;
    LAS float* qs = (LAS float*)(lds + wave * 1024);
    const bf16_t* SK = (const bf16_t*)(p.ws + WS_SUBK) + (size_t)layer * 8 * 2 * 128 * 128;
    for (int item = gw; item < NTOK * 8; item += NGW) {
        const int h = item & 7, t = item >> 3;
        LDS_FENCE();
        { const u32x2 qv = *(const u32x2*)(QP + (size_t)t * 2048 + h * 256 + lane * 4); *(LAS f32x4*)(qs + lane * 4) = (f32x4){bf_lo(qv.x), bf_hi(qv.x), bf_lo(qv.y), bf_hi(qv.y)}; }
        LDS_FENCE();
        float sv[2];
#pragma unroll
        for (int c = 0; c < 2; ++c) {
            float v[2];
#pragma unroll
            for (int kk = 0; kk < 2; ++kk) {
                const int key = lane + 64 * kk; const bf16_t* krow = SK + ((size_t)(h * 2 + c) * 128 + key) * 128;
                float acc = 0.f;
#pragma unroll 4
                for (int d8 = 0; d8 < 16; ++d8) { const u32x4 kv = *(const u32x4*)(krow + d8 * 8); const f32x4 q0 = *(const LAS f32x4*)(qs + c * 128 + d8 * 8), q1 = *(const LAS f32x4*)(qs + c * 128 + d8 * 8 + 4);
                    acc += q0.x * bf_lo(kv.x) + q0.y * bf_hi(kv.x) + q0.z * bf_lo(kv.y) + q0.w * bf_hi(kv.y) + q1.x * bf_lo(kv.z) + q1.y * bf_hi(kv.z) + q1.z * bf_lo(kv.w) + q1.w * bf_hi(kv.w); }
                v[kk] = pack_idx(acc, 127u - (unsigned)key, 127u);
            }
            float mine = 0.f;
#pragma unroll 1
            for (int n = 0; n < 16; ++n) { const float w = wave_max(fmaxf(v[0], v[1])); if (v[0] == w) v[0] = -INFINITY; if (v[1] == w) v[1] = -INFINITY; if (lane == n) mine = w; }
            sv[c] = mine;
        }
        const int a = lane & 15, bq = lane >> 4;
        const float s0 = __shfl(sv[0], a);
        float cv[4];
#pragma unroll
        for (int i = 0; i < 4; ++i) { const float s1 = __shfl(sv[1], 4 * bq + i); cv[i] = pack_idx(s0 + s1, 255u - (unsigned)(a * 16 + 4 * bq + i), 255u); }
        float cs = 0.f;
#pragma unroll 1
        for (int n = 0; n < 16; ++n) { const float w = wave_max(fmaxf(fmaxf(cv[0], cv[1]), fmaxf(cv[2], cv[3])));
#pragma unroll
            for (int i = 0; i < 4; ++i) if (cv[i] == w) cv[i] = -INFINITY;
            if (lane == n) cs = w; }
        const unsigned flat = 255u - (__float_as_uint(cs) & 255u);
        const int wa = (int)(flat >> 4) & 15, wb = (int)flat & 15;
        const unsigned i0 = 127u - (__float_as_uint(__shfl(sv[0], wa)) & 127u), i1 = 127u - (__float_as_uint(__shfl(sv[1], wb)) & 127u);
        const float mx = __shfl(cs, 0);
        const float ex = (lane < 16) ? __expf(cs - mx) : 0.f;
        const float sum = wave_sum(ex);
        if (lane < 16) { EIDX[(size_t)t * 128 + h * 16 + lane] = (int)(i0 * 128u + i1); GW[(size_t)t * 128 + h * 16 + lane] = ex / sum; }
    }
}

namespace rt {
typedef float f32x16 __attribute__((ext_vector_type(16)));
constexpr int SKSTR = 272;
constexpr int OFF_SK = 0, OFF_IDX = 2 * 128 * SKSTR, LDS_END = OFF_IDX + 8 * 64 * 32;
__device__ __forceinline__ void ce_desc(float& a, float& b) { const float hi = fmaxf(a, b), lo = fminf(a, b); a = hi; b = lo; }
__device__ __forceinline__ void sort16_desc(float (&v)[16]) {
#pragma unroll
    for (int k = 2; k <= 16; k <<= 1)
#pragma unroll
        for (int j = k >> 1; j > 0; j >>= 1)
#pragma unroll
            for (int i = 0; i < 16; ++i) { const int l = i ^ j; if (l > i) { if ((i & k) == 0) ce_desc(v[i], v[l]); else ce_desc(v[l], v[i]); } }
}
__device__ __forceinline__ void merge16_desc(float (&v)[16]) {
#pragma unroll
    for (int j = 8; j > 0; j >>= 1)
#pragma unroll
        for (int i = 0; i < 16; ++i) { const int l = i ^ j; if (l > i) ce_desc(v[i], v[l]); }
}
__device__ __forceinline__ void top16_merge(float (&a)[16], const float (&b)[16]) {
#pragma unroll
    for (int i = 0; i < 16; ++i) a[i] = fmaxf(a[i], b[15 - i]);
    merge16_desc(a);
}
}
__device__ __forceinline__ void phase_peer_route(const Params& p, LAS unsigned char* lds, int layer, const bf16_t* QP, int* EIDX, float* GW) {
    using namespace rt;
    const int tid = threadIdx.x, lane = tid & 63, wave = __builtin_amdgcn_readfirstlane(tid >> 6), tok = lane & 31, hi = lane >> 5;
    const bf16_t* SK = (const bf16_t*)(p.ws + WS_SUBK) + (size_t)layer * 8 * 2 * 128 * 128;
    LAS unsigned char* idxs = lds + OFF_IDX + wave * 2048 + lane * 32;
    const int nbpi = NTOK / 1024;
    for (int bi = blockIdx.x; bi < 8 * nbpi; bi += gridDim.x) {
        const int h = bi & 7, tb = bi >> 3;
        __syncthreads();
        for (int i = tid; i < 256 * 16; i += NTHREADS) { const int r = i >> 4, c = i & 15; *(LAS u32x4*)(lds + OFF_SK + r * SKSTR + c * 16) = *(const u32x4*)(SK + ((size_t)h * 256 + r) * 128 + c * 8); }
        __syncthreads();
#pragma unroll 1
        for (int gi = 0; gi < 4; ++gi) {
            const int t = tb * 1024 + wave * 128 + gi * 32 + tok;
            float top[2][16];
#pragma unroll
            for (int c = 0; c < 2; ++c) {
                bf16x8 qf[8];
#pragma unroll
                for (int ks = 0; ks < 8; ++ks) qf[ks] = *(const bf16x8*)(QP + (size_t)t * 2048 + h * 256 + c * 128 + ks * 16 + hi * 8);
                float cur[16];
#pragma unroll
                for (int kb = 0; kb < 4; ++kb) {
                    f32x16 acc;
#pragma unroll
                    for (int r = 0; r < 16; ++r) acc[r] = 0.f;
                    const LAS unsigned char* kp = lds + OFF_SK + (c * 128 + kb * 32 + tok) * SKSTR + hi * 16;
#pragma unroll
                    for (int ks = 0; ks < 8; ++ks) acc = __builtin_amdgcn_mfma_f32_32x32x16_bf16(*(const LAS bf16x8*)(kp + ks * 32), qf[ks], acc, 0, 0, 0);
                    float v[16];
#pragma unroll
                    for (int r = 0; r < 16; ++r) { const unsigned key = (unsigned)(32 * kb + (r & 3) + 8 * (r >> 2)) + 4u * (unsigned)hi; v[r] = __uint_as_float((__float_as_uint(acc[r]) & ~127u) | (127u - key)); }
                    sort16_desc(v);
                    if (kb == 0) {
#pragma unroll
                        for (int r = 0; r < 16; ++r) cur[r] = v[r];
                    } else top16_merge(cur, v);
                }
                float oth[16];
#pragma unroll
                for (int r = 0; r < 16; ++r) oth[r] = __shfl_xor(cur[r], 32);
                top16_merge(cur, oth);
#pragma unroll
                for (int r = 0; r < 16; ++r) top[c][r] = cur[r];
            }
            { u32x4 w0, w1;
#pragma unroll
              for (int c = 0; c < 2; ++c) {
                  u32x4 w;
#pragma unroll
                  for (int jj = 0; jj < 4; ++jj) { unsigned x = 0;
#pragma unroll
                      for (int e = 0; e < 4; ++e) x |= (127u - (__float_as_uint(top[c][4 * jj + e]) & 127u)) << (8 * e);
                      w[jj] = x; }
                  if (c == 0) w0 = w; else w1 = w; }
              *(LAS u32x4*)idxs = w0; *(LAS u32x4*)(idxs + 16) = w1; }
#define CAND(a, b) __uint_as_float((__float_as_uint(top[0][a] + top[1][b]) & ~255u) | (255u - (unsigned)(16 * (a) + (b))))
            float A[16], B[16], X[16], Y[16];
#pragma unroll
            for (int b = 0; b < 16; ++b) A[b] = CAND(0, b);
#pragma unroll
            for (int b = 0; b < 8; ++b) B[b] = CAND(1, b);
#pragma unroll
            for (int b = 8; b < 16; ++b) B[b] = -INFINITY;
            top16_merge(A, B);
            X[0] = CAND(2, 0); X[1] = CAND(2, 1); X[2] = CAND(2, 2); X[3] = CAND(2, 3); X[4] = CAND(2, 4); X[5] = CAND(3, 0); X[6] = CAND(3, 1); X[7] = CAND(3, 2); X[8] = CAND(3, 3);
            X[9] = CAND(4, 0); X[10] = CAND(4, 1); X[11] = CAND(4, 2); X[12] = CAND(5, 0); X[13] = CAND(5, 1); X[14] = CAND(6, 0); X[15] = CAND(6, 1);
            Y[0] = CAND(7, 0); Y[1] = CAND(7, 1); Y[2] = CAND(8, 0); Y[3] = CAND(9, 0); Y[4] = CAND(10, 0); Y[5] = CAND(11, 0); Y[6] = CAND(12, 0); Y[7] = CAND(13, 0); Y[8] = CAND(14, 0); Y[9] = CAND(15, 0);
#pragma unroll
            for (int i = 10; i < 16; ++i) Y[i] = -INFINITY;
#undef CAND
            sort16_desc(X); sort16_desc(Y);
            top16_merge(A, X); top16_merge(A, Y);
            float ex[16], sum = 0.f;
#pragma unroll
            for (int n = 0; n < 16; ++n) { ex[n] = __expf(A[n] - A[0]); sum += ex[n]; }
            const float inv = 1.f / sum;
            LDS_FENCE();
            if (hi == 0) {
                int* ep = EIDX + (size_t)t * 128 + h * 16;
#pragma unroll
                for (int jj = 0; jj < 4; ++jj) { u32x4 w;
#pragma unroll
                    for (int e = 0; e < 4; ++e) { const unsigned flat = 255u - (__float_as_uint(A[4 * jj + e]) & 255u); const unsigned i0 = idxs[flat >> 4], i1 = idxs[16 + (flat & 15u)]; w[e] = i0 * 128u + i1; }
                    *(u32x4*)(ep + 4 * jj) = w; }
            } else {
                float* gp = GW + (size_t)t * 128 + h * 16;
#pragma unroll
                for (int jj = 0; jj < 4; ++jj) *(f32x4*)(gp + 4 * jj) = (f32x4){ex[4 * jj] * inv, ex[4 * jj + 1] * inv, ex[4 * jj + 2] * inv, ex[4 * jj + 3] * inv};
            }
            LDS_FENCE();
        }
    }
}

__device__ __forceinline__ float dot2bf(unsigned a, unsigned b, float acc) {
    float r; asm("v_dot2c_f32_bf16 %0, %1, %2" : "=v"(r) : "v"(a), "v"(b), "0"(acc)); return r;
}
__device__ __forceinline__ float dot8(const u32x4& a, const u32x4& b, float acc) {
    acc = dot2bf(a.x, b.x, acc); acc = dot2bf(a.y, b.y, acc); acc = dot2bf(a.z, b.z, acc); acc = dot2bf(a.w, b.w, acc);
    return acc;
}
__device__ __forceinline__ void axpy8(float* o, const u32x4& v, float w) {
    o[0] += w * bf_lo(v.x); o[1] += w * bf_hi(v.x); o[2] += w * bf_lo(v.y); o[3] += w * bf_hi(v.y); o[4] += w * bf_lo(v.z); o[5] += w * bf_hi(v.z); o[6] += w * bf_lo(v.w); o[7] += w * bf_hi(v.w);
}
__device__ __forceinline__ void dec16(float (&f)[16], const u32x4& w) {
#pragma unroll
    for (int j = 0; j < 4; ++j) { const f32x2 lo = __builtin_amdgcn_cvt_pk_f32_fp8((int)w[j], false), hh = __builtin_amdgcn_cvt_pk_f32_fp8((int)w[j], true); f[4 * j] = lo.x; f[4 * j + 1] = lo.y; f[4 * j + 2] = hh.x; f[4 * j + 3] = hh.y; }
}
__device__ __forceinline__ void phase_peer_gather(const Params& p, int layer, const int* EIDX, const float* GW, const bf16_t* HB, bf16_t* HBO, float* OUT, float fs) {
    const int lane = threadIdx.x & 63, wave = threadIdx.x >> 6;
    const int gw = blockIdx.x * NWAVES + wave, NGW = gridDim.x * NWAVES;
    const unsigned char* U8 = p.ws + WS_TAB + (size_t)layer * 32 * MiB; const unsigned char* V8 = U8 + 16 * MiB;
    const float* lg = p.in[I_PEER_LNG] + layer * 1024; const float* lb = p.in[I_PEER_LNB] + layer * 1024;
    for (int t = gw; t < NTOK; t += NGW) {
        const u32x4 x0 = *(const u32x4*)(HB + (size_t)t * 1024 + lane * 16), x1 = *(const u32x4*)(HB + (size_t)t * 1024 + lane * 16 + 8);
        const float xf[16] = {bf_lo(x0.x), bf_hi(x0.x), bf_lo(x0.y), bf_hi(x0.y), bf_lo(x0.z), bf_hi(x0.z), bf_lo(x0.w), bf_hi(x0.w), bf_lo(x1.x), bf_hi(x1.x), bf_lo(x1.y), bf_hi(x1.y), bf_lo(x1.z), bf_hi(x1.z), bf_lo(x1.w), bf_hi(x1.w)};
        const int e0 = EIDX[(size_t)t * 128 + lane], e1 = EIDX[(size_t)t * 128 + 64 + lane];
        const float g0 = GW[(size_t)t * 128 + lane], g1 = GW[(size_t)t * 128 + 64 + lane];
        float o[16];
#pragma unroll
        for (int i = 0; i < 16; ++i) o[i] = 0.f;
#pragma unroll 1
        for (int half = 0; half < 2; ++half) {
            const int eh = half ? e1 : e0; const float gh = half ? g1 : g0;
#pragma unroll 1
            for (int kb = 0; kb < 64; kb += 8) {
                u32x4 uw[8], vw[8]; float gg[8];
#pragma unroll
                for (int i = 0; i < 8; ++i) { const int e = __shfl(eh, kb + i); gg[i] = __shfl(gh, kb + i);
                    uw[i] = *(const u32x4*)(U8 + (size_t)e * 1024 + lane * 16); vw[i] = *(const u32x4*)(V8 + (size_t)e * 1024 + lane * 16); }
#pragma unroll
                for (int i = 0; i < 8; ++i) {
                    float uf[16]; dec16(uf, uw[i]);
                    float d0 = 0.f, d1 = 0.f;
#pragma unroll
                    for (int j = 0; j < 8; ++j) { d0 += xf[2 * j] * uf[2 * j]; d1 += xf[2 * j + 1] * uf[2 * j + 1]; }
                    const float d = wave_sum(d0 + d1) * (1.f / U_SCALE);
                    const float w = gg[i] * gelu_tanh(d);
                    float vf[16]; dec16(vf, vw[i]);
#pragma unroll
                    for (int j = 0; j < 16; ++j) o[j] += w * vf[j];
                }
            }
        }
        float z[16]; float s = 0.f;
#pragma unroll
        for (int i = 0; i < 16; ++i) { z[i] = DN_ALPHA * xf[i] + fs * (1.f / V_SCALE) * o[i]; s += z[i]; }
        const float mean = wave_sum(s) * (1.f / 1024.f); float q = 0.f;
#pragma unroll
        for (int i = 0; i < 16; ++i) { z[i] -= mean; q += z[i] * z[i]; }
        const float rstd = rsqrtf(wave_sum(q) * (1.f / 1024.f) + LN_EPS);
#pragma unroll
        for (int j = 0; j < 4; ++j) { const f32x4 ga = *(const f32x4*)(lg + lane * 16 + 4 * j), ba = *(const f32x4*)(lb + lane * 16 + 4 * j);
#pragma unroll
            for (int i = 0; i < 4; ++i) z[4 * j + i] = z[4 * j + i] * rstd * ga[i] + ba[i]; }
        if (OUT) {
#pragma unroll
            for (int j = 0; j < 4; ++j) *(f32x4*)(OUT + (size_t)t * 1024 + lane * 16 + 4 * j) = (f32x4){z[4 * j], z[4 * j + 1], z[4 * j + 2], z[4 * j + 3]};
        } else {
            u32x4 w0, w1; w0.x = pk2(z[0], z[1]); w0.y = pk2(z[2], z[3]); w0.z = pk2(z[4], z[5]); w0.w = pk2(z[6], z[7]); w1.x = pk2(z[8], z[9]); w1.y = pk2(z[10], z[11]); w1.z = pk2(z[12], z[13]); w1.w = pk2(z[14], z[15]);
            *(u32x4*)(HBO + (size_t)t * 1024 + lane * 16) = w0; *(u32x4*)(HBO + (size_t)t * 1024 + lane * 16 + 8) = w1;
        }
    }
}

constexpr int NPHASES = 19;
__global__ void __launch_bounds__(NTHREADS, 2) fwd_kernel(Params p) {
    extern __shared__ __attribute__((aligned(16))) unsigned char lds_raw[];
    LAS unsigned char* lds = (LAS unsigned char*)lds_raw;
    unsigned char* ws = p.ws;
    bf16_t* HB = (bf16_t*)(ws + WS_HB);
    const int lo = p.ph_lo, hi = p.ph_hi;
#ifndef PH_MASK
#define PH_MASK 0xFFFFFFFFu
#endif
#define IN(k) (((PH_MASK >> (k)) & 1u) && lo <= (k) && (k) < hi)
#define SEAM(k) do { if (IN(k) && IN((k) + 1)) { asm volatile("s_waitcnt vmcnt(0) lgkmcnt(0)" ::: "memory"); __builtin_amdgcn_fence(__ATOMIC_RELEASE, "agent"); asm volatile("s_waitcnt vmcnt(0)" ::: "memory"); \
        cg::this_grid().sync(); __builtin_amdgcn_fence(__ATOMIC_ACQUIRE, "agent"); asm volatile("s_waitcnt vmcnt(0)" ::: "memory"); __syncthreads(); } } while (0)
    if (IN(0)) for (int rep_ = 0; rep_ < ((PROBE_REP == 0) ? 1 + PROBE_N : 1); ++rep_) { phase_prologue(p, lds); } SEAM(0);
    if (IN(1)) for (int rep_ = 0; rep_ < ((PROBE_REP == 1) ? 1 + PROBE_N : 1); ++rep_) { EpiNsaProj E{(bf16_t*)(ws + S_Q), (bf16_t*)(ws + S_KV6), (float*)(ws + S_GATES)};
        run_gemm(lds, HB, 1024, (const bf16_t*)(ws + WS_W_IN_T), 1024, NTOK, NSA_IN_PAD, 1024, (int)blockIdx.x, E); } SEAM(1);
    if (IN(2)) for (int rep_ = 0; rep_ < ((PROBE_REP == 2) ? 1 + PROBE_N : 1); ++rep_) { EpiF32 Ek{(float*)(ws + S_PK), 256}, Ev{(float*)(ws + S_PV), 256};
        run_gemm(lds, (const bf16_t*)(ws + S_KV6), 1024, (const bf16_t*)(ws + WS_W_CK1_T), 1024, 8192, 256, 1024, (int)blockIdx.x, Ek);
        run_gemm(lds, (const bf16_t*)(ws + S_KV6) + (size_t)NTOK * 256, 1024, (const bf16_t*)(ws + WS_W_CV1_T), 1024, 8192, 256, 1024, (int)((blockIdx.x + gridDim.x / 2) % gridDim.x), Ev); } SEAM(2);
    if (IN(3)) for (int rep_ = 0; rep_ < ((PROBE_REP == 3) ? 1 + PROBE_N : 1); ++rep_) { phase_cmp_finish(p, lds); } SEAM(3);
    if (IN(4)) for (int rep_ = 0; rep_ < ((PROBE_REP == 4) ? 1 + PROBE_N : 1); ++rep_) { if (USE_MFMA_NSA) phase_nsa_attn(p, lds); else phase_nsa_attn_ref(p, lds); } SEAM(4);
    if (IN(5)) for (int rep_ = 0; rep_ < ((PROBE_REP == 5) ? 1 + PROBE_N : 1); ++rep_) { EpiResid E{HB, (bf16_t*)(ws + S_Z), (ABL & 1) ? 0.f : 1.f};
        run_gemm(lds, (const bf16_t*)(ws + S_AO), 1024, (const bf16_t*)(ws + WS_W_NSAOUT_T), 1024, NTOK, 1024, 1024, (int)blockIdx.x, E); } SEAM(5);
    if (IN(6)) for (int rep_ = 0; rep_ < ((PROBE_REP == 6) ? 1 + PROBE_N : 1); ++rep_) { phase_ln((const bf16_t*)(ws + S_Z), HB, p.in[I_NSA_LNG], p.in[I_NSA_LNB]); } SEAM(6);
    if (IN(7)) for (int rep_ = 0; rep_ < ((PROBE_REP == 7) ? 1 + PROBE_N : 1); ++rep_) { EpiBf16 E{(bf16_t*)(ws + S_QP0), 2048};
        run_gemm(lds, HB, 1024, (const bf16_t*)(ws + WS_W_PQ_T), 1024, NTOK, 2048, 1024, (int)blockIdx.x, E); } SEAM(7);
    if (IN(8) && ((PROBE_DUP & 1) || PROBE_REP == 8)) for (int rep_ = 0; rep_ < PROBE_N; ++rep_) { phase_peer_route(p, lds, 0, (const bf16_t*)(ws + S_QP0), (int*)(ws + S_Z), (float*)(ws + S_Z + 16 * MiB)); }
    if (IN(8)) { if (USE_MFMA_ROUTE) phase_peer_route(p, lds, 0, (const bf16_t*)(ws + S_QP0), (int*)(ws + S_EIDX0), (float*)(ws + S_GW0)); else phase_peer_route_ref(p, lds, 0, (const bf16_t*)(ws + S_QP0), (int*)(ws + S_EIDX0), (float*)(ws + S_GW0)); } SEAM(8);
    if (IN(9) && ((PROBE_DUP & 2) || PROBE_REP == 9)) for (int rep_ = 0; rep_ < PROBE_N; ++rep_) { phase_peer_gather(p, 0, (const int*)(ws + S_EIDX0), (const float*)(ws + S_GW0), HB, (bf16_t*)(ws + S_Z), nullptr, 1.f); }
    if (IN(9)) { phase_peer_gather(p, 0, (const int*)(ws + S_EIDX0), (const float*)(ws + S_GW0), HB, HB, nullptr, (ABL & 2) ? 0.f : 1.f); } SEAM(9);
    if (IN(10)) for (int rep_ = 0; rep_ < ((PROBE_REP == 10) ? 1 + PROBE_N : 1); ++rep_) { EpiBf16 E{(bf16_t*)(ws + S_DQ), MLA_DOWN_PAD};
        run_gemm(lds, HB, 1024, (const bf16_t*)(ws + WS_W_MLADOWN_T), 1024, NTOK, MLA_DOWN_PAD, 1024, (int)blockIdx.x, E); } SEAM(10);
    if (IN(11)) for (int rep_ = 0; rep_ < ((PROBE_REP == 11) ? 1 + PROBE_N : 1); ++rep_) { phase_mla_rowstats(p); } SEAM(11);
    if (IN(12)) for (int rep_ = 0; rep_ < ((PROBE_REP == 12) ? 1 + PROBE_N : 1); ++rep_) { EpiBf16 Eq{(bf16_t*)(ws + S_QF), 1536}; EpiKV Ekv{(bf16_t*)(ws + S_KNOPE), (bf16_t*)(ws + S_V)};
        run_gemm(lds, (const bf16_t*)(ws + S_DQ), MLA_DOWN_PAD, (const bf16_t*)(ws + WS_W_UQ_T), 768, NTOK, 1536, 768, (int)blockIdx.x, Eq);
        run_gemm(lds, (const bf16_t*)(ws + S_DQ) + 768, MLA_DOWN_PAD, (const bf16_t*)(ws + WS_W_UKV_T), 256, NTOK, 2048, 256, (int)blockIdx.x, Ekv); } SEAM(12);
    if (IN(13)) for (int rep_ = 0; rep_ < ((PROBE_REP == 13) ? 1 + PROBE_N : 1); ++rep_) { if (USE_MFMA_MLA) phase_mla_attn(p, lds); else phase_mla_attn_ref(p, lds); } SEAM(13);
    if (IN(14)) for (int rep_ = 0; rep_ < ((PROBE_REP == 14) ? 1 + PROBE_N : 1); ++rep_) { EpiResid E{HB, (bf16_t*)(ws + S_Z2), (ABL & 4) ? 0.f : 1.f};
        run_gemm(lds, (const bf16_t*)(ws + S_AO2), 1024, (const bf16_t*)(ws + WS_W_MLAOUT_T), 1024, NTOK, 1024, 1024, (int)blockIdx.x, E); } SEAM(14);
    if (IN(15)) for (int rep_ = 0; rep_ < ((PROBE_REP == 15) ? 1 + PROBE_N : 1); ++rep_) { phase_ln((const bf16_t*)(ws + S_Z2), HB, p.in[I_MLA_LNG], p.in[I_MLA_LNB]); } SEAM(15);
    if (IN(16)) for (int rep_ = 0; rep_ < ((PROBE_REP == 16) ? 1 + PROBE_N : 1); ++rep_) { EpiBf16 E{(bf16_t*)(ws + S_QP1), 2048};
        run_gemm(lds, HB, 1024, (const bf16_t*)(ws + WS_W_PQ_T) + (size_t)2048 * 1024, 1024, NTOK, 2048, 1024, (int)blockIdx.x, E); } SEAM(16);
    if (IN(17) && ((PROBE_DUP & 1) || PROBE_REP == 17)) for (int rep_ = 0; rep_ < PROBE_N; ++rep_) { phase_peer_route_ref(p, lds, 1, (const bf16_t*)(ws + S_QP1), (int*)(ws + S_EIDX1), (float*)(ws + S_GW1)); }
    if (IN(17)) { if (USE_MFMA_ROUTE) phase_peer_route(p, lds, 1, (const bf16_t*)(ws + S_QP1), (int*)(ws + S_EIDX1), (float*)(ws + S_GW1)); else phase_peer_route_ref(p, lds, 1, (const bf16_t*)(ws + S_QP1), (int*)(ws + S_EIDX1), (float*)(ws + S_GW1)); } SEAM(17);
    if (IN(18) && ((PROBE_DUP & 2) || PROBE_REP == 18)) for (int rep_ = 0; rep_ < PROBE_N; ++rep_) { phase_peer_gather(p, 1, (const int*)(ws + S_EIDX1), (const float*)(ws + S_GW1), HB, (bf16_t*)(ws + S_Z2), nullptr, 1.f); }
    if (IN(18)) { phase_peer_gather(p, 1, (const int*)(ws + S_EIDX1), (const float*)(ws + S_GW1), HB, HB, p.out, (ABL & 8) ? 0.f : 1.f); }
#if DBG_STAT
    if (IN(18)) { asm volatile("s_waitcnt vmcnt(0) lgkmcnt(0)" ::: "memory"); __builtin_amdgcn_fence(__ATOMIC_RELEASE, "agent"); cg::this_grid().sync(); __builtin_amdgcn_fence(__ATOMIC_ACQUIRE, "agent");
        const float c = 1.f + __hip_atomic_load((float*)(ws + WS_CTL) + 16, __ATOMIC_RELAXED, __HIP_MEMORY_SCOPE_AGENT);
        for (size_t i = (size_t)blockIdx.x * NTHREADS + threadIdx.x; i < (size_t)NTOK * DM; i += (size_t)gridDim.x * NTHREADS) p.out[i] = c; }
#endif
#undef IN
#undef SEAM
}

extern "C" void kernel_launch(void* const* d_in, const int* in_sizes, int n_in, void* d_out, int out_size, void* d_ws, size_t ws_size, hipStream_t stream) {
    static int grid = 0;
    if (grid == 0) {
        if (n_in != 28 || out_size != NTOK * DM || ws_size < WS_NEED) { fprintf(stderr, "kernel_launch: unexpected problem (n_in %d, out %d, ws %zu)\n", n_in, out_size, ws_size); grid = -1; return; }
        int dev = 0, cus = 0, per_cu = 0;
        (void)hipGetDevice(&dev); (void)hipDeviceGetAttribute(&cus, hipDeviceAttributeMultiprocessorCount, dev);
        if (hipFuncSetAttribute((const void*)fwd_kernel, hipFuncAttributeMaxDynamicSharedMemorySize, LDS_BYTES) != hipSuccess) { fprintf(stderr, "kernel_launch: hipFuncSetAttribute failed\n"); grid = -1; return; }
        if (hipOccupancyMaxActiveBlocksPerMultiprocessor(&per_cu, (const void*)fwd_kernel, NTHREADS, LDS_BYTES) != hipSuccess || per_cu < 1) { fprintf(stderr, "kernel_launch: occupancy query says %d blocks per CU\n", per_cu); grid = -1; return; }
        grid = cus;
    }
    if (grid < 0) return;
    Params p{};
    for (int i = 0; i < 28; ++i) p.in[i] = (const float*)d_in[i];
    p.out = (float*)d_out; p.ws = (unsigned char*)d_ws;
#if MK_ONE_LAUNCH
    p.ph_lo = 0; p.ph_hi = NPHASES;
    void* args[] = {&p};
    hipError_t e = hipLaunchCooperativeKernel((const void*)fwd_kernel, dim3(grid), dim3(NTHREADS), args, LDS_BYTES, stream);
    if (e != hipSuccess) fprintf(stderr, "kernel_launch: cooperative launch failed: %s\n", hipGetErrorString(e));
#else
    for (int k = 0; k < NPHASES; ++k) { p.ph_lo = k; p.ph_hi = k + 1; hipLaunchKernelGGL(fwd_kernel, dim3(grid), dim3(NTHREADS), LDS_BYTES, stream, p); }
#endif
}
#ifdef REGTEST
__global__ void __launch_bounds__(256) regtest_nsa(Params p) { extern __shared__ __attribute__((aligned(16))) unsigned char l2[]; phase_nsa_attn(p, (LAS unsigned char*)l2); }
__global__ void __launch_bounds__(256) regtest_mla(Params p) { extern __shared__ __attribute__((aligned(16))) unsigned char l2[]; phase_mla_attn(p, (LAS unsigned char*)l2); }
#endif
```

```cpp
#include <hip/hip_runtime.h>
#include <hip/hip_cooperative_groups.h>
#include <cstdio>
#include <cstdint>
namespace cg = cooperative_groups;

#ifndef ABL
#define ABL 0
#endif
#ifndef PROBE_DUP
#define PROBE_DUP 0
#endif
#ifndef PROBE_REP
#define PROBE_REP -1
#endif
#ifndef PROBE_N
#define PROBE_N 2
#endif
#ifndef USE_MFMA_ROUTE
#define USE_MFMA_ROUTE 1
#endif
#ifndef USE_MFMA_NSA
#define USE_MFMA_NSA 1
#endif
#ifndef USE_MFMA_MLA
#define USE_MFMA_MLA 1
#endif
#ifndef DBG_STAT
#define DBG_STAT 0
#endif
#ifndef MK_ONE_LAUNCH
#define MK_ONE_LAUNCH 1
#endif

#define LAS __attribute__((address_space(3)))
typedef unsigned short bf16_t;
typedef short bf16x8 __attribute__((ext_vector_type(8)));
typedef float f32x4 __attribute__((ext_vector_type(4)));
typedef float f32x2 __attribute__((ext_vector_type(2)));
typedef unsigned u32x4 __attribute__((ext_vector_type(4)));
typedef unsigned u32x2 __attribute__((ext_vector_type(2)));
typedef __bf16 bf16x2_t __attribute__((ext_vector_type(2)));

constexpr int BATCH = 8, SEQ = 4096, DM = 1024, NTOK = BATCH * SEQ;
constexpr int NSA_IN = 2608, NSA_IN_PAD = 2816;
constexpr int MLA_DOWN = 1056, MLA_DOWN_PAD = 1280;
constexpr int NEXP = 16384;
constexpr float DN_ALPHA = 1.4142135623730951f;
constexpr float LN_EPS = 1e-5f, RMS_EPS = 1e-6f;
constexpr float U_SCALE = 1024.f, V_SCALE = 64.f;
constexpr int NWAVES = 8, NTHREADS = 512;
constexpr int LDS_BYTES = 147456;

constexpr size_t KiB = 1024, MiB = 1024 * 1024;
constexpr size_t WS_CTL = 0, CTL_BYTES = 64 * KiB;
constexpr size_t WS_W_IN_T = 1 * MiB;
constexpr size_t WS_W_NSAOUT_T = 6 * MiB + 512 * KiB;
constexpr size_t WS_W_CK1_T = 8 * MiB + 512 * KiB;
constexpr size_t WS_W_CV1_T = 9 * MiB;
constexpr size_t WS_W_MLADOWN_T = 9 * MiB + 512 * KiB;
constexpr size_t WS_W_UQ_T = 12 * MiB;
constexpr size_t WS_W_UKV_T = 14 * MiB + 256 * KiB;
constexpr size_t WS_W_MLAOUT_T = 15 * MiB + 256 * KiB;
constexpr size_t WS_W_PQ_T = 17 * MiB + 256 * KiB;
constexpr size_t WS_SUBK = 25 * MiB + 256 * KiB;
constexpr size_t WS_MISC = 27 * MiB;
constexpr size_t WS_PE = WS_MISC;
constexpr size_t WS_ROPE_COS = WS_MISC + 4 * KiB;
constexpr size_t WS_ROPE_SIN = WS_ROPE_COS + 256 * KiB;
constexpr size_t WS_RSTD_Q = WS_ROPE_SIN + 256 * KiB;
constexpr size_t WS_RSTD_KV = WS_RSTD_Q + 128 * KiB;
constexpr size_t WS_TAB = 32 * MiB;
constexpr size_t WS_HB = 160 * MiB;
constexpr size_t WS_S = 224 * MiB;
constexpr size_t S_Q = WS_S;
constexpr size_t S_KV6 = WS_S + 64 * MiB;
constexpr size_t S_AO = WS_S + 160 * MiB;
constexpr size_t S_GATES = WS_S + 224 * MiB;
constexpr size_t S_PK = WS_S + 230 * MiB;
constexpr size_t S_PV = WS_S + 238 * MiB;
constexpr size_t S_KCMP = WS_S + 246 * MiB;
constexpr size_t S_VCMP = S_KCMP + 512 * KiB;
constexpr size_t S_Z = WS_S;
constexpr size_t S_QP0 = WS_S + 64 * MiB;
constexpr size_t S_EIDX0 = WS_S + 192 * MiB;
constexpr size_t S_GW0 = WS_S + 208 * MiB;
constexpr size_t S_DQ = WS_S;
constexpr size_t S_QF = WS_S + 80 * MiB;
constexpr size_t S_V = WS_S + 176 * MiB;
constexpr size_t S_KROPE = WS_S + 240 * MiB;
constexpr size_t S_KNOPE = WS_TAB + 64 * MiB;
constexpr size_t S_AO2 = WS_S;
constexpr size_t S_Z2 = WS_S + 80 * MiB;
constexpr size_t S_QP1 = WS_S + 144 * MiB;
constexpr size_t S_EIDX1 = WS_S;
constexpr size_t S_GW1 = WS_S + 16 * MiB;
constexpr size_t WS_NEED = 512 * MiB;
static_assert(S_QP1 + 128 * MiB <= WS_NEED && S_VCMP + 512 * KiB <= WS_NEED, "workspace map");

__device__ __forceinline__ float bf_lo(unsigned u) { return __uint_as_float(u << 16); }
__device__ __forceinline__ float bf_hi(unsigned u) { return __uint_as_float(u & 0xffff0000u); }
__device__ __forceinline__ float bf2f(bf16_t v) { return __uint_as_float((unsigned)v << 16); }
__device__ __forceinline__ unsigned pk2(float lo, float hi) { f32x2 v = {lo, hi}; bf16x2_t b = __builtin_convertvector(v, bf16x2_t); return __builtin_bit_cast(unsigned, b); }
__device__ __forceinline__ bf16_t f2bf(float f) { return (bf16_t)(pk2(f, 0.f) & 0xffffu); }
__device__ __forceinline__ float wave_sum(float v) {
#pragma unroll
    for (int o = 32; o >= 1; o >>= 1) v += __shfl_xor(v, o);
    return v;
}
__device__ __forceinline__ float wave_max(float v) {
#pragma unroll
    for (int o = 32; o >= 1; o >>= 1) v = fmaxf(v, __shfl_xor(v, o));
    return v;
}
__device__ __forceinline__ float gelu_tanh(float x) {
    const float y = 0.7978845608028654f * (x + 0.044715f * x * x * x);
    const float e = __expf(2.f * y);
    const float th = 1.f - 2.f / (1.f + e);
    return 0.5f * x * (1.f + th);
}
#define LDS_FENCE() asm volatile("s_waitcnt lgkmcnt(0)" ::: "memory")

namespace pg8 {
constexpr int BM = 256, BK = 64, HALF = 128, HTB = HALF * BK * 2, STAGE_BYTES = 8 * HTB, NXCD = 8, WGM = 8;
__host__ __device__ __forceinline__ int lds_byte(int r, int c) { const int st = (r >> 4) * 2 + (c >> 5), rr = r & 15, cc = c & 31, ob = rr * 64 + cc * 2; return st * 1024 + (ob ^ (((ob >> 9) & 1) << 5)); }
__host__ __device__ __forceinline__ void stage_rc(int b, int& R, int& C) { const int st = b / 1024, sb = b % 1024, swz = sb ^ (((sb >> 9) & 1) << 5); R = (st >> 1) * 16 + swz / 64; C = (st & 1) * 32 + (swz % 64) / 2; }
__host__ __device__ __forceinline__ int perm32(int rho) { const int n = rho >> 4, i = rho & 15; return 8 * (i >> 2) + 4 * n + (i & 3); }
struct Unit { int pm, pn; };
struct Gemm { const bf16_t* A; const bf16_t* Bt; int M, N, K, lda, ldb; };
struct StaticOrder {
    int nM, nN, nwg, G, c;
    __device__ void init(int M, int N, int G_, int c_) { nM = M / BM; nN = N / BM; nwg = nM * nN; G = G_; c = c_; }
    __device__ bool next(int i, Unit& u) const {
        const long L = (long)i * G + c; if (L >= nwg) return false;
        int wgid = (int)L; { const int q = nwg / NXCD, r = nwg % NXCD, xcd = wgid % NXCD, off = wgid / NXCD; wgid = (xcd < r ? xcd * (q + 1) : r * (q + 1) + (xcd - r) * q) + off; }
        const int nig = WGM * nN, gid = wgid / nig, fm = gid * WGM, gsz = (nM - fm) < WGM ? (nM - fm) : WGM;
        u.pm = fm + ((wgid % nig) % gsz); u.pn = (wgid % nig) / gsz; return true;
    }
};
template <class F> struct EpiFn {
    static constexpr bool PERM = true;
    F f;
    __device__ __forceinline__ void operator()(const f32x4 (&acc)[2][2][4][2], const Unit& u, int wr, int wc, int fr, int fq) const {
        const int row0 = u.pm * BM + wr * 64 + fr, col0 = u.pn * BM + wc * 32 + 8 * fq;
#pragma unroll
        for (int ai = 0; ai < 2; ++ai)
#pragma unroll
            for (int m = 0; m < 4; ++m)
#pragma unroll
                for (int bj = 0; bj < 2; ++bj) f(row0 + ai * HALF + m * 16, col0 + bj * HALF, acc[ai][bj][m][0], acc[ai][bj][m][1]);
    }
};

template <class Epi, class Sched>
__device__ __forceinline__ void gemm_phase(LAS unsigned char* lds, const Gemm g, const Sched& S, const Epi& E) {
    const int tid = threadIdx.x, wid = __builtin_amdgcn_readfirstlane(tid >> 6), lane = tid & 63, wr = wid >> 2, wc = wid & 3, fr = lane & 15, fq = lane >> 4;
    const int K = g.K, nt = K / BK;
    unsigned voffA[2], voffB[2];
#pragma unroll
    for (int i = 0; i < 2; ++i) { int R, C; stage_rc(tid * 16 + i * 8192, R, C); const int Rb = Epi::PERM ? ((R & ~31) + perm32(R & 31)) : R;
        voffA[i] = (unsigned)(R * g.lda + C) * 2u; voffB[i] = (unsigned)(Rb * g.ldb + C) * 2u; }
    const size_t kstep = (size_t)(BK * 2);
    const size_t hstepA = (size_t)HALF * g.lda * 2, hstepB = (size_t)HALF * g.ldb * 2;
    const size_t tstepA = 2 * hstepA, tstepB = 2 * hstepB;
    const unsigned ldsw = (unsigned)wid * 1024u;
    const int aoff = lds_byte(wr * 64 + fr, fq * 8), boff = lds_byte(wc * 32 + fr, fq * 8);
#define PG8_SA(b, h) (((b) * 2 + (h)) * HTB)
#define PG8_SB(b, h) ((4 + (b) * 2 + (h)) * HTB)
#define PG8_STAGE(bufoff, gbase, voff) do { _Pragma("unroll") for (int _i = 0; _i < 2; ++_i) \
        __builtin_amdgcn_global_load_lds((const unsigned*)((const char*)(gbase) + (voff)[_i]), (LAS unsigned*)(lds + (bufoff) + ldsw + _i * 8192), 16, 0, 0); } while (0)
#define PG8_LDA(dst, b, h) do { _Pragma("unroll") for (int m = 0; m < 4; ++m) _Pragma("unroll") for (int k = 0; k < 2; ++k) dst[m][k] = *(const LAS bf16x8*)(lds + PG8_SA(b, h) + aoff + m * 2048 + k * 1024); } while (0)
#define PG8_LDB(dst, b, h) do { _Pragma("unroll") for (int n = 0; n < 2; ++n) _Pragma("unroll") for (int k = 0; k < 2; ++k) dst[n][k] = *(const LAS bf16x8*)(lds + PG8_SB(b, h) + boff + n * 2048 + k * 1024); } while (0)
#define PG8_MMA(ai, bj, At, Bt) do { __builtin_amdgcn_s_setprio(1); _Pragma("unroll") for (int m = 0; m < 4; ++m) _Pragma("unroll") for (int n = 0; n < 2; ++n) _Pragma("unroll") for (int k = 0; k < 2; ++k) \
        acc[ai][bj][m][n] = __builtin_amdgcn_mfma_f32_16x16x32_bf16(Bt[n][k], At[m][k], acc[ai][bj][m][n], 0, 0, 0); __builtin_amdgcn_s_setprio(0); } while (0)
#define PG8_WAIT_V(n) asm volatile("s_waitcnt vmcnt(" #n ")" ::: "memory")
#define PG8_WAIT_L(n) asm volatile("s_waitcnt lgkmcnt(" #n ")" ::: "memory")
#define PG8_BAR __builtin_amdgcn_s_barrier()
#define PG8_SCHED __builtin_amdgcn_sched_barrier(0)
    Unit cur, nxt; int ui = 0;
    if (!S.next(0, cur)) return;
    f32x4 acc[2][2][4][2];
#pragma unroll
    for (int a = 0; a < 2; ++a)
#pragma unroll
        for (int b = 0; b < 2; ++b)
#pragma unroll
            for (int m = 0; m < 4; ++m)
#pragma unroll
                for (int n = 0; n < 2; ++n) acc[a][b][m][n] = (f32x4){0.f, 0.f, 0.f, 0.f};
    bf16x8 At[4][2], B0[2][2], B1[2][2];
    const char* cA = (const char*)g.A + (size_t)cur.pm * tstepA; const char* cB = (const char*)g.Bt + (size_t)cur.pn * tstepB;
    PG8_STAGE(PG8_SB(0, 0), cB, voffB); PG8_STAGE(PG8_SB(0, 1), cB + hstepB, voffB); PG8_STAGE(PG8_SA(0, 0), cA, voffA); PG8_STAGE(PG8_SA(0, 1), cA + hstepA, voffA);
    if (wr == 1) PG8_BAR;
    PG8_WAIT_V(2); PG8_BAR;
    PG8_STAGE(PG8_SB(1, 0), cB + kstep, voffB); PG8_STAGE(PG8_SA(1, 0), cA + kstep, voffA); PG8_STAGE(PG8_SB(1, 1), cB + hstepB + kstep, voffB);
    PG8_WAIT_V(6); PG8_BAR;
    for (;;) {
        const bool has_next = S.next(ui + 1, nxt);
        const char* nA = has_next ? (const char*)g.A + (size_t)nxt.pm * tstepA : cA; const char* nB = has_next ? (const char*)g.Bt + (size_t)nxt.pn * tstepB : cB;
        for (int t = 0; t < nt; t += 2) {
            const bool last = (t == nt - 2);
            const char* a1 = cA + (size_t)(t + 1) * kstep;
            const char* a2 = last ? nA : cA + (size_t)(t + 2) * kstep; const char* b2 = last ? nB : cB + (size_t)(t + 2) * kstep;
            const char* a3 = a2 + kstep; const char* b3 = b2 + kstep;
            PG8_LDB(B0, 0, 0); PG8_LDB(B1, 0, 1); PG8_SCHED; PG8_LDA(At, 0, 0); PG8_STAGE(PG8_SA(1, 1), a1 + hstepA, voffA);
            PG8_WAIT_V(8); PG8_WAIT_L(0); PG8_BAR; PG8_MMA(0, 0, At, B0); PG8_MMA(0, 1, At, B1); PG8_BAR; PG8_SCHED;
            PG8_LDA(At, 0, 1); PG8_STAGE(PG8_SB(0, 0), b2, voffB); PG8_STAGE(PG8_SB(0, 1), b2 + hstepB, voffB); PG8_STAGE(PG8_SA(0, 0), a2, voffA);
            PG8_WAIT_V(8); PG8_WAIT_L(0); PG8_BAR; PG8_MMA(1, 0, At, B0); PG8_MMA(1, 1, At, B1); PG8_BAR; PG8_SCHED;
            PG8_LDB(B0, 1, 0); PG8_LDB(B1, 1, 1); PG8_SCHED; PG8_LDA(At, 1, 0); PG8_STAGE(PG8_SA(0, 1), a2 + hstepA, voffA);
            PG8_WAIT_V(8); PG8_WAIT_L(0); PG8_BAR; PG8_MMA(0, 0, At, B0); PG8_MMA(0, 1, At, B1); PG8_BAR; PG8_SCHED;
            PG8_LDA(At, 1, 1); PG8_STAGE(PG8_SB(1, 0), b3, voffB); PG8_STAGE(PG8_SB(1, 1), b3 + hstepB, voffB); PG8_STAGE(PG8_SA(1, 0), a3, voffA);
            PG8_WAIT_V(8); PG8_WAIT_L(0); PG8_BAR; PG8_MMA(1, 0, At, B0); PG8_MMA(1, 1, At, B1); PG8_BAR; PG8_SCHED;
        }
        if (wr == 0) PG8_BAR;
        E(acc, cur, wr, wc, fr, fq);
        if (!has_next) break;
#pragma unroll
        for (int a = 0; a < 2; ++a)
#pragma unroll
            for (int b = 0; b < 2; ++b)
#pragma unroll
                for (int m = 0; m < 4; ++m)
#pragma unroll
                    for (int n = 0; n < 2; ++n) acc[a][b][m][n] = (f32x4){0.f, 0.f, 0.f, 0.f};
        cur = nxt; cA = nA; cB = nB; ++ui;
        if (wr == 1) PG8_BAR;
    }
    PG8_WAIT_V(0);
    PG8_BAR;
#undef PG8_SA
#undef PG8_SB
#undef PG8_STAGE
#undef PG8_LDA
#undef PG8_LDB
#undef PG8_MMA
#undef PG8_WAIT_V
#undef PG8_WAIT_L
#undef PG8_BAR
#undef PG8_SCHED
}
}

template <class F>
__device__ __forceinline__ void run_gemm(LAS unsigned char* lds, const bf16_t* A, int lda, const bf16_t* Bt, int ldb, int M, int N, int K, int vblock, const F& f) {
    pg8::Gemm g{A, Bt, M, N, K, lda, ldb}; pg8::StaticOrder S; S.init(M, N, (int)gridDim.x, vblock);
    pg8::EpiFn<F> E{f};
    pg8::gemm_phase<pg8::EpiFn<F>, pg8::StaticOrder>(lds, g, S, E);
}

struct Params {
    const float* in[28];
    float* out;
    unsigned char* ws;
    int ph_lo, ph_hi;
};
enum { I_X = 0, I_NSA_WIN, I_CK_W1, I_CK_W2, I_CK_PE, I_CV_W1, I_CV_W2, I_CV_PE, I_NSA_WOUT, I_NSA_LNG, I_NSA_LNB, I_MLA_WDKV, I_MLA_KVG, I_MLA_WKR, I_MLA_WUK, I_MLA_WUV,
       I_MLA_WDQ, I_MLA_QG, I_MLA_WUQ, I_MLA_WOUT, I_MLA_LNG, I_MLA_LNB, I_PEER_WQ, I_PEER_SUBK, I_PEER_U, I_PEER_V, I_PEER_LNG, I_PEER_LNB };

__device__ __forceinline__ void p0_transpose_item(const float* W, int ldw, int n_valid, int K, bf16_t* WT, int row_off, const float* kscale, LAS float* scr, int nblk, int item, int lane) {
    const int kb = item / nblk, nb = item % nblk, k0 = 64 * kb, n0 = 32 * nb;
    const int n = n0 + (lane & 31);
#pragma unroll 8
    for (int i = 0; i < 32; ++i) { const int kk = 2 * i + (lane >> 5); float v = 0.f; if (n < n_valid) { v = W[(size_t)(k0 + kk) * ldw + n]; if (kscale) v *= kscale[k0 + kk]; } scr[kk * 33 + (lane & 31)] = v; }
    LDS_FENCE();
    const int c = lane & 7;
#pragma unroll
    for (int j = 0; j < 4; ++j) { const int nn = (lane >> 3) + 8 * j; const LAS float* s = scr + (8 * c) * 33 + nn;
        u32x4 o; o.x = pk2(s[0 * 33], s[1 * 33]); o.y = pk2(s[2 * 33], s[3 * 33]); o.z = pk2(s[4 * 33], s[5 * 33]); o.w = pk2(s[6 * 33], s[7 * 33]);
        *(u32x4*)(WT + (size_t)(row_off + n0 + nn) * K + k0 + 8 * c) = o; }
    LDS_FENCE();
}
__device__ __forceinline__ void cvt_f32_bf16(const float* src, bf16_t* dst, size_t n, size_t gtid, size_t gsz) {
    for (size_t i = gtid * 8; i < n; i += gsz * 8) { const f32x4 a = *(const f32x4*)(src + i), b = *(const f32x4*)(src + i + 4);
        u32x4 o; o.x = pk2(a.x, a.y); o.y = pk2(a.z, a.w); o.z = pk2(b.x, b.y); o.w = pk2(b.z, b.w); *(u32x4*)(dst + i) = o; }
}
__device__ __forceinline__ void cvt_f32_fp8(const float* src, unsigned char* dst, size_t n, float scale, size_t gtid, size_t gsz) {
    for (size_t i = gtid * 16; i < n; i += gsz * 16) {
        u32x4 o;
#pragma unroll
        for (int j = 0; j < 4; ++j) { f32x4 a = *(const f32x4*)(src + i + 4 * j) * scale;
#pragma unroll
            for (int e = 0; e < 4; ++e) a[e] = fminf(fmaxf(a[e], -448.f), 448.f);
            int pk = 0; pk = __builtin_amdgcn_cvt_pk_fp8_f32(a.x, a.y, pk, false); pk = __builtin_amdgcn_cvt_pk_fp8_f32(a.z, a.w, pk, true); o[j] = (unsigned)pk; }
        *(u32x4*)(dst + i) = o;
    }
}
__device__ __forceinline__ void phase_prologue(const Params& p, LAS unsigned char* lds) {
    const int tid = threadIdx.x, lane = tid & 63, wave = tid >> 6;
    LAS float* scr = (LAS float*)(lds + wave * 16384);
    const int gw = blockIdx.x * NWAVES + wave, NGW = gridDim.x * NWAVES;
    unsigned char* ws = p.ws;
    int base = 0;
#define TJOB(W_, ldw_, nvalid_, K_, npad_, WT_, rowoff_, ks_) do { const int nblk = (npad_) / 32, nit = ((K_) / 64) * nblk; \
        for (int it = gw - base; it < nit; it += NGW) { if (it >= 0) p0_transpose_item((W_), (ldw_), (nvalid_), (K_), (WT_), (rowoff_), (ks_), scr, nblk, it, lane); } \
        base = (base + nit) % NGW; } while (0)
    TJOB(p.in[I_NSA_WIN], NSA_IN, NSA_IN, 1024, NSA_IN_PAD, (bf16_t*)(ws + WS_W_IN_T), 0, (const float*)nullptr);
    TJOB(p.in[I_NSA_WOUT], 1024, 1024, 1024, 1024, (bf16_t*)(ws + WS_W_NSAOUT_T), 0, (const float*)nullptr);
    TJOB(p.in[I_CK_W1], 128, 128, 1024, 128, (bf16_t*)(ws + WS_W_CK1_T), 0, (const float*)nullptr);
    TJOB(p.in[I_CK_W1] + 1024 * 128, 128, 128, 1024, 128, (bf16_t*)(ws + WS_W_CK1_T), 128, (const float*)nullptr);
    TJOB(p.in[I_CV_W1], 128, 128, 1024, 128, (bf16_t*)(ws + WS_W_CV1_T), 0, (const float*)nullptr);
    TJOB(p.in[I_CV_W1] + 1024 * 128, 128, 128, 1024, 128, (bf16_t*)(ws + WS_W_CV1_T), 128, (const float*)nullptr);
    TJOB(p.in[I_MLA_WDQ], 768, 768, 1024, 768, (bf16_t*)(ws + WS_W_MLADOWN_T), 0, (const float*)nullptr);
    TJOB(p.in[I_MLA_WDKV], 256, 256, 1024, 256, (bf16_t*)(ws + WS_W_MLADOWN_T), 768, (const float*)nullptr);
    TJOB(p.in[I_MLA_WKR], 32, 32, 1024, 256, (bf16_t*)(ws + WS_W_MLADOWN_T), 1024, (const float*)nullptr);
    TJOB(p.in[I_MLA_WUQ], 1536, 1536, 768, 1536, (bf16_t*)(ws + WS_W_UQ_T), 0, p.in[I_MLA_QG]);
    TJOB(p.in[I_MLA_WUK], 1024, 1024, 256, 1024, (bf16_t*)(ws + WS_W_UKV_T), 0, p.in[I_MLA_KVG]);
    TJOB(p.in[I_MLA_WUV], 1024, 1024, 256, 1024, (bf16_t*)(ws + WS_W_UKV_T), 1024, p.in[I_MLA_KVG]);
    TJOB(p.in[I_MLA_WOUT], 1024, 1024, 1024, 1024, (bf16_t*)(ws + WS_W_MLAOUT_T), 0, (const float*)nullptr);
    TJOB(p.in[I_PEER_WQ], 2048, 2048, 1024, 2048, (bf16_t*)(ws + WS_W_PQ_T), 0, (const float*)nullptr);
    TJOB(p.in[I_PEER_WQ] + (size_t)1024 * 2048, 2048, 2048, 1024, 2048, (bf16_t*)(ws + WS_W_PQ_T) + (size_t)2048 * 1024, 0, (const float*)nullptr);
#undef TJOB
#if DBG_STAT
    if (blockIdx.x == 0 && tid == 0) ((float*)(ws + WS_CTL))[16] = 0.f;
#endif
    const size_t gtid = (size_t)blockIdx.x * NTHREADS + tid, gsz = (size_t)gridDim.x * NTHREADS;
    cvt_f32_bf16(p.in[I_X], (bf16_t*)(ws + WS_HB), (size_t)NTOK * DM, gtid, gsz);
    cvt_f32_bf16(p.in[I_PEER_SUBK], (bf16_t*)(ws + WS_SUBK), (size_t)2 * 8 * 2 * 128 * 128, gtid, gsz);
    cvt_f32_fp8(p.in[I_PEER_U], ws + WS_TAB, (size_t)NEXP * DM, U_SCALE, gtid, gsz);
    cvt_f32_fp8(p.in[I_PEER_V], ws + WS_TAB + 16 * MiB, (size_t)NEXP * DM, V_SCALE, gtid, gsz);
    cvt_f32_fp8(p.in[I_PEER_U] + (size_t)NEXP * DM, ws + WS_TAB + 32 * MiB, (size_t)NEXP * DM, U_SCALE, gtid, gsz);
    cvt_f32_fp8(p.in[I_PEER_V] + (size_t)NEXP * DM, ws + WS_TAB + 48 * MiB, (size_t)NEXP * DM, V_SCALE, gtid, gsz);
    for (int o = gw; o < 256; o += NGW) {
        const float* pe = (o < 128) ? p.in[I_CK_PE] : p.in[I_CV_PE]; const float* w1 = (o < 128) ? p.in[I_CK_W1] : p.in[I_CV_W1]; const int h = o & 127;
        float s = 0.f; for (int i = lane; i < 2048; i += 64) s += pe[i] * w1[(size_t)i * 128 + h];
        s = wave_sum(s); if (lane == 0) ((float*)(ws + WS_PE))[o] = s;
    }
    for (size_t i = gtid; i < (size_t)SEQ * 16; i += gsz) {
        const int pos = (int)(i >> 4), fi = (int)(i & 15);
        const float inv = 1.0f / powf(10000.0f, (float)(2 * fi) / 32.0f);
        const float ang = (float)pos * inv;
        const double rev = (double)ang * 0.15915494309189535; const double fr = rev - rint(rev);
        ((float*)(ws + WS_ROPE_COS))[i] = __builtin_amdgcn_cosf((float)fr); ((float*)(ws + WS_ROPE_SIN))[i] = __builtin_amdgcn_sinf((float)fr);
    }
}

__device__ __forceinline__ u32x4 pack8(const f32x4& a, const f32x4& b) { u32x4 o; o.x = pk2(a.x, a.y); o.y = pk2(a.z, a.w); o.z = pk2(b.x, b.y); o.w = pk2(b.z, b.w); return o; }
struct EpiNsaProj {
    bf16_t* q; bf16_t* kv6; float* gates;
    __device__ __forceinline__ void operator()(int row, int col, const f32x4& a, const f32x4& b) const {
        if (col < 1024) { *(u32x4*)(q + (size_t)row * 1024 + col) = pack8(a, b); }
        else if (col < 2560) {
            const int which = (col - 1024) >> 8, cc = (col - 1024) & 255;
            bf16_t* base = kv6 + (size_t)which * NTOK * 256;
            if (which < 2) { const int g = cc >> 6, d = cc & 63, bb = row >> 12, t = row & 4095, n = t >> 4, l = t & 15;
                *(u32x4*)(base + ((((size_t)(bb * 256 + n) * 4 + g) * 16 + l) * 64 + d)) = pack8(a, b); }
            else *(u32x4*)(base + (size_t)row * 256 + cc) = pack8(a, b);
        } else if (col < NSA_IN) {
            float* gp = gates + (size_t)row * 48 + (col - 2560);
            f32x4 s0, s1;
#pragma unroll
            for (int i = 0; i < 4; ++i) { s0[i] = 1.f / (1.f + __expf(-a[i])); s1[i] = 1.f / (1.f + __expf(-b[i])); }
            *(f32x4*)gp = s0; *(f32x4*)(gp + 4) = s1;
        }
    }
};
struct EpiF32 { float* O; int ldc; __device__ __forceinline__ void operator()(int row, int col, const f32x4& a, const f32x4& b) const { float* o = O + (size_t)row * ldc + col; *(f32x4*)o = a; *(f32x4*)(o + 4) = b; } };
struct EpiBf16 { bf16_t* O; int ldc; __device__ __forceinline__ void operator()(int row, int col, const f32x4& a, const f32x4& b) const { *(u32x4*)(O + (size_t)row * ldc + col) = pack8(a, b); } };
struct EpiResid {
    const bf16_t* H; bf16_t* Z; float ms;
    __device__ __forceinline__ void operator()(int row, int col, const f32x4& a_, const f32x4& b_) const {
        const f32x4 a = a_ * ms, b = b_ * ms;
        const u32x4 h = *(const u32x4*)(H + (size_t)row * 1024 + col);
        f32x4 x, y;
        x.x = DN_ALPHA * bf_lo(h.x) + a.x; x.y = DN_ALPHA * bf_hi(h.x) + a.y; x.z = DN_ALPHA * bf_lo(h.y) + a.z; x.w = DN_ALPHA * bf_hi(h.y) + a.w;
        y.x = DN_ALPHA * bf_lo(h.z) + b.x; y.y = DN_ALPHA * bf_hi(h.z) + b.y; y.z = DN_ALPHA * bf_lo(h.w) + b.z; y.w = DN_ALPHA * bf_hi(h.w) + b.w;
        *(u32x4*)(Z + (size_t)row * 1024 + col) = pack8(x, y);
    }
};
struct EpiKV {
    bf16_t* KN; bf16_t* V;
    __device__ __forceinline__ void operator()(int row, int col, const f32x4& a, const f32x4& b) const {
        bf16_t* dst = (col < 1024) ? KN + (size_t)row * 1024 + col : V + (size_t)row * 1024 + (col - 1024);
        *(u32x4*)dst = pack8(a, b);
    }
};

__device__ __forceinline__ void phase_ln(const bf16_t* Z, bf16_t* H, const float* g, const float* b) {
    const int lane = threadIdx.x & 63, wave = threadIdx.x >> 6;
    const int gw = blockIdx.x * NWAVES + wave, NGW = gridDim.x * NWAVES;
    for (int row = gw; row < NTOK; row += NGW) {
        const u32x4 a = *(const u32x4*)(Z + (size_t)row * 1024 + lane * 8), c = *(const u32x4*)(Z + (size_t)row * 1024 + 512 + lane * 8);
        float v[16] = {bf_lo(a.x), bf_hi(a.x), bf_lo(a.y), bf_hi(a.y), bf_lo(a.z), bf_hi(a.z), bf_lo(a.w), bf_hi(a.w), bf_lo(c.x), bf_hi(c.x), bf_lo(c.y), bf_hi(c.y), bf_lo(c.z), bf_hi(c.z), bf_lo(c.w), bf_hi(c.w)};
        float s = 0.f;
#pragma unroll
        for (int i = 0; i < 16; ++i) s += v[i];
        const float mean = wave_sum(s) * (1.f / 1024.f); float q = 0.f;
#pragma unroll
        for (int i = 0; i < 16; ++i) { v[i] -= mean; q += v[i] * v[i]; }
        const float rstd = rsqrtf(wave_sum(q) * (1.f / 1024.f) + LN_EPS);
        float o[16];
#pragma unroll
        for (int hh = 0; hh < 2; ++hh) { const int c0 = hh * 512 + lane * 8; const f32x4 g0 = *(const f32x4*)(g + c0), g1 = *(const f32x4*)(g + c0 + 4), b0 = *(const f32x4*)(b + c0), b1 = *(const f32x4*)(b + c0 + 4);
#pragma unroll
            for (int i = 0; i < 4; ++i) { o[hh * 8 + i] = v[hh * 8 + i] * rstd * g0[i] + b0[i]; o[hh * 8 + 4 + i] = v[hh * 8 + 4 + i] * rstd * g1[i] + b1[i]; } }
        u32x4 w0, w1; w0.x = pk2(o[0], o[1]); w0.y = pk2(o[2], o[3]); w0.z = pk2(o[4], o[5]); w0.w = pk2(o[6], o[7]); w1.x = pk2(o[8], o[9]); w1.y = pk2(o[10], o[11]); w1.z = pk2(o[12], o[13]); w1.w = pk2(o[14], o[15]);
        *(u32x4*)(H + (size_t)row * 1024 + lane * 8) = w0; *(u32x4*)(H + (size_t)row * 1024 + 512 + lane * 8) = w1;
    }
}
__device__ __forceinline__ void phase_cmp_finish(const Params& p, LAS unsigned char* lds) {
    const int lane = threadIdx.x & 63, wave = threadIdx.x >> 6;
    const int gw = blockIdx.x * NWAVES + wave, NGW = gridDim.x * NWAVES;
    LAS float* hs = (LAS float*)(lds + wave * 512);
    for (int item = gw; item < 2 * 8192; item += NGW) {
        const int kv = item >> 13, r = item & 8191, n = (r >> 2) & 255;
        const float* P = (const float*)(p.ws + (kv ? S_PV : S_PK)); const float* pe = (const float*)(p.ws + WS_PE) + kv * 128;
        const float* w2 = p.in[kv ? I_CV_W2 : I_CK_W2];
        bf16_t* out = (bf16_t*)(p.ws + (kv ? S_VCMP : S_KCMP)) + (size_t)r * 64;
        if (n == 255) { out[lane] = 0; continue; }
        const float a0 = P[(size_t)r * 256 + lane] + P[(size_t)(r + 4) * 256 + 128 + lane] + pe[lane];
        const float a1 = P[(size_t)r * 256 + 64 + lane] + P[(size_t)(r + 4) * 256 + 192 + lane] + pe[64 + lane];
        LDS_FENCE();
        hs[lane] = gelu_tanh(a0); hs[64 + lane] = gelu_tanh(a1);
        LDS_FENCE();
        float s = 0.f;
#pragma unroll 8
        for (int h = 0; h < 128; ++h) s += hs[h] * w2[h * 64 + lane];
        out[lane] = f2bf(s);
    }
}
__device__ __forceinline__ void phase_mla_rowstats(const Params& p) {
    const int lane = threadIdx.x & 63, wave = threadIdx.x >> 6;
    const int gw = blockIdx.x * NWAVES + wave, NGW = gridDim.x * NWAVES;
    bf16_t* DQ = (bf16_t*)(p.ws + S_DQ);
    const float* rc = (const float*)(p.ws + WS_ROPE_COS); const float* rs = (const float*)(p.ws + WS_ROPE_SIN);
    for (int row = gw; row < NTOK; row += NGW) {
        bf16_t* r = DQ + (size_t)row * MLA_DOWN_PAD;
        u32x2 v[4]; float sq = 0.f, skv = 0.f;
#pragma unroll
        for (int j = 0; j < 4; ++j) { v[j] = *(const u32x2*)(r + j * 256 + lane * 4); const float a = bf_lo(v[j].x), b = bf_hi(v[j].x), c = bf_lo(v[j].y), d = bf_hi(v[j].y); const float ss = (a * a + b * b) + (c * c + d * d); if (j < 3) sq += ss; else skv += ss; }
        sq = wave_sum(sq); skv = wave_sum(skv);
        const float rq = rsqrtf(sq * (1.f / 768.f) + RMS_EPS), rkv = rsqrtf(skv * (1.f / 256.f) + RMS_EPS);
#pragma unroll
        for (int j = 0; j < 4; ++j) { const float f = (j < 3) ? rq : rkv; u32x2 o; o.x = pk2(bf_lo(v[j].x) * f, bf_hi(v[j].x) * f); o.y = pk2(bf_lo(v[j].y) * f, bf_hi(v[j].y) * f); *(u32x2*)(r + j * 256 + lane * 4) = o; }
        if (lane < 16) { const int pos = row & 4095; const float x1 = bf2f(r[1024 + lane]), x2 = bf2f(r[1040 + lane]), c = rc[pos * 16 + lane], s = rs[pos * 16 + lane];
            bf16_t* kr = (bf16_t*)(p.ws + S_KROPE) + (size_t)row * 32; kr[lane] = f2bf(x1 * c - x2 * s); kr[16 + lane] = f2bf(x2 * c + x1 * s); }
    }
}

struct OnlineSt { float m[4], l[4], o[4][2]; };
__device__ __forceinline__ void nsa_attend_block(OnlineSt& st, const bf16_t* Kb, const bf16_t* Vb, int pos0, int t, const float (&slope)[4], LAS float* qs, LAS float* ps, int lane) {
    const int pos = pos0 + lane; const bool valid = pos <= t;
    const bf16_t* krow = Kb + (size_t)(valid ? pos : t) * 256;
    float acc[4] = {0.f, 0.f, 0.f, 0.f};
#pragma unroll 2
    for (int d8 = 0; d8 < 8; ++d8) { const u32x4 kv = *(const u32x4*)(krow + d8 * 8);
        const float kf[8] = {bf_lo(kv.x), bf_hi(kv.x), bf_lo(kv.y), bf_hi(kv.y), bf_lo(kv.z), bf_hi(kv.z), bf_lo(kv.w), bf_hi(kv.w)};
#pragma unroll
        for (int e = 0; e < 8; ++e) { const f32x4 qv = *(const LAS f32x4*)(qs + (d8 * 8 + e) * 4);
#pragma unroll
            for (int r = 0; r < 4; ++r) acc[r] += qv[r] * kf[e]; } }
    const float dist = (float)(t - pos);
    f32x4 pe;
#pragma unroll
    for (int r = 0; r < 4; ++r) {
        const float s = valid ? acc[r] - slope[r] * dist : -1e30f;
        const float mb = wave_max(s), mn = fmaxf(st.m[r], mb);
        const float alpha = __expf(st.m[r] - mn);
        const float e = valid ? __expf(s - mn) : 0.f;
        st.l[r] = st.l[r] * alpha + wave_sum(e); st.o[r][0] *= alpha; st.o[r][1] *= alpha; st.m[r] = mn; pe[r] = e;
    }
    LDS_FENCE();
    *(LAS f32x4*)(ps + lane * 4) = pe;
    LDS_FENCE();
    const int hf = lane >> 5, dp = lane & 31;
    const int nk = (t - pos0 + 1 < 64) ? t - pos0 + 1 : 64;
#pragma unroll 4
    for (int kk = hf; kk < nk; kk += 2) {
        const unsigned vv = *(const unsigned*)(Vb + (size_t)(pos0 + kk) * 256 + 2 * dp); const f32x4 pp = *(const LAS f32x4*)(ps + kk * 4);
        const float lo = bf_lo(vv), hi = bf_hi(vv);
#pragma unroll
        for (int r = 0; r < 4; ++r) { st.o[r][0] += pp[r] * lo; st.o[r][1] += pp[r] * hi; }
    }
}
__device__ __forceinline__ void phase_nsa_attn_ref(const Params& p, LAS unsigned char* lds) {
    const int lane = threadIdx.x & 63, wave = threadIdx.x >> 6;
    const int gw = blockIdx.x * NWAVES + wave, NGW = gridDim.x * NWAVES;
    LAS float* qs = (LAS float*)(lds + wave * 6144);
    LAS float* pc = qs + 256;
    LAS float* ptot = pc + 1024;
    const bf16_t* Q = (const bf16_t*)(p.ws + S_Q); const bf16_t* KV6 = (const bf16_t*)(p.ws + S_KV6);
    const bf16_t* KS = KV6 + (size_t)2 * NTOK * 256; const bf16_t* VS = KV6 + (size_t)3 * NTOK * 256; const bf16_t* KW = KV6 + (size_t)4 * NTOK * 256; const bf16_t* VW = KV6 + (size_t)5 * NTOK * 256;
    const bf16_t* KC = (const bf16_t*)(p.ws + S_KCMP); const bf16_t* VC = (const bf16_t*)(p.ws + S_VCMP);
    const float* GATES = (const float*)(p.ws + S_GATES); bf16_t* AO = (bf16_t*)(p.ws + S_AO);
    const int hf = lane >> 5, dp = lane & 31;
    for (int item = gw; item < NTOK * 4; item += NGW) {
        const int g = item & 3, row = item >> 2, b = row >> 12, t = row & 4095;
        float slope[4];
#pragma unroll
        for (int r = 0; r < 4; ++r) slope[r] = exp2f(-0.5f * (float)(g * 4 + r + 1));
        LDS_FENCE();
        { f32x4 qv;
#pragma unroll
          for (int r = 0; r < 4; ++r) qv[r] = bf2f(Q[(size_t)row * 1024 + (g * 4 + r) * 64 + lane]) * 0.125f;
          *(LAS f32x4*)(qs + lane * 4) = qv; }
        LDS_FENCE();
        const int nv = (t >= 31) ? (((t - 31) >> 4) + 1 < 255 ? ((t - 31) >> 4) + 1 : 255) : 0;
        float mloc[4] = {-1e30f, -1e30f, -1e30f, -1e30f};
#pragma unroll 1
        for (int c = 0; c < 4; ++c) {
            const int i = 64 * c + lane;
            f32x4 sv = (f32x4){-1e30f, -1e30f, -1e30f, -1e30f};
            if (64 * c < nv) {
                const bf16_t* krow = KC + ((size_t)(b * 256 + i) * 4 + g) * 64;
                float acc[4] = {0.f, 0.f, 0.f, 0.f};
#pragma unroll 2
                for (int d8 = 0; d8 < 8; ++d8) { const u32x4 kv = *(const u32x4*)(krow + d8 * 8);
                    const float kf[8] = {bf_lo(kv.x), bf_hi(kv.x), bf_lo(kv.y), bf_hi(kv.y), bf_lo(kv.z), bf_hi(kv.z), bf_lo(kv.w), bf_hi(kv.w)};
#pragma unroll
                    for (int e = 0; e < 8; ++e) { const f32x4 qv = *(const LAS f32x4*)(qs + (d8 * 8 + e) * 4);
#pragma unroll
                        for (int r = 0; r < 4; ++r) acc[r] += qv[r] * kf[e]; } }
                const float dist = (float)(t - (16 * i + 31));
                if (i < nv) {
#pragma unroll
                    for (int r = 0; r < 4; ++r) { sv[r] = acc[r] - slope[r] * dist; mloc[r] = fmaxf(mloc[r], sv[r]); } }
            }
            *(LAS f32x4*)(pc + i * 4) = sv;
        }
        float ssum[4] = {0.f, 0.f, 0.f, 0.f};
#pragma unroll
        for (int r = 0; r < 4; ++r) mloc[r] = wave_max(mloc[r]);
        LDS_FENCE();
#pragma unroll 1
        for (int c = 0; c < 4; ++c) {
            const int i = 64 * c + lane; f32x4 sv = *(const LAS f32x4*)(pc + i * 4);
#pragma unroll
            for (int r = 0; r < 4; ++r) { sv[r] = (sv[r] > -1e29f) ? __expf(sv[r] - mloc[r]) : 0.f; ssum[r] += sv[r]; }
            *(LAS f32x4*)(pc + i * 4) = sv;
        }
#pragma unroll
        for (int r = 0; r < 4; ++r) { const float sm = wave_sum(ssum[r]); ssum[r] = (sm > 0.f) ? 1.f / sm : 0.f; }
        LDS_FENCE();
#pragma unroll 1
        for (int c = 0; c < 4; ++c) {
            const int i = 64 * c + lane; f32x4 sv = *(const LAS f32x4*)(pc + i * 4);
#pragma unroll
            for (int r = 0; r < 4; ++r) sv[r] *= ssum[r];
            *(LAS f32x4*)(pc + i * 4) = sv; ptot[i] = (sv[0] + sv[1]) + (sv[2] + sv[3]);
        }
        LDS_FENCE();
        const int j = lane, blk = t >> 6;
        const float imp = ptot[4 * j] + ptot[4 * j + 1] + ptot[4 * j + 2] + 0.5f * ptot[4 * j + 3] + (j > 0 ? 0.5f * ptot[4 * j - 1] : 0.f);
        const bool elig = j <= blk, forced = (j == 0) || (j == blk) || (j == blk - 1);
        const float val = elig ? imp + (forced ? 1e4f : 0.f) : -1e30f;
        int rank = 0;
#pragma unroll 8
        for (int k = 0; k < 64; ++k) { const float vk = __shfl(val, k); rank += (vk > val || (vk == val && k < j)) ? 1 : 0; }
        const unsigned long long selmask = __ballot(elig && rank < 16);
        float oc[4][2] = {{0.f, 0.f}, {0.f, 0.f}, {0.f, 0.f}, {0.f, 0.f}};
        for (int i = hf; i < nv; i += 2) {
            const unsigned vv = *(const unsigned*)(VC + ((size_t)(b * 256 + i) * 4 + g) * 64 + 2 * dp); const f32x4 pp = *(const LAS f32x4*)(pc + i * 4);
            const float lo = bf_lo(vv), hi = bf_hi(vv);
#pragma unroll
            for (int r = 0; r < 4; ++r) { oc[r][0] += pp[r] * lo; oc[r][1] += pp[r] * hi; }
        }
#pragma unroll
        for (int r = 0; r < 4; ++r) { oc[r][0] += __shfl_xor(oc[r][0], 32); oc[r][1] += __shfl_xor(oc[r][1], 32); }
        OnlineSt st;
#pragma unroll
        for (int r = 0; r < 4; ++r) { st.m[r] = -1e30f; st.l[r] = 0.f; st.o[r][0] = 0.f; st.o[r][1] = 0.f; }
        const bf16_t* ksb = KS + (size_t)b * SEQ * 256 + g * 64; const bf16_t* vsb = VS + (size_t)b * SEQ * 256 + g * 64;
        for (unsigned long long mm = selmask; mm; mm &= mm - 1) { const int jj = __builtin_ctzll(mm); nsa_attend_block(st, ksb, vsb, 64 * jj, t, slope, qs, pc, lane); }
        float os[4][2];
#pragma unroll
        for (int r = 0; r < 4; ++r) { const float il = 1.f / st.l[r]; os[r][0] = (st.o[r][0] + __shfl_xor(st.o[r][0], 32)) * il; os[r][1] = (st.o[r][1] + __shfl_xor(st.o[r][1], 32)) * il; }
#pragma unroll
        for (int r = 0; r < 4; ++r) { st.m[r] = -1e30f; st.l[r] = 0.f; st.o[r][0] = 0.f; st.o[r][1] = 0.f; }
        const bf16_t* kwb = KW + (size_t)b * SEQ * 256 + g * 64; const bf16_t* vwb = VW + (size_t)b * SEQ * 256 + g * 64;
        const int lo = (t - 511 > 0) ? t - 511 : 0;
        for (int p0 = lo; p0 <= t; p0 += 64) nsa_attend_block(st, kwb, vwb, p0, t, slope, qs, pc, lane);
        const float* gp = GATES + (size_t)row * 48 + g * 12;
#pragma unroll
        for (int r = 0; r < 4; ++r) {
            const float il = 1.f / st.l[r]; const float ow0 = (st.o[r][0] + __shfl_xor(st.o[r][0], 32)) * il, ow1 = (st.o[r][1] + __shfl_xor(st.o[r][1], 32)) * il;
            const float gc = gp[r * 3 + 0], gs = gp[r * 3 + 1], gwv = gp[r * 3 + 2];
            const float o0 = gc * oc[r][0] + gs * os[r][0] + gwv * ow0, o1 = gc * oc[r][1] + gs * os[r][1] + gwv * ow1;
            if (hf == 0) *(unsigned*)(AO + (size_t)row * 1024 + (g * 4 + r) * 64 + 2 * dp) = pk2(o0, o1);
        }
    }
}

__device__ __forceinline__ void phase_mla_attn_ref(const Params& p, LAS unsigned char* lds) {
    const int lane = threadIdx.x & 63, wave = threadIdx.x >> 6;
    const int gw = blockIdx.x * NWAVES + wave, NGW = gridDim.x * NWAVES;
    LAS float* qs = (LAS float*)(lds + wave * 1024);
    LAS float* ps = qs + 128;
    const bf16_t* QF = (const bf16_t*)(p.ws + S_QF); const bf16_t* KN = (const bf16_t*)(p.ws + S_KNOPE); const bf16_t* KR = (const bf16_t*)(p.ws + S_KROPE); const bf16_t* V = (const bf16_t*)(p.ws + S_V);
    const float* rc = (const float*)(p.ws + WS_ROPE_COS); const float* rs = (const float*)(p.ws + WS_ROPE_SIN);
    bf16_t* AO = (bf16_t*)(p.ws + S_AO2);
    const float scale = 0.10206207261596577f;
    const int hf = lane >> 5, dp = lane & 31;
    for (int item = gw; item < NTOK * 16; item += NGW) {
        const int h = item & 15, row = item >> 4, b = row >> 12, t = row & 4095;
        const bf16_t* qrow = QF + (size_t)row * 1536 + h * 96; const float rq = scale;
        LDS_FENCE();
        qs[lane] = bf2f(qrow[lane]) * rq;
        if (lane < 16) { const float x1 = bf2f(qrow[64 + lane]), x2 = bf2f(qrow[80 + lane]), c = rc[t * 16 + lane], s = rs[t * 16 + lane]; qs[64 + lane] = (x1 * c - x2 * s) * rq; qs[80 + lane] = (x2 * c + x1 * s) * rq; }
        LDS_FENCE();
        float m = -1e30f, l = 0.f, o0 = 0.f, o1 = 0.f;
        for (int p0 = 0; p0 <= t; p0 += 64) {
            const int pos = p0 + lane; const bool valid = pos <= t;
            const int posc = valid ? pos : t;
            const bf16_t* kn = KN + ((size_t)(b * SEQ + posc)) * 1024 + h * 64; const bf16_t* kr = KR + ((size_t)(b * SEQ + posc)) * 32;
            float acc = 0.f;
#pragma unroll 4
            for (int d8 = 0; d8 < 12; ++d8) { const u32x4 kv = (d8 < 8) ? *(const u32x4*)(kn + d8 * 8) : *(const u32x4*)(kr + (d8 - 8) * 8);
                const f32x4 q0 = *(const LAS f32x4*)(qs + d8 * 8), q1 = *(const LAS f32x4*)(qs + d8 * 8 + 4);
                acc += q0.x * bf_lo(kv.x) + q0.y * bf_hi(kv.x) + q0.z * bf_lo(kv.y) + q0.w * bf_hi(kv.y) + q1.x * bf_lo(kv.z) + q1.y * bf_hi(kv.z) + q1.z * bf_lo(kv.w) + q1.w * bf_hi(kv.w); }
            const float s = valid ? acc : -1e30f;
            const float mn = fmaxf(m, wave_max(s)), alpha = __expf(m - mn), e = valid ? __expf(s - mn) : 0.f;
            l = l * alpha + wave_sum(e); o0 *= alpha; o1 *= alpha; m = mn;
            LDS_FENCE();
            ps[lane] = e;
            LDS_FENCE();
            const int nk = (t - p0 + 1 < 64) ? t - p0 + 1 : 64;
            for (int kk = hf; kk < nk; kk += 2) { const unsigned vv = *(const unsigned*)(V + ((size_t)(b * SEQ + p0 + kk)) * 1024 + h * 64 + 2 * dp); const float pp = ps[kk]; o0 += pp * bf_lo(vv); o1 += pp * bf_hi(vv); }
        }
        const float il = 1.f / l; o0 = (o0 + __shfl_xor(o0, 32)) * il; o1 = (o1 + __shfl_xor(o1, 32)) * il;
        if (hf == 0) *(unsigned*)(AO + (size_t)row * 1024 + h * 64 + 2 * dp) = pk2(o0, o1);
    }
}

namespace att {
typedef float f32x16 __attribute__((ext_vector_type(16)));
typedef short s16x4 __attribute__((ext_vector_type(4)));
constexpr int KSTR64 = 144, KSTR96 = 208;
constexpr int KBUF = 64 * KSTR96, VBUF = 8192;
constexpr int OFF_K = 0, OFF_V = 2 * KBUF, OFF_IMPM = OFF_V + 2 * VBUF, OFF_IMPS = OFF_IMPM + 8 * 8 * 64 * 4, OFF_SELB = OFF_IMPS + 8 * 8 * 72 * 4, OFF_UNION = OFF_SELB + 8 * 8 * 8, OFF_FIN = OFF_UNION + 16, LDS_END = OFF_FIN + 8 * 32 * 64 * 4;
static_assert(LDS_END <= 147456, "attention LDS map");
constexpr float LOG2E = 1.4426950408889634f;
__device__ __forceinline__ int crow(int r, int hi) { return (r & 3) + 8 * (r >> 2) + 4 * hi; }
__device__ __forceinline__ float xhalf(float v) { return __shfl_xor(v, 32); }

struct TileRegs { u32x4 k0, k1, v; };
__device__ __forceinline__ const char* uni_ptr(const void* p) {
    const unsigned long long v = (unsigned long long)p; const unsigned lo = __builtin_amdgcn_readfirstlane((unsigned)v), hh = __builtin_amdgcn_readfirstlane((unsigned)(v >> 32));
    return (const char*)(((unsigned long long)hh << 32) | lo);
}
template <bool MLA>
__device__ __forceinline__ void tile_load(TileRegs& R, const bf16_t* Kg, const bf16_t* KRg, const bf16_t* Vg, unsigned koff, unsigned voff, unsigned roff, int tid) {
    R.k0 = *(const u32x4*)(uni_ptr(Kg) + koff);
    R.v = *(const u32x4*)(uni_ptr(Vg) + voff);
    if (MLA) { if (tid < 256) R.k1 = *(const u32x4*)(uni_ptr(KRg) + roff); }
}
template <bool MLA, int KSTR>
__device__ __forceinline__ void tile_store(const TileRegs& R, LAS unsigned char* Kb, LAS unsigned char* Vb, int tid) {
    const int key = tid >> 3, c = tid & 7;
    *(LAS u32x4*)(Kb + key * KSTR + c * 16) = R.k0;
    if (MLA) { if (tid < 256) *(LAS u32x4*)(Kb + (tid >> 2) * KSTR + 128 + (tid & 3) * 16) = R.k1; }
    *(LAS u32x4*)(Vb + (c >> 2) * 4096 + key * 64 + (c & 3) * 16) = R.v;
}
template <int NKS, int KSTR>
__device__ __forceinline__ void qk(f32x16& p0, f32x16& p1, const LAS unsigned char* Kb, const bf16x8 (&qf)[NKS], int lane) {
    const LAS unsigned char* kp = Kb + (lane & 31) * KSTR + (lane >> 5) * 16;
#pragma unroll
    for (int r = 0; r < 16; ++r) { p0[r] = 0.f; p1[r] = 0.f; }
#pragma unroll
    for (int ks = 0; ks < NKS; ++ks) {
        const bf16x8 a0 = *(const LAS bf16x8*)(kp + ks * 32), a1 = *(const LAS bf16x8*)(kp + 32 * KSTR + ks * 32);
        p0 = __builtin_amdgcn_mfma_f32_32x32x16_bf16(a0, qf[ks], p0, 0, 0, 0);
        p1 = __builtin_amdgcn_mfma_f32_32x32x16_bf16(a1, qf[ks], p1, 0, 0, 0);
    }
}
__device__ __forceinline__ s16x4 vtr(const LAS unsigned char* p) { return __builtin_bit_cast(s16x4, __builtin_amdgcn_ds_read_tr16_b64_v4i16((LAS s16x4*)p)); }
__device__ __forceinline__ void pv(f32x16& o0, f32x16& o1, const f32x16& p0, const f32x16& p1, const LAS unsigned char* Vb, int lane) {
    const int hi = lane >> 5;
    const LAS unsigned char* vp = Vb + ((lane >> 4) & 1) * 32 + (lane & 3) * 8 + (4 * hi + ((lane & 15) >> 2)) * 64;
#pragma unroll
    for (int S = 0; S < 4; ++S) {
        u32x4 pw;
#pragma unroll
        for (int jj = 0; jj < 4; ++jj) { const int r = 8 * (S & 1) + 2 * jj; pw[jj] = (S < 2) ? pk2(p0[r], p0[r + 1]) : pk2(p1[r], p1[r + 1]); }
        const bf16x8 pf = __builtin_bit_cast(bf16x8, pw);
#pragma unroll
        for (int dh = 0; dh < 2; ++dh) {
            const s16x4 lo = vtr(vp + dh * 4096 + S * 1024), hh = vtr(vp + dh * 4096 + S * 1024 + 512);
            const bf16x8 vf = (bf16x8){lo[0], lo[1], lo[2], lo[3], hh[0], hh[1], hh[2], hh[3]};
            if (dh == 0) o0 = __builtin_amdgcn_mfma_f32_32x32x16_bf16(vf, pf, o0, 0, 0, 0); else o1 = __builtin_amdgcn_mfma_f32_32x32x16_bf16(vf, pf, o1, 0, 0, 0);
        }
    }
}
template <int PS, bool ALIBI, bool CAUS, bool WLOW, bool ROWEN>
__device__ __forceinline__ void transform(f32x16& p0, f32x16& p1, float c1, float c2, float tbf, bool en) {
#pragma unroll
    for (int r = 0; r < 16; ++r) {
        const float k0 = (float)(PS * ((r & 3) + 8 * (r >> 2))), k1 = (float)(PS * (32 + (r & 3) + 8 * (r >> 2)));
        const float d0 = tbf - k0, d1 = tbf - k1;
        float s0 = p0[r] * c1, s1 = p1[r] * c1;
        if (ALIBI) { s0 -= c2 * d0; s1 -= c2 * d1; }
        bool v0 = true, v1 = true;
        if (CAUS) { v0 = v0 && (d0 >= 0.f); v1 = v1 && (d1 >= 0.f); }
        if (WLOW) { v0 = v0 && (d0 < 512.f); v1 = v1 && (d1 < 512.f); }
        if (ROWEN) { v0 = v0 && en; v1 = v1 && en; }
        p0[r] = v0 ? s0 : -1e30f; p1[r] = v1 ? s1 : -1e30f;
    }
}
__device__ __forceinline__ float tile_max(const f32x16& p0, const f32x16& p1) {
    float a = fmaxf(p0[0], p1[0]);
#pragma unroll
    for (int r = 1; r < 16; ++r) a = fmaxf(a, fmaxf(p0[r], p1[r]));
    return fmaxf(a, xhalf(a));
}
__device__ __forceinline__ void softmax_pv(f32x16& p0, f32x16& p1, float& m, float& l, f32x16& o0, f32x16& o1, const LAS unsigned char* Vb, int lane) {
    const float mn = fmaxf(m, tile_max(p0, p1));
    if (__any(mn > m)) { const float alpha = __builtin_amdgcn_exp2f(m - mn); l *= alpha; o0 *= alpha; o1 *= alpha; m = mn; }
    const float mu = fmaxf(m, -1e20f);
    float s = 0.f;
#pragma unroll
    for (int r = 0; r < 16; ++r) { p0[r] = __builtin_amdgcn_exp2f(p0[r] - mu); p1[r] = __builtin_amdgcn_exp2f(p1[r] - mu); s += p0[r] + p1[r]; }
    l += s;
    pv(o0, o1, p0, p1, Vb, lane);
}
template <bool FIRST> __device__ __forceinline__ void fold(LAS float* fb, const f32x16& o0, const f32x16& o1, float sc, int lane) {
#pragma unroll
    for (int r = 0; r < 16; ++r) { const float a = o0[r] * sc, b = o1[r] * sc; if (FIRST) { fb[r * 64 + lane] = a; fb[(16 + r) * 64 + lane] = b; } else { fb[r * 64 + lane] += a; fb[(16 + r) * 64 + lane] += b; } }
}
__device__ __forceinline__ void store_o(bf16_t* dst  , const f32x16& f0, const f32x16& f1, int hi) {
#pragma unroll
    for (int dh = 0; dh < 2; ++dh)
#pragma unroll
        for (int a = 0; a < 4; ++a) { const f32x16& f = dh ? f1 : f0; u32x2 w; w.x = pk2(f[4 * a], f[4 * a + 1]); w.y = pk2(f[4 * a + 2], f[4 * a + 3]); *(u32x2*)(dst + 32 * dh + 8 * a + 4 * hi) = w; }
}
}

__device__ __forceinline__ void phase_nsa_attn(const Params& p, LAS unsigned char* lds) {
    using namespace att;
    const int tid0 = threadIdx.x, wave = __builtin_amdgcn_readfirstlane(tid0 >> 6);
    const bf16_t* Q = (const bf16_t*)(p.ws + S_Q); const bf16_t* KV6 = (const bf16_t*)(p.ws + S_KV6);
    const bf16_t* KS = KV6 + (size_t)2 * NTOK * 256; const bf16_t* VS = KV6 + (size_t)3 * NTOK * 256; const bf16_t* KW = KV6 + (size_t)4 * NTOK * 256; const bf16_t* VW = KV6 + (size_t)5 * NTOK * 256;
    const bf16_t* KC = (const bf16_t*)(p.ws + S_KCMP); const bf16_t* VC = (const bf16_t*)(p.ws + S_VCMP);
    const float* GATES = (const float*)(p.ws + S_GATES); bf16_t* AO = (bf16_t*)(p.ws + S_AO);
    LAS unsigned char* Kb0 = lds + OFF_K; LAS unsigned char* Vb0 = lds + OFF_V;
    LAS float* impM = (LAS float*)(lds + OFF_IMPM) + wave * 512; LAS float* impS = (LAS float*)(lds + OFF_IMPS) + wave * 576;
    LAS unsigned char* selb = lds + OFF_SELB + wave * 64; LAS unsigned long long* uni = (LAS unsigned long long*)(lds + OFF_UNION);
    const float c1 = 0.125f * LOG2E;
    const int vcu = blockIdx.x;
#pragma unroll 1
    for (int ui = 0; ui < 8; ++ui) {
        int tid = tid0; asm volatile("" : "+v"(tid));
        const int lane = tid & 63, q = lane & 31, hi = lane >> 5, tl = q & 7, rh = q >> 3;
        const unsigned koff = (unsigned)((tid >> 3) * 256 + (tid & 7) * 8) * 2u;
        const int pair = vcu >> 3, kk = vcu & 7, b = pair >> 2, g = pair & 3;
        const int tile = (ui >> 1) * 16 + ((ui & 1) ? 15 - kk : kk);
        const int q0 = tile * 64, t = q0 + 8 * wave + tl, head = 4 * g + rh;
        const size_t row = (size_t)b * SEQ + t;
        const float c2 = exp2f(-0.5f * (float)(head + 1)) * LOG2E;
        bf16x8 qf[4];
#pragma unroll
        for (int ks = 0; ks < 4; ++ks) qf[ks] = *(const bf16x8*)(Q + row * 1024 + head * 64 + ks * 16 + hi * 8);
        const float gc = GATES[row * 48 + head * 3 + 0], gs = GATES[row * 48 + head * 3 + 1], gwd = GATES[row * 48 + head * 3 + 2];
        LAS float* fb = (LAS float*)(lds + OFF_FIN) + wave * 2048;
        TileRegs R;
        for (int i = lane; i < 512; i += 64) impM[i] = 0.f;
        for (int i = lane; i < 576; i += 64) impS[i] = 0.f;
        if (tid0 == 0) *uni = 0ull;
        const int nc = (4 * tile + 3 < 255) ? 4 * tile + 3 : 255, ntc = (nc + 63) >> 6;
        const bf16_t* kcb = KC + ((size_t)b * 256 * 4 + g) * 64; const bf16_t* vcb = VC + ((size_t)b * 256 * 4 + g) * 64;
        float m = -1e30f, l = 0.f;
#pragma unroll 1
        for (int pass = 0; pass < 2; ++pass) {
            f32x16 o0, o1;
#pragma unroll
            for (int r = 0; r < 16; ++r) { o0[r] = 0.f; o1[r] = 0.f; }
            const float ltc = l + xhalf(l); const float invl = (ltc > 0.f) ? 1.f / ltc : 0.f;
            tile_load<false>(R, kcb, nullptr, vcb, koff, koff, 0u, tid);
#pragma unroll 1
            for (int T = 0; T < ntc; ++T) {
                LAS unsigned char* Kb = Kb0 + (T & 1) * KBUF; LAS unsigned char* Vb = Vb0 + (T & 1) * VBUF;
                tile_store<false, KSTR64>(R, Kb, Vb, tid);
                __syncthreads();
                if (T + 1 < ntc) tile_load<false>(R, kcb + (size_t)(T + 1) * 64 * 256, nullptr, vcb + (size_t)(T + 1) * 64 * 256, koff, koff, 0u, tid);
                f32x16 p0, p1;
                qk<4, KSTR64>(p0, p1, Kb, qf, lane);
                const float tbf = (float)(t - (16 * 64 * T + 31) - 64 * hi);
                transform<16, true, true, false, false>(p0, p1, c1, c2, tbf, true);
                if (pass == 0) {
                    const float mn = fmaxf(m, tile_max(p0, p1)); const float alpha = __builtin_amdgcn_exp2f(m - mn); const float mu = fmaxf(mn, -1e20f);
                    float s = 0.f;
#pragma unroll
                    for (int r = 0; r < 16; ++r) s += __builtin_amdgcn_exp2f(p0[r] - mu) + __builtin_amdgcn_exp2f(p1[r] - mu);
                    l = l * alpha + s; m = mn;
                } else {
                    const float mu = fmaxf(m, -1e20f);
#pragma unroll
                    for (int r = 0; r < 16; ++r) { p0[r] = __builtin_amdgcn_exp2f(p0[r] - mu); p1[r] = __builtin_amdgcn_exp2f(p1[r] - mu); }
#pragma unroll
                    for (int kbk = 0; kbk < 2; ++kbk)
#pragma unroll
                        for (int a = 0; a < 4; ++a) {
                            const f32x16& pp = kbk ? p1 : p0;
                            float mainv = (pp[4 * a] + pp[4 * a + 1] + pp[4 * a + 2] + 0.5f * pp[4 * a + 3]) * invl, spill = 0.5f * pp[4 * a + 3] * invl;
                            mainv += __shfl_xor(mainv, 8); mainv += __shfl_xor(mainv, 16); spill += __shfl_xor(spill, 8); spill += __shfl_xor(spill, 16);
                            const int jb = 16 * T + 8 * kbk + 2 * a + hi;
                            if (rh == 0) { impM[tl * 64 + jb] = mainv; impS[tl * 72 + jb + 1] = spill; }
                            __builtin_amdgcn_sched_barrier(0);
                        }
                    pv(o0, o1, p0, p1, Vb, lane);
                }
            }
            if (pass == 1) fold<true>(fb, o0, o1, gc * invl, lane);
            __syncthreads();
        }
        const int blk = tile;
        unsigned long long mymask;
        if (blk < 16) { mymask = (2ull << blk) - 1ull; }
        else {
            LDS_FENCE();
            const int stl = lane >> 3, sub = lane & 7;
            float mv[8]; int rk[8];
#pragma unroll
            for (int i = 0; i < 8; ++i) { const int j = sub * 8 + i; mv[i] = impM[stl * 64 + j] + impS[stl * 72 + j]; rk[i] = 0; }
#pragma unroll 1
            for (int j2 = 1; j2 < blk - 1; ++j2) {
                const float v2 = impM[stl * 64 + j2] + impS[stl * 72 + j2];
#pragma unroll
                for (int i = 0; i < 8; ++i) { const int j = sub * 8 + i; rk[i] += (v2 > mv[i] || (v2 == mv[i] && j2 < j)) ? 1 : 0; }
            }
            unsigned bits = 0;
#pragma unroll
            for (int i = 0; i < 8; ++i) { const int j = sub * 8 + i; const bool forced = (j == 0) || (j == blk) || (j == blk - 1); const bool sel = (j <= blk) && (forced || rk[i] < 13); bits |= sel ? (1u << i) : 0u; }
            selb[stl * 8 + sub] = (unsigned char)bits;
            LDS_FENCE();
            mymask = *(const LAS unsigned long long*)(selb + tl * 8);
        }
        { unsigned long long um = mymask;
#pragma unroll
          for (int o = 1; o < 8; o <<= 1) { const unsigned lo = __shfl_xor((unsigned)um, o), hh = __shfl_xor((unsigned)(um >> 32), o); um |= ((unsigned long long)hh << 32) | lo; }
          if (lane == 0) atomicOr((unsigned long long*)uni, um); }
        __syncthreads();
        const unsigned long long umask = *uni;
        {
            f32x16 o0, o1;
#pragma unroll
            for (int r = 0; r < 16; ++r) { o0[r] = 0.f; o1[r] = 0.f; }
            m = -1e30f; l = 0.f;
            const bf16_t* kb_ = KS + ((size_t)b * SEQ) * 256 + g * 64; const bf16_t* vb_ = VS + ((size_t)b * SEQ) * 256 + g * 64;
            unsigned long long rem = umask; int it = 0;
            int j = 63 - __builtin_clzll(rem); rem &= ~(1ull << j);
            tile_load<false>(R, kb_ + (size_t)j * 64 * 256, nullptr, vb_ + (size_t)j * 64 * 256, koff, koff, 0u, tid);
#pragma unroll 1
            for (;;) {
                LAS unsigned char* Kb = Kb0 + (it & 1) * KBUF; LAS unsigned char* Vb = Vb0 + (it & 1) * VBUF;
                tile_store<false, KSTR64>(R, Kb, Vb, tid);
                __syncthreads();
                const int jn = rem ? 63 - __builtin_clzll(rem) : -1;
                if (jn >= 0) { rem &= ~(1ull << jn); tile_load<false>(R, kb_ + (size_t)jn * 64 * 256, nullptr, vb_ + (size_t)jn * 64 * 256, koff, koff, 0u, tid); }
                const bool en = (mymask >> j) & 1ull;
                if (__any(en)) {
                    f32x16 p0, p1;
                    qk<4, KSTR64>(p0, p1, Kb, qf, lane);
                    const float tbf = (float)(t - 64 * j - 4 * hi);
                    if (j == blk) transform<1, true, true, false, true>(p0, p1, c1, c2, tbf, en); else transform<1, true, false, false, true>(p0, p1, c1, c2, tbf, en);
                    softmax_pv(p0, p1, m, l, o0, o1, Vb, lane);
                }
                if (jn < 0) break;
                j = jn; ++it;
            }
            const float lt = l + xhalf(l);
            fold<false>(fb, o0, o1, (lt > 0.f) ? gs / lt : 0.f, lane);
            __syncthreads();
        }
        {
            f32x16 o0, o1;
#pragma unroll
            for (int r = 0; r < 16; ++r) { o0[r] = 0.f; o1[r] = 0.f; }
            m = -1e30f; l = 0.f;
            const bf16_t* kb_ = KW + ((size_t)b * SEQ) * 256 + g * 64; const bf16_t* vb_ = VW + ((size_t)b * SEQ) * 256 + g * 64;
            const int jlo = (blk - 8 > 0) ? blk - 8 : 0;
            tile_load<false>(R, kb_ + (size_t)blk * 64 * 256, nullptr, vb_ + (size_t)blk * 64 * 256, koff, koff, 0u, tid);
#pragma unroll 1
            for (int j = blk, it = 0; j >= jlo; --j, ++it) {
                LAS unsigned char* Kb = Kb0 + (it & 1) * KBUF; LAS unsigned char* Vb = Vb0 + (it & 1) * VBUF;
                tile_store<false, KSTR64>(R, Kb, Vb, tid);
                __syncthreads();
                if (j > jlo) tile_load<false>(R, kb_ + (size_t)(j - 1) * 64 * 256, nullptr, vb_ + (size_t)(j - 1) * 64 * 256, koff, koff, 0u, tid);
                f32x16 p0, p1;
                qk<4, KSTR64>(p0, p1, Kb, qf, lane);
                const float tbf = (float)(t - 64 * j - 4 * hi);
                if (j == blk) transform<1, true, true, false, false>(p0, p1, c1, c2, tbf, true);
                else if (j == blk - 8) transform<1, true, false, true, false>(p0, p1, c1, c2, tbf, true);
                else transform<1, true, false, false, false>(p0, p1, c1, c2, tbf, true);
                softmax_pv(p0, p1, m, l, o0, o1, Vb, lane);
            }
            const float lt = l + xhalf(l);
            const float scw = (lt > 0.f) ? gwd / lt : 0.f;
#pragma unroll
            for (int r = 0; r < 16; ++r) { o0[r] = o0[r] * scw + fb[r * 64 + lane]; o1[r] = o1[r] * scw + fb[(16 + r) * 64 + lane]; }
            store_o(AO + row * 1024 + head * 64, o0, o1, hi);
            __syncthreads();
        }
    }
}

__device__ __forceinline__ void phase_mla_attn(const Params& p, LAS unsigned char* lds) {
    using namespace att;
    const int tid0 = threadIdx.x, wave = __builtin_amdgcn_readfirstlane(tid0 >> 6);
    const bf16_t* QF = (const bf16_t*)(p.ws + S_QF); const bf16_t* KN = (const bf16_t*)(p.ws + S_KNOPE); const bf16_t* KR = (const bf16_t*)(p.ws + S_KROPE); const bf16_t* V = (const bf16_t*)(p.ws + S_V);
    const float* rc = (const float*)(p.ws + WS_ROPE_COS); const float* rs = (const float*)(p.ws + WS_ROPE_SIN);
    bf16_t* AO = (bf16_t*)(p.ws + S_AO2);
    LAS unsigned char* Kb0 = lds + OFF_K; LAS unsigned char* Vb0 = lds + OFF_V;
    const float c1 = 0.10206207261596577f * LOG2E;
    const int vcu = blockIdx.x;
#pragma unroll 1
    for (int ui = 0; ui < 8; ++ui) {
        int tid = tid0; asm volatile("" : "+v"(tid));
        const int lane = tid & 63, q = lane & 31, hi = lane >> 5;
        const unsigned koff = (unsigned)((tid >> 3) * 1024 + (tid & 7) * 8) * 2u, roff = (unsigned)((tid >> 2) * 32 + (tid & 3) * 8) * 2u;
        const int bh = vcu >> 1, b = bh >> 4, h = bh & 15, par = vcu & 1;
        const int qb = (ui & 1) ? 15 - (ui - 1) - par : ui + par;
        const int t = 256 * qb + 32 * wave + q; const size_t row = (size_t)b * SEQ + t;
        bf16x8 qf[6];
        { const bf16_t* qrow = QF + row * 1536 + h * 96;
#pragma unroll
          for (int ks = 0; ks < 4; ++ks) qf[ks] = *(const bf16x8*)(qrow + ks * 16 + hi * 8);
          const u32x4 x1 = *(const u32x4*)(qrow + 64 + hi * 8), x2 = *(const u32x4*)(qrow + 80 + hi * 8);
          const f32x4 ca = *(const f32x4*)(rc + t * 16 + hi * 8), cb = *(const f32x4*)(rc + t * 16 + hi * 8 + 4), sa = *(const f32x4*)(rs + t * 16 + hi * 8), sb = *(const f32x4*)(rs + t * 16 + hi * 8 + 4);
          const float a1[8] = {bf_lo(x1.x), bf_hi(x1.x), bf_lo(x1.y), bf_hi(x1.y), bf_lo(x1.z), bf_hi(x1.z), bf_lo(x1.w), bf_hi(x1.w)};
          const float a2[8] = {bf_lo(x2.x), bf_hi(x2.x), bf_lo(x2.y), bf_hi(x2.y), bf_lo(x2.z), bf_hi(x2.z), bf_lo(x2.w), bf_hi(x2.w)};
          const float cc[8] = {ca.x, ca.y, ca.z, ca.w, cb.x, cb.y, cb.z, cb.w}, ss[8] = {sa.x, sa.y, sa.z, sa.w, sb.x, sb.y, sb.z, sb.w};
          u32x4 w1, w2;
#pragma unroll
          for (int jj = 0; jj < 4; ++jj) { const int e = 2 * jj;
              w1[jj] = pk2(a1[e] * cc[e] - a2[e] * ss[e], a1[e + 1] * cc[e + 1] - a2[e + 1] * ss[e + 1]);
              w2[jj] = pk2(a2[e] * cc[e] + a1[e] * ss[e], a2[e + 1] * cc[e + 1] + a1[e + 1] * ss[e + 1]); }
          qf[4] = __builtin_bit_cast(bf16x8, w1); qf[5] = __builtin_bit_cast(bf16x8, w2); }
        f32x16 o0, o1;
#pragma unroll
        for (int r = 0; r < 16; ++r) { o0[r] = 0.f; o1[r] = 0.f; }
        float m = -1e30f, l = 0.f;
        const bf16_t* knb = KN + ((size_t)b * SEQ) * 1024 + h * 64; const bf16_t* krb = KR + ((size_t)b * SEQ) * 32; const bf16_t* vb_ = V + ((size_t)b * SEQ) * 1024 + h * 64;
        const int nt = 4 * qb + 4; const int tmin = 256 * qb + 32 * wave;
        TileRegs R;
        tile_load<true>(R, knb, krb, vb_, koff, koff, roff, tid);
#pragma unroll 1
        for (int j = 0; j < nt; ++j) {
            LAS unsigned char* Kb = Kb0 + (j & 1) * KBUF; LAS unsigned char* Vb = Vb0 + (j & 1) * VBUF;
            tile_store<true, KSTR96>(R, Kb, Vb, tid);
            __syncthreads();
            if (j + 1 < nt) tile_load<true>(R, knb + (size_t)(j + 1) * 64 * 1024, krb + (size_t)(j + 1) * 64 * 32, vb_ + (size_t)(j + 1) * 64 * 1024, koff, koff, roff, tid);
            if (64 * j <= tmin + 31) {
                f32x16 p0, p1;
                qk<6, KSTR96>(p0, p1, Kb, qf, lane);
                const float tbf = (float)(t - 64 * j - 4 * hi);
                if (64 * j + 63 > tmin) transform<1, false, true, false, false>(p0, p1, c1, 0.f, tbf, true); else transform<1, false, false, false, false>(p0, p1, c1, 0.f, tbf, true);
                softmax_pv(p0, p1, m, l, o0, o1, Vb, lane);
            }
        }
        const float lt = l + xhalf(l); const float il = 1.f / lt;
        o0 *= il; o1 *= il;
        store_o(AO + row * 1024 + h * 64, o0, o1, hi);
        __syncthreads();
    }
}

__device__ __forceinline__ float pack_idx(float v, unsigned bits, unsigned mask) { return __uint_as_float((__float_as_uint(v) & ~mask) | bits); }
__device__ __forceinline__ void phase_peer_route_ref(const Params& p, LAS unsigned char* lds, int layer, const bf16_t* QP, int* EIDX, float* GW) {
    const int lane = threadIdx.x & 63, wave = threadIdx.x >> 6;
    const int gw = blockIdx.x * NWAVES + wave, NGW = gridDim.x * NWAVES;
    LAS float* qs = (LAS float*)(lds + wave * 1024);
    const bf16_t* SK = (const bf16_t*)(p.ws + WS_SUBK) + (size_t)layer * 8 * 2 * 128 * 128;
    for (int item = gw; item < NTOK * 8; item += NGW) {
        const int h = item & 7, t = item >> 3;
        LDS_FENCE();
        { const u32x2 qv = *(const u32x2*)(QP + (size_t)t * 2048 + h * 256 + lane * 4); *(LAS f32x4*)(qs + lane * 4) = (f32x4){bf_lo(qv.x), bf_hi(qv.x), bf_lo(qv.y), bf_hi(qv.y)}; }
        LDS_FENCE();
        float sv[2];
#pragma unroll
        for (int c = 0; c < 2; ++c) {
            float v[2];
#pragma unroll
            for (int kk = 0; kk < 2; ++kk) {
                const int key = lane + 64 * kk; const bf16_t* krow = SK + ((size_t)(h * 2 + c) * 128 + key) * 128;
                float acc = 0.f;
#pragma unroll 4
                for (int d8 = 0; d8 < 16; ++d8) { const u32x4 kv = *(const u32x4*)(krow + d8 * 8); const f32x4 q0 = *(const LAS f32x4*)(qs + c * 128 + d8 * 8), q1 = *(const LAS f32x4*)(qs + c * 128 + d8 * 8 + 4);
                    acc += q0.x * bf_lo(kv.x) + q0.y * bf_hi(kv.x) + q0.z * bf_lo(kv.y) + q0.w * bf_hi(kv.y) + q1.x * bf_lo(kv.z) + q1.y * bf_hi(kv.z) + q1.z * bf_lo(kv.w) + q1.w * bf_hi(kv.w); }
                v[kk] = pack_idx(acc, 127u - (unsigned)key, 127u);
            }
            float mine = 0.f;
#pragma unroll 1
            for (int n = 0; n < 16; ++n) { const float w = wave_max(fmaxf(v[0], v[1])); if (v[0] == w) v[0] = -INFINITY; if (v[1] == w) v[1] = -INFINITY; if (lane == n) mine = w; }
            sv[c] = mine;
        }
        const int a = lane & 15, bq = lane >> 4;
        const float s0 = __shfl(sv[0], a);
        float cv[4];
#pragma unroll
        for (int i = 0; i < 4; ++i) { const float s1 = __shfl(sv[1], 4 * bq + i); cv[i] = pack_idx(s0 + s1, 255u - (unsigned)(a * 16 + 4 * bq + i), 255u); }
        float cs = 0.f;
#pragma unroll 1
        for (int n = 0; n < 16; ++n) { const float w = wave_max(fmaxf(fmaxf(cv[0], cv[1]), fmaxf(cv[2], cv[3])));
#pragma unroll
            for (int i = 0; i < 4; ++i) if (cv[i] == w) cv[i] = -INFINITY;
            if (lane == n) cs = w; }
        const unsigned flat = 255u - (__float_as_uint(cs) & 255u);
        const int wa = (int)(flat >> 4) & 15, wb = (int)flat & 15;
        const unsigned i0 = 127u - (__float_as_uint(__shfl(sv[0], wa)) & 127u), i1 = 127u - (__float_as_uint(__shfl(sv[1], wb)) & 127u);
        const float mx = __shfl(cs, 0);
        const float ex = (lane < 16) ? __expf(cs - mx) : 0.f;
        const float sum = wave_sum(ex);
        if (lane < 16) { EIDX[(size_t)t * 128 + h * 16 + lane] = (int)(i0 * 128u + i1); GW[(size_t)t * 128 + h * 16 + lane] = ex / sum; }
    }
}

namespace rt {
typedef float f32x16 __attribute__((ext_vector_type(16)));
constexpr int SKSTR = 272;
constexpr int OFF_SK = 0, OFF_IDX = 2 * 128 * SKSTR, LDS_END = OFF_IDX + 8 * 64 * 32;
__device__ __forceinline__ void ce_desc(float& a, float& b) { const float hi = fmaxf(a, b), lo = fminf(a, b); a = hi; b = lo; }
__device__ __forceinline__ void sort16_desc(float (&v)[16]) {
#pragma unroll
    for (int k = 2; k <= 16; k <<= 1)
#pragma unroll
        for (int j = k >> 1; j > 0; j >>= 1)
#pragma unroll
            for (int i = 0; i < 16; ++i) { const int l = i ^ j; if (l > i) { if ((i & k) == 0) ce_desc(v[i], v[l]); else ce_desc(v[l], v[i]); } }
}
__device__ __forceinline__ void merge16_desc(float (&v)[16]) {
#pragma unroll
    for (int j = 8; j > 0; j >>= 1)
#pragma unroll
        for (int i = 0; i < 16; ++i) { const int l = i ^ j; if (l > i) ce_desc(v[i], v[l]); }
}
__device__ __forceinline__ void top16_merge(float (&a)[16], const float (&b)[16]) {
#pragma unroll
    for (int i = 0; i < 16; ++i) a[i] = fmaxf(a[i], b[15 - i]);
    merge16_desc(a);
}
}
__device__ __forceinline__ void phase_peer_route(const Params& p, LAS unsigned char* lds, int layer, const bf16_t* QP, int* EIDX, float* GW) {
    using namespace rt;
    const int tid = threadIdx.x, lane = tid & 63, wave = __builtin_amdgcn_readfirstlane(tid >> 6), tok = lane & 31, hi = lane >> 5;
    const bf16_t* SK = (const bf16_t*)(p.ws + WS_SUBK) + (size_t)layer * 8 * 2 * 128 * 128;
    LAS unsigned char* idxs = lds + OFF_IDX + wave * 2048 + lane * 32;
    const int nbpi = NTOK / 1024;
    for (int bi = blockIdx.x; bi < 8 * nbpi; bi += gridDim.x) {
        const int h = bi & 7, tb = bi >> 3;
        __syncthreads();
        for (int i = tid; i < 256 * 16; i += NTHREADS) { const int r = i >> 4, c = i & 15; *(LAS u32x4*)(lds + OFF_SK + r * SKSTR + c * 16) = *(const u32x4*)(SK + ((size_t)h * 256 + r) * 128 + c * 8); }
        __syncthreads();
#pragma unroll 1
        for (int gi = 0; gi < 4; ++gi) {
            const int t = tb * 1024 + wave * 128 + gi * 32 + tok;
            float top[2][16];
#pragma unroll
            for (int c = 0; c < 2; ++c) {
                bf16x8 qf[8];
#pragma unroll
                for (int ks = 0; ks < 8; ++ks) qf[ks] = *(const bf16x8*)(QP + (size_t)t * 2048 + h * 256 + c * 128 + ks * 16 + hi * 8);
                float cur[16];
#pragma unroll
                for (int kb = 0; kb < 4; ++kb) {
                    f32x16 acc;
#pragma unroll
                    for (int r = 0; r < 16; ++r) acc[r] = 0.f;
                    const LAS unsigned char* kp = lds + OFF_SK + (c * 128 + kb * 32 + tok) * SKSTR + hi * 16;
#pragma unroll
                    for (int ks = 0; ks < 8; ++ks) acc = __builtin_amdgcn_mfma_f32_32x32x16_bf16(*(const LAS bf16x8*)(kp + ks * 32), qf[ks], acc, 0, 0, 0);
                    float v[16];
#pragma unroll
                    for (int r = 0; r < 16; ++r) { const unsigned key = (unsigned)(32 * kb + (r & 3) + 8 * (r >> 2)) + 4u * (unsigned)hi; v[r] = __uint_as_float((__float_as_uint(acc[r]) & ~127u) | (127u - key)); }
                    sort16_desc(v);
                    if (kb == 0) {
#pragma unroll
                        for (int r = 0; r < 16; ++r) cur[r] = v[r];
                    } else top16_merge(cur, v);
                }
                float oth[16];
#pragma unroll
                for (int r = 0; r < 16; ++r) oth[r] = __shfl_xor(cur[r], 32);
                top16_merge(cur, oth);
#pragma unroll
                for (int r = 0; r < 16; ++r) top[c][r] = cur[r];
            }
            { u32x4 w0, w1;
#pragma unroll
              for (int c = 0; c < 2; ++c) {
                  u32x4 w;
#pragma unroll
                  for (int jj = 0; jj < 4; ++jj) { unsigned x = 0;
#pragma unroll
                      for (int e = 0; e < 4; ++e) x |= (127u - (__float_as_uint(top[c][4 * jj + e]) & 127u)) << (8 * e);
                      w[jj] = x; }
                  if (c == 0) w0 = w; else w1 = w; }
              *(LAS u32x4*)idxs = w0; *(LAS u32x4*)(idxs + 16) = w1; }
#define CAND(a, b) __uint_as_float((__float_as_uint(top[0][a] + top[1][b]) & ~255u) | (255u - (unsigned)(16 * (a) + (b))))
            float A[16], B[16], X[16], Y[16];
#pragma unroll
            for (int b = 0; b < 16; ++b) A[b] = CAND(0, b);
#pragma unroll
            for (int b = 0; b < 8; ++b) B[b] = CAND(1, b);
#pragma unroll
            for (int b = 8; b < 16; ++b) B[b] = -INFINITY;
            top16_merge(A, B);
            X[0] = CAND(2, 0); X[1] = CAND(2, 1); X[2] = CAND(2, 2); X[3] = CAND(2, 3); X[4] = CAND(2, 4); X[5] = CAND(3, 0); X[6] = CAND(3, 1); X[7] = CAND(3, 2); X[8] = CAND(3, 3);
            X[9] = CAND(4, 0); X[10] = CAND(4, 1); X[11] = CAND(4, 2); X[12] = CAND(5, 0); X[13] = CAND(5, 1); X[14] = CAND(6, 0); X[15] = CAND(6, 1);
            Y[0] = CAND(7, 0); Y[1] = CAND(7, 1); Y[2] = CAND(8, 0); Y[3] = CAND(9, 0); Y[4] = CAND(10, 0); Y[5] = CAND(11, 0); Y[6] = CAND(12, 0); Y[7] = CAND(13, 0); Y[8] = CAND(14, 0); Y[9] = CAND(15, 0);
#pragma unroll
            for (int i = 10; i < 16; ++i) Y[i] = -INFINITY;
#undef CAND
            sort16_desc(X); sort16_desc(Y);
            top16_merge(A, X); top16_merge(A, Y);
            float ex[16], sum = 0.f;
#pragma unroll
            for (int n = 0; n < 16; ++n) { ex[n] = __expf(A[n] - A[0]); sum += ex[n]; }
            const float inv = 1.f / sum;
            LDS_FENCE();
            if (hi == 0) {
                int* ep = EIDX + (size_t)t * 128 + h * 16;
#pragma unroll
                for (int jj = 0; jj < 4; ++jj) { u32x4 w;
#pragma unroll
                    for (int e = 0; e < 4; ++e) { const unsigned flat = 255u - (__float_as_uint(A[4 * jj + e]) & 255u); const unsigned i0 = idxs[flat >> 4], i1 = idxs[16 + (flat & 15u)]; w[e] = i0 * 128u + i1; }
                    *(u32x4*)(ep + 4 * jj) = w; }
            } else {
                float* gp = GW + (size_t)t * 128 + h * 16;
#pragma unroll
                for (int jj = 0; jj < 4; ++jj) *(f32x4*)(gp + 4 * jj) = (f32x4){ex[4 * jj] * inv, ex[4 * jj + 1] * inv, ex[4 * jj + 2] * inv, ex[4 * jj + 3] * inv};
            }
            LDS_FENCE();
        }
    }
}

__device__ __forceinline__ float dot2bf(unsigned a, unsigned b, float acc) {
    float r; asm("v_dot2c_f32_bf16 %0, %1, %2" : "=v"(r) : "v"(a), "v"(b), "0"(acc)); return r;
}
__device__ __forceinline__ float dot8(const u32x4& a, const u32x4& b, float acc) {
    acc = dot2bf(a.x, b.x, acc); acc = dot2bf(a.y, b.y, acc); acc = dot2bf(a.z, b.z, acc); acc = dot2bf(a.w, b.w, acc);
    return acc;
}
__device__ __forceinline__ void axpy8(float* o, const u32x4& v, float w) {
    o[0] += w * bf_lo(v.x); o[1] += w * bf_hi(v.x); o[2] += w * bf_lo(v.y); o[3] += w * bf_hi(v.y); o[4] += w * bf_lo(v.z); o[5] += w * bf_hi(v.z); o[6] += w * bf_lo(v.w); o[7] += w * bf_hi(v.w);
}
__device__ __forceinline__ void dec16(float (&f)[16], const u32x4& w) {
#pragma unroll
    for (int j = 0; j < 4; ++j) { const f32x2 lo = __builtin_amdgcn_cvt_pk_f32_fp8((int)w[j], false), hh = __builtin_amdgcn_cvt_pk_f32_fp8((int)w[j], true); f[4 * j] = lo.x; f[4 * j + 1] = lo.y; f[4 * j + 2] = hh.x; f[4 * j + 3] = hh.y; }
}
__device__ __forceinline__ void phase_peer_gather(const Params& p, int layer, const int* EIDX, const float* GW, const bf16_t* HB, bf16_t* HBO, float* OUT, float fs) {
    const int lane = threadIdx.x & 63, wave = threadIdx.x >> 6;
    const int gw = blockIdx.x * NWAVES + wave, NGW = gridDim.x * NWAVES;
    const unsigned char* U8 = p.ws + WS_TAB + (size_t)layer * 32 * MiB; const unsigned char* V8 = U8 + 16 * MiB;
    const float* lg = p.in[I_PEER_LNG] + layer * 1024; const float* lb = p.in[I_PEER_LNB] + layer * 1024;
    for (int t = gw; t < NTOK; t += NGW) {
        const u32x4 x0 = *(const u32x4*)(HB + (size_t)t * 1024 + lane * 16), x1 = *(const u32x4*)(HB + (size_t)t * 1024 + lane * 16 + 8);
        const float xf[16] = {bf_lo(x0.x), bf_hi(x0.x), bf_lo(x0.y), bf_hi(x0.y), bf_lo(x0.z), bf_hi(x0.z), bf_lo(x0.w), bf_hi(x0.w), bf_lo(x1.x), bf_hi(x1.x), bf_lo(x1.y), bf_hi(x1.y), bf_lo(x1.z), bf_hi(x1.z), bf_lo(x1.w), bf_hi(x1.w)};
        const int e0 = EIDX[(size_t)t * 128 + lane], e1 = EIDX[(size_t)t * 128 + 64 + lane];
        const float g0 = GW[(size_t)t * 128 + lane], g1 = GW[(size_t)t * 128 + 64 + lane];
        float o[16];
#pragma unroll
        for (int i = 0; i < 16; ++i) o[i] = 0.f;
#pragma unroll 1
        for (int half = 0; half < 2; ++half) {
            const int eh = half ? e1 : e0; const float gh = half ? g1 : g0;
#pragma unroll 1
            for (int kb = 0; kb < 64; kb += 8) {
                u32x4 uw[8], vw[8]; float gg[8];
#pragma unroll
                for (int i = 0; i < 8; ++i) { const int e = __shfl(eh, kb + i); gg[i] = __shfl(gh, kb + i);
                    uw[i] = *(const u32x4*)(U8 + (size_t)e * 1024 + lane * 16); vw[i] = *(const u32x4*)(V8 + (size_t)e * 1024 + lane * 16); }
#pragma unroll
                for (int i = 0; i < 8; ++i) {
                    float uf[16]; dec16(uf, uw[i]);
                    float d0 = 0.f, d1 = 0.f;
#pragma unroll
                    for (int j = 0; j < 8; ++j) { d0 += xf[2 * j] * uf[2 * j]; d1 += xf[2 * j + 1] * uf[2 * j + 1]; }
                    const float d = wave_sum(d0 + d1) * (1.f / U_SCALE);
                    const float w = gg[i] * gelu_tanh(d);
                    float vf[16]; dec16(vf, vw[i]);
#pragma unroll
                    for (int j = 0; j < 16; ++j) o[j] += w * vf[j];
                }
            }
        }
        float z[16]; float s = 0.f;
#pragma unroll
        for (int i = 0; i < 16; ++i) { z[i] = DN_ALPHA * xf[i] + fs * (1.f / V_SCALE) * o[i]; s += z[i]; }
        const float mean = wave_sum(s) * (1.f / 1024.f); float q = 0.f;
#pragma unroll
        for (int i = 0; i < 16; ++i) { z[i] -= mean; q += z[i] * z[i]; }
        const float rstd = rsqrtf(wave_sum(q) * (1.f / 1024.f) + LN_EPS);
#pragma unroll
        for (int j = 0; j < 4; ++j) { const f32x4 ga = *(const f32x4*)(lg + lane * 16 + 4 * j), ba = *(const f32x4*)(lb + lane * 16 + 4 * j);
#pragma unroll
            for (int i = 0; i < 4; ++i) z[4 * j + i] = z[4 * j + i] * rstd * ga[i] + ba[i]; }
        if (OUT) {
#pragma unroll
            for (int j = 0; j < 4; ++j) *(f32x4*)(OUT + (size_t)t * 1024 + lane * 16 + 4 * j) = (f32x4){z[4 * j], z[4 * j + 1], z[4 * j + 2], z[4 * j + 3]};
        } else {
            u32x4 w0, w1; w0.x = pk2(z[0], z[1]); w0.y = pk2(z[2], z[3]); w0.z = pk2(z[4], z[5]); w0.w = pk2(z[6], z[7]); w1.x = pk2(z[8], z[9]); w1.y = pk2(z[10], z[11]); w1.z = pk2(z[12], z[13]); w1.w = pk2(z[14], z[15]);
            *(u32x4*)(HBO + (size_t)t * 1024 + lane * 16) = w0; *(u32x4*)(HBO + (size_t)t * 1024 + lane * 16 + 8) = w1;
        }
    }
}

#define XB_TMO      128
#define XB_XCNT(j)  (256  + 64 * (j))
#define XB_XSUB(j)  (1280 + 64 * (j))
#define XB_XGEN(j)  (2304 + 64 * (j))
#define XB_TOP      3328
#define XB_TOPGEN   3392
#define XCD_BAR_WORDS 3456
#define XB_SPIN_CAP (1u << 18)
__device__ __forceinline__ unsigned xb_ld(unsigned* p)              { return __hip_atomic_load(p, __ATOMIC_RELAXED, __HIP_MEMORY_SCOPE_AGENT); }
__device__ __forceinline__ unsigned xb_add(unsigned* p, unsigned v) { return __hip_atomic_fetch_add(p, v, __ATOMIC_RELAXED, __HIP_MEMORY_SCOPE_AGENT); }
__device__ __forceinline__ unsigned xb_xcc_id() { return (unsigned)__builtin_amdgcn_s_getreg((3 << 11) | 20) & 0xFu; }
#define XB_SPIN(cond, bar) do { unsigned _sp = 0; while (cond) { __builtin_amdgcn_s_sleep(1); \
    if ((++_sp & 255u) == 0u) { if (xb_ld(&(bar)[XB_TMO])) break; if (_sp > XB_SPIN_CAP) { atomicAdd(&(bar)[XB_TMO], 1u); break; } } } } while (0)
struct XcdBarrier { unsigned* bar; unsigned x; volatile LAS unsigned* st; };
__device__ __forceinline__ XcdBarrier xcd_barrier_post(unsigned* bar, volatile LAS unsigned* st) {
    XcdBarrier b; b.bar = bar; b.x = xb_xcc_id(); b.st = st;
    if (threadIdx.x == 0) (void)xb_add(&bar[XB_XCNT(b.x)], 1u);
    return b;
}
__device__ __forceinline__ void xcd_barrier_complete(unsigned* bar, unsigned x, unsigned& nloc, unsigned& nx) {
    const unsigned G = gridDim.x * gridDim.y * gridDim.z;
    unsigned sum, cnt, mine, sp = 0u;
    for (;;) {
        sum = 0u; cnt = 0u; mine = 0u;
#pragma unroll
        for (unsigned j = 0; j < 16; ++j) { const unsigned c = xb_ld(&bar[XB_XCNT(j)]); sum += c; cnt += (c > 0u) ? 1u : 0u; mine = (j == x) ? c : mine; }
        if (sum == G) break;
        __builtin_amdgcn_s_sleep(1);
        if ((++sp & 255u) == 0u) { if (xb_ld(&bar[XB_TMO])) break; if (sp > XB_SPIN_CAP) { atomicAdd(&bar[XB_TMO], 1u); break; } }
    }
    nloc = mine > 0u ? mine : 1u; nx = cnt > 0u ? cnt : 1u;
}
__device__ __forceinline__ void xcd_barrier(const XcdBarrier& b) {
    asm volatile("s_waitcnt vmcnt(0)" ::: "memory");
    __syncthreads();
    if (threadIdx.x == 0) {
        unsigned* bar = b.bar;
        __builtin_amdgcn_s_waitcnt(0);
        unsigned nloc = b.st[0], nx = b.st[1];
        if (nloc == 0u) { xcd_barrier_complete(bar, b.x, nloc, nx); b.st[0] = nloc; b.st[1] = nx; }
        const unsigned old = xb_add(&bar[XB_XSUB(b.x)], 1u);
        const unsigned gen = old / nloc;
        if (old + 1u == (gen + 1u) * nloc) {
            __builtin_amdgcn_fence(__ATOMIC_RELEASE, "agent");
            asm volatile("s_waitcnt vmcnt(0)" ::: "memory");
            const unsigned og = xb_add(&bar[XB_TOP], 1u);
            const unsigned tg = og / nx;
            if (og + 1u == (tg + 1u) * nx) xb_add(&bar[XB_TOPGEN], 1u);
            else XB_SPIN(xb_ld(&bar[XB_TOPGEN]) == tg, bar);
            __builtin_amdgcn_fence(__ATOMIC_ACQUIRE, "agent");
            xb_add(&bar[XB_XGEN(b.x)], 1u);
            asm volatile("s_waitcnt vmcnt(0)" ::: "memory");
        } else {
            XB_SPIN(xb_ld(&bar[XB_XGEN(b.x)]) == gen, bar);
            __builtin_amdgcn_fence(__ATOMIC_ACQUIRE, "agent");
            asm volatile("s_waitcnt vmcnt(0)" ::: "memory");
        }
    }
    __syncthreads();
}

constexpr int NPHASES = 19;
__global__ void __launch_bounds__(NTHREADS, 2) fwd_kernel(Params p) {
    extern __shared__ __attribute__((aligned(16))) unsigned char lds_raw[];
    LAS unsigned char* lds = (LAS unsigned char*)lds_raw;
    unsigned char* ws = p.ws;
    bf16_t* HB = (bf16_t*)(ws + WS_HB);
    const int lo = p.ph_lo, hi = p.ph_hi;
    volatile LAS unsigned* bst = (volatile LAS unsigned*)(lds + LDS_BYTES - 64);
    if (threadIdx.x < 16) bst[threadIdx.x] = 0u;
    __syncthreads();
    XcdBarrier gbar; gbar.bar = (unsigned*)(ws + WS_CTL) + 4096; gbar.x = 0; gbar.st = bst;
    if (hi - lo > 1) { cg::this_grid().sync();
        gbar = xcd_barrier_post((unsigned*)(ws + WS_CTL) + 4096, bst); }
#ifndef PH_MASK
#define PH_MASK 0xFFFFFFFFu
#endif
#define IN(k) (((PH_MASK >> (k)) & 1u) && lo <= (k) && (k) < hi)
#define SEAM(k) do { if (IN(k) && IN((k) + 1)) { xcd_barrier(gbar); } } while (0)
    if (IN(0)) for (int rep_ = 0; rep_ < ((PROBE_REP == 0) ? 1 + PROBE_N : 1); ++rep_) { phase_prologue(p, lds); } SEAM(0);
    if (IN(1)) for (int rep_ = 0; rep_ < ((PROBE_REP == 1) ? 1 + PROBE_N : 1); ++rep_) { EpiNsaProj E{(bf16_t*)(ws + S_Q), (bf16_t*)(ws + S_KV6), (float*)(ws + S_GATES)};
        run_gemm(lds, HB, 1024, (const bf16_t*)(ws + WS_W_IN_T), 1024, NTOK, NSA_IN_PAD, 1024, (int)blockIdx.x, E); } SEAM(1);
    if (IN(2)) for (int rep_ = 0; rep_ < ((PROBE_REP == 2) ? 1 + PROBE_N : 1); ++rep_) { EpiF32 Ek{(float*)(ws + S_PK), 256}, Ev{(float*)(ws + S_PV), 256};
        run_gemm(lds, (const bf16_t*)(ws + S_KV6), 1024, (const bf16_t*)(ws + WS_W_CK1_T), 1024, 8192, 256, 1024, (int)blockIdx.x, Ek);
        run_gemm(lds, (const bf16_t*)(ws + S_KV6) + (size_t)NTOK * 256, 1024, (const bf16_t*)(ws + WS_W_CV1_T), 1024, 8192, 256, 1024, (int)((blockIdx.x + gridDim.x / 2) % gridDim.x), Ev); } SEAM(2);
    if (IN(3)) for (int rep_ = 0; rep_ < ((PROBE_REP == 3) ? 1 + PROBE_N : 1); ++rep_) { phase_cmp_finish(p, lds); } SEAM(3);
    if (IN(4)) for (int rep_ = 0; rep_ < ((PROBE_REP == 4) ? 1 + PROBE_N : 1); ++rep_) { if (USE_MFMA_NSA) phase_nsa_attn(p, lds); else phase_nsa_attn_ref(p, lds); } SEAM(4);
    if (IN(5)) for (int rep_ = 0; rep_ < ((PROBE_REP == 5) ? 1 + PROBE_N : 1); ++rep_) { EpiResid E{HB, (bf16_t*)(ws + S_Z), (ABL & 1) ? 0.f : 1.f};
        run_gemm(lds, (const bf16_t*)(ws + S_AO), 1024, (const bf16_t*)(ws + WS_W_NSAOUT_T), 1024, NTOK, 1024, 1024, (int)blockIdx.x, E); } SEAM(5);
    if (IN(6)) for (int rep_ = 0; rep_ < ((PROBE_REP == 6) ? 1 + PROBE_N : 1); ++rep_) { phase_ln((const bf16_t*)(ws + S_Z), HB, p.in[I_NSA_LNG], p.in[I_NSA_LNB]); } SEAM(6);
    if (IN(7)) for (int rep_ = 0; rep_ < ((PROBE_REP == 7) ? 1 + PROBE_N : 1); ++rep_) { EpiBf16 E{(bf16_t*)(ws + S_QP0), 2048};
        run_gemm(lds, HB, 1024, (const bf16_t*)(ws + WS_W_PQ_T), 1024, NTOK, 2048, 1024, (int)blockIdx.x, E); } SEAM(7);
    if (IN(8) && ((PROBE_DUP & 1) || PROBE_REP == 8)) for (int rep_ = 0; rep_ < PROBE_N; ++rep_) { phase_peer_route(p, lds, 0, (const bf16_t*)(ws + S_QP0), (int*)(ws + S_Z), (float*)(ws + S_Z + 16 * MiB)); }
    if (IN(8)) { if (USE_MFMA_ROUTE) phase_peer_route(p, lds, 0, (const bf16_t*)(ws + S_QP0), (int*)(ws + S_EIDX0), (float*)(ws + S_GW0)); else phase_peer_route_ref(p, lds, 0, (const bf16_t*)(ws + S_QP0), (int*)(ws + S_EIDX0), (float*)(ws + S_GW0)); } SEAM(8);
    if (IN(9) && ((PROBE_DUP & 2) || PROBE_REP == 9)) for (int rep_ = 0; rep_ < PROBE_N; ++rep_) { phase_peer_gather(p, 0, (const int*)(ws + S_EIDX0), (const float*)(ws + S_GW0), HB, (bf16_t*)(ws + S_Z), nullptr, 1.f); }
    if (IN(9)) { phase_peer_gather(p, 0, (const int*)(ws + S_EIDX0), (const float*)(ws + S_GW0), HB, HB, nullptr, (ABL & 2) ? 0.f : 1.f); } SEAM(9);
    if (IN(10)) for (int rep_ = 0; rep_ < ((PROBE_REP == 10) ? 1 + PROBE_N : 1); ++rep_) { EpiBf16 E{(bf16_t*)(ws + S_DQ), MLA_DOWN_PAD};
        run_gemm(lds, HB, 1024, (const bf16_t*)(ws + WS_W_MLADOWN_T), 1024, NTOK, MLA_DOWN_PAD, 1024, (int)blockIdx.x, E); } SEAM(10);
    if (IN(11)) for (int rep_ = 0; rep_ < ((PROBE_REP == 11) ? 1 + PROBE_N : 1); ++rep_) { phase_mla_rowstats(p); } SEAM(11);
    if (IN(12)) for (int rep_ = 0; rep_ < ((PROBE_REP == 12) ? 1 + PROBE_N : 1); ++rep_) { EpiBf16 Eq{(bf16_t*)(ws + S_QF), 1536}; EpiKV Ekv{(bf16_t*)(ws + S_KNOPE), (bf16_t*)(ws + S_V)};
        run_gemm(lds, (const bf16_t*)(ws + S_DQ), MLA_DOWN_PAD, (const bf16_t*)(ws + WS_W_UQ_T), 768, NTOK, 1536, 768, (int)blockIdx.x, Eq);
        run_gemm(lds, (const bf16_t*)(ws + S_DQ) + 768, MLA_DOWN_PAD, (const bf16_t*)(ws + WS_W_UKV_T), 256, NTOK, 2048, 256, (int)blockIdx.x, Ekv); } SEAM(12);
    if (IN(13)) for (int rep_ = 0; rep_ < ((PROBE_REP == 13) ? 1 + PROBE_N : 1); ++rep_) { if (USE_MFMA_MLA) phase_mla_attn(p, lds); else phase_mla_attn_ref(p, lds); } SEAM(13);
    if (IN(14)) for (int rep_ = 0; rep_ < ((PROBE_REP == 14) ? 1 + PROBE_N : 1); ++rep_) { EpiResid E{HB, (bf16_t*)(ws + S_Z2), (ABL & 4) ? 0.f : 1.f};
        run_gemm(lds, (const bf16_t*)(ws + S_AO2), 1024, (const bf16_t*)(ws + WS_W_MLAOUT_T), 1024, NTOK, 1024, 1024, (int)blockIdx.x, E); } SEAM(14);
    if (IN(15)) for (int rep_ = 0; rep_ < ((PROBE_REP == 15) ? 1 + PROBE_N : 1); ++rep_) { phase_ln((const bf16_t*)(ws + S_Z2), HB, p.in[I_MLA_LNG], p.in[I_MLA_LNB]); } SEAM(15);
    if (IN(16)) for (int rep_ = 0; rep_ < ((PROBE_REP == 16) ? 1 + PROBE_N : 1); ++rep_) { EpiBf16 E{(bf16_t*)(ws + S_QP1), 2048};
        run_gemm(lds, HB, 1024, (const bf16_t*)(ws + WS_W_PQ_T) + (size_t)2048 * 1024, 1024, NTOK, 2048, 1024, (int)blockIdx.x, E); } SEAM(16);
    if (IN(17) && ((PROBE_DUP & 1) || PROBE_REP == 17)) for (int rep_ = 0; rep_ < PROBE_N; ++rep_) { phase_peer_route_ref(p, lds, 1, (const bf16_t*)(ws + S_QP1), (int*)(ws + S_EIDX1), (float*)(ws + S_GW1)); }
    if (IN(17)) { if (USE_MFMA_ROUTE) phase_peer_route(p, lds, 1, (const bf16_t*)(ws + S_QP1), (int*)(ws + S_EIDX1), (float*)(ws + S_GW1)); else phase_peer_route_ref(p, lds, 1, (const bf16_t*)(ws + S_QP1), (int*)(ws + S_EIDX1), (float*)(ws + S_GW1)); } SEAM(17);
    if (IN(18) && ((PROBE_DUP & 2) || PROBE_REP == 18)) for (int rep_ = 0; rep_ < PROBE_N; ++rep_) { phase_peer_gather(p, 1, (const int*)(ws + S_EIDX1), (const float*)(ws + S_GW1), HB, (bf16_t*)(ws + S_Z2), nullptr, 1.f); }
    if (IN(18)) { phase_peer_gather(p, 1, (const int*)(ws + S_EIDX1), (const float*)(ws + S_GW1), HB, HB, p.out, (ABL & 8) ? 0.f : 1.f); }
#if DBG_STAT
    if (IN(18)) { asm volatile("s_waitcnt vmcnt(0) lgkmcnt(0)" ::: "memory"); __builtin_amdgcn_fence(__ATOMIC_RELEASE, "agent"); cg::this_grid().sync(); __builtin_amdgcn_fence(__ATOMIC_ACQUIRE, "agent");
        const float c = 1.f + __hip_atomic_load((float*)(ws + WS_CTL) + 16, __ATOMIC_RELAXED, __HIP_MEMORY_SCOPE_AGENT);
        for (size_t i = (size_t)blockIdx.x * NTHREADS + threadIdx.x; i < (size_t)NTOK * DM; i += (size_t)gridDim.x * NTHREADS) p.out[i] = c; }
#endif
#undef IN
#undef SEAM
}

extern "C" void kernel_launch(void* const* d_in, const int* in_sizes, int n_in, void* d_out, int out_size, void* d_ws, size_t ws_size, hipStream_t stream) {
    static int grid = 0;
    if (grid == 0) {
        if (n_in != 28 || out_size != NTOK * DM || ws_size < WS_NEED) { fprintf(stderr, "kernel_launch: unexpected problem (n_in %d, out %d, ws %zu)\n", n_in, out_size, ws_size); grid = -1; return; }
        int dev = 0, cus = 0, per_cu = 0;
        (void)hipGetDevice(&dev); (void)hipDeviceGetAttribute(&cus, hipDeviceAttributeMultiprocessorCount, dev);
        if (hipFuncSetAttribute((const void*)fwd_kernel, hipFuncAttributeMaxDynamicSharedMemorySize, LDS_BYTES) != hipSuccess) { fprintf(stderr, "kernel_launch: hipFuncSetAttribute failed\n"); grid = -1; return; }
        if (hipOccupancyMaxActiveBlocksPerMultiprocessor(&per_cu, (const void*)fwd_kernel, NTHREADS, LDS_BYTES) != hipSuccess || per_cu < 1) { fprintf(stderr, "kernel_launch: occupancy query says %d blocks per CU\n", per_cu); grid = -1; return; }
        grid = cus;
    }
    if (grid < 0) return;
    if (hipMemsetAsync((char*)d_ws + WS_CTL, 0, CTL_BYTES, stream) != hipSuccess) { fprintf(stderr, "kernel_launch: memset of the control words failed\n"); return; }
    Params p{};
    for (int i = 0; i < 28; ++i) p.in[i] = (const float*)d_in[i];
    p.out = (float*)d_out; p.ws = (unsigned char*)d_ws;
#if MK_ONE_LAUNCH
    p.ph_lo = 0; p.ph_hi = NPHASES;
    void* args[] = {&p};
    hipError_t e = hipLaunchCooperativeKernel((const void*)fwd_kernel, dim3(grid), dim3(NTHREADS), args, LDS_BYTES, stream);
    if (e != hipSuccess) fprintf(stderr, "kernel_launch: cooperative launch failed: %s\n", hipGetErrorString(e));
#else
    for (int k = 0; k < NPHASES; ++k) { p.ph_lo = k; p.ph_hi = k + 1; hipLaunchKernelGGL(fwd_kernel, dim3(grid), dim3(NTHREADS), LDS_BYTES, stream, p); }
#endif
}
#ifdef REGTEST
__global__ void __launch_bounds__(256) regtest_nsa(Params p) { extern __shared__ __attribute__((aligned(16))) unsigned char l2[]; phase_nsa_attn(p, (LAS unsigned char*)l2); }
__global__ void __launch_bounds__(256) regtest_mla(Params p) { extern __shared__ __attribute__((aligned(16))) unsigned char l2[]; phase_mla_attn(p, (LAS unsigned char*)l2); }
#endif
```

```cpp
#include <hip/hip_runtime.h>
#include <hip/hip_cooperative_groups.h>
#include <cstdio>
#include <cstdint>
namespace cg = cooperative_groups;

#ifndef ABL
#define ABL 0
#endif
#ifndef PROBE_DUP
#define PROBE_DUP 0
#endif
#ifndef PROBE_REP
#define PROBE_REP -1
#endif
#ifndef PROBE_N
#define PROBE_N 2
#endif
#ifndef TAB_MODE
#define TAB_MODE 6
#endif
#define TAB_FP4 (TAB_MODE == 4)
#ifndef USE_MFMA_ROUTE
#define USE_MFMA_ROUTE 1
#endif
#ifndef USE_MFMA_NSA
#define USE_MFMA_NSA 1
#endif
#ifndef USE_MFMA_MLA
#define USE_MFMA_MLA 1
#endif
#ifndef DBG_STAT
#define DBG_STAT 0
#endif
#ifndef MK_ONE_LAUNCH
#define MK_ONE_LAUNCH 1
#endif

#define LAS __attribute__((address_space(3)))
typedef unsigned short bf16_t;
typedef short bf16x8 __attribute__((ext_vector_type(8)));
typedef float f32x4 __attribute__((ext_vector_type(4)));
typedef float f32x2 __attribute__((ext_vector_type(2)));
typedef unsigned u32x4 __attribute__((ext_vector_type(4)));
typedef unsigned u32x2 __attribute__((ext_vector_type(2)));
typedef __bf16 bf16x2_t __attribute__((ext_vector_type(2)));

constexpr int BATCH = 8, SEQ = 4096, DM = 1024, NTOK = BATCH * SEQ;
constexpr int NSA_IN = 2608, NSA_IN_PAD = 2816;
constexpr int MLA_DOWN = 1056, MLA_DOWN_PAD = 1280;
constexpr int NEXP = 16384;
constexpr float DN_ALPHA = 1.4142135623730951f;
constexpr float LN_EPS = 1e-5f, RMS_EPS = 1e-6f;
#if TAB_FP4
constexpr float U_SCALE = 64.f, V_SCALE = 4.f;
constexpr size_t TAB_ROW = 512, TAB_BYTES = 8u << 20;
#elif TAB_MODE == 6
constexpr float U_SCALE = 64.f, V_SCALE = 4.f;
constexpr size_t TAB_ROW = 768, TAB_BYTES = 12u << 20;
#else
constexpr float U_SCALE = 1024.f, V_SCALE = 64.f;
constexpr size_t TAB_ROW = 1024, TAB_BYTES = 16u << 20;
#endif
constexpr int NWAVES = 8, NTHREADS = 512;
constexpr int LDS_BYTES = 147456;

constexpr size_t KiB = 1024, MiB = 1024 * 1024;
constexpr size_t WS_CTL = 0, CTL_BYTES = 64 * KiB;
constexpr size_t WS_W_IN_T = 1 * MiB;
constexpr size_t WS_W_NSAOUT_T = 6 * MiB + 512 * KiB;
constexpr size_t WS_W_CK1_T = 8 * MiB + 512 * KiB;
constexpr size_t WS_W_CV1_T = 9 * MiB;
constexpr size_t WS_W_MLADOWN_T = 9 * MiB + 512 * KiB;
constexpr size_t WS_W_UQ_T = 12 * MiB;
constexpr size_t WS_W_UKV_T = 14 * MiB + 256 * KiB;
constexpr size_t WS_W_MLAOUT_T = 15 * MiB + 256 * KiB;
constexpr size_t WS_W_PQ_T = 17 * MiB + 256 * KiB;
constexpr size_t WS_SUBK = 25 * MiB + 256 * KiB;
constexpr size_t WS_MISC = 27 * MiB;
constexpr size_t WS_PE = WS_MISC;
constexpr size_t WS_ROPE_COS = WS_MISC + 4 * KiB;
constexpr size_t WS_ROPE_SIN = WS_ROPE_COS + 256 * KiB;
constexpr size_t WS_RSTD_Q = WS_ROPE_SIN + 256 * KiB;
constexpr size_t WS_RSTD_KV = WS_RSTD_Q + 128 * KiB;
constexpr size_t WS_TAB = 32 * MiB;
constexpr size_t WS_HB = 160 * MiB;
constexpr size_t WS_S = 224 * MiB;
constexpr size_t S_Q = WS_S;
constexpr size_t S_KV6 = WS_S + 64 * MiB;
constexpr size_t S_AO = WS_S + 160 * MiB;
constexpr size_t S_GATES = WS_S + 224 * MiB;
constexpr size_t S_PK = WS_S + 230 * MiB;
constexpr size_t S_PV = WS_S + 238 * MiB;
constexpr size_t S_KCMP = WS_S + 246 * MiB;
constexpr size_t S_VCMP = S_KCMP + 512 * KiB;
constexpr size_t S_Z = WS_S;
constexpr size_t S_QP0 = WS_S + 64 * MiB;
constexpr size_t S_EIDX0 = WS_S + 192 * MiB;
constexpr size_t S_GW0 = WS_S + 208 * MiB;
constexpr size_t S_DQ = WS_S;
constexpr size_t S_QF = WS_S + 80 * MiB;
constexpr size_t S_V = WS_S + 176 * MiB;
constexpr size_t S_KROPE = WS_S + 240 * MiB;
constexpr size_t S_KNOPE = WS_TAB + 64 * MiB;
constexpr size_t S_AO2 = WS_S;
constexpr size_t S_Z2 = WS_S + 80 * MiB;
constexpr size_t S_QP1 = WS_S + 144 * MiB;
constexpr size_t S_EIDX1 = WS_S;
constexpr size_t S_GW1 = WS_S + 16 * MiB;
constexpr size_t WS_NEED = 512 * MiB;
static_assert(S_QP1 + 128 * MiB <= WS_NEED && S_VCMP + 512 * KiB <= WS_NEED, "workspace map");

__device__ __forceinline__ float bf_lo(unsigned u) { return __uint_as_float(u << 16); }
__device__ __forceinline__ float bf_hi(unsigned u) { return __uint_as_float(u & 0xffff0000u); }
__device__ __forceinline__ float bf2f(bf16_t v) { return __uint_as_float((unsigned)v << 16); }
__device__ __forceinline__ unsigned pk2(float lo, float hi) { f32x2 v = {lo, hi}; bf16x2_t b = __builtin_convertvector(v, bf16x2_t); return __builtin_bit_cast(unsigned, b); }
__device__ __forceinline__ bf16_t f2bf(float f) { return (bf16_t)(pk2(f, 0.f) & 0xffffu); }
__device__ __forceinline__ float wave_sum(float v) {
#pragma unroll
    for (int o = 32; o >= 1; o >>= 1) v += __shfl_xor(v, o);
    return v;
}
__device__ __forceinline__ float wave_max(float v) {
#pragma unroll
    for (int o = 32; o >= 1; o >>= 1) v = fmaxf(v, __shfl_xor(v, o));
    return v;
}
__device__ __forceinline__ float gelu_tanh(float x) {
    const float y = 0.7978845608028654f * (x + 0.044715f * x * x * x);
    const float e = __expf(2.f * y);
    const float th = 1.f - 2.f / (1.f + e);
    return 0.5f * x * (1.f + th);
}
#define LDS_FENCE() asm volatile("s_waitcnt lgkmcnt(0)" ::: "memory")

namespace pg8 {
constexpr int BM = 256, BK = 64, HALF = 128, HTB = HALF * BK * 2, STAGE_BYTES = 8 * HTB, NXCD = 8, WGM = 8;
__host__ __device__ __forceinline__ int lds_byte(int r, int c) { const int st = (r >> 4) * 2 + (c >> 5), rr = r & 15, cc = c & 31, ob = rr * 64 + cc * 2; return st * 1024 + (ob ^ (((ob >> 9) & 1) << 5)); }
__host__ __device__ __forceinline__ void stage_rc(int b, int& R, int& C) { const int st = b / 1024, sb = b % 1024, swz = sb ^ (((sb >> 9) & 1) << 5); R = (st >> 1) * 16 + swz / 64; C = (st & 1) * 32 + (swz % 64) / 2; }
__host__ __device__ __forceinline__ int perm32(int rho) { const int n = rho >> 4, i = rho & 15; return 8 * (i >> 2) + 4 * n + (i & 3); }
struct Unit { int pm, pn; };
struct Gemm { const bf16_t* A; const bf16_t* Bt; int M, N, K, lda, ldb; };
struct StaticOrder {
    int nM, nN, nwg, G, c;
    __device__ void init(int M, int N, int G_, int c_) { nM = M / BM; nN = N / BM; nwg = nM * nN; G = G_; c = c_; }
    __device__ bool next(int i, Unit& u) const {
        const long L = (long)i * G + c; if (L >= nwg) return false;
        int wgid = (int)L; { const int q = nwg / NXCD, r = nwg % NXCD, xcd = wgid % NXCD, off = wgid / NXCD; wgid = (xcd < r ? xcd * (q + 1) : r * (q + 1) + (xcd - r) * q) + off; }
        const int nig = WGM * nN, gid = wgid / nig, fm = gid * WGM, gsz = (nM - fm) < WGM ? (nM - fm) : WGM;
        u.pm = fm + ((wgid % nig) % gsz); u.pn = (wgid % nig) / gsz; return true;
    }
};
template <class F> struct EpiFn {
    static constexpr bool PERM = true;
    F f;
    __device__ __forceinline__ void operator()(const f32x4 (&acc)[2][2][4][2], const Unit& u, int wr, int wc, int fr, int fq) const {
        const int row0 = u.pm * BM + wr * 64 + fr, col0 = u.pn * BM + wc * 32 + 8 * fq;
#pragma unroll
        for (int ai = 0; ai < 2; ++ai)
#pragma unroll
            for (int m = 0; m < 4; ++m)
#pragma unroll
                for (int bj = 0; bj < 2; ++bj) f(row0 + ai * HALF + m * 16, col0 + bj * HALF, acc[ai][bj][m][0], acc[ai][bj][m][1]);
    }
};

template <class Epi, class Sched>
__device__ __forceinline__ void gemm_phase(LAS unsigned char* lds, const Gemm g, const Sched& S, const Epi& E) {
    const int tid = threadIdx.x, wid = __builtin_amdgcn_readfirstlane(tid >> 6), lane = tid & 63, wr = wid >> 2, wc = wid & 3, fr = lane & 15, fq = lane >> 4;
    const int K = g.K, nt = K / BK;
    unsigned voffA[2], voffB[2];
#pragma unroll
    for (int i = 0; i < 2; ++i) { int R, C; stage_rc(tid * 16 + i * 8192, R, C); const int Rb = Epi::PERM ? ((R & ~31) + perm32(R & 31)) : R;
        voffA[i] = (unsigned)(R * g.lda + C) * 2u; voffB[i] = (unsigned)(Rb * g.ldb + C) * 2u; }
    const size_t kstep = (size_t)(BK * 2);
    const size_t hstepA = (size_t)HALF * g.lda * 2, hstepB = (size_t)HALF * g.ldb * 2;
    const size_t tstepA = 2 * hstepA, tstepB = 2 * hstepB;
    const unsigned ldsw = (unsigned)wid * 1024u;
    const int aoff = lds_byte(wr * 64 + fr, fq * 8), boff = lds_byte(wc * 32 + fr, fq * 8);
#define PG8_SA(b, h) (((b) * 2 + (h)) * HTB)
#define PG8_SB(b, h) ((4 + (b) * 2 + (h)) * HTB)
#define PG8_STAGE(bufoff, gbase, voff) do { _Pragma("unroll") for (int _i = 0; _i < 2; ++_i) \
        __builtin_amdgcn_global_load_lds((const unsigned*)((const char*)(gbase) + (voff)[_i]), (LAS unsigned*)(lds + (bufoff) + ldsw + _i * 8192), 16, 0, 0); } while (0)
#define PG8_LDA(dst, b, h) do { _Pragma("unroll") for (int m = 0; m < 4; ++m) _Pragma("unroll") for (int k = 0; k < 2; ++k) dst[m][k] = *(const LAS bf16x8*)(lds + PG8_SA(b, h) + aoff + m * 2048 + k * 1024); } while (0)
#define PG8_LDB(dst, b, h) do { _Pragma("unroll") for (int n = 0; n < 2; ++n) _Pragma("unroll") for (int k = 0; k < 2; ++k) dst[n][k] = *(const LAS bf16x8*)(lds + PG8_SB(b, h) + boff + n * 2048 + k * 1024); } while (0)
#define PG8_MMA(ai, bj, At, Bt) do { __builtin_amdgcn_s_setprio(1); _Pragma("unroll") for (int m = 0; m < 4; ++m) _Pragma("unroll") for (int n = 0; n < 2; ++n) _Pragma("unroll") for (int k = 0; k < 2; ++k) \
        acc[ai][bj][m][n] = __builtin_amdgcn_mfma_f32_16x16x32_bf16(Bt[n][k], At[m][k], acc[ai][bj][m][n], 0, 0, 0); __builtin_amdgcn_s_setprio(0); } while (0)
#define PG8_WAIT_V(n) asm volatile("s_waitcnt vmcnt(" #n ")" ::: "memory")
#define PG8_WAIT_L(n) asm volatile("s_waitcnt lgkmcnt(" #n ")" ::: "memory")
#define PG8_BAR __builtin_amdgcn_s_barrier()
#define PG8_SCHED __builtin_amdgcn_sched_barrier(0)
    Unit cur, nxt; int ui = 0;
    if (!S.next(0, cur)) return;
    f32x4 acc[2][2][4][2];
#pragma unroll
    for (int a = 0; a < 2; ++a)
#pragma unroll
        for (int b = 0; b < 2; ++b)
#pragma unroll
            for (int m = 0; m < 4; ++m)
#pragma unroll
                for (int n = 0; n < 2; ++n) acc[a][b][m][n] = (f32x4){0.f, 0.f, 0.f, 0.f};
    bf16x8 At[4][2], B0[2][2], B1[2][2];
    const char* cA = (const char*)g.A + (size_t)cur.pm * tstepA; const char* cB = (const char*)g.Bt + (size_t)cur.pn * tstepB;
    PG8_STAGE(PG8_SB(0, 0), cB, voffB); PG8_STAGE(PG8_SB(0, 1), cB + hstepB, voffB); PG8_STAGE(PG8_SA(0, 0), cA, voffA); PG8_STAGE(PG8_SA(0, 1), cA + hstepA, voffA);
    if (wr == 1) PG8_BAR;
    PG8_WAIT_V(2); PG8_BAR;
    PG8_STAGE(PG8_SB(1, 0), cB + kstep, voffB); PG8_STAGE(PG8_SA(1, 0), cA + kstep, voffA); PG8_STAGE(PG8_SB(1, 1), cB + hstepB + kstep, voffB);
    PG8_WAIT_V(6); PG8_BAR;
    for (;;) {
        const bool has_next = S.next(ui + 1, nxt);
        const char* nA = has_next ? (const char*)g.A + (size_t)nxt.pm * tstepA : cA; const char* nB = has_next ? (const char*)g.Bt + (size_t)nxt.pn * tstepB : cB;
        for (int t = 0; t < nt; t += 2) {
            const bool last = (t == nt - 2);
            const char* a1 = cA + (size_t)(t + 1) * kstep;
            const char* a2 = last ? nA : cA + (size_t)(t + 2) * kstep; const char* b2 = last ? nB : cB + (size_t)(t + 2) * kstep;
            const char* a3 = a2 + kstep; const char* b3 = b2 + kstep;
            PG8_LDB(B0, 0, 0); PG8_LDB(B1, 0, 1); PG8_SCHED; PG8_LDA(At, 0, 0); PG8_STAGE(PG8_SA(1, 1), a1 + hstepA, voffA);
            PG8_WAIT_V(8); PG8_WAIT_L(0); PG8_BAR; PG8_MMA(0, 0, At, B0); PG8_MMA(0, 1, At, B1); PG8_BAR; PG8_SCHED;
            PG8_LDA(At, 0, 1); PG8_STAGE(PG8_SB(0, 0), b2, voffB); PG8_STAGE(PG8_SB(0, 1), b2 + hstepB, voffB); PG8_STAGE(PG8_SA(0, 0), a2, voffA);
            PG8_WAIT_V(8); PG8_WAIT_L(0); PG8_BAR; PG8_MMA(1, 0, At, B0); PG8_MMA(1, 1, At, B1); PG8_BAR; PG8_SCHED;
            PG8_LDB(B0, 1, 0); PG8_LDB(B1, 1, 1); PG8_SCHED; PG8_LDA(At, 1, 0); PG8_STAGE(PG8_SA(0, 1), a2 + hstepA, voffA);
            PG8_WAIT_V(8); PG8_WAIT_L(0); PG8_BAR; PG8_MMA(0, 0, At, B0); PG8_MMA(0, 1, At, B1); PG8_BAR; PG8_SCHED;
            PG8_LDA(At, 1, 1); PG8_STAGE(PG8_SB(1, 0), b3, voffB); PG8_STAGE(PG8_SB(1, 1), b3 + hstepB, voffB); PG8_STAGE(PG8_SA(1, 0), a3, voffA);
            PG8_WAIT_V(8); PG8_WAIT_L(0); PG8_BAR; PG8_MMA(1, 0, At, B0); PG8_MMA(1, 1, At, B1); PG8_BAR; PG8_SCHED;
        }
        if (wr == 0) PG8_BAR;
        E(acc, cur, wr, wc, fr, fq);
        if (!has_next) break;
#pragma unroll
        for (int a = 0; a < 2; ++a)
#pragma unroll
            for (int b = 0; b < 2; ++b)
#pragma unroll
                for (int m = 0; m < 4; ++m)
#pragma unroll
                    for (int n = 0; n < 2; ++n) acc[a][b][m][n] = (f32x4){0.f, 0.f, 0.f, 0.f};
        cur = nxt; cA = nA; cB = nB; ++ui;
        if (wr == 1) PG8_BAR;
    }
    PG8_WAIT_V(0);
    PG8_BAR;
#undef PG8_SA
#undef PG8_SB
#undef PG8_STAGE
#undef PG8_LDA
#undef PG8_LDB
#undef PG8_MMA
#undef PG8_WAIT_V
#undef PG8_WAIT_L
#undef PG8_BAR
#undef PG8_SCHED
}
}

template <class F>
__device__ __forceinline__ void run_gemm(LAS unsigned char* lds, const bf16_t* A, int lda, const bf16_t* Bt, int ldb, int M, int N, int K, int vblock, const F& f) {
    pg8::Gemm g{A, Bt, M, N, K, lda, ldb}; pg8::StaticOrder S; S.init(M, N, (int)gridDim.x, vblock);
    pg8::EpiFn<F> E{f};
    pg8::gemm_phase<pg8::EpiFn<F>, pg8::StaticOrder>(lds, g, S, E);
}

struct Params {
    const float* in[28];
    float* out;
    unsigned char* ws;
    int ph_lo, ph_hi;
};
enum { I_X = 0, I_NSA_WIN, I_CK_W1, I_CK_W2, I_CK_PE, I_CV_W1, I_CV_W2, I_CV_PE, I_NSA_WOUT, I_NSA_LNG, I_NSA_LNB, I_MLA_WDKV, I_MLA_KVG, I_MLA_WKR, I_MLA_WUK, I_MLA_WUV,
       I_MLA_WDQ, I_MLA_QG, I_MLA_WUQ, I_MLA_WOUT, I_MLA_LNG, I_MLA_LNB, I_PEER_WQ, I_PEER_SUBK, I_PEER_U, I_PEER_V, I_PEER_LNG, I_PEER_LNB };

__device__ __forceinline__ void p0_transpose_item(const float* W, int ldw, int n_valid, int K, bf16_t* WT, int row_off, const float* kscale, LAS float* scr, int nblk, int item, int lane) {
    const int kb = item / nblk, nb = item % nblk, k0 = 64 * kb, n0 = 32 * nb;
    const int n = n0 + (lane & 31);
#pragma unroll 8
    for (int i = 0; i < 32; ++i) { const int kk = 2 * i + (lane >> 5); float v = 0.f; if (n < n_valid) { v = W[(size_t)(k0 + kk) * ldw + n]; if (kscale) v *= kscale[k0 + kk]; } scr[kk * 33 + (lane & 31)] = v; }
    LDS_FENCE();
    const int c = lane & 7;
#pragma unroll
    for (int j = 0; j < 4; ++j) { const int nn = (lane >> 3) + 8 * j; const LAS float* s = scr + (8 * c) * 33 + nn;
        u32x4 o; o.x = pk2(s[0 * 33], s[1 * 33]); o.y = pk2(s[2 * 33], s[3 * 33]); o.z = pk2(s[4 * 33], s[5 * 33]); o.w = pk2(s[6 * 33], s[7 * 33]);
        *(u32x4*)(WT + (size_t)(row_off + n0 + nn) * K + k0 + 8 * c) = o; }
    LDS_FENCE();
}
__device__ __forceinline__ void cvt_f32_bf16(const float* src, bf16_t* dst, size_t n, size_t gtid, size_t gsz) {
    for (size_t i = gtid * 8; i < n; i += gsz * 8) { const f32x4 a = *(const f32x4*)(src + i), b = *(const f32x4*)(src + i + 4);
        u32x4 o; o.x = pk2(a.x, a.y); o.y = pk2(a.z, a.w); o.z = pk2(b.x, b.y); o.w = pk2(b.z, b.w); *(u32x4*)(dst + i) = o; }
}
__device__ __forceinline__ void cvt_f32_fp8(const float* src, unsigned char* dst, size_t n, float scale, size_t gtid, size_t gsz) {
    for (size_t i = gtid * 16; i < n; i += gsz * 16) {
        u32x4 o;
#pragma unroll
        for (int j = 0; j < 4; ++j) { f32x4 a = *(const f32x4*)(src + i + 4 * j) * scale;
#pragma unroll
            for (int e = 0; e < 4; ++e) a[e] = fminf(fmaxf(a[e], -448.f), 448.f);
            int pk = 0; pk = __builtin_amdgcn_cvt_pk_fp8_f32(a.x, a.y, pk, false); pk = __builtin_amdgcn_cvt_pk_fp8_f32(a.z, a.w, pk, true); o[j] = (unsigned)pk; }
        *(u32x4*)(dst + i) = o;
    }
}
__device__ __forceinline__ void cvt_f32_fp4(const float* src, unsigned char* dst, size_t n, float scale, size_t gtid, size_t gsz) {
    for (size_t i = gtid * 32; i < n; i += gsz * 32) {
        u32x4 o;
#pragma unroll
        for (int j = 0; j < 4; ++j) { const f32x4 a = *(const f32x4*)(src + i + 8 * j) * scale, b = *(const f32x4*)(src + i + 8 * j + 4) * scale;
            unsigned pk = 0u;
            pk = __builtin_amdgcn_cvt_scalef32_pk_fp4_f32(pk, a.x, a.y, 1.0f, 0); pk = __builtin_amdgcn_cvt_scalef32_pk_fp4_f32(pk, a.z, a.w, 1.0f, 1);
            pk = __builtin_amdgcn_cvt_scalef32_pk_fp4_f32(pk, b.x, b.y, 1.0f, 2); pk = __builtin_amdgcn_cvt_scalef32_pk_fp4_f32(pk, b.z, b.w, 1.0f, 3); o[j] = pk; }
        *(u32x4*)(dst + (i >> 1)) = o;
    }
}
typedef float v16f_t __attribute__((ext_vector_type(16)));
typedef float v32f_t __attribute__((ext_vector_type(32)));
typedef unsigned v6u_t __attribute__((ext_vector_type(6)));
__device__ __forceinline__ void cvt_f32_fp6(const float* src, unsigned char* dst, size_t n, float scale, size_t gtid, size_t gsz) {
    for (size_t i = gtid * 32; i < n; i += gsz * 32) {
        v16f_t a, b;
#pragma unroll
        for (int j = 0; j < 8; ++j) { f32x4 v = *(const f32x4*)(src + i + 4 * j) * scale;
#pragma unroll
            for (int e = 0; e < 4; ++e) v[e] = fminf(fmaxf(v[e], -7.5f), 7.5f);
            a[2 * j] = v.x; b[2 * j] = v.y; a[2 * j + 1] = v.z; b[2 * j + 1] = v.w; }
        const v6u_t pk = __builtin_amdgcn_cvt_scalef32_2xpk16_fp6_f32(a, b, 1.0f);
        unsigned char* d = dst + (i >> 5) * 24;
        *(u32x2*)d = (u32x2){pk[0], pk[1]}; *(u32x2*)(d + 8) = (u32x2){pk[2], pk[3]}; *(u32x2*)(d + 16) = (u32x2){pk[4], pk[5]};
    }
}
__device__ __forceinline__ void phase_prologue(const Params& p, LAS unsigned char* lds) {
    const int tid = threadIdx.x, lane = tid & 63, wave = tid >> 6;
    LAS float* scr = (LAS float*)(lds + wave * 16384);
    const int gw = blockIdx.x * NWAVES + wave, NGW = gridDim.x * NWAVES;
    unsigned char* ws = p.ws;
    int base = 0;
#define TJOB(W_, ldw_, nvalid_, K_, npad_, WT_, rowoff_, ks_) do { const int nblk = (npad_) / 32, nit = ((K_) / 64) * nblk; \
        for (int it = gw - base; it < nit; it += NGW) { if (it >= 0) p0_transpose_item((W_), (ldw_), (nvalid_), (K_), (WT_), (rowoff_), (ks_), scr, nblk, it, lane); } \
        base = (base + nit) % NGW; } while (0)
    TJOB(p.in[I_NSA_WIN], NSA_IN, NSA_IN, 1024, NSA_IN_PAD, (bf16_t*)(ws + WS_W_IN_T), 0, (const float*)nullptr);
    TJOB(p.in[I_NSA_WOUT], 1024, 1024, 1024, 1024, (bf16_t*)(ws + WS_W_NSAOUT_T), 0, (const float*)nullptr);
    TJOB(p.in[I_CK_W1], 128, 128, 1024, 128, (bf16_t*)(ws + WS_W_CK1_T), 0, (const float*)nullptr);
    TJOB(p.in[I_CK_W1] + 1024 * 128, 128, 128, 1024, 128, (bf16_t*)(ws + WS_W_CK1_T), 128, (const float*)nullptr);
    TJOB(p.in[I_CV_W1], 128, 128, 1024, 128, (bf16_t*)(ws + WS_W_CV1_T), 0, (const float*)nullptr);
    TJOB(p.in[I_CV_W1] + 1024 * 128, 128, 128, 1024, 128, (bf16_t*)(ws + WS_W_CV1_T), 128, (const float*)nullptr);
    TJOB(p.in[I_MLA_WDQ], 768, 768, 1024, 768, (bf16_t*)(ws + WS_W_MLADOWN_T), 0, (const float*)nullptr);
    TJOB(p.in[I_MLA_WDKV], 256, 256, 1024, 256, (bf16_t*)(ws + WS_W_MLADOWN_T), 768, (const float*)nullptr);
    TJOB(p.in[I_MLA_WKR], 32, 32, 1024, 256, (bf16_t*)(ws + WS_W_MLADOWN_T), 1024, (const float*)nullptr);
    TJOB(p.in[I_MLA_WUQ], 1536, 1536, 768, 1536, (bf16_t*)(ws + WS_W_UQ_T), 0, p.in[I_MLA_QG]);
    TJOB(p.in[I_MLA_WUK], 1024, 1024, 256, 1024, (bf16_t*)(ws + WS_W_UKV_T), 0, p.in[I_MLA_KVG]);
    TJOB(p.in[I_MLA_WUV], 1024, 1024, 256, 1024, (bf16_t*)(ws + WS_W_UKV_T), 1024, p.in[I_MLA_KVG]);
    TJOB(p.in[I_MLA_WOUT], 1024, 1024, 1024, 1024, (bf16_t*)(ws + WS_W_MLAOUT_T), 0, (const float*)nullptr);
    TJOB(p.in[I_PEER_WQ], 2048, 2048, 1024, 2048, (bf16_t*)(ws + WS_W_PQ_T), 0, (const float*)nullptr);
    TJOB(p.in[I_PEER_WQ] + (size_t)1024 * 2048, 2048, 2048, 1024, 2048, (bf16_t*)(ws + WS_W_PQ_T) + (size_t)2048 * 1024, 0, (const float*)nullptr);
#undef TJOB
#if DBG_STAT
    if (blockIdx.x == 0 && tid == 0) ((float*)(ws + WS_CTL))[16] = 0.f;
#endif
    const size_t gtid = (size_t)blockIdx.x * NTHREADS + tid, gsz = (size_t)gridDim.x * NTHREADS;
    cvt_f32_bf16(p.in[I_X], (bf16_t*)(ws + WS_HB), (size_t)NTOK * DM, gtid, gsz);
    cvt_f32_bf16(p.in[I_PEER_SUBK], (bf16_t*)(ws + WS_SUBK), (size_t)2 * 8 * 2 * 128 * 128, gtid, gsz);
#if TAB_MODE == 4
#define CVT_TAB cvt_f32_fp4
#elif TAB_MODE == 6
#define CVT_TAB cvt_f32_fp6
#else
#define CVT_TAB cvt_f32_fp8
#endif
    CVT_TAB(p.in[I_PEER_U], ws + WS_TAB, (size_t)NEXP * DM, U_SCALE, gtid, gsz);
    CVT_TAB(p.in[I_PEER_V], ws + WS_TAB + TAB_BYTES, (size_t)NEXP * DM, V_SCALE, gtid, gsz);
    CVT_TAB(p.in[I_PEER_U] + (size_t)NEXP * DM, ws + WS_TAB + 2 * TAB_BYTES, (size_t)NEXP * DM, U_SCALE, gtid, gsz);
    CVT_TAB(p.in[I_PEER_V] + (size_t)NEXP * DM, ws + WS_TAB + 3 * TAB_BYTES, (size_t)NEXP * DM, V_SCALE, gtid, gsz);
#undef CVT_TAB
    for (int o = gw; o < 256; o += NGW) {
        const float* pe = (o < 128) ? p.in[I_CK_PE] : p.in[I_CV_PE]; const float* w1 = (o < 128) ? p.in[I_CK_W1] : p.in[I_CV_W1]; const int h = o & 127;
        float s = 0.f; for (int i = lane; i < 2048; i += 64) s += pe[i] * w1[(size_t)i * 128 + h];
        s = wave_sum(s); if (lane == 0) ((float*)(ws + WS_PE))[o] = s;
    }
    for (size_t i = gtid; i < (size_t)SEQ * 16; i += gsz) {
        const int pos = (int)(i >> 4), fi = (int)(i & 15);
        const float inv = 1.0f / powf(10000.0f, (float)(2 * fi) / 32.0f);
        const float ang = (float)pos * inv;
        const double rev = (double)ang * 0.15915494309189535; const double fr = rev - rint(rev);
        ((float*)(ws + WS_ROPE_COS))[i] = __builtin_amdgcn_cosf((float)fr); ((float*)(ws + WS_ROPE_SIN))[i] = __builtin_amdgcn_sinf((float)fr);
    }
}

__device__ __forceinline__ u32x4 pack8(const f32x4& a, const f32x4& b) { u32x4 o; o.x = pk2(a.x, a.y); o.y = pk2(a.z, a.w); o.z = pk2(b.x, b.y); o.w = pk2(b.z, b.w); return o; }
struct EpiNsaProj {
    bf16_t* q; bf16_t* kv6; float* gates;
    __device__ __forceinline__ void operator()(int row, int col, const f32x4& a, const f32x4& b) const {
        if (col < 1024) { *(u32x4*)(q + (size_t)row * 1024 + col) = pack8(a, b); }
        else if (col < 2560) {
            const int which = (col - 1024) >> 8, cc = (col - 1024) & 255;
            bf16_t* base = kv6 + (size_t)which * NTOK * 256;
            if (which < 2) { const int g = cc >> 6, d = cc & 63, bb = row >> 12, t = row & 4095, n = t >> 4, l = t & 15;
                *(u32x4*)(base + ((((size_t)(bb * 256 + n) * 4 + g) * 16 + l) * 64 + d)) = pack8(a, b); }
            else *(u32x4*)(base + (size_t)row * 256 + cc) = pack8(a, b);
        } else if (col < NSA_IN) {
            float* gp = gates + (size_t)row * 48 + (col - 2560);
            f32x4 s0, s1;
#pragma unroll
            for (int i = 0; i < 4; ++i) { s0[i] = 1.f / (1.f + __expf(-a[i])); s1[i] = 1.f / (1.f + __expf(-b[i])); }
            *(f32x4*)gp = s0; *(f32x4*)(gp + 4) = s1;
        }
    }
};
struct EpiF32 { float* O; int ldc; __device__ __forceinline__ void operator()(int row, int col, const f32x4& a, const f32x4& b) const { float* o = O + (size_t)row * ldc + col; *(f32x4*)o = a; *(f32x4*)(o + 4) = b; } };
struct EpiBf16 { bf16_t* O; int ldc; __device__ __forceinline__ void operator()(int row, int col, const f32x4& a, const f32x4& b) const { *(u32x4*)(O + (size_t)row * ldc + col) = pack8(a, b); } };
struct EpiResid {
    const bf16_t* H; bf16_t* Z; float ms;
    __device__ __forceinline__ void operator()(int row, int col, const f32x4& a_, const f32x4& b_) const {
        const f32x4 a = a_ * ms, b = b_ * ms;
        const u32x4 h = *(const u32x4*)(H + (size_t)row * 1024 + col);
        f32x4 x, y;
        x.x = DN_ALPHA * bf_lo(h.x) + a.x; x.y = DN_ALPHA * bf_hi(h.x) + a.y; x.z = DN_ALPHA * bf_lo(h.y) + a.z; x.w = DN_ALPHA * bf_hi(h.y) + a.w;
        y.x = DN_ALPHA * bf_lo(h.z) + b.x; y.y = DN_ALPHA * bf_hi(h.z) + b.y; y.z = DN_ALPHA * bf_lo(h.w) + b.z; y.w = DN_ALPHA * bf_hi(h.w) + b.w;
        *(u32x4*)(Z + (size_t)row * 1024 + col) = pack8(x, y);
    }
};
struct EpiKV {
    bf16_t* KN; bf16_t* V;
    __device__ __forceinline__ void operator()(int row, int col, const f32x4& a, const f32x4& b) const {
        bf16_t* dst = (col < 1024) ? KN + (size_t)row * 1024 + col : V + (size_t)row * 1024 + (col - 1024);
        *(u32x4*)dst = pack8(a, b);
    }
};

__device__ __forceinline__ void phase_ln(const bf16_t* Z, bf16_t* H, const float* g, const float* b) {
    const int lane = threadIdx.x & 63, wave = threadIdx.x >> 6;
    const int gw = blockIdx.x * NWAVES + wave, NGW = gridDim.x * NWAVES;
    for (int row = gw; row < NTOK; row += NGW) {
        const u32x4 a = *(const u32x4*)(Z + (size_t)row * 1024 + lane * 8), c = *(const u32x4*)(Z + (size_t)row * 1024 + 512 + lane * 8);
        float v[16] = {bf_lo(a.x), bf_hi(a.x), bf_lo(a.y), bf_hi(a.y), bf_lo(a.z), bf_hi(a.z), bf_lo(a.w), bf_hi(a.w), bf_lo(c.x), bf_hi(c.x), bf_lo(c.y), bf_hi(c.y), bf_lo(c.z), bf_hi(c.z), bf_lo(c.w), bf_hi(c.w)};
        float s = 0.f;
#pragma unroll
        for (int i = 0; i < 16; ++i) s += v[i];
        const float mean = wave_sum(s) * (1.f / 1024.f); float q = 0.f;
#pragma unroll
        for (int i = 0; i < 16; ++i) { v[i] -= mean; q += v[i] * v[i]; }
        const float rstd = rsqrtf(wave_sum(q) * (1.f / 1024.f) + LN_EPS);
        float o[16];
#pragma unroll
        for (int hh = 0; hh < 2; ++hh) { const int c0 = hh * 512 + lane * 8; const f32x4 g0 = *(const f32x4*)(g + c0), g1 = *(const f32x4*)(g + c0 + 4), b0 = *(const f32x4*)(b + c0), b1 = *(const f32x4*)(b + c0 + 4);
#pragma unroll
            for (int i = 0; i < 4; ++i) { o[hh * 8 + i] = v[hh * 8 + i] * rstd * g0[i] + b0[i]; o[hh * 8 + 4 + i] = v[hh * 8 + 4 + i] * rstd * g1[i] + b1[i]; } }
        u32x4 w0, w1; w0.x = pk2(o[0], o[1]); w0.y = pk2(o[2], o[3]); w0.z = pk2(o[4], o[5]); w0.w = pk2(o[6], o[7]); w1.x = pk2(o[8], o[9]); w1.y = pk2(o[10], o[11]); w1.z = pk2(o[12], o[13]); w1.w = pk2(o[14], o[15]);
        *(u32x4*)(H + (size_t)row * 1024 + lane * 8) = w0; *(u32x4*)(H + (size_t)row * 1024 + 512 + lane * 8) = w1;
    }
}
__device__ __forceinline__ void phase_cmp_finish(const Params& p, LAS unsigned char* lds) {
    const int lane = threadIdx.x & 63, wave = threadIdx.x >> 6;
    const int gw = blockIdx.x * NWAVES + wave, NGW = gridDim.x * NWAVES;
    LAS float* hs = (LAS float*)(lds + wave * 512);
    for (int item = gw; item < 2 * 8192; item += NGW) {
        const int kv = item >> 13, r = item & 8191, n = (r >> 2) & 255;
        const float* P = (const float*)(p.ws + (kv ? S_PV : S_PK)); const float* pe = (const float*)(p.ws + WS_PE) + kv * 128;
        const float* w2 = p.in[kv ? I_CV_W2 : I_CK_W2];
        bf16_t* out = (bf16_t*)(p.ws + (kv ? S_VCMP : S_KCMP)) + (size_t)r * 64;
        if (n == 255) { out[lane] = 0; continue; }
        const float a0 = P[(size_t)r * 256 + lane] + P[(size_t)(r + 4) * 256 + 128 + lane] + pe[lane];
        const float a1 = P[(size_t)r * 256 + 64 + lane] + P[(size_t)(r + 4) * 256 + 192 + lane] + pe[64 + lane];
        LDS_FENCE();
        hs[lane] = gelu_tanh(a0); hs[64 + lane] = gelu_tanh(a1);
        LDS_FENCE();
        float s = 0.f;
#pragma unroll 8
        for (int h = 0; h < 128; ++h) s += hs[h] * w2[h * 64 + lane];
        out[lane] = f2bf(s);
    }
}
__device__ __forceinline__ void phase_mla_rowstats(const Params& p) {
    const int lane = threadIdx.x & 63, wave = threadIdx.x >> 6;
    const int gw = blockIdx.x * NWAVES + wave, NGW = gridDim.x * NWAVES;
    bf16_t* DQ = (bf16_t*)(p.ws + S_DQ);
    const float* rc = (const float*)(p.ws + WS_ROPE_COS); const float* rs = (const float*)(p.ws + WS_ROPE_SIN);
    for (int row = gw; row < NTOK; row += NGW) {
        bf16_t* r = DQ + (size_t)row * MLA_DOWN_PAD;
        u32x2 v[4]; float sq = 0.f, skv = 0.f;
#pragma unroll
        for (int j = 0; j < 4; ++j) { v[j] = *(const u32x2*)(r + j * 256 + lane * 4); const float a = bf_lo(v[j].x), b = bf_hi(v[j].x), c = bf_lo(v[j].y), d = bf_hi(v[j].y); const float ss = (a * a + b * b) + (c * c + d * d); if (j < 3) sq += ss; else skv += ss; }
        sq = wave_sum(sq); skv = wave_sum(skv);
        const float rq = rsqrtf(sq * (1.f / 768.f) + RMS_EPS), rkv = rsqrtf(skv * (1.f / 256.f) + RMS_EPS);
#pragma unroll
        for (int j = 0; j < 4; ++j) { const float f = (j < 3) ? rq : rkv; u32x2 o; o.x = pk2(bf_lo(v[j].x) * f, bf_hi(v[j].x) * f); o.y = pk2(bf_lo(v[j].y) * f, bf_hi(v[j].y) * f); *(u32x2*)(r + j * 256 + lane * 4) = o; }
        if (lane < 16) { const int pos = row & 4095; const float x1 = bf2f(r[1024 + lane]), x2 = bf2f(r[1040 + lane]), c = rc[pos * 16 + lane], s = rs[pos * 16 + lane];
            bf16_t* kr = (bf16_t*)(p.ws + S_KROPE) + (size_t)row * 32; kr[lane] = f2bf(x1 * c - x2 * s); kr[16 + lane] = f2bf(x2 * c + x1 * s); }
    }
}

struct OnlineSt { float m[4], l[4], o[4][2]; };
__device__ __forceinline__ void nsa_attend_block(OnlineSt& st, const bf16_t* Kb, const bf16_t* Vb, int pos0, int t, const float (&slope)[4], LAS float* qs, LAS float* ps, int lane) {
    const int pos = pos0 + lane; const bool valid = pos <= t;
    const bf16_t* krow = Kb + (size_t)(valid ? pos : t) * 256;
    float acc[4] = {0.f, 0.f, 0.f, 0.f};
#pragma unroll 2
    for (int d8 = 0; d8 < 8; ++d8) { const u32x4 kv = *(const u32x4*)(krow + d8 * 8);
        const float kf[8] = {bf_lo(kv.x), bf_hi(kv.x), bf_lo(kv.y), bf_hi(kv.y), bf_lo(kv.z), bf_hi(kv.z), bf_lo(kv.w), bf_hi(kv.w)};
#pragma unroll
        for (int e = 0; e < 8; ++e) { const f32x4 qv = *(const LAS f32x4*)(qs + (d8 * 8 + e) * 4);
#pragma unroll
            for (int r = 0; r < 4; ++r) acc[r] += qv[r] * kf[e]; } }
    const float dist = (float)(t - pos);
    f32x4 pe;
#pragma unroll
    for (int r = 0; r < 4; ++r) {
        const float s = valid ? acc[r] - slope[r] * dist : -1e30f;
        const float mb = wave_max(s), mn = fmaxf(st.m[r], mb);
        const float alpha = __expf(st.m[r] - mn);
        const float e = valid ? __expf(s - mn) : 0.f;
        st.l[r] = st.l[r] * alpha + wave_sum(e); st.o[r][0] *= alpha; st.o[r][1] *= alpha; st.m[r] = mn; pe[r] = e;
    }
    LDS_FENCE();
    *(LAS f32x4*)(ps + lane * 4) = pe;
    LDS_FENCE();
    const int hf = lane >> 5, dp = lane & 31;
    const int nk = (t - pos0 + 1 < 64) ? t - pos0 + 1 : 64;
#pragma unroll 4
    for (int kk = hf; kk < nk; kk += 2) {
        const unsigned vv = *(const unsigned*)(Vb + (size_t)(pos0 + kk) * 256 + 2 * dp); const f32x4 pp = *(const LAS f32x4*)(ps + kk * 4);
        const float lo = bf_lo(vv), hi = bf_hi(vv);
#pragma unroll
        for (int r = 0; r < 4; ++r) { st.o[r][0] += pp[r] * lo; st.o[r][1] += pp[r] * hi; }
    }
}
__device__ __forceinline__ void phase_nsa_attn_ref(const Params& p, LAS unsigned char* lds) {
    const int lane = threadIdx.x & 63, wave = threadIdx.x >> 6;
    const int gw = blockIdx.x * NWAVES + wave, NGW = gridDim.x * NWAVES;
    LAS float* qs = (LAS float*)(lds + wave * 6144);
    LAS float* pc = qs + 256;
    LAS float* ptot = pc + 1024;
    const bf16_t* Q = (const bf16_t*)(p.ws + S_Q); const bf16_t* KV6 = (const bf16_t*)(p.ws + S_KV6);
    const bf16_t* KS = KV6 + (size_t)2 * NTOK * 256; const bf16_t* VS = KV6 + (size_t)3 * NTOK * 256; const bf16_t* KW = KV6 + (size_t)4 * NTOK * 256; const bf16_t* VW = KV6 + (size_t)5 * NTOK * 256;
    const bf16_t* KC = (const bf16_t*)(p.ws + S_KCMP); const bf16_t* VC = (const bf16_t*)(p.ws + S_VCMP);
    const float* GATES = (const float*)(p.ws + S_GATES); bf16_t* AO = (bf16_t*)(p.ws + S_AO);
    const int hf = lane >> 5, dp = lane & 31;
    for (int item = gw; item < NTOK * 4; item += NGW) {
        const int g = item & 3, row = item >> 2, b = row >> 12, t = row & 4095;
        float slope[4];
#pragma unroll
        for (int r = 0; r < 4; ++r) slope[r] = exp2f(-0.5f * (float)(g * 4 + r + 1));
        LDS_FENCE();
        { f32x4 qv;
#pragma unroll
          for (int r = 0; r < 4; ++r) qv[r] = bf2f(Q[(size_t)row * 1024 + (g * 4 + r) * 64 + lane]) * 0.125f;
          *(LAS f32x4*)(qs + lane * 4) = qv; }
        LDS_FENCE();
        const int nv = (t >= 31) ? (((t - 31) >> 4) + 1 < 255 ? ((t - 31) >> 4) + 1 : 255) : 0;
        float mloc[4] = {-1e30f, -1e30f, -1e30f, -1e30f};
#pragma unroll 1
        for (int c = 0; c < 4; ++c) {
            const int i = 64 * c + lane;
            f32x4 sv = (f32x4){-1e30f, -1e30f, -1e30f, -1e30f};
            if (64 * c < nv) {
                const bf16_t* krow = KC + ((size_t)(b * 256 + i) * 4 + g) * 64;
                float acc[4] = {0.f, 0.f, 0.f, 0.f};
#pragma unroll 2
                for (int d8 = 0; d8 < 8; ++d8) { const u32x4 kv = *(const u32x4*)(krow + d8 * 8);
                    const float kf[8] = {bf_lo(kv.x), bf_hi(kv.x), bf_lo(kv.y), bf_hi(kv.y), bf_lo(kv.z), bf_hi(kv.z), bf_lo(kv.w), bf_hi(kv.w)};
#pragma unroll
                    for (int e = 0; e < 8; ++e) { const f32x4 qv = *(const LAS f32x4*)(qs + (d8 * 8 + e) * 4);
#pragma unroll
                        for (int r = 0; r < 4; ++r) acc[r] += qv[r] * kf[e]; } }
                const float dist = (float)(t - (16 * i + 31));
                if (i < nv) {
#pragma unroll
                    for (int r = 0; r < 4; ++r) { sv[r] = acc[r] - slope[r] * dist; mloc[r] = fmaxf(mloc[r], sv[r]); } }
            }
            *(LAS f32x4*)(pc + i * 4) = sv;
        }
        float ssum[4] = {0.f, 0.f, 0.f, 0.f};
#pragma unroll
        for (int r = 0; r < 4; ++r) mloc[r] = wave_max(mloc[r]);
        LDS_FENCE();
#pragma unroll 1
        for (int c = 0; c < 4; ++c) {
            const int i = 64 * c + lane; f32x4 sv = *(const LAS f32x4*)(pc + i * 4);
#pragma unroll
            for (int r = 0; r < 4; ++r) { sv[r] = (sv[r] > -1e29f) ? __expf(sv[r] - mloc[r]) : 0.f; ssum[r] += sv[r]; }
            *(LAS f32x4*)(pc + i * 4) = sv;
        }
#pragma unroll
        for (int r = 0; r < 4; ++r) { const float sm = wave_sum(ssum[r]); ssum[r] = (sm > 0.f) ? 1.f / sm : 0.f; }
        LDS_FENCE();
#pragma unroll 1
        for (int c = 0; c < 4; ++c) {
            const int i = 64 * c + lane; f32x4 sv = *(const LAS f32x4*)(pc + i * 4);
#pragma unroll
            for (int r = 0; r < 4; ++r) sv[r] *= ssum[r];
            *(LAS f32x4*)(pc + i * 4) = sv; ptot[i] = (sv[0] + sv[1]) + (sv[2] + sv[3]);
        }
        LDS_FENCE();
        const int j = lane, blk = t >> 6;
        const float imp = ptot[4 * j] + ptot[4 * j + 1] + ptot[4 * j + 2] + 0.5f * ptot[4 * j + 3] + (j > 0 ? 0.5f * ptot[4 * j - 1] : 0.f);
        const bool elig = j <= blk, forced = (j == 0) || (j == blk) || (j == blk - 1);
        const float val = elig ? imp + (forced ? 1e4f : 0.f) : -1e30f;
        int rank = 0;
#pragma unroll 8
        for (int k = 0; k < 64; ++k) { const float vk = __shfl(val, k); rank += (vk > val || (vk == val && k < j)) ? 1 : 0; }
        const unsigned long long selmask = __ballot(elig && rank < 16);
        float oc[4][2] = {{0.f, 0.f}, {0.f, 0.f}, {0.f, 0.f}, {0.f, 0.f}};
        for (int i = hf; i < nv; i += 2) {
            const unsigned vv = *(const unsigned*)(VC + ((size_t)(b * 256 + i) * 4 + g) * 64 + 2 * dp); const f32x4 pp = *(const LAS f32x4*)(pc + i * 4);
            const float lo = bf_lo(vv), hi = bf_hi(vv);
#pragma unroll
            for (int r = 0; r < 4; ++r) { oc[r][0] += pp[r] * lo; oc[r][1] += pp[r] * hi; }
        }
#pragma unroll
        for (int r = 0; r < 4; ++r) { oc[r][0] += __shfl_xor(oc[r][0], 32); oc[r][1] += __shfl_xor(oc[r][1], 32); }
        OnlineSt st;
#pragma unroll
        for (int r = 0; r < 4; ++r) { st.m[r] = -1e30f; st.l[r] = 0.f; st.o[r][0] = 0.f; st.o[r][1] = 0.f; }
        const bf16_t* ksb = KS + (size_t)b * SEQ * 256 + g * 64; const bf16_t* vsb = VS + (size_t)b * SEQ * 256 + g * 64;
        for (unsigned long long mm = selmask; mm; mm &= mm - 1) { const int jj = __builtin_ctzll(mm); nsa_attend_block(st, ksb, vsb, 64 * jj, t, slope, qs, pc, lane); }
        float os[4][2];
#pragma unroll
        for (int r = 0; r < 4; ++r) { const float il = 1.f / st.l[r]; os[r][0] = (st.o[r][0] + __shfl_xor(st.o[r][0], 32)) * il; os[r][1] = (st.o[r][1] + __shfl_xor(st.o[r][1], 32)) * il; }
#pragma unroll
        for (int r = 0; r < 4; ++r) { st.m[r] = -1e30f; st.l[r] = 0.f; st.o[r][0] = 0.f; st.o[r][1] = 0.f; }
        const bf16_t* kwb = KW + (size_t)b * SEQ * 256 + g * 64; const bf16_t* vwb = VW + (size_t)b * SEQ * 256 + g * 64;
        const int lo = (t - 511 > 0) ? t - 511 : 0;
        for (int p0 = lo; p0 <= t; p0 += 64) nsa_attend_block(st, kwb, vwb, p0, t, slope, qs, pc, lane);
        const float* gp = GATES + (size_t)row * 48 + g * 12;
#pragma unroll
        for (int r = 0; r < 4; ++r) {
            const float il = 1.f / st.l[r]; const float ow0 = (st.o[r][0] + __shfl_xor(st.o[r][0], 32)) * il, ow1 = (st.o[r][1] + __shfl_xor(st.o[r][1], 32)) * il;
            const float gc = gp[r * 3 + 0], gs = gp[r * 3 + 1], gwv = gp[r * 3 + 2];
            const float o0 = gc * oc[r][0] + gs * os[r][0] + gwv * ow0, o1 = gc * oc[r][1] + gs * os[r][1] + gwv * ow1;
            if (hf == 0) *(unsigned*)(AO + (size_t)row * 1024 + (g * 4 + r) * 64 + 2 * dp) = pk2(o0, o1);
        }
    }
}

__device__ __forceinline__ void phase_mla_attn_ref(const Params& p, LAS unsigned char* lds) {
    const int lane = threadIdx.x & 63, wave = threadIdx.x >> 6;
    const int gw = blockIdx.x * NWAVES + wave, NGW = gridDim.x * NWAVES;
    LAS float* qs = (LAS float*)(lds + wave * 1024);
    LAS float* ps = qs + 128;
    const bf16_t* QF = (const bf16_t*)(p.ws + S_QF); const bf16_t* KN = (const bf16_t*)(p.ws + S_KNOPE); const bf16_t* KR = (const bf16_t*)(p.ws + S_KROPE); const bf16_t* V = (const bf16_t*)(p.ws + S_V);
    const float* rc = (const float*)(p.ws + WS_ROPE_COS); const float* rs = (const float*)(p.ws + WS_ROPE_SIN);
    bf16_t* AO = (bf16_t*)(p.ws + S_AO2);
    const float scale = 0.10206207261596577f;
    const int hf = lane >> 5, dp = lane & 31;
    for (int item = gw; item < NTOK * 16; item += NGW) {
        const int h = item & 15, row = item >> 4, b = row >> 12, t = row & 4095;
        const bf16_t* qrow = QF + (size_t)row * 1536 + h * 96; const float rq = scale;
        LDS_FENCE();
        qs[lane] = bf2f(qrow[lane]) * rq;
        if (lane < 16) { const float x1 = bf2f(qrow[64 + lane]), x2 = bf2f(qrow[80 + lane]), c = rc[t * 16 + lane], s = rs[t * 16 + lane]; qs[64 + lane] = (x1 * c - x2 * s) * rq; qs[80 + lane] = (x2 * c + x1 * s) * rq; }
        LDS_FENCE();
        float m = -1e30f, l = 0.f, o0 = 0.f, o1 = 0.f;
        for (int p0 = 0; p0 <= t; p0 += 64) {
            const int pos = p0 + lane; const bool valid = pos <= t;
            const int posc = valid ? pos : t;
            const bf16_t* kn = KN + ((size_t)(b * SEQ + posc)) * 1024 + h * 64; const bf16_t* kr = KR + ((size_t)(b * SEQ + posc)) * 32;
            float acc = 0.f;
#pragma unroll 4
            for (int d8 = 0; d8 < 12; ++d8) { const u32x4 kv = (d8 < 8) ? *(const u32x4*)(kn + d8 * 8) : *(const u32x4*)(kr + (d8 - 8) * 8);
                const f32x4 q0 = *(const LAS f32x4*)(qs + d8 * 8), q1 = *(const LAS f32x4*)(qs + d8 * 8 + 4);
                acc += q0.x * bf_lo(kv.x) + q0.y * bf_hi(kv.x) + q0.z * bf_lo(kv.y) + q0.w * bf_hi(kv.y) + q1.x * bf_lo(kv.z) + q1.y * bf_hi(kv.z) + q1.z * bf_lo(kv.w) + q1.w * bf_hi(kv.w); }
            const float s = valid ? acc : -1e30f;
            const float mn = fmaxf(m, wave_max(s)), alpha = __expf(m - mn), e = valid ? __expf(s - mn) : 0.f;
            l = l * alpha + wave_sum(e); o0 *= alpha; o1 *= alpha; m = mn;
            LDS_FENCE();
            ps[lane] = e;
            LDS_FENCE();
            const int nk = (t - p0 + 1 < 64) ? t - p0 + 1 : 64;
            for (int kk = hf; kk < nk; kk += 2) { const unsigned vv = *(const unsigned*)(V + ((size_t)(b * SEQ + p0 + kk)) * 1024 + h * 64 + 2 * dp); const float pp = ps[kk]; o0 += pp * bf_lo(vv); o1 += pp * bf_hi(vv); }
        }
        const float il = 1.f / l; o0 = (o0 + __shfl_xor(o0, 32)) * il; o1 = (o1 + __shfl_xor(o1, 32)) * il;
        if (hf == 0) *(unsigned*)(AO + (size_t)row * 1024 + h * 64 + 2 * dp) = pk2(o0, o1);
    }
}

namespace att {
typedef float f32x16 __attribute__((ext_vector_type(16)));
typedef short s16x4 __attribute__((ext_vector_type(4)));
constexpr int KSTR64 = 144, KSTR96 = 208;
constexpr int KBUF = 64 * KSTR96, VBUF = 8192;
constexpr int OFF_K = 0, OFF_V = 2 * KBUF, OFF_IMPM = OFF_V + 2 * VBUF, OFF_IMPS = OFF_IMPM + 8 * 8 * 64 * 4, OFF_SELB = OFF_IMPS + 8 * 8 * 72 * 4, OFF_UNION = OFF_SELB + 8 * 8 * 8, OFF_FIN = OFF_UNION + 16, LDS_END = OFF_FIN + 8 * 32 * 64 * 4;
static_assert(LDS_END <= 147456, "attention LDS map");
constexpr float LOG2E = 1.4426950408889634f;
__device__ __forceinline__ int crow(int r, int hi) { return (r & 3) + 8 * (r >> 2) + 4 * hi; }
__device__ __forceinline__ float xhalf(float v) { return __shfl_xor(v, 32); }

struct TileRegs { u32x4 k0, k1, v; };
__device__ __forceinline__ const char* uni_ptr(const void* p) {
    const unsigned long long v = (unsigned long long)p; const unsigned lo = __builtin_amdgcn_readfirstlane((unsigned)v), hh = __builtin_amdgcn_readfirstlane((unsigned)(v >> 32));
    return (const char*)(((unsigned long long)hh << 32) | lo);
}
template <bool MLA>
__device__ __forceinline__ void tile_load(TileRegs& R, const bf16_t* Kg, const bf16_t* KRg, const bf16_t* Vg, unsigned koff, unsigned voff, unsigned roff, int tid) {
    R.k0 = *(const u32x4*)(uni_ptr(Kg) + koff);
    R.v = *(const u32x4*)(uni_ptr(Vg) + voff);
    if (MLA) { if (tid < 256) R.k1 = *(const u32x4*)(uni_ptr(KRg) + roff); }
}
template <bool MLA, int KSTR>
__device__ __forceinline__ void tile_store(const TileRegs& R, LAS unsigned char* Kb, LAS unsigned char* Vb, int tid) {
    const int key = tid >> 3, c = tid & 7;
    *(LAS u32x4*)(Kb + key * KSTR + c * 16) = R.k0;
    if (MLA) { if (tid < 256) *(LAS u32x4*)(Kb + (tid >> 2) * KSTR + 128 + (tid & 3) * 16) = R.k1; }
    *(LAS u32x4*)(Vb + (c >> 2) * 4096 + key * 64 + (c & 3) * 16) = R.v;
}
template <int NKS, int KSTR>
__device__ __forceinline__ void qk(f32x16& p0, f32x16& p1, const LAS unsigned char* Kb, const bf16x8 (&qf)[NKS], int lane) {
    const LAS unsigned char* kp = Kb + (lane & 31) * KSTR + (lane >> 5) * 16;
#pragma unroll
    for (int r = 0; r < 16; ++r) { p0[r] = 0.f; p1[r] = 0.f; }
#pragma unroll
    for (int ks = 0; ks < NKS; ++ks) {
        const bf16x8 a0 = *(const LAS bf16x8*)(kp + ks * 32), a1 = *(const LAS bf16x8*)(kp + 32 * KSTR + ks * 32);
        p0 = __builtin_amdgcn_mfma_f32_32x32x16_bf16(a0, qf[ks], p0, 0, 0, 0);
        p1 = __builtin_amdgcn_mfma_f32_32x32x16_bf16(a1, qf[ks], p1, 0, 0, 0);
    }
}
__device__ __forceinline__ s16x4 vtr(const LAS unsigned char* p) { return __builtin_bit_cast(s16x4, __builtin_amdgcn_ds_read_tr16_b64_v4i16((LAS s16x4*)p)); }
__device__ __forceinline__ void pv(f32x16& o0, f32x16& o1, const f32x16& p0, const f32x16& p1, const LAS unsigned char* Vb, int lane) {
    const int hi = lane >> 5;
    const LAS unsigned char* vp = Vb + ((lane >> 4) & 1) * 32 + (lane & 3) * 8 + (4 * hi + ((lane & 15) >> 2)) * 64;
#pragma unroll
    for (int S = 0; S < 4; ++S) {
        u32x4 pw;
#pragma unroll
        for (int jj = 0; jj < 4; ++jj) { const int r = 8 * (S & 1) + 2 * jj; pw[jj] = (S < 2) ? pk2(p0[r], p0[r + 1]) : pk2(p1[r], p1[r + 1]); }
        const bf16x8 pf = __builtin_bit_cast(bf16x8, pw);
#pragma unroll
        for (int dh = 0; dh < 2; ++dh) {
            const s16x4 lo = vtr(vp + dh * 4096 + S * 1024), hh = vtr(vp + dh * 4096 + S * 1024 + 512);
            const bf16x8 vf = (bf16x8){lo[0], lo[1], lo[2], lo[3], hh[0], hh[1], hh[2], hh[3]};
            if (dh == 0) o0 = __builtin_amdgcn_mfma_f32_32x32x16_bf16(vf, pf, o0, 0, 0, 0); else o1 = __builtin_amdgcn_mfma_f32_32x32x16_bf16(vf, pf, o1, 0, 0, 0);
        }
    }
}
template <int PS, bool ALIBI, bool CAUS, bool WLOW, bool ROWEN>
__device__ __forceinline__ void transform(f32x16& p0, f32x16& p1, float c1, float c2, float tbf, bool en) {
#pragma unroll
    for (int r = 0; r < 16; ++r) {
        const float k0 = (float)(PS * ((r & 3) + 8 * (r >> 2))), k1 = (float)(PS * (32 + (r & 3) + 8 * (r >> 2)));
        const float d0 = tbf - k0, d1 = tbf - k1;
        float s0 = p0[r] * c1, s1 = p1[r] * c1;
        if (ALIBI) { s0 -= c2 * d0; s1 -= c2 * d1; }
        bool v0 = true, v1 = true;
        if (CAUS) { v0 = v0 && (d0 >= 0.f); v1 = v1 && (d1 >= 0.f); }
        if (WLOW) { v0 = v0 && (d0 < 512.f); v1 = v1 && (d1 < 512.f); }
        if (ROWEN) { v0 = v0 && en; v1 = v1 && en; }
        p0[r] = v0 ? s0 : -1e30f; p1[r] = v1 ? s1 : -1e30f;
    }
}
__device__ __forceinline__ float tile_max(const f32x16& p0, const f32x16& p1) {
    float a = fmaxf(p0[0], p1[0]);
#pragma unroll
    for (int r = 1; r < 16; ++r) a = fmaxf(a, fmaxf(p0[r], p1[r]));
    return fmaxf(a, xhalf(a));
}
__device__ __forceinline__ void softmax_pv(f32x16& p0, f32x16& p1, float& m, float& l, f32x16& o0, f32x16& o1, const LAS unsigned char* Vb, int lane) {
    const float mn = fmaxf(m, tile_max(p0, p1));
    if (__any(mn > m)) { const float alpha = __builtin_amdgcn_exp2f(m - mn); l *= alpha; o0 *= alpha; o1 *= alpha; m = mn; }
    const float mu = fmaxf(m, -1e20f);
    float s = 0.f;
#pragma unroll
    for (int r = 0; r < 16; ++r) { p0[r] = __builtin_amdgcn_exp2f(p0[r] - mu); p1[r] = __builtin_amdgcn_exp2f(p1[r] - mu); s += p0[r] + p1[r]; }
    l += s;
    pv(o0, o1, p0, p1, Vb, lane);
}
template <bool FIRST> __device__ __forceinline__ void fold(LAS float* fb, const f32x16& o0, const f32x16& o1, float sc, int lane) {
#pragma unroll
    for (int r = 0; r < 16; ++r) { const float a = o0[r] * sc, b = o1[r] * sc; if (FIRST) { fb[r * 64 + lane] = a; fb[(16 + r) * 64 + lane] = b; } else { fb[r * 64 + lane] += a; fb[(16 + r) * 64 + lane] += b; } }
}
__device__ __forceinline__ void store_o(bf16_t* dst  , const f32x16& f0, const f32x16& f1, int hi) {
#pragma unroll
    for (int dh = 0; dh < 2; ++dh)
#pragma unroll
        for (int a = 0; a < 4; ++a) { const f32x16& f = dh ? f1 : f0; u32x2 w; w.x = pk2(f[4 * a], f[4 * a + 1]); w.y = pk2(f[4 * a + 2], f[4 * a + 3]); *(u32x2*)(dst + 32 * dh + 8 * a + 4 * hi) = w; }
}
}

__device__ __forceinline__ void phase_nsa_attn(const Params& p, LAS unsigned char* lds) {
    using namespace att;
    const int tid0 = threadIdx.x, wave = __builtin_amdgcn_readfirstlane(tid0 >> 6);
    const bf16_t* Q = (const bf16_t*)(p.ws + S_Q); const bf16_t* KV6 = (const bf16_t*)(p.ws + S_KV6);
    const bf16_t* KS = KV6 + (size_t)2 * NTOK * 256; const bf16_t* VS = KV6 + (size_t)3 * NTOK * 256; const bf16_t* KW = KV6 + (size_t)4 * NTOK * 256; const bf16_t* VW = KV6 + (size_t)5 * NTOK * 256;
    const bf16_t* KC = (const bf16_t*)(p.ws + S_KCMP); const bf16_t* VC = (const bf16_t*)(p.ws + S_VCMP);
    const float* GATES = (const float*)(p.ws + S_GATES); bf16_t* AO = (bf16_t*)(p.ws + S_AO);
    LAS unsigned char* Kb0 = lds + OFF_K; LAS unsigned char* Vb0 = lds + OFF_V;
    LAS float* impM = (LAS float*)(lds + OFF_IMPM) + wave * 512; LAS float* impS = (LAS float*)(lds + OFF_IMPS) + wave * 576;
    LAS unsigned char* selb = lds + OFF_SELB + wave * 64; LAS unsigned long long* uni = (LAS unsigned long long*)(lds + OFF_UNION);
    const float c1 = 0.125f * LOG2E;
    const int vcu = blockIdx.x;
#pragma unroll 1
    for (int ui = 0; ui < 8; ++ui) {
        int tid = tid0; asm volatile("" : "+v"(tid));
        const int lane = tid & 63, q = lane & 31, hi = lane >> 5, tl = q & 7, rh = q >> 3;
        const unsigned koff = (unsigned)((tid >> 3) * 256 + (tid & 7) * 8) * 2u;
        const int pair = vcu >> 3, kk = vcu & 7, b = pair >> 2, g = pair & 3;
        const int tile = (ui >> 1) * 16 + ((ui & 1) ? 15 - kk : kk);
        const int q0 = tile * 64, t = q0 + 8 * wave + tl, head = 4 * g + rh;
        const size_t row = (size_t)b * SEQ + t;
        const float c2 = exp2f(-0.5f * (float)(head + 1)) * LOG2E;
        bf16x8 qf[4];
#pragma unroll
        for (int ks = 0; ks < 4; ++ks) qf[ks] = *(const bf16x8*)(Q + row * 1024 + head * 64 + ks * 16 + hi * 8);
        const float gc = GATES[row * 48 + head * 3 + 0], gs = GATES[row * 48 + head * 3 + 1], gwd = GATES[row * 48 + head * 3 + 2];
        LAS float* fb = (LAS float*)(lds + OFF_FIN) + wave * 2048;
        TileRegs R;
        for (int i = lane; i < 512; i += 64) impM[i] = 0.f;
        for (int i = lane; i < 576; i += 64) impS[i] = 0.f;
        if (tid0 == 0) *uni = 0ull;
        const int nc = (4 * tile + 3 < 255) ? 4 * tile + 3 : 255, ntc = (nc + 63) >> 6;
        const bf16_t* kcb = KC + ((size_t)b * 256 * 4 + g) * 64; const bf16_t* vcb = VC + ((size_t)b * 256 * 4 + g) * 64;
        float m = -1e30f, l = 0.f;
#pragma unroll 1
        for (int pass = 0; pass < 2; ++pass) {
            f32x16 o0, o1;
#pragma unroll
            for (int r = 0; r < 16; ++r) { o0[r] = 0.f; o1[r] = 0.f; }
            const float ltc = l + xhalf(l); const float invl = (ltc > 0.f) ? 1.f / ltc : 0.f;
            tile_load<false>(R, kcb, nullptr, vcb, koff, koff, 0u, tid);
#pragma unroll 1
            for (int T = 0; T < ntc; ++T) {
                LAS unsigned char* Kb = Kb0 + (T & 1) * KBUF; LAS unsigned char* Vb = Vb0 + (T & 1) * VBUF;
                tile_store<false, KSTR64>(R, Kb, Vb, tid);
                __syncthreads();
                if (T + 1 < ntc) tile_load<false>(R, kcb + (size_t)(T + 1) * 64 * 256, nullptr, vcb + (size_t)(T + 1) * 64 * 256, koff, koff, 0u, tid);
                f32x16 p0, p1;
                qk<4, KSTR64>(p0, p1, Kb, qf, lane);
                const float tbf = (float)(t - (16 * 64 * T + 31) - 64 * hi);
                transform<16, true, true, false, false>(p0, p1, c1, c2, tbf, true);
                if (pass == 0) {
                    const float mn = fmaxf(m, tile_max(p0, p1)); const float alpha = __builtin_amdgcn_exp2f(m - mn); const float mu = fmaxf(mn, -1e20f);
                    float s = 0.f;
#pragma unroll
                    for (int r = 0; r < 16; ++r) s += __builtin_amdgcn_exp2f(p0[r] - mu) + __builtin_amdgcn_exp2f(p1[r] - mu);
                    l = l * alpha + s; m = mn;
                } else {
                    const float mu = fmaxf(m, -1e20f);
#pragma unroll
                    for (int r = 0; r < 16; ++r) { p0[r] = __builtin_amdgcn_exp2f(p0[r] - mu); p1[r] = __builtin_amdgcn_exp2f(p1[r] - mu); }
#pragma unroll
                    for (int kbk = 0; kbk < 2; ++kbk)
#pragma unroll
                        for (int a = 0; a < 4; ++a) {
                            const f32x16& pp = kbk ? p1 : p0;
                            float mainv = (pp[4 * a] + pp[4 * a + 1] + pp[4 * a + 2] + 0.5f * pp[4 * a + 3]) * invl, spill = 0.5f * pp[4 * a + 3] * invl;
                            mainv += __shfl_xor(mainv, 8); mainv += __shfl_xor(mainv, 16); spill += __shfl_xor(spill, 8); spill += __shfl_xor(spill, 16);
                            const int jb = 16 * T + 8 * kbk + 2 * a + hi;
                            if (rh == 0) { impM[tl * 64 + jb] = mainv; impS[tl * 72 + jb + 1] = spill; }
                            __builtin_amdgcn_sched_barrier(0);
                        }
                    pv(o0, o1, p0, p1, Vb, lane);
                }
            }
            if (pass == 1) fold<true>(fb, o0, o1, gc * invl, lane);
            __syncthreads();
        }
        const int blk = tile;
        unsigned long long mymask;
        if (blk < 16) { mymask = (2ull << blk) - 1ull; }
        else {
            LDS_FENCE();
            const int stl = lane >> 3, sub = lane & 7;
            float mv[8]; int rk[8];
#pragma unroll
            for (int i = 0; i < 8; ++i) { const int j = sub * 8 + i; mv[i] = impM[stl * 64 + j] + impS[stl * 72 + j]; rk[i] = 0; }
#pragma unroll 1
            for (int j2 = 1; j2 < blk - 1; ++j2) {
                const float v2 = impM[stl * 64 + j2] + impS[stl * 72 + j2];
#pragma unroll
                for (int i = 0; i < 8; ++i) { const int j = sub * 8 + i; rk[i] += (v2 > mv[i] || (v2 == mv[i] && j2 < j)) ? 1 : 0; }
            }
            unsigned bits = 0;
#pragma unroll
            for (int i = 0; i < 8; ++i) { const int j = sub * 8 + i; const bool forced = (j == 0) || (j == blk) || (j == blk - 1); const bool sel = (j <= blk) && (forced || rk[i] < 13); bits |= sel ? (1u << i) : 0u; }
            selb[stl * 8 + sub] = (unsigned char)bits;
            LDS_FENCE();
            mymask = *(const LAS unsigned long long*)(selb + tl * 8);
        }
        { unsigned long long um = mymask;
#pragma unroll
          for (int o = 1; o < 8; o <<= 1) { const unsigned lo = __shfl_xor((unsigned)um, o), hh = __shfl_xor((unsigned)(um >> 32), o); um |= ((unsigned long long)hh << 32) | lo; }
          if (lane == 0) atomicOr((unsigned long long*)uni, um); }
        __syncthreads();
        const unsigned long long umask = *uni;
        {
            f32x16 o0, o1;
#pragma unroll
            for (int r = 0; r < 16; ++r) { o0[r] = 0.f; o1[r] = 0.f; }
            m = -1e30f; l = 0.f;
            const bf16_t* kb_ = KS + ((size_t)b * SEQ) * 256 + g * 64; const bf16_t* vb_ = VS + ((size_t)b * SEQ) * 256 + g * 64;
            unsigned long long rem = umask; int it = 0;
            int j = 63 - __builtin_clzll(rem); rem &= ~(1ull << j);
            tile_load<false>(R, kb_ + (size_t)j * 64 * 256, nullptr, vb_ + (size_t)j * 64 * 256, koff, koff, 0u, tid);
#pragma unroll 1
            for (;;) {
                LAS unsigned char* Kb = Kb0 + (it & 1) * KBUF; LAS unsigned char* Vb = Vb0 + (it & 1) * VBUF;
                tile_store<false, KSTR64>(R, Kb, Vb, tid);
                __syncthreads();
                const int jn = rem ? 63 - __builtin_clzll(rem) : -1;
                if (jn >= 0) { rem &= ~(1ull << jn); tile_load<false>(R, kb_ + (size_t)jn * 64 * 256, nullptr, vb_ + (size_t)jn * 64 * 256, koff, koff, 0u, tid); }
                const bool en = (mymask >> j) & 1ull;
                if (__any(en)) {
                    f32x16 p0, p1;
                    qk<4, KSTR64>(p0, p1, Kb, qf, lane);
                    const float tbf = (float)(t - 64 * j - 4 * hi);
                    if (j == blk) transform<1, true, true, false, true>(p0, p1, c1, c2, tbf, en); else transform<1, true, false, false, true>(p0, p1, c1, c2, tbf, en);
                    softmax_pv(p0, p1, m, l, o0, o1, Vb, lane);
                }
                if (jn < 0) break;
                j = jn; ++it;
            }
            const float lt = l + xhalf(l);
            fold<false>(fb, o0, o1, (lt > 0.f) ? gs / lt : 0.f, lane);
            __syncthreads();
        }
        {
            f32x16 o0, o1;
#pragma unroll
            for (int r = 0; r < 16; ++r) { o0[r] = 0.f; o1[r] = 0.f; }
            m = -1e30f; l = 0.f;
            const bf16_t* kb_ = KW + ((size_t)b * SEQ) * 256 + g * 64; const bf16_t* vb_ = VW + ((size_t)b * SEQ) * 256 + g * 64;
            const int jlo = (blk - 8 > 0) ? blk - 8 : 0;
            tile_load<false>(R, kb_ + (size_t)blk * 64 * 256, nullptr, vb_ + (size_t)blk * 64 * 256, koff, koff, 0u, tid);
#pragma unroll 1
            for (int j = blk, it = 0; j >= jlo; --j, ++it) {
                LAS unsigned char* Kb = Kb0 + (it & 1) * KBUF; LAS unsigned char* Vb = Vb0 + (it & 1) * VBUF;
                tile_store<false, KSTR64>(R, Kb, Vb, tid);
                __syncthreads();
                if (j > jlo) tile_load<false>(R, kb_ + (size_t)(j - 1) * 64 * 256, nullptr, vb_ + (size_t)(j - 1) * 64 * 256, koff, koff, 0u, tid);
                f32x16 p0, p1;
                qk<4, KSTR64>(p0, p1, Kb, qf, lane);
                const float tbf = (float)(t - 64 * j - 4 * hi);
                if (j == blk) transform<1, true, true, false, false>(p0, p1, c1, c2, tbf, true);
                else if (j == blk - 8) transform<1, true, false, true, false>(p0, p1, c1, c2, tbf, true);
                else transform<1, true, false, false, false>(p0, p1, c1, c2, tbf, true);
                softmax_pv(p0, p1, m, l, o0, o1, Vb, lane);
            }
            const float lt = l + xhalf(l);
            const float scw = (lt > 0.f) ? gwd / lt : 0.f;
#pragma unroll
            for (int r = 0; r < 16; ++r) { o0[r] = o0[r] * scw + fb[r * 64 + lane]; o1[r] = o1[r] * scw + fb[(16 + r) * 64 + lane]; }
            store_o(AO + row * 1024 + head * 64, o0, o1, hi);
            __syncthreads();
        }
    }
}

__device__ __forceinline__ void phase_mla_attn(const Params& p, LAS unsigned char* lds) {
    using namespace att;
    const int tid0 = threadIdx.x, wave = __builtin_amdgcn_readfirstlane(tid0 >> 6);
    const bf16_t* QF = (const bf16_t*)(p.ws + S_QF); const bf16_t* KN = (const bf16_t*)(p.ws + S_KNOPE); const bf16_t* KR = (const bf16_t*)(p.ws + S_KROPE); const bf16_t* V = (const bf16_t*)(p.ws + S_V);
    const float* rc = (const float*)(p.ws + WS_ROPE_COS); const float* rs = (const float*)(p.ws + WS_ROPE_SIN);
    bf16_t* AO = (bf16_t*)(p.ws + S_AO2);
    LAS unsigned char* Kb0 = lds + OFF_K; LAS unsigned char* Vb0 = lds + OFF_V;
    const float c1 = 0.10206207261596577f * LOG2E;
    const int vcu = blockIdx.x;
#pragma unroll 1
    for (int ui = 0; ui < 8; ++ui) {
        int tid = tid0; asm volatile("" : "+v"(tid));
        const int lane = tid & 63, q = lane & 31, hi = lane >> 5;
        const unsigned koff = (unsigned)((tid >> 3) * 1024 + (tid & 7) * 8) * 2u, roff = (unsigned)((tid >> 2) * 32 + (tid & 3) * 8) * 2u;
        const int bh = vcu >> 1, b = bh >> 4, h = bh & 15, par = vcu & 1;
        const int qb = (ui & 1) ? 15 - (ui - 1) - par : ui + par;
        const int t = 256 * qb + 32 * wave + q; const size_t row = (size_t)b * SEQ + t;
        bf16x8 qf[6];
        { const bf16_t* qrow = QF + row * 1536 + h * 96;
#pragma unroll
          for (int ks = 0; ks < 4; ++ks) qf[ks] = *(const bf16x8*)(qrow + ks * 16 + hi * 8);
          const u32x4 x1 = *(const u32x4*)(qrow + 64 + hi * 8), x2 = *(const u32x4*)(qrow + 80 + hi * 8);
          const f32x4 ca = *(const f32x4*)(rc + t * 16 + hi * 8), cb = *(const f32x4*)(rc + t * 16 + hi * 8 + 4), sa = *(const f32x4*)(rs + t * 16 + hi * 8), sb = *(const f32x4*)(rs + t * 16 + hi * 8 + 4);
          const float a1[8] = {bf_lo(x1.x), bf_hi(x1.x), bf_lo(x1.y), bf_hi(x1.y), bf_lo(x1.z), bf_hi(x1.z), bf_lo(x1.w), bf_hi(x1.w)};
          const float a2[8] = {bf_lo(x2.x), bf_hi(x2.x), bf_lo(x2.y), bf_hi(x2.y), bf_lo(x2.z), bf_hi(x2.z), bf_lo(x2.w), bf_hi(x2.w)};
          const float cc[8] = {ca.x, ca.y, ca.z, ca.w, cb.x, cb.y, cb.z, cb.w}, ss[8] = {sa.x, sa.y, sa.z, sa.w, sb.x, sb.y, sb.z, sb.w};
          u32x4 w1, w2;
#pragma unroll
          for (int jj = 0; jj < 4; ++jj) { const int e = 2 * jj;
              w1[jj] = pk2(a1[e] * cc[e] - a2[e] * ss[e], a1[e + 1] * cc[e + 1] - a2[e + 1] * ss[e + 1]);
              w2[jj] = pk2(a2[e] * cc[e] + a1[e] * ss[e], a2[e + 1] * cc[e + 1] + a1[e + 1] * ss[e + 1]); }
          qf[4] = __builtin_bit_cast(bf16x8, w1); qf[5] = __builtin_bit_cast(bf16x8, w2); }
        f32x16 o0, o1;
#pragma unroll
        for (int r = 0; r < 16; ++r) { o0[r] = 0.f; o1[r] = 0.f; }
        float m = -1e30f, l = 0.f;
        const bf16_t* knb = KN + ((size_t)b * SEQ) * 1024 + h * 64; const bf16_t* krb = KR + ((size_t)b * SEQ) * 32; const bf16_t* vb_ = V + ((size_t)b * SEQ) * 1024 + h * 64;
        const int nt = 4 * qb + 4; const int tmin = 256 * qb + 32 * wave;
        TileRegs R;
        tile_load<true>(R, knb, krb, vb_, koff, koff, roff, tid);
#pragma unroll 1
        for (int j = 0; j < nt; ++j) {
            LAS unsigned char* Kb = Kb0 + (j & 1) * KBUF; LAS unsigned char* Vb = Vb0 + (j & 1) * VBUF;
            tile_store<true, KSTR96>(R, Kb, Vb, tid);
            __syncthreads();
            if (j + 1 < nt) tile_load<true>(R, knb + (size_t)(j + 1) * 64 * 1024, krb + (size_t)(j + 1) * 64 * 32, vb_ + (size_t)(j + 1) * 64 * 1024, koff, koff, roff, tid);
            if (64 * j <= tmin + 31) {
                f32x16 p0, p1;
                qk<6, KSTR96>(p0, p1, Kb, qf, lane);
                const float tbf = (float)(t - 64 * j - 4 * hi);
                if (64 * j + 63 > tmin) transform<1, false, true, false, false>(p0, p1, c1, 0.f, tbf, true); else transform<1, false, false, false, false>(p0, p1, c1, 0.f, tbf, true);
                softmax_pv(p0, p1, m, l, o0, o1, Vb, lane);
            }
        }
        const float lt = l + xhalf(l); const float il = 1.f / lt;
        o0 *= il; o1 *= il;
        store_o(AO + row * 1024 + h * 64, o0, o1, hi);
        __syncthreads();
    }
}

__device__ __forceinline__ float pack_idx(float v, unsigned bits, unsigned mask) { return __uint_as_float((__float_as_uint(v) & ~mask) | bits); }
__device__ __forceinline__ void phase_peer_route_ref(const Params& p, LAS unsigned char* lds, int layer, const bf16_t* QP, int* EIDX, float* GW) {
    const int lane = threadIdx.x & 63, wave = threadIdx.x >> 6;
    const int gw = blockIdx.x * NWAVES + wave, NGW = gridDim.x * NWAVES;
    LAS float* qs = (LAS float*)(lds + wave * 1024);
    const bf16_t* SK = (const bf16_t*)(p.ws + WS_SUBK) + (size_t)layer * 8 * 2 * 128 * 128;
    for (int item = gw; item < NTOK * 8; item += NGW) {
        const int h = item & 7, t = item >> 3;
        LDS_FENCE();
        { const u32x2 qv = *(const u32x2*)(QP + (size_t)t * 2048 + h * 256 + lane * 4); *(LAS f32x4*)(qs + lane * 4) = (f32x4){bf_lo(qv.x), bf_hi(qv.x), bf_lo(qv.y), bf_hi(qv.y)}; }
        LDS_FENCE();
        float sv[2];
#pragma unroll
        for (int c = 0; c < 2; ++c) {
            float v[2];
#pragma unroll
            for (int kk = 0; kk < 2; ++kk) {
                const int key = lane + 64 * kk; const bf16_t* krow = SK + ((size_t)(h * 2 + c) * 128 + key) * 128;
                float acc = 0.f;
#pragma unroll 4
                for (int d8 = 0; d8 < 16; ++d8) { const u32x4 kv = *(const u32x4*)(krow + d8 * 8); const f32x4 q0 = *(const LAS f32x4*)(qs + c * 128 + d8 * 8), q1 = *(const LAS f32x4*)(qs + c * 128 + d8 * 8 + 4);
                    acc += q0.x * bf_lo(kv.x) + q0.y * bf_hi(kv.x) + q0.z * bf_lo(kv.y) + q0.w * bf_hi(kv.y) + q1.x * bf_lo(kv.z) + q1.y * bf_hi(kv.z) + q1.z * bf_lo(kv.w) + q1.w * bf_hi(kv.w); }
                v[kk] = pack_idx(acc, 127u - (unsigned)key, 127u);
            }
            float mine = 0.f;
#pragma unroll 1
            for (int n = 0; n < 16; ++n) { const float w = wave_max(fmaxf(v[0], v[1])); if (v[0] == w) v[0] = -INFINITY; if (v[1] == w) v[1] = -INFINITY; if (lane == n) mine = w; }
            sv[c] = mine;
        }
        const int a = lane & 15, bq = lane >> 4;
        const float s0 = __shfl(sv[0], a);
        float cv[4];
#pragma unroll
        for (int i = 0; i < 4; ++i) { const float s1 = __shfl(sv[1], 4 * bq + i); cv[i] = pack_idx(s0 + s1, 255u - (unsigned)(a * 16 + 4 * bq + i), 255u); }
        float cs = 0.f;
#pragma unroll 1
        for (int n = 0; n < 16; ++n) { const float w = wave_max(fmaxf(fmaxf(cv[0], cv[1]), fmaxf(cv[2], cv[3])));
#pragma unroll
            for (int i = 0; i < 4; ++i) if (cv[i] == w) cv[i] = -INFINITY;
            if (lane == n) cs = w; }
        const unsigned flat = 255u - (__float_as_uint(cs) & 255u);
        const int wa = (int)(flat >> 4) & 15, wb = (int)flat & 15;
        const unsigned i0 = 127u - (__float_as_uint(__shfl(sv[0], wa)) & 127u), i1 = 127u - (__float_as_uint(__shfl(sv[1], wb)) & 127u);
        const float mx = __shfl(cs, 0);
        const float ex = (lane < 16) ? __expf(cs - mx) : 0.f;
        const float sum = wave_sum(ex);
        if (lane < 16) { EIDX[(size_t)t * 128 + h * 16 + lane] = (int)(i0 * 128u + i1); GW[(size_t)t * 128 + h * 16 + lane] = ex / sum; }
    }
}

namespace rt {
typedef float f32x16 __attribute__((ext_vector_type(16)));
constexpr int SKSTR = 272;
constexpr int OFF_SK = 0, OFF_IDX = 2 * 128 * SKSTR, LDS_END = OFF_IDX + 8 * 64 * 32;
__device__ __forceinline__ void ce_desc(float& a, float& b) { const float hi = fmaxf(a, b), lo = fminf(a, b); a = hi; b = lo; }
__device__ __forceinline__ void sort16_desc(float (&v)[16]) {
#pragma unroll
    for (int k = 2; k <= 16; k <<= 1)
#pragma unroll
        for (int j = k >> 1; j > 0; j >>= 1)
#pragma unroll
            for (int i = 0; i < 16; ++i) { const int l = i ^ j; if (l > i) { if ((i & k) == 0) ce_desc(v[i], v[l]); else ce_desc(v[l], v[i]); } }
}
__device__ __forceinline__ void merge16_desc(float (&v)[16]) {
#pragma unroll
    for (int j = 8; j > 0; j >>= 1)
#pragma unroll
        for (int i = 0; i < 16; ++i) { const int l = i ^ j; if (l > i) ce_desc(v[i], v[l]); }
}
__device__ __forceinline__ void top16_merge(float (&a)[16], const float (&b)[16]) {
#pragma unroll
    for (int i = 0; i < 16; ++i) a[i] = fmaxf(a[i], b[15 - i]);
    merge16_desc(a);
}
}
__device__ __forceinline__ void phase_peer_route(const Params& p, LAS unsigned char* lds, int layer, const bf16_t* QP, int* EIDX, float* GW) {
    using namespace rt;
    const int tid = threadIdx.x, lane = tid & 63, wave = __builtin_amdgcn_readfirstlane(tid >> 6), tok = lane & 31, hi = lane >> 5;
    const bf16_t* SK = (const bf16_t*)(p.ws + WS_SUBK) + (size_t)layer * 8 * 2 * 128 * 128;
    LAS unsigned char* idxs = lds + OFF_IDX + wave * 2048 + lane * 32;
    const int nbpi = NTOK / 1024;
    for (int bi = blockIdx.x; bi < 8 * nbpi; bi += gridDim.x) {
        const int h = bi & 7, tb = bi >> 3;
        __syncthreads();
        for (int i = tid; i < 256 * 16; i += NTHREADS) { const int r = i >> 4, c = i & 15; *(LAS u32x4*)(lds + OFF_SK + r * SKSTR + c * 16) = *(const u32x4*)(SK + ((size_t)h * 256 + r) * 128 + c * 8); }
        __syncthreads();
#pragma unroll 1
        for (int gi = 0; gi < 4; ++gi) {
            const int t = tb * 1024 + wave * 128 + gi * 32 + tok;
            float top[2][16];
#pragma unroll
            for (int c = 0; c < 2; ++c) {
                bf16x8 qf[8];
#pragma unroll
                for (int ks = 0; ks < 8; ++ks) qf[ks] = *(const bf16x8*)(QP + (size_t)t * 2048 + h * 256 + c * 128 + ks * 16 + hi * 8);
                float cur[16];
#pragma unroll
                for (int kb = 0; kb < 4; ++kb) {
                    f32x16 acc;
#pragma unroll
                    for (int r = 0; r < 16; ++r) acc[r] = 0.f;
                    const LAS unsigned char* kp = lds + OFF_SK + (c * 128 + kb * 32 + tok) * SKSTR + hi * 16;
#pragma unroll
                    for (int ks = 0; ks < 8; ++ks) acc = __builtin_amdgcn_mfma_f32_32x32x16_bf16(*(const LAS bf16x8*)(kp + ks * 32), qf[ks], acc, 0, 0, 0);
                    float v[16];
#pragma unroll
                    for (int r = 0; r < 16; ++r) { const unsigned key = (unsigned)(32 * kb + (r & 3) + 8 * (r >> 2)) + 4u * (unsigned)hi; v[r] = __uint_as_float((__float_as_uint(acc[r]) & ~127u) | (127u - key)); }
                    sort16_desc(v);
                    if (kb == 0) {
#pragma unroll
                        for (int r = 0; r < 16; ++r) cur[r] = v[r];
                    } else top16_merge(cur, v);
                }
                float oth[16];
#pragma unroll
                for (int r = 0; r < 16; ++r) oth[r] = __shfl_xor(cur[r], 32);
                top16_merge(cur, oth);
#pragma unroll
                for (int r = 0; r < 16; ++r) top[c][r] = cur[r];
            }
            { u32x4 w0, w1;
#pragma unroll
              for (int c = 0; c < 2; ++c) {
                  u32x4 w;
#pragma unroll
                  for (int jj = 0; jj < 4; ++jj) { unsigned x = 0;
#pragma unroll
                      for (int e = 0; e < 4; ++e) x |= (127u - (__float_as_uint(top[c][4 * jj + e]) & 127u)) << (8 * e);
                      w[jj] = x; }
                  if (c == 0) w0 = w; else w1 = w; }
              *(LAS u32x4*)idxs = w0; *(LAS u32x4*)(idxs + 16) = w1; }
#define CAND(a, b) __uint_as_float((__float_as_uint(top[0][a] + top[1][b]) & ~255u) | (255u - (unsigned)(16 * (a) + (b))))
            float A[16], B[16], X[16], Y[16];
#pragma unroll
            for (int b = 0; b < 16; ++b) A[b] = CAND(0, b);
#pragma unroll
            for (int b = 0; b < 8; ++b) B[b] = CAND(1, b);
#pragma unroll
            for (int b = 8; b < 16; ++b) B[b] = -INFINITY;
            top16_merge(A, B);
            X[0] = CAND(2, 0); X[1] = CAND(2, 1); X[2] = CAND(2, 2); X[3] = CAND(2, 3); X[4] = CAND(2, 4); X[5] = CAND(3, 0); X[6] = CAND(3, 1); X[7] = CAND(3, 2); X[8] = CAND(3, 3);
            X[9] = CAND(4, 0); X[10] = CAND(4, 1); X[11] = CAND(4, 2); X[12] = CAND(5, 0); X[13] = CAND(5, 1); X[14] = CAND(6, 0); X[15] = CAND(6, 1);
            Y[0] = CAND(7, 0); Y[1] = CAND(7, 1); Y[2] = CAND(8, 0); Y[3] = CAND(9, 0); Y[4] = CAND(10, 0); Y[5] = CAND(11, 0); Y[6] = CAND(12, 0); Y[7] = CAND(13, 0); Y[8] = CAND(14, 0); Y[9] = CAND(15, 0);
#pragma unroll
            for (int i = 10; i < 16; ++i) Y[i] = -INFINITY;
#undef CAND
            sort16_desc(X); sort16_desc(Y);
            top16_merge(A, X); top16_merge(A, Y);
            float ex[16], sum = 0.f;
#pragma unroll
            for (int n = 0; n < 16; ++n) { ex[n] = __expf(A[n] - A[0]); sum += ex[n]; }
            const float inv = 1.f / sum;
            LDS_FENCE();
            if (hi == 0) {
                int* ep = EIDX + (size_t)t * 128 + h * 16;
#pragma unroll
                for (int jj = 0; jj < 4; ++jj) { u32x4 w;
#pragma unroll
                    for (int e = 0; e < 4; ++e) { const unsigned flat = 255u - (__float_as_uint(A[4 * jj + e]) & 255u); const unsigned i0 = idxs[flat >> 4], i1 = idxs[16 + (flat & 15u)]; w[e] = i0 * 128u + i1; }
                    *(u32x4*)(ep + 4 * jj) = w; }
            } else {
                float* gp = GW + (size_t)t * 128 + h * 16;
#pragma unroll
                for (int jj = 0; jj < 4; ++jj) *(f32x4*)(gp + 4 * jj) = (f32x4){ex[4 * jj] * inv, ex[4 * jj + 1] * inv, ex[4 * jj + 2] * inv, ex[4 * jj + 3] * inv};
            }
            LDS_FENCE();
        }
    }
}

__device__ __forceinline__ float dot2bf(unsigned a, unsigned b, float acc) {
    float r; asm("v_dot2c_f32_bf16 %0, %1, %2" : "=v"(r) : "v"(a), "v"(b), "0"(acc)); return r;
}
__device__ __forceinline__ float dot8(const u32x4& a, const u32x4& b, float acc) {
    acc = dot2bf(a.x, b.x, acc); acc = dot2bf(a.y, b.y, acc); acc = dot2bf(a.z, b.z, acc); acc = dot2bf(a.w, b.w, acc);
    return acc;
}
__device__ __forceinline__ void axpy8(float* o, const u32x4& v, float w) {
    o[0] += w * bf_lo(v.x); o[1] += w * bf_hi(v.x); o[2] += w * bf_lo(v.y); o[3] += w * bf_hi(v.y); o[4] += w * bf_lo(v.z); o[5] += w * bf_hi(v.z); o[6] += w * bf_lo(v.w); o[7] += w * bf_hi(v.w);
}
#if TAB_FP4
typedef u32x2 tabw_t;
__device__ __forceinline__ void dec16(float (&f)[16], const tabw_t& w) {
#pragma unroll
    for (int j = 0; j < 2; ++j) { const f32x2 a = __builtin_amdgcn_cvt_scalef32_pk_f32_fp4(w[j], 1.0f, 0), b = __builtin_amdgcn_cvt_scalef32_pk_f32_fp4(w[j], 1.0f, 1), c = __builtin_amdgcn_cvt_scalef32_pk_f32_fp4(w[j], 1.0f, 2), d = __builtin_amdgcn_cvt_scalef32_pk_f32_fp4(w[j], 1.0f, 3);
        f[8 * j] = a.x; f[8 * j + 1] = a.y; f[8 * j + 2] = b.x; f[8 * j + 3] = b.y; f[8 * j + 4] = c.x; f[8 * j + 5] = c.y; f[8 * j + 6] = d.x; f[8 * j + 7] = d.y; }
}
#else
typedef u32x4 tabw_t;
__device__ __forceinline__ void dec16(float (&f)[16], const tabw_t& w) {
#pragma unroll
    for (int j = 0; j < 4; ++j) { const f32x2 lo = __builtin_amdgcn_cvt_pk_f32_fp8((int)w[j], false), hh = __builtin_amdgcn_cvt_pk_f32_fp8((int)w[j], true); f[4 * j] = lo.x; f[4 * j + 1] = lo.y; f[4 * j + 2] = hh.x; f[4 * j + 3] = hh.y; }
}
#endif
__device__ __forceinline__ void phase_peer_gather(const Params& p, int layer, const int* EIDX, const float* GW, const bf16_t* HB, bf16_t* HBO, float* OUT, float fs) {
    const int lane = threadIdx.x & 63, wave = threadIdx.x >> 6;
    const int gw = blockIdx.x * NWAVES + wave, NGW = gridDim.x * NWAVES;
    const unsigned char* U8 = p.ws + WS_TAB + (size_t)layer * 2 * TAB_BYTES; const unsigned char* V8 = U8 + TAB_BYTES;
    const float* lg = p.in[I_PEER_LNG] + layer * 1024; const float* lb = p.in[I_PEER_LNB] + layer * 1024;
    for (int t = gw; t < NTOK; t += NGW) {
        const u32x4 x0 = *(const u32x4*)(HB + (size_t)t * 1024 + lane * 16), x1 = *(const u32x4*)(HB + (size_t)t * 1024 + lane * 16 + 8);
        const float xf[16] = {bf_lo(x0.x), bf_hi(x0.x), bf_lo(x0.y), bf_hi(x0.y), bf_lo(x0.z), bf_hi(x0.z), bf_lo(x0.w), bf_hi(x0.w), bf_lo(x1.x), bf_hi(x1.x), bf_lo(x1.y), bf_hi(x1.y), bf_lo(x1.z), bf_hi(x1.z), bf_lo(x1.w), bf_hi(x1.w)};
        const int e0 = EIDX[(size_t)t * 128 + lane], e1 = EIDX[(size_t)t * 128 + 64 + lane];
        const float g0 = GW[(size_t)t * 128 + lane], g1 = GW[(size_t)t * 128 + 64 + lane];
        float o[16];
#pragma unroll
        for (int i = 0; i < 16; ++i) o[i] = 0.f;
#pragma unroll 1
        for (int half = 0; half < 2; ++half) {
            const int eh = half ? e1 : e0; const float gh = half ? g1 : g0;
#pragma unroll 1
            for (int kb = 0; kb < 64; kb += 8) {
                tabw_t uw[8], vw[8]; float gg[8];
#pragma unroll
                for (int i = 0; i < 8; ++i) { const int e = __shfl(eh, kb + i); gg[i] = __shfl(gh, kb + i);
                    uw[i] = *(const tabw_t*)(U8 + (size_t)e * TAB_ROW + lane * (TAB_ROW / 64)); vw[i] = *(const tabw_t*)(V8 + (size_t)e * TAB_ROW + lane * (TAB_ROW / 64)); }
#pragma unroll
                for (int i = 0; i < 8; ++i) {
                    float uf[16]; dec16(uf, uw[i]);
                    float d0 = 0.f, d1 = 0.f;
#pragma unroll
                    for (int j = 0; j < 8; ++j) { d0 += xf[2 * j] * uf[2 * j]; d1 += xf[2 * j + 1] * uf[2 * j + 1]; }
                    const float d = wave_sum(d0 + d1) * (1.f / U_SCALE);
                    const float w = gg[i] * gelu_tanh(d);
                    float vf[16]; dec16(vf, vw[i]);
#pragma unroll
                    for (int j = 0; j < 16; ++j) o[j] += w * vf[j];
                }
            }
        }
        float z[16]; float s = 0.f;
#pragma unroll
        for (int i = 0; i < 16; ++i) { z[i] = DN_ALPHA * xf[i] + fs * (1.f / V_SCALE) * o[i]; s += z[i]; }
        const float mean = wave_sum(s) * (1.f / 1024.f); float q = 0.f;
#pragma unroll
        for (int i = 0; i < 16; ++i) { z[i] -= mean; q += z[i] * z[i]; }
        const float rstd = rsqrtf(wave_sum(q) * (1.f / 1024.f) + LN_EPS);
#pragma unroll
        for (int j = 0; j < 4; ++j) { const f32x4 ga = *(const f32x4*)(lg + lane * 16 + 4 * j), ba = *(const f32x4*)(lb + lane * 16 + 4 * j);
#pragma unroll
            for (int i = 0; i < 4; ++i) z[4 * j + i] = z[4 * j + i] * rstd * ga[i] + ba[i]; }
        if (OUT) {
#pragma unroll
            for (int j = 0; j < 4; ++j) *(f32x4*)(OUT + (size_t)t * 1024 + lane * 16 + 4 * j) = (f32x4){z[4 * j], z[4 * j + 1], z[4 * j + 2], z[4 * j + 3]};
        } else {
            u32x4 w0, w1; w0.x = pk2(z[0], z[1]); w0.y = pk2(z[2], z[3]); w0.z = pk2(z[4], z[5]); w0.w = pk2(z[6], z[7]); w1.x = pk2(z[8], z[9]); w1.y = pk2(z[10], z[11]); w1.z = pk2(z[12], z[13]); w1.w = pk2(z[14], z[15]);
            *(u32x4*)(HBO + (size_t)t * 1024 + lane * 16) = w0; *(u32x4*)(HBO + (size_t)t * 1024 + lane * 16 + 8) = w1;
        }
    }
}

__device__ __forceinline__ void phase_peer_gather6(const Params& p, int layer, const int* EIDX, const float* GW, const bf16_t* HB, bf16_t* HBO, float* OUT, float fs) {
    const int lane = threadIdx.x & 63, wave = threadIdx.x >> 6, hl = lane & 31, half = lane >> 5;
    const int gw = blockIdx.x * NWAVES + wave, NGW = gridDim.x * NWAVES;
    const unsigned char* U6 = p.ws + WS_TAB + (size_t)layer * 2 * TAB_BYTES; const unsigned char* V6 = U6 + TAB_BYTES;
    const float* lg = p.in[I_PEER_LNG] + layer * 1024; const float* lb = p.in[I_PEER_LNB] + layer * 1024;
    for (int t = gw; t < NTOK; t += NGW) {
        float xf[32];
#pragma unroll
        for (int j = 0; j < 4; ++j) { const u32x4 xv = *(const u32x4*)(HB + (size_t)t * 1024 + hl * 32 + j * 8);
            xf[8 * j] = bf_lo(xv.x); xf[8 * j + 1] = bf_hi(xv.x); xf[8 * j + 2] = bf_lo(xv.y); xf[8 * j + 3] = bf_hi(xv.y); xf[8 * j + 4] = bf_lo(xv.z); xf[8 * j + 5] = bf_hi(xv.z); xf[8 * j + 6] = bf_lo(xv.w); xf[8 * j + 7] = bf_hi(xv.w); }
        const int e0 = EIDX[(size_t)t * 128 + lane], e1 = EIDX[(size_t)t * 128 + 64 + lane];
        const float g0 = GW[(size_t)t * 128 + lane], g1 = GW[(size_t)t * 128 + 64 + lane];
        float o[32];
#pragma unroll
        for (int i = 0; i < 32; ++i) o[i] = 0.f;
#pragma unroll 1
        for (int hs = 0; hs < 2; ++hs) {
            const int eh = hs ? e1 : e0; const float gh = hs ? g1 : g0;
#pragma unroll 1
            for (int kb = 0; kb < 64; kb += 8) {
                u32x4 ua[4], va[4]; u32x2 ub[4], vb[4]; float gg[4];
#pragma unroll
                for (int i = 0; i < 4; ++i) { const int k = kb + 2 * i + half; const int e = __shfl(eh, k); gg[i] = __shfl(gh, k);
                    const unsigned char* ur = U6 + (size_t)e * 768 + hl * 24; const unsigned char* vr = V6 + (size_t)e * 768 + hl * 24;
                    ua[i] = *(const u32x4*)ur; ub[i] = *(const u32x2*)(ur + 16); va[i] = *(const u32x4*)vr; vb[i] = *(const u32x2*)(vr + 16); }
#pragma unroll
                for (int i = 0; i < 4; ++i) {
                    const v32f_t uf = __builtin_amdgcn_cvt_scalef32_pk32_f32_fp6((v6u_t){ua[i].x, ua[i].y, ua[i].z, ua[i].w, ub[i].x, ub[i].y}, 1.0f);
                    float d0 = 0.f, d1 = 0.f;
#pragma unroll
                    for (int j = 0; j < 16; ++j) { d0 += xf[2 * j] * uf[2 * j]; d1 += xf[2 * j + 1] * uf[2 * j + 1]; }
                    float d = d0 + d1;
#pragma unroll
                    for (int ofs = 16; ofs >= 1; ofs >>= 1) d += __shfl_xor(d, ofs);
                    const float w = gg[i] * gelu_tanh(d * (1.f / U_SCALE));
                    const v32f_t vf = __builtin_amdgcn_cvt_scalef32_pk32_f32_fp6((v6u_t){va[i].x, va[i].y, va[i].z, va[i].w, vb[i].x, vb[i].y}, 1.0f);
#pragma unroll
                    for (int j = 0; j < 32; ++j) o[j] += w * vf[j];
                }
            }
        }
        float z[32]; float s = 0.f;
#pragma unroll
        for (int i = 0; i < 32; ++i) { const float ot = o[i] + __shfl_xor(o[i], 32); z[i] = DN_ALPHA * xf[i] + fs * (1.f / V_SCALE) * ot; s += z[i]; }
#pragma unroll
        for (int ofs = 16; ofs >= 1; ofs >>= 1) s += __shfl_xor(s, ofs);
        const float mean = s * (1.f / 1024.f); float q = 0.f;
#pragma unroll
        for (int i = 0; i < 32; ++i) { z[i] -= mean; q += z[i] * z[i]; }
#pragma unroll
        for (int ofs = 16; ofs >= 1; ofs >>= 1) q += __shfl_xor(q, ofs);
        const float rstd = rsqrtf(q * (1.f / 1024.f) + LN_EPS);
        float y[16]; const int c0 = hl * 32 + half * 16;
#pragma unroll
        for (int j = 0; j < 4; ++j) { const f32x4 ga = *(const f32x4*)(lg + c0 + 4 * j), ba = *(const f32x4*)(lb + c0 + 4 * j);
#pragma unroll
            for (int i = 0; i < 4; ++i) { float za = z[4 * j + i], zb = z[16 + 4 * j + i]; asm volatile("" : "+v"(za), "+v"(zb));
                const float zz = half ? zb : za; y[4 * j + i] = zz * rstd * ga[i] + ba[i]; } }
        if (OUT) {
#pragma unroll
            for (int j = 0; j < 4; ++j) *(f32x4*)(OUT + (size_t)t * 1024 + c0 + 4 * j) = (f32x4){y[4 * j], y[4 * j + 1], y[4 * j + 2], y[4 * j + 3]};
        } else {
            u32x4 w0, w1; w0.x = pk2(y[0], y[1]); w0.y = pk2(y[2], y[3]); w0.z = pk2(y[4], y[5]); w0.w = pk2(y[6], y[7]); w1.x = pk2(y[8], y[9]); w1.y = pk2(y[10], y[11]); w1.z = pk2(y[12], y[13]); w1.w = pk2(y[14], y[15]);
            *(u32x4*)(HBO + (size_t)t * 1024 + c0) = w0; *(u32x4*)(HBO + (size_t)t * 1024 + c0 + 8) = w1;
        }
    }
}

#define XB_TMO      128
#define XB_XCNT(j)  (256  + 64 * (j))
#define XB_XSUB(j)  (1280 + 64 * (j))
#define XB_XGEN(j)  (2304 + 64 * (j))
#define XB_TOP      3328
#define XB_TOPGEN   3392
#define XCD_BAR_WORDS 3456
#define XB_SPIN_CAP (1u << 18)
__device__ __forceinline__ unsigned xb_ld(unsigned* p)              { return __hip_atomic_load(p, __ATOMIC_RELAXED, __HIP_MEMORY_SCOPE_AGENT); }
__device__ __forceinline__ unsigned xb_add(unsigned* p, unsigned v) { return __hip_atomic_fetch_add(p, v, __ATOMIC_RELAXED, __HIP_MEMORY_SCOPE_AGENT); }
__device__ __forceinline__ unsigned xb_xcc_id() { return (unsigned)__builtin_amdgcn_s_getreg((3 << 11) | 20) & 0xFu; }
#define XB_SPIN(cond, bar) do { unsigned _sp = 0; while (cond) { __builtin_amdgcn_s_sleep(1); \
    if ((++_sp & 255u) == 0u) { if (xb_ld(&(bar)[XB_TMO])) break; if (_sp > XB_SPIN_CAP) { atomicAdd(&(bar)[XB_TMO], 1u); break; } } } } while (0)
struct XcdBarrier { unsigned* bar; unsigned x; volatile LAS unsigned* st; };
__device__ __forceinline__ XcdBarrier xcd_barrier_post(unsigned* bar, volatile LAS unsigned* st) {
    XcdBarrier b; b.bar = bar; b.x = xb_xcc_id(); b.st = st;
    if (threadIdx.x == 0) (void)xb_add(&bar[XB_XCNT(b.x)], 1u);
    return b;
}
__device__ __forceinline__ void xcd_barrier_complete(unsigned* bar, unsigned x, unsigned& nloc, unsigned& nx) {
    const unsigned G = gridDim.x * gridDim.y * gridDim.z;
    unsigned sum, cnt, mine, sp = 0u;
    for (;;) {
        sum = 0u; cnt = 0u; mine = 0u;
#pragma unroll
        for (unsigned j = 0; j < 16; ++j) { const unsigned c = xb_ld(&bar[XB_XCNT(j)]); sum += c; cnt += (c > 0u) ? 1u : 0u; mine = (j == x) ? c : mine; }
        if (sum == G) break;
        __builtin_amdgcn_s_sleep(1);
        if ((++sp & 255u) == 0u) { if (xb_ld(&bar[XB_TMO])) break; if (sp > XB_SPIN_CAP) { atomicAdd(&bar[XB_TMO], 1u); break; } }
    }
    nloc = mine > 0u ? mine : 1u; nx = cnt > 0u ? cnt : 1u;
}
__device__ __forceinline__ void xcd_barrier(const XcdBarrier& b) {
    asm volatile("s_waitcnt vmcnt(0)" ::: "memory");
    __syncthreads();
    if (threadIdx.x == 0) {
        unsigned* bar = b.bar;
        __builtin_amdgcn_s_waitcnt(0);
        unsigned nloc = b.st[0], nx = b.st[1];
        if (nloc == 0u) { xcd_barrier_complete(bar, b.x, nloc, nx); b.st[0] = nloc; b.st[1] = nx; }
        const unsigned old = xb_add(&bar[XB_XSUB(b.x)], 1u);
        const unsigned gen = old / nloc;
        if (old + 1u == (gen + 1u) * nloc) {
            __builtin_amdgcn_fence(__ATOMIC_RELEASE, "agent");
            asm volatile("s_waitcnt vmcnt(0)" ::: "memory");
            const unsigned og = xb_add(&bar[XB_TOP], 1u);
            const unsigned tg = og / nx;
            if (og + 1u == (tg + 1u) * nx) xb_add(&bar[XB_TOPGEN], 1u);
            else XB_SPIN(xb_ld(&bar[XB_TOPGEN]) == tg, bar);
            __builtin_amdgcn_fence(__ATOMIC_ACQUIRE, "agent");
            xb_add(&bar[XB_XGEN(b.x)], 1u);
            asm volatile("s_waitcnt vmcnt(0)" ::: "memory");
        } else {
            XB_SPIN(xb_ld(&bar[XB_XGEN(b.x)]) == gen, bar);
            __builtin_amdgcn_fence(__ATOMIC_ACQUIRE, "agent");
            asm volatile("s_waitcnt vmcnt(0)" ::: "memory");
        }
    }
    __syncthreads();
}

constexpr int NPHASES = 19;
#if TAB_MODE == 6
#define PEER_GATHER phase_peer_gather6
#else
#define PEER_GATHER phase_peer_gather
#endif
__global__ void __launch_bounds__(NTHREADS, 2) fwd_kernel(Params p) {
    extern __shared__ __attribute__((aligned(16))) unsigned char lds_raw[];
    LAS unsigned char* lds = (LAS unsigned char*)lds_raw;
    unsigned char* ws = p.ws;
    bf16_t* HB = (bf16_t*)(ws + WS_HB);
    const int lo = p.ph_lo, hi = p.ph_hi;
    volatile LAS unsigned* bst = (volatile LAS unsigned*)(lds + LDS_BYTES - 64);
    if (threadIdx.x < 16) bst[threadIdx.x] = 0u;
    __syncthreads();
    XcdBarrier gbar; gbar.bar = (unsigned*)(ws + WS_CTL) + 4096; gbar.x = 0; gbar.st = bst;
    if (hi - lo > 1) { cg::this_grid().sync();
        gbar = xcd_barrier_post((unsigned*)(ws + WS_CTL) + 4096, bst); }
#ifndef PH_MASK
#define PH_MASK 0xFFFFFFFFu
#endif
#define IN(k) (((PH_MASK >> (k)) & 1u) && lo <= (k) && (k) < hi)
#define SEAM(k) do { if (IN(k) && IN((k) + 1)) { xcd_barrier(gbar); } } while (0)
    if (IN(0)) for (int rep_ = 0; rep_ < ((PROBE_REP == 0) ? 1 + PROBE_N : 1); ++rep_) { phase_prologue(p, lds); } SEAM(0);
    if (IN(1)) for (int rep_ = 0; rep_ < ((PROBE_REP == 1) ? 1 + PROBE_N : 1); ++rep_) { EpiNsaProj E{(bf16_t*)(ws + S_Q), (bf16_t*)(ws + S_KV6), (float*)(ws + S_GATES)};
        run_gemm(lds, HB, 1024, (const bf16_t*)(ws + WS_W_IN_T), 1024, NTOK, NSA_IN_PAD, 1024, (int)blockIdx.x, E); } SEAM(1);
    if (IN(2)) for (int rep_ = 0; rep_ < ((PROBE_REP == 2) ? 1 + PROBE_N : 1); ++rep_) { EpiF32 Ek{(float*)(ws + S_PK), 256}, Ev{(float*)(ws + S_PV), 256};
        run_gemm(lds, (const bf16_t*)(ws + S_KV6), 1024, (const bf16_t*)(ws + WS_W_CK1_T), 1024, 8192, 256, 1024, (int)blockIdx.x, Ek);
        run_gemm(lds, (const bf16_t*)(ws + S_KV6) + (size_t)NTOK * 256, 1024, (const bf16_t*)(ws + WS_W_CV1_T), 1024, 8192, 256, 1024, (int)((blockIdx.x + gridDim.x / 2) % gridDim.x), Ev); } SEAM(2);
    if (IN(3)) for (int rep_ = 0; rep_ < ((PROBE_REP == 3) ? 1 + PROBE_N : 1); ++rep_) { phase_cmp_finish(p, lds); } SEAM(3);
    if (IN(4)) for (int rep_ = 0; rep_ < ((PROBE_REP == 4) ? 1 + PROBE_N : 1); ++rep_) { if (USE_MFMA_NSA) phase_nsa_attn(p, lds); else phase_nsa_attn_ref(p, lds); } SEAM(4);
    if (IN(5)) for (int rep_ = 0; rep_ < ((PROBE_REP == 5) ? 1 + PROBE_N : 1); ++rep_) { EpiResid E{HB, (bf16_t*)(ws + S_Z), (ABL & 1) ? 0.f : 1.f};
        run_gemm(lds, (const bf16_t*)(ws + S_AO), 1024, (const bf16_t*)(ws + WS_W_NSAOUT_T), 1024, NTOK, 1024, 1024, (int)blockIdx.x, E); } SEAM(5);
    if (IN(6)) for (int rep_ = 0; rep_ < ((PROBE_REP == 6) ? 1 + PROBE_N : 1); ++rep_) { phase_ln((const bf16_t*)(ws + S_Z), HB, p.in[I_NSA_LNG], p.in[I_NSA_LNB]); } SEAM(6);
    if (IN(7)) for (int rep_ = 0; rep_ < ((PROBE_REP == 7) ? 1 + PROBE_N : 1); ++rep_) { EpiBf16 E{(bf16_t*)(ws + S_QP0), 2048};
        run_gemm(lds, HB, 1024, (const bf16_t*)(ws + WS_W_PQ_T), 1024, NTOK, 2048, 1024, (int)blockIdx.x, E); } SEAM(7);
    if (IN(8) && ((PROBE_DUP & 1) || PROBE_REP == 8)) for (int rep_ = 0; rep_ < PROBE_N; ++rep_) { phase_peer_route(p, lds, 0, (const bf16_t*)(ws + S_QP0), (int*)(ws + S_Z), (float*)(ws + S_Z + 16 * MiB)); }
    if (IN(8)) { if (USE_MFMA_ROUTE) phase_peer_route(p, lds, 0, (const bf16_t*)(ws + S_QP0), (int*)(ws + S_EIDX0), (float*)(ws + S_GW0)); else phase_peer_route_ref(p, lds, 0, (const bf16_t*)(ws + S_QP0), (int*)(ws + S_EIDX0), (float*)(ws + S_GW0)); } SEAM(8);
    if (IN(9) && ((PROBE_DUP & 2) || PROBE_REP == 9)) for (int rep_ = 0; rep_ < PROBE_N; ++rep_) { PEER_GATHER(p, 0, (const int*)(ws + S_EIDX0), (const float*)(ws + S_GW0), HB, (bf16_t*)(ws + S_Z), nullptr, 1.f); }
    if (IN(9)) { PEER_GATHER(p, 0, (const int*)(ws + S_EIDX0), (const float*)(ws + S_GW0), HB, HB, nullptr, (ABL & 2) ? 0.f : 1.f); } SEAM(9);
    if (IN(10)) for (int rep_ = 0; rep_ < ((PROBE_REP == 10) ? 1 + PROBE_N : 1); ++rep_) { EpiBf16 E{(bf16_t*)(ws + S_DQ), MLA_DOWN_PAD};
        run_gemm(lds, HB, 1024, (const bf16_t*)(ws + WS_W_MLADOWN_T), 1024, NTOK, MLA_DOWN_PAD, 1024, (int)blockIdx.x, E); } SEAM(10);
    if (IN(11)) for (int rep_ = 0; rep_ < ((PROBE_REP == 11) ? 1 + PROBE_N : 1); ++rep_) { phase_mla_rowstats(p); } SEAM(11);
    if (IN(12)) for (int rep_ = 0; rep_ < ((PROBE_REP == 12) ? 1 + PROBE_N : 1); ++rep_) { EpiBf16 Eq{(bf16_t*)(ws + S_QF), 1536}; EpiKV Ekv{(bf16_t*)(ws + S_KNOPE), (bf16_t*)(ws + S_V)};
        run_gemm(lds, (const bf16_t*)(ws + S_DQ), MLA_DOWN_PAD, (const bf16_t*)(ws + WS_W_UQ_T), 768, NTOK, 1536, 768, (int)blockIdx.x, Eq);
        run_gemm(lds, (const bf16_t*)(ws + S_DQ) + 768, MLA_DOWN_PAD, (const bf16_t*)(ws + WS_W_UKV_T), 256, NTOK, 2048, 256, (int)blockIdx.x, Ekv); } SEAM(12);
    if (IN(13)) for (int rep_ = 0; rep_ < ((PROBE_REP == 13) ? 1 + PROBE_N : 1); ++rep_) { if (USE_MFMA_MLA) phase_mla_attn(p, lds); else phase_mla_attn_ref(p, lds); } SEAM(13);
    if (IN(14)) for (int rep_ = 0; rep_ < ((PROBE_REP == 14) ? 1 + PROBE_N : 1); ++rep_) { EpiResid E{HB, (bf16_t*)(ws + S_Z2), (ABL & 4) ? 0.f : 1.f};
        run_gemm(lds, (const bf16_t*)(ws + S_AO2), 1024, (const bf16_t*)(ws + WS_W_MLAOUT_T), 1024, NTOK, 1024, 1024, (int)blockIdx.x, E); } SEAM(14);
    if (IN(15)) for (int rep_ = 0; rep_ < ((PROBE_REP == 15) ? 1 + PROBE_N : 1); ++rep_) { phase_ln((const bf16_t*)(ws + S_Z2), HB, p.in[I_MLA_LNG], p.in[I_MLA_LNB]); } SEAM(15);
    if (IN(16)) for (int rep_ = 0; rep_ < ((PROBE_REP == 16) ? 1 + PROBE_N : 1); ++rep_) { EpiBf16 E{(bf16_t*)(ws + S_QP1), 2048};
        run_gemm(lds, HB, 1024, (const bf16_t*)(ws + WS_W_PQ_T) + (size_t)2048 * 1024, 1024, NTOK, 2048, 1024, (int)blockIdx.x, E); } SEAM(16);
    if (IN(17) && ((PROBE_DUP & 1) || PROBE_REP == 17)) for (int rep_ = 0; rep_ < PROBE_N; ++rep_) { phase_peer_route_ref(p, lds, 1, (const bf16_t*)(ws + S_QP1), (int*)(ws + S_EIDX1), (float*)(ws + S_GW1)); }
    if (IN(17)) { if (USE_MFMA_ROUTE) phase_peer_route(p, lds, 1, (const bf16_t*)(ws + S_QP1), (int*)(ws + S_EIDX1), (float*)(ws + S_GW1)); else phase_peer_route_ref(p, lds, 1, (const bf16_t*)(ws + S_QP1), (int*)(ws + S_EIDX1), (float*)(ws + S_GW1)); } SEAM(17);
    if (IN(18) && ((PROBE_DUP & 2) || PROBE_REP == 18)) for (int rep_ = 0; rep_ < PROBE_N; ++rep_) { PEER_GATHER(p, 1, (const int*)(ws + S_EIDX1), (const float*)(ws + S_GW1), HB, (bf16_t*)(ws + S_Z2), nullptr, 1.f); }
    if (IN(18)) { PEER_GATHER(p, 1, (const int*)(ws + S_EIDX1), (const float*)(ws + S_GW1), HB, HB, p.out, (ABL & 8) ? 0.f : 1.f); }
#if DBG_STAT == 7
    if (IN(18)) { xcd_barrier(gbar);
        typedef float v16f_ __attribute__((ext_vector_type(16))); typedef float v32f_ __attribute__((ext_vector_type(32))); typedef unsigned v6u_ __attribute__((ext_vector_type(6)));
        v16f_ a, b;
#pragma unroll
        for (int i = 0; i < 16; ++i) { a[i] = 0.125f * (float)i; b[i] = (i < 8) ? 2.f + 0.25f * (float)i : 4.f + 0.5f * (float)(i - 8); }
        asm volatile("" : "+v"(a), "+v"(b));
        const v6u_ pk = __builtin_amdgcn_cvt_scalef32_2xpk16_fp6_f32(a, b, 1.0f);
        const v32f_ r = __builtin_amdgcn_cvt_scalef32_pk32_f32_fp6(pk, 1.0f);
        bool seq = true, itl = true;
#pragma unroll
        for (int i = 0; i < 16; ++i) { seq = seq && (r[i] == a[i]) && (r[16 + i] == b[i]); itl = itl && (r[2 * i] == a[i]) && (r[2 * i + 1] == b[i]); }
        const float c = seq ? 1.f : (itl ? 2.f : 3.f);
        for (size_t i = (size_t)blockIdx.x * NTHREADS + threadIdx.x; i < (size_t)NTOK * DM; i += (size_t)gridDim.x * NTHREADS) p.out[i] = c; }
#elif DBG_STAT
    if (IN(18)) { asm volatile("s_waitcnt vmcnt(0) lgkmcnt(0)" ::: "memory"); __builtin_amdgcn_fence(__ATOMIC_RELEASE, "agent"); cg::this_grid().sync(); __builtin_amdgcn_fence(__ATOMIC_ACQUIRE, "agent");
        const float c = 1.f + __hip_atomic_load((float*)(ws + WS_CTL) + 16, __ATOMIC_RELAXED, __HIP_MEMORY_SCOPE_AGENT);
        for (size_t i = (size_t)blockIdx.x * NTHREADS + threadIdx.x; i < (size_t)NTOK * DM; i += (size_t)gridDim.x * NTHREADS) p.out[i] = c; }
#endif
#undef IN
#undef SEAM
}

extern "C" void kernel_launch(void* const* d_in, const int* in_sizes, int n_in, void* d_out, int out_size, void* d_ws, size_t ws_size, hipStream_t stream) {
    static int grid = 0;
    if (grid == 0) {
        if (n_in != 28 || out_size != NTOK * DM || ws_size < WS_NEED) { fprintf(stderr, "kernel_launch: unexpected problem (n_in %d, out %d, ws %zu)\n", n_in, out_size, ws_size); grid = -1; return; }
        int dev = 0, cus = 0, per_cu = 0;
        (void)hipGetDevice(&dev); (void)hipDeviceGetAttribute(&cus, hipDeviceAttributeMultiprocessorCount, dev);
        if (hipFuncSetAttribute((const void*)fwd_kernel, hipFuncAttributeMaxDynamicSharedMemorySize, LDS_BYTES) != hipSuccess) { fprintf(stderr, "kernel_launch: hipFuncSetAttribute failed\n"); grid = -1; return; }
        if (hipOccupancyMaxActiveBlocksPerMultiprocessor(&per_cu, (const void*)fwd_kernel, NTHREADS, LDS_BYTES) != hipSuccess || per_cu < 1) { fprintf(stderr, "kernel_launch: occupancy query says %d blocks per CU\n", per_cu); grid = -1; return; }
        grid = cus;
    }
    if (grid < 0) return;
    if (hipMemsetAsync((char*)d_ws + WS_CTL, 0, CTL_BYTES, stream) != hipSuccess) { fprintf(stderr, "kernel_launch: memset of the control words failed\n"); return; }
    Params p{};
    for (int i = 0; i < 28; ++i) p.in[i] = (const float*)d_in[i];
    p.out = (float*)d_out; p.ws = (unsigned char*)d_ws;
#if MK_ONE_LAUNCH
    p.ph_lo = 0; p.ph_hi = NPHASES;
    void* args[] = {&p};
    hipError_t e = hipLaunchCooperativeKernel((const void*)fwd_kernel, dim3(grid), dim3(NTHREADS), args, LDS_BYTES, stream);
    if (e != hipSuccess) fprintf(stderr, "kernel_launch: cooperative launch failed: %s\n", hipGetErrorString(e));
#else
    for (int k = 0; k < NPHASES; ++k) { p.ph_lo = k; p.ph_hi = k + 1; hipLaunchKernelGGL(fwd_kernel, dim3(grid), dim3(NTHREADS), LDS_BYTES, stream, p); }
#endif
}
#ifdef REGTEST
__global__ void __launch_bounds__(256) regtest_nsa(Params p) { extern __shared__ __attribute__((aligned(16))) unsigned char l2[]; phase_nsa_attn(p, (LAS unsigned char*)l2); }
__global__ void __launch_bounds__(256) regtest_mla(Params p) { extern __shared__ __attribute__((aligned(16))) unsigned char l2[]; phase_mla_attn(p, (LAS unsigned char*)l2); }
#endif
```

```cpp
#include <hip/hip_runtime.h>
#include <hip/hip_cooperative_groups.h>
#include <cstdio>
#include <cstdint>
namespace cg = cooperative_groups;

#ifndef ABL
#define ABL 0
#endif
#ifndef PROBE_DUP
#define PROBE_DUP 0
#endif
#ifndef MLA_VAR
#define MLA_VAR -1
#endif
#ifndef V_FP4
#define V_FP4 1
#endif
#ifndef U_MM
#define U_MM 1
#endif
#ifndef U_SPLIT
#define U_SPLIT 1
#endif
#ifndef V_SPLIT
#define V_SPLIT 1
#endif
#ifndef PROBE_REP2
#define PROBE_REP2 -1
#endif
#ifndef PROBE_REP
#define PROBE_REP -1
#endif
#ifndef PROBE_N
#define PROBE_N 2
#endif
#ifndef TAB_MODE
#define TAB_MODE 6
#endif
#define TAB_FP4 (TAB_MODE == 4)
#ifndef SPLIT_UV
#define SPLIT_UV 1
#endif
#ifndef USE_MFMA_ROUTE
#define USE_MFMA_ROUTE 1
#endif
#ifndef USE_MFMA_NSA
#define USE_MFMA_NSA 1
#endif
#ifndef USE_MFMA_MLA
#define USE_MFMA_MLA 1
#endif
#ifndef DBG_TIME
#define DBG_TIME 0u
#endif
#ifndef DBG_STAT
#define DBG_STAT 0
#endif
#ifndef MK_ONE_LAUNCH
#define MK_ONE_LAUNCH 1
#endif

#define LAS __attribute__((address_space(3)))
typedef unsigned short bf16_t;
typedef short bf16x8 __attribute__((ext_vector_type(8)));
typedef float f32x4 __attribute__((ext_vector_type(4)));
typedef float f32x2 __attribute__((ext_vector_type(2)));
typedef unsigned u32x4 __attribute__((ext_vector_type(4)));
typedef unsigned u32x2 __attribute__((ext_vector_type(2)));
typedef __bf16 bf16x2_t __attribute__((ext_vector_type(2)));

constexpr int BATCH = 8, SEQ = 4096, DM = 1024, NTOK = BATCH * SEQ;
constexpr int NSA_IN = 2608, NSA_IN_PAD = 2816;
constexpr int MLA_DOWN = 1056, MLA_DOWN_PAD = 1280;
constexpr int NEXP = 16384;
constexpr float DN_ALPHA = 1.4142135623730951f;
constexpr float LN_EPS = 1e-5f, RMS_EPS = 1e-6f;
#if TAB_FP4
constexpr float U_SCALE = 64.f, V_SCALE = 4.f;
constexpr size_t TAB_ROW = 512, TAB_BYTES = 8u << 20;
#elif TAB_MODE == 6
constexpr float U_SCALE = 64.f, V_SCALE = 4.f;
constexpr size_t TAB_ROW = 768, TAB_BYTES = 12u << 20;
#else
constexpr float U_SCALE = 1024.f, V_SCALE = 64.f;
constexpr size_t TAB_ROW = 1024, TAB_BYTES = 16u << 20;
#endif
constexpr int NWAVES = 8, NTHREADS = 512;
constexpr int LDS_BYTES = 147456;

constexpr size_t KiB = 1024, MiB = 1024 * 1024;
constexpr size_t WS_CTL = 0, CTL_BYTES = 64 * KiB;
constexpr size_t WS_W_IN_T = 1 * MiB;
constexpr size_t WS_W_NSAOUT_T = 6 * MiB + 512 * KiB;
constexpr size_t WS_W_CK1_T = 8 * MiB + 512 * KiB;
constexpr size_t WS_W_CV1_T = 9 * MiB;
constexpr size_t WS_W_MLADOWN_T = 9 * MiB + 512 * KiB;
constexpr size_t WS_W_UQ_T = 12 * MiB;
constexpr size_t WS_W_UKV_T = 14 * MiB + 256 * KiB;
constexpr size_t WS_W_MLAOUT_T = 15 * MiB + 256 * KiB;
constexpr size_t WS_W_PQ_T = 17 * MiB + 256 * KiB;
constexpr size_t WS_SUBK = 25 * MiB + 256 * KiB;
constexpr size_t WS_MISC = 27 * MiB;
constexpr size_t WS_PE = WS_MISC;
constexpr size_t WS_ROPE_COS = WS_MISC + 4 * KiB;
constexpr size_t WS_ROPE_SIN = WS_ROPE_COS + 256 * KiB;
constexpr size_t WS_RSTD_Q = WS_ROPE_SIN + 256 * KiB;
constexpr size_t WS_RSTD_KV = WS_RSTD_Q + 128 * KiB;
constexpr size_t WS_STATS = 28 * MiB;
constexpr size_t WS_TAB = 32 * MiB;
constexpr size_t WS_HB = 160 * MiB;
constexpr size_t WS_S = 224 * MiB;
constexpr size_t S_Q = WS_S;
constexpr size_t S_KV6 = WS_S + 64 * MiB;
constexpr size_t S_AO = WS_S + 160 * MiB;
constexpr size_t S_GATES = WS_S + 224 * MiB;
constexpr size_t S_PK = WS_S + 230 * MiB;
constexpr size_t S_PV = WS_S + 238 * MiB;
constexpr size_t S_KCMP = WS_S + 246 * MiB;
constexpr size_t S_VCMP = S_KCMP + 512 * KiB;
constexpr size_t S_Z = WS_S;
constexpr size_t S_QP0 = WS_S + 64 * MiB;
constexpr size_t S_EIDX0 = WS_S + 192 * MiB;
constexpr size_t S_GW0 = WS_S + 208 * MiB;
constexpr size_t S_DQ = WS_S;
constexpr size_t S_QF = WS_S + 80 * MiB;
constexpr size_t S_V = WS_S + 176 * MiB;
constexpr size_t S_KROPE = WS_S + 240 * MiB;
constexpr size_t S_KNOPE = WS_TAB + 64 * MiB;
constexpr size_t S_AO2 = WS_S;
constexpr size_t S_Z2 = WS_S + 80 * MiB;
constexpr size_t S_QP1 = WS_S + 144 * MiB;
constexpr size_t S_EIDX1 = WS_S;
constexpr size_t S_GW1 = WS_S + 16 * MiB;
constexpr size_t WS_NEED = 512 * MiB;
static_assert(S_QP1 + 128 * MiB <= WS_NEED && S_VCMP + 512 * KiB <= WS_NEED, "workspace map");

__device__ __forceinline__ float bf_lo(unsigned u) { return __uint_as_float(u << 16); }
__device__ __forceinline__ float bf_hi(unsigned u) { return __uint_as_float(u & 0xffff0000u); }
__device__ __forceinline__ float bf2f(bf16_t v) { return __uint_as_float((unsigned)v << 16); }
__device__ __forceinline__ unsigned pk2(float lo, float hi) { f32x2 v = {lo, hi}; bf16x2_t b = __builtin_convertvector(v, bf16x2_t); return __builtin_bit_cast(unsigned, b); }
__device__ __forceinline__ bf16_t f2bf(float f) { return (bf16_t)(pk2(f, 0.f) & 0xffffu); }
__device__ __forceinline__ float wave_sum(float v) {
#pragma unroll
    for (int o = 32; o >= 1; o >>= 1) v += __shfl_xor(v, o);
    return v;
}
__device__ __forceinline__ float wave_sum_fast(float v) {
#define WSF_DPP(ctrl) __builtin_bit_cast(float, __builtin_amdgcn_update_dpp(0, __builtin_bit_cast(int, v), ctrl, 0xF, 0xF, true))
    v += WSF_DPP(0xB1); v += WSF_DPP(0x4E); v += WSF_DPP(0x141); v += WSF_DPP(0x140);
#undef WSF_DPP
    v += __builtin_bit_cast(float, __builtin_amdgcn_update_dpp(0, __builtin_bit_cast(int, v), 0x142, 0xA, 0xF, false));
    v += __builtin_bit_cast(float, __builtin_amdgcn_update_dpp(0, __builtin_bit_cast(int, v), 0x143, 0xC, 0xF, false));
    return __builtin_bit_cast(float, __builtin_amdgcn_readlane(__builtin_bit_cast(int, v), 63));
}
__device__ __forceinline__ float wave_max(float v) {
#pragma unroll
    for (int o = 32; o >= 1; o >>= 1) v = fmaxf(v, __shfl_xor(v, o));
    return v;
}
__device__ __forceinline__ float gelu_tanh(float x) {
    const float y = 0.7978845608028654f * (x + 0.044715f * x * x * x);
    const float e = __expf(2.f * y);
    const float th = 1.f - 2.f / (1.f + e);
    return 0.5f * x * (1.f + th);
}
#define LDS_FENCE() asm volatile("s_waitcnt lgkmcnt(0)" ::: "memory")

namespace pg8 {
constexpr int BM = 256, BK = 64, HALF = 128, HTB = HALF * BK * 2, STAGE_BYTES = 8 * HTB, NXCD = 8, WGM = 8;
__host__ __device__ __forceinline__ int lds_byte(int r, int c) { const int st = (r >> 4) * 2 + (c >> 5), rr = r & 15, cc = c & 31, ob = rr * 64 + cc * 2; return st * 1024 + (ob ^ (((ob >> 9) & 1) << 5)); }
__host__ __device__ __forceinline__ void stage_rc(int b, int& R, int& C) { const int st = b / 1024, sb = b % 1024, swz = sb ^ (((sb >> 9) & 1) << 5); R = (st >> 1) * 16 + swz / 64; C = (st & 1) * 32 + (swz % 64) / 2; }
__host__ __device__ __forceinline__ int perm32(int rho) { const int n = rho >> 4, i = rho & 15; return 8 * (i >> 2) + 4 * n + (i & 3); }
struct Unit { int pm, pn; };
struct Gemm { const bf16_t* A; const bf16_t* Bt; int M, N, K, lda, ldb; };
struct StaticOrder {
    int nM, nN, nwg, G, c;
    __device__ void init(int M, int N, int G_, int c_) { nM = M / BM; nN = N / BM; nwg = nM * nN; G = G_; c = c_; }
    __device__ bool next(int i, Unit& u) const {
        const long L = (long)i * G + c; if (L >= nwg) return false;
        int wgid = (int)L; { const int q = nwg / NXCD, r = nwg % NXCD, xcd = wgid % NXCD, off = wgid / NXCD; wgid = (xcd < r ? xcd * (q + 1) : r * (q + 1) + (xcd - r) * q) + off; }
        const int nig = WGM * nN, gid = wgid / nig, fm = gid * WGM, gsz = (nM - fm) < WGM ? (nM - fm) : WGM;
        u.pm = fm + ((wgid % nig) % gsz); u.pn = (wgid % nig) / gsz; return true;
    }
};
template <class F> struct EpiFn {
    static constexpr bool PERM = true;
    F f;
    __device__ __forceinline__ void operator()(const f32x4 (&acc)[2][2][4][2], const Unit& u, int wr, int wc, int fr, int fq) const {
        const int row0 = u.pm * BM + wr * 64 + fr, col0 = u.pn * BM + wc * 32 + 8 * fq;
#pragma unroll
        for (int ai = 0; ai < 2; ++ai)
#pragma unroll
            for (int m = 0; m < 4; ++m)
#pragma unroll
                for (int bj = 0; bj < 2; ++bj) f(row0 + ai * HALF + m * 16, col0 + bj * HALF, acc[ai][bj][m][0], acc[ai][bj][m][1]);
    }
};

template <class Epi, class Sched>
__device__ __forceinline__ void gemm_phase(LAS unsigned char* lds, const Gemm g, const Sched& S, const Epi& E) {
    int tid = threadIdx.x; asm volatile("" : "+v"(tid));
    const int wid = __builtin_amdgcn_readfirstlane(tid >> 6), lane = tid & 63, wr = wid >> 2, wc = wid & 3, fr = lane & 15, fq = lane >> 4;
    const int K = g.K, nt = K / BK;
    unsigned voffA[2], voffB[2];
#pragma unroll
    for (int i = 0; i < 2; ++i) { int R, C; stage_rc(tid * 16 + i * 8192, R, C); const int Rb = Epi::PERM ? ((R & ~31) + perm32(R & 31)) : R;
        voffA[i] = (unsigned)(R * g.lda + C) * 2u; voffB[i] = (unsigned)(Rb * g.ldb + C) * 2u; }
    const size_t kstep = (size_t)(BK * 2);
    const size_t hstepA = (size_t)HALF * g.lda * 2, hstepB = (size_t)HALF * g.ldb * 2;
    const size_t tstepA = 2 * hstepA, tstepB = 2 * hstepB;
    const unsigned ldsw = (unsigned)wid * 1024u;
    const int aoff = lds_byte(wr * 64 + fr, fq * 8), boff = lds_byte(wc * 32 + fr, fq * 8);
#define PG8_SA(b, h) (((b) * 2 + (h)) * HTB)
#define PG8_SB(b, h) ((4 + (b) * 2 + (h)) * HTB)
#define PG8_STAGE(bufoff, gbase, voff) do { _Pragma("unroll") for (int _i = 0; _i < 2; ++_i) \
        __builtin_amdgcn_global_load_lds((const unsigned*)((const char*)(gbase) + (voff)[_i]), (LAS unsigned*)(lds + (bufoff) + ldsw + _i * 8192), 16, 0, 0); } while (0)
#define PG8_LDA(dst, b, h) do { _Pragma("unroll") for (int m = 0; m < 4; ++m) _Pragma("unroll") for (int k = 0; k < 2; ++k) dst[m][k] = *(const LAS bf16x8*)(lds + PG8_SA(b, h) + aoff + m * 2048 + k * 1024); } while (0)
#define PG8_LDB(dst, b, h) do { _Pragma("unroll") for (int n = 0; n < 2; ++n) _Pragma("unroll") for (int k = 0; k < 2; ++k) dst[n][k] = *(const LAS bf16x8*)(lds + PG8_SB(b, h) + boff + n * 2048 + k * 1024); } while (0)
#define PG8_MMA(ai, bj, At, Bt) do { __builtin_amdgcn_s_setprio(1); _Pragma("unroll") for (int m = 0; m < 4; ++m) _Pragma("unroll") for (int n = 0; n < 2; ++n) _Pragma("unroll") for (int k = 0; k < 2; ++k) \
        acc[ai][bj][m][n] = __builtin_amdgcn_mfma_f32_16x16x32_bf16(Bt[n][k], At[m][k], acc[ai][bj][m][n], 0, 0, 0); __builtin_amdgcn_s_setprio(0); } while (0)
#define PG8_WAIT_V(n) asm volatile("s_waitcnt vmcnt(" #n ")" ::: "memory")
#define PG8_WAIT_L(n) asm volatile("s_waitcnt lgkmcnt(" #n ")" ::: "memory")
#define PG8_BAR __builtin_amdgcn_s_barrier()
#define PG8_SCHED __builtin_amdgcn_sched_barrier(0)
    Unit cur, nxt; int ui = 0;
    if (!S.next(0, cur)) return;
    f32x4 acc[2][2][4][2];
#pragma unroll
    for (int a = 0; a < 2; ++a)
#pragma unroll
        for (int b = 0; b < 2; ++b)
#pragma unroll
            for (int m = 0; m < 4; ++m)
#pragma unroll
                for (int n = 0; n < 2; ++n) acc[a][b][m][n] = (f32x4){0.f, 0.f, 0.f, 0.f};
    bf16x8 At[4][2], B0[2][2], B1[2][2];
    const char* cA = (const char*)g.A + (size_t)cur.pm * tstepA; const char* cB = (const char*)g.Bt + (size_t)cur.pn * tstepB;
    PG8_STAGE(PG8_SB(0, 0), cB, voffB); PG8_STAGE(PG8_SB(0, 1), cB + hstepB, voffB); PG8_STAGE(PG8_SA(0, 0), cA, voffA); PG8_STAGE(PG8_SA(0, 1), cA + hstepA, voffA);
    if (wr == 1) PG8_BAR;
    PG8_WAIT_V(2); PG8_BAR;
    PG8_STAGE(PG8_SB(1, 0), cB + kstep, voffB); PG8_STAGE(PG8_SA(1, 0), cA + kstep, voffA); PG8_STAGE(PG8_SB(1, 1), cB + hstepB + kstep, voffB);
    PG8_WAIT_V(6); PG8_BAR;
    for (;;) {
        const bool has_next = S.next(ui + 1, nxt);
        const char* nA = has_next ? (const char*)g.A + (size_t)nxt.pm * tstepA : cA; const char* nB = has_next ? (const char*)g.Bt + (size_t)nxt.pn * tstepB : cB;
        for (int t = 0; t < nt; t += 2) {
            const bool last = (t == nt - 2);
            const char* a1 = cA + (size_t)(t + 1) * kstep;
            const char* a2 = last ? nA : cA + (size_t)(t + 2) * kstep; const char* b2 = last ? nB : cB + (size_t)(t + 2) * kstep;
            const char* a3 = a2 + kstep; const char* b3 = b2 + kstep;
            PG8_LDB(B0, 0, 0); PG8_LDB(B1, 0, 1); PG8_SCHED; PG8_LDA(At, 0, 0); PG8_STAGE(PG8_SA(1, 1), a1 + hstepA, voffA);
            PG8_WAIT_V(8); PG8_WAIT_L(0); PG8_BAR; PG8_MMA(0, 0, At, B0); PG8_MMA(0, 1, At, B1); PG8_BAR; PG8_SCHED;
            PG8_LDA(At, 0, 1); PG8_STAGE(PG8_SB(0, 0), b2, voffB); PG8_STAGE(PG8_SB(0, 1), b2 + hstepB, voffB); PG8_STAGE(PG8_SA(0, 0), a2, voffA);
            PG8_WAIT_V(8); PG8_WAIT_L(0); PG8_BAR; PG8_MMA(1, 0, At, B0); PG8_MMA(1, 1, At, B1); PG8_BAR; PG8_SCHED;
            PG8_LDB(B0, 1, 0); PG8_LDB(B1, 1, 1); PG8_SCHED; PG8_LDA(At, 1, 0); PG8_STAGE(PG8_SA(0, 1), a2 + hstepA, voffA);
            PG8_WAIT_V(8); PG8_WAIT_L(0); PG8_BAR; PG8_MMA(0, 0, At, B0); PG8_MMA(0, 1, At, B1); PG8_BAR; PG8_SCHED;
            PG8_LDA(At, 1, 1); PG8_STAGE(PG8_SB(1, 0), b3, voffB); PG8_STAGE(PG8_SB(1, 1), b3 + hstepB, voffB); PG8_STAGE(PG8_SA(1, 0), a3, voffA);
            PG8_WAIT_V(8); PG8_WAIT_L(0); PG8_BAR; PG8_MMA(1, 0, At, B0); PG8_MMA(1, 1, At, B1); PG8_BAR; PG8_SCHED;
        }
        if (wr == 0) PG8_BAR;
        E(acc, cur, wr, wc, fr, fq);
        if (!has_next) break;
#pragma unroll
        for (int a = 0; a < 2; ++a)
#pragma unroll
            for (int b = 0; b < 2; ++b)
#pragma unroll
                for (int m = 0; m < 4; ++m)
#pragma unroll
                    for (int n = 0; n < 2; ++n) acc[a][b][m][n] = (f32x4){0.f, 0.f, 0.f, 0.f};
        cur = nxt; cA = nA; cB = nB; ++ui;
        if (wr == 1) PG8_BAR;
    }
    PG8_WAIT_V(0);
    PG8_BAR;
#undef PG8_SA
#undef PG8_SB
#undef PG8_STAGE
#undef PG8_LDA
#undef PG8_LDB
#undef PG8_MMA
#undef PG8_WAIT_V
#undef PG8_WAIT_L
#undef PG8_BAR
#undef PG8_SCHED
}
}

template <class F>
__device__ __forceinline__ void run_gemm(LAS unsigned char* lds, const bf16_t* A, int lda, const bf16_t* Bt, int ldb, int M, int N, int K, int vblock, const F& f) {
    pg8::Gemm g{A, Bt, M, N, K, lda, ldb}; pg8::StaticOrder S; S.init(M, N, (int)gridDim.x, vblock);
    pg8::EpiFn<F> E{f};
    pg8::gemm_phase<pg8::EpiFn<F>, pg8::StaticOrder>(lds, g, S, E);
}

struct Params {
    const float* in[28];
    float* out;
    unsigned char* ws;
    int ph_lo, ph_hi;
};
enum { I_X = 0, I_NSA_WIN, I_CK_W1, I_CK_W2, I_CK_PE, I_CV_W1, I_CV_W2, I_CV_PE, I_NSA_WOUT, I_NSA_LNG, I_NSA_LNB, I_MLA_WDKV, I_MLA_KVG, I_MLA_WKR, I_MLA_WUK, I_MLA_WUV,
       I_MLA_WDQ, I_MLA_QG, I_MLA_WUQ, I_MLA_WOUT, I_MLA_LNG, I_MLA_LNB, I_PEER_WQ, I_PEER_SUBK, I_PEER_U, I_PEER_V, I_PEER_LNG, I_PEER_LNB };

__device__ __forceinline__ void p0_transpose_item(const float* W, int ldw, int n_valid, int K, bf16_t* WT, int row_off, const float* kscale, LAS float* scr, int nblk, int item, int lane) {
    const int kb = item / nblk, nb = item % nblk, k0 = 64 * kb, n0 = 32 * nb;
    const int n = n0 + (lane & 31);
#pragma unroll 8
    for (int i = 0; i < 32; ++i) { const int kk = 2 * i + (lane >> 5); float v = 0.f; if (n < n_valid) { v = W[(size_t)(k0 + kk) * ldw + n]; if (kscale) v *= kscale[k0 + kk]; } scr[kk * 33 + (lane & 31)] = v; }
    LDS_FENCE();
    const int c = lane & 7;
#pragma unroll
    for (int j = 0; j < 4; ++j) { const int nn = (lane >> 3) + 8 * j; const LAS float* s = scr + (8 * c) * 33 + nn;
        u32x4 o; o.x = pk2(s[0 * 33], s[1 * 33]); o.y = pk2(s[2 * 33], s[3 * 33]); o.z = pk2(s[4 * 33], s[5 * 33]); o.w = pk2(s[6 * 33], s[7 * 33]);
        *(u32x4*)(WT + (size_t)(row_off + n0 + nn) * K + k0 + 8 * c) = o; }
    LDS_FENCE();
}
__device__ __forceinline__ void cvt_f32_bf16(const float* src, bf16_t* dst, size_t n, size_t gtid, size_t gsz) {
    for (size_t i = gtid * 8; i < n; i += gsz * 8) { const f32x4 a = *(const f32x4*)(src + i), b = *(const f32x4*)(src + i + 4);
        u32x4 o; o.x = pk2(a.x, a.y); o.y = pk2(a.z, a.w); o.z = pk2(b.x, b.y); o.w = pk2(b.z, b.w); *(u32x4*)(dst + i) = o; }
}
__device__ __forceinline__ void cvt_f32_fp8(const float* src, unsigned char* dst, size_t n, float scale, size_t gtid, size_t gsz) {
    for (size_t i = gtid * 16; i < n; i += gsz * 16) {
        u32x4 o;
#pragma unroll
        for (int j = 0; j < 4; ++j) { f32x4 a = *(const f32x4*)(src + i + 4 * j) * scale;
#pragma unroll
            for (int e = 0; e < 4; ++e) a[e] = fminf(fmaxf(a[e], -448.f), 448.f);
            int pk = 0; pk = __builtin_amdgcn_cvt_pk_fp8_f32(a.x, a.y, pk, false); pk = __builtin_amdgcn_cvt_pk_fp8_f32(a.z, a.w, pk, true); o[j] = (unsigned)pk; }
        *(u32x4*)(dst + i) = o;
    }
}
__device__ __forceinline__ void cvt_f32_fp4(const float* src, unsigned char* dst, size_t n, float scale, size_t gtid, size_t gsz) {
    for (size_t i = gtid * 32; i < n; i += gsz * 32) {
        u32x4 o;
#pragma unroll
        for (int j = 0; j < 4; ++j) { const f32x4 a = *(const f32x4*)(src + i + 8 * j) * scale, b = *(const f32x4*)(src + i + 8 * j + 4) * scale;
            unsigned pk = 0u;
            pk = __builtin_amdgcn_cvt_scalef32_pk_fp4_f32(pk, a.x, a.y, 1.0f, 0); pk = __builtin_amdgcn_cvt_scalef32_pk_fp4_f32(pk, a.z, a.w, 1.0f, 1);
            pk = __builtin_amdgcn_cvt_scalef32_pk_fp4_f32(pk, b.x, b.y, 1.0f, 2); pk = __builtin_amdgcn_cvt_scalef32_pk_fp4_f32(pk, b.z, b.w, 1.0f, 3); o[j] = pk; }
        *(u32x4*)(dst + (i >> 1)) = o;
    }
}
typedef float v16f_t __attribute__((ext_vector_type(16)));
typedef float v32f_t __attribute__((ext_vector_type(32)));
typedef unsigned v6u_t __attribute__((ext_vector_type(6)));
__device__ __forceinline__ void cvt_f32_fp6(const float* src, unsigned char* dst, size_t n, float scale, size_t gtid, size_t gsz) {
    for (size_t i = gtid * 32; i < n; i += gsz * 32) {
        v16f_t a, b;
#pragma unroll
        for (int j = 0; j < 8; ++j) { f32x4 v = *(const f32x4*)(src + i + 4 * j) * scale;
#pragma unroll
            for (int e = 0; e < 4; ++e) v[e] = fminf(fmaxf(v[e], -7.5f), 7.5f);
            a[2 * j] = v.x; b[2 * j] = v.y; a[2 * j + 1] = v.z; b[2 * j + 1] = v.w; }
        const v6u_t pk = __builtin_amdgcn_cvt_scalef32_2xpk16_fp6_f32(a, b, 1.0f);
        unsigned char* d = dst + (i >> 5) * 24;
        *(u32x2*)d = (u32x2){pk[0], pk[1]}; *(u32x2*)(d + 8) = (u32x2){pk[2], pk[3]}; *(u32x2*)(d + 16) = (u32x2){pk[4], pk[5]};
    }
}
__device__ __forceinline__ void phase_prologue(const Params& p, LAS unsigned char* lds) {
    int tid = threadIdx.x; asm volatile("" : "+v"(tid));
    const int lane = tid & 63, wave = tid >> 6;
    LAS float* scr = (LAS float*)(lds + wave * 16384);
    const int gw = blockIdx.x * NWAVES + wave, NGW = gridDim.x * NWAVES;
    unsigned char* ws = p.ws;
    int base = 0;
#define TJOB(W_, ldw_, nvalid_, K_, npad_, WT_, rowoff_, ks_) do { const int nblk = (npad_) / 32, nit = ((K_) / 64) * nblk; \
        for (int it = gw - base; it < nit; it += NGW) { if (it >= 0) p0_transpose_item((W_), (ldw_), (nvalid_), (K_), (WT_), (rowoff_), (ks_), scr, nblk, it, lane); } \
        base = (base + nit) % NGW; } while (0)
#define TJOBS_EARLY() do {   \
    TJOB(p.in[I_NSA_WIN], NSA_IN, NSA_IN, 1024, NSA_IN_PAD, (bf16_t*)(ws + WS_W_IN_T), 0, (const float*)nullptr); \
    TJOB(p.in[I_CK_W1], 128, 128, 1024, 128, (bf16_t*)(ws + WS_W_CK1_T), 0, (const float*)nullptr); \
    TJOB(p.in[I_CK_W1] + 1024 * 128, 128, 128, 1024, 128, (bf16_t*)(ws + WS_W_CK1_T), 128, (const float*)nullptr); \
    TJOB(p.in[I_CV_W1], 128, 128, 1024, 128, (bf16_t*)(ws + WS_W_CV1_T), 0, (const float*)nullptr); \
    TJOB(p.in[I_CV_W1] + 1024 * 128, 128, 128, 1024, 128, (bf16_t*)(ws + WS_W_CV1_T), 128, (const float*)nullptr); } while (0)
#define TJOBS_LATE() do {   \
    TJOB(p.in[I_NSA_WOUT], 1024, 1024, 1024, 1024, (bf16_t*)(ws + WS_W_NSAOUT_T), 0, (const float*)nullptr); \
    TJOB(p.in[I_MLA_WDQ], 768, 768, 1024, 768, (bf16_t*)(ws + WS_W_MLADOWN_T), 0, (const float*)nullptr); \
    TJOB(p.in[I_MLA_WDKV], 256, 256, 1024, 256, (bf16_t*)(ws + WS_W_MLADOWN_T), 768, (const float*)nullptr); \
    TJOB(p.in[I_MLA_WKR], 32, 32, 1024, 256, (bf16_t*)(ws + WS_W_MLADOWN_T), 1024, (const float*)nullptr);   \
    TJOB(p.in[I_MLA_WUQ], 1536, 1536, 768, 1536, (bf16_t*)(ws + WS_W_UQ_T), 0, p.in[I_MLA_QG]); \
    TJOB(p.in[I_MLA_WUK], 1024, 1024, 256, 1024, (bf16_t*)(ws + WS_W_UKV_T), 0, p.in[I_MLA_KVG]); \
    TJOB(p.in[I_MLA_WUV], 1024, 1024, 256, 1024, (bf16_t*)(ws + WS_W_UKV_T), 1024, p.in[I_MLA_KVG]); \
    TJOB(p.in[I_MLA_WOUT], 1024, 1024, 1024, 1024, (bf16_t*)(ws + WS_W_MLAOUT_T), 0, (const float*)nullptr); \
    TJOB(p.in[I_PEER_WQ], 2048, 2048, 1024, 2048, (bf16_t*)(ws + WS_W_PQ_T), 0, (const float*)nullptr); \
    TJOB(p.in[I_PEER_WQ] + (size_t)1024 * 2048, 2048, 2048, 1024, 2048, (bf16_t*)(ws + WS_W_PQ_T) + (size_t)2048 * 1024, 0, (const float*)nullptr); } while (0)
    TJOBS_EARLY();
    if (gridDim.x != 256) TJOBS_LATE();
#if DBG_STAT
    if (blockIdx.x == 0 && tid == 0) ((float*)(ws + WS_CTL))[16] = 0.f;
#endif
    const size_t gtid = (size_t)blockIdx.x * NTHREADS + tid, gsz = (size_t)gridDim.x * NTHREADS;
    cvt_f32_bf16(p.in[I_X], (bf16_t*)(ws + WS_HB), (size_t)NTOK * DM, gtid, gsz);
    cvt_f32_bf16(p.in[I_PEER_SUBK], (bf16_t*)(ws + WS_SUBK), (size_t)2 * 8 * 2 * 128 * 128, gtid, gsz);
#if TAB_MODE == 4
#define CVT_TAB cvt_f32_fp4
#define CVT_TAB_U cvt_f32_fp4
#define CVT_TAB_V cvt_f32_fp4
#elif TAB_MODE == 6
#define CVT_TAB cvt_f32_fp6
#if U_MM
#define CVT_TAB_U cvt_f32_fp4
#else
#define CVT_TAB_U cvt_f32_fp6
#endif
#if V_FP4
#define CVT_TAB_V cvt_f32_fp4
#else
#define CVT_TAB_V cvt_f32_fp6
#endif
#else
#define CVT_TAB cvt_f32_fp8
#define CVT_TAB_U cvt_f32_fp8
#define CVT_TAB_V cvt_f32_fp8
#endif
    if (gridDim.x != 256) {
        CVT_TAB_U(p.in[I_PEER_U], ws + WS_TAB, (size_t)NEXP * DM, U_SCALE, gtid, gsz);
        CVT_TAB_V(p.in[I_PEER_V], ws + WS_TAB + TAB_BYTES, (size_t)NEXP * DM, V_SCALE, gtid, gsz);
        CVT_TAB_U(p.in[I_PEER_U] + (size_t)NEXP * DM, ws + WS_TAB + 2 * TAB_BYTES, (size_t)NEXP * DM, U_SCALE, gtid, gsz);
        CVT_TAB_V(p.in[I_PEER_V] + (size_t)NEXP * DM, ws + WS_TAB + 3 * TAB_BYTES, (size_t)NEXP * DM, V_SCALE, gtid, gsz);
    }
    for (int o = gw; o < 256; o += NGW) {
        const float* pe = (o < 128) ? p.in[I_CK_PE] : p.in[I_CV_PE]; const float* w1 = (o < 128) ? p.in[I_CK_W1] : p.in[I_CV_W1]; const int h = o & 127;
        float s = 0.f; for (int i = lane; i < 2048; i += 64) s += pe[i] * w1[(size_t)i * 128 + h];
        s = wave_sum(s); if (lane == 0) ((float*)(ws + WS_PE))[o] = s;
    }
    for (size_t i = gtid; i < (size_t)SEQ * 16; i += gsz) {
        const int pos = (int)(i >> 4), fi = (int)(i & 15);
        const float inv = 1.0f / powf(10000.0f, (float)(2 * fi) / 32.0f);
        const float ang = (float)pos * inv;
        const double rev = (double)ang * 0.15915494309189535; const double fr = rev - rint(rev);
        ((float*)(ws + WS_ROPE_COS))[i] = __builtin_amdgcn_cosf((float)fr); ((float*)(ws + WS_ROPE_SIN))[i] = __builtin_amdgcn_sinf((float)fr);
    }
}

__device__ __forceinline__ void late_weight_transposes(const Params& p, LAS unsigned char* lds) {
    if (gridDim.x != 256 || blockIdx.x < 128) return;
    int tid = threadIdx.x; asm volatile("" : "+v"(tid));
    const int lane = tid & 63, wave = tid >> 6;
    LAS float* scr = (LAS float*)(lds + wave * 16384);
    const int gw = ((int)blockIdx.x - 128) * NWAVES + wave, NGW = 128 * NWAVES;
    unsigned char* ws = p.ws;
    int base = 0;
    TJOBS_LATE();
}
#undef TJOBS_EARLY
#undef TJOBS_LATE
#undef TJOB
__device__ __forceinline__ void convert_tables_idle(const Params& p) {
    const int bid = (int)blockIdx.x;
    if (gridDim.x != 256 || bid < 32 || (bid >= 128 && bid < 160)) return;
    const int rank = (bid < 128) ? bid - 32 : bid - 64;
    const size_t gtid = (size_t)rank * NTHREADS + threadIdx.x, gsz = (size_t)192 * NTHREADS;
    unsigned char* ws = p.ws;
    CVT_TAB_U(p.in[I_PEER_U], ws + WS_TAB, (size_t)NEXP * DM, U_SCALE, gtid, gsz);
    CVT_TAB_V(p.in[I_PEER_V], ws + WS_TAB + TAB_BYTES, (size_t)NEXP * DM, V_SCALE, gtid, gsz);
    CVT_TAB_U(p.in[I_PEER_U] + (size_t)NEXP * DM, ws + WS_TAB + 2 * TAB_BYTES, (size_t)NEXP * DM, U_SCALE, gtid, gsz);
    CVT_TAB_V(p.in[I_PEER_V] + (size_t)NEXP * DM, ws + WS_TAB + 3 * TAB_BYTES, (size_t)NEXP * DM, V_SCALE, gtid, gsz);
}
#undef CVT_TAB
#undef CVT_TAB_U
#undef CVT_TAB_V
__device__ __forceinline__ u32x4 pack8(const f32x4& a, const f32x4& b) { u32x4 o; o.x = pk2(a.x, a.y); o.y = pk2(a.z, a.w); o.z = pk2(b.x, b.y); o.w = pk2(b.z, b.w); return o; }
__device__ __forceinline__ void store16_wt(void* p, const u32x4& v) { asm volatile("global_store_dwordx4 %0, %1, off sc0 sc1\n\ts_nop 1" :: "v"(p), "v"(v) : "memory"); }
struct EpiNsaProj {
    bf16_t* q; bf16_t* kv6; float* gates;
    __device__ __forceinline__ void operator()(int row, int col, const f32x4& a, const f32x4& b) const {
        if (col < 1024) { store16_wt(q + (size_t)row * 1024 + col, pack8(a, b)); }
        else if (col < 2560) {
            const int which = (col - 1024) >> 8, cc = (col - 1024) & 255;
            bf16_t* base = kv6 + (size_t)which * NTOK * 256;
            if (which < 2) { const int g = cc >> 6, d = cc & 63, bb = row >> 12, t = row & 4095, n = t >> 4, l = t & 15;
                store16_wt(base + ((((size_t)(bb * 256 + n) * 4 + g) * 16 + l) * 64 + d), pack8(a, b)); }
            else store16_wt(base + (size_t)row * 256 + cc, pack8(a, b));
        } else if (col < NSA_IN) {
            float* gp = gates + (size_t)row * 48 + (col - 2560);
            f32x4 s0, s1;
#pragma unroll
            for (int i = 0; i < 4; ++i) { s0[i] = 1.f / (1.f + __expf(-a[i])); s1[i] = 1.f / (1.f + __expf(-b[i])); }
            *(f32x4*)gp = s0; *(f32x4*)(gp + 4) = s1;
        }
    }
};
struct EpiF32 { float* O; int ldc; __device__ __forceinline__ void operator()(int row, int col, const f32x4& a, const f32x4& b) const { float* o = O + (size_t)row * ldc + col; *(f32x4*)o = a; *(f32x4*)(o + 4) = b; } };
struct EpiBf16 { bf16_t* O; int ldc; __device__ __forceinline__ void operator()(int row, int col, const f32x4& a, const f32x4& b) const { store16_wt(O + (size_t)row * ldc + col, pack8(a, b)); } };
struct EpiResid {
    const bf16_t* H; bf16_t* Z; float ms;
    __device__ __forceinline__ void operator()(int row, int col, const f32x4& a_, const f32x4& b_) const {
        const f32x4 a = a_ * ms, b = b_ * ms;
        const u32x4 h = *(const u32x4*)(H + (size_t)row * 1024 + col);
        f32x4 x, y;
        x.x = DN_ALPHA * bf_lo(h.x) + a.x; x.y = DN_ALPHA * bf_hi(h.x) + a.y; x.z = DN_ALPHA * bf_lo(h.y) + a.z; x.w = DN_ALPHA * bf_hi(h.y) + a.w;
        y.x = DN_ALPHA * bf_lo(h.z) + b.x; y.y = DN_ALPHA * bf_hi(h.z) + b.y; y.z = DN_ALPHA * bf_lo(h.w) + b.z; y.w = DN_ALPHA * bf_hi(h.w) + b.w;
        store16_wt(Z + (size_t)row * 1024 + col, pack8(x, y));
    }
};
struct EpiKV {
    bf16_t* KN; bf16_t* V;
    __device__ __forceinline__ void operator()(int row, int col, const f32x4& a, const f32x4& b) const {
        bf16_t* dst = (col < 1024) ? KN + (size_t)row * 1024 + col : V + (size_t)row * 1024 + (col - 1024);
        store16_wt(dst, pack8(a, b));
    }
};

__device__ __forceinline__ void phase_ln(const bf16_t* Z, bf16_t* H, const float* g, const float* b) {
    int tid_ = threadIdx.x; asm volatile("" : "+v"(tid_));
    const int lane = tid_ & 63, wave = tid_ >> 6;
    const int gw = blockIdx.x * NWAVES + wave, NGW = gridDim.x * NWAVES;
    if (gw >= NTOK) return;
    f32x4 gg[4], bb[4];
#pragma unroll
    for (int hh = 0; hh < 2; ++hh) { const int c0 = hh * 512 + lane * 8; gg[2 * hh] = *(const f32x4*)(g + c0); gg[2 * hh + 1] = *(const f32x4*)(g + c0 + 4); bb[2 * hh] = *(const f32x4*)(b + c0); bb[2 * hh + 1] = *(const f32x4*)(b + c0 + 4); }
    u32x4 an = *(const u32x4*)(Z + (size_t)gw * 1024 + lane * 8), cn = *(const u32x4*)(Z + (size_t)gw * 1024 + 512 + lane * 8);
    for (int row = gw; row < NTOK; row += NGW) {
        const u32x4 a = an, c = cn;
        { const int rn = row + NGW; if (rn < NTOK) { an = *(const u32x4*)(Z + (size_t)rn * 1024 + lane * 8); cn = *(const u32x4*)(Z + (size_t)rn * 1024 + 512 + lane * 8); } }
        float v[16] = {bf_lo(a.x), bf_hi(a.x), bf_lo(a.y), bf_hi(a.y), bf_lo(a.z), bf_hi(a.z), bf_lo(a.w), bf_hi(a.w), bf_lo(c.x), bf_hi(c.x), bf_lo(c.y), bf_hi(c.y), bf_lo(c.z), bf_hi(c.z), bf_lo(c.w), bf_hi(c.w)};
        float s = 0.f;
#pragma unroll
        for (int i = 0; i < 16; ++i) s += v[i];
        const float mean = wave_sum_fast(s) * (1.f / 1024.f); float q = 0.f;
#pragma unroll
        for (int i = 0; i < 16; ++i) { v[i] -= mean; q += v[i] * v[i]; }
        const float rstd = rsqrtf(wave_sum_fast(q) * (1.f / 1024.f) + LN_EPS);
        float o[16];
#pragma unroll
        for (int j = 0; j < 4; ++j)
#pragma unroll
            for (int i = 0; i < 4; ++i) o[4 * j + i] = v[4 * j + i] * rstd * gg[j][i] + bb[j][i];
        u32x4 w0, w1; w0.x = pk2(o[0], o[1]); w0.y = pk2(o[2], o[3]); w0.z = pk2(o[4], o[5]); w0.w = pk2(o[6], o[7]); w1.x = pk2(o[8], o[9]); w1.y = pk2(o[10], o[11]); w1.z = pk2(o[12], o[13]); w1.w = pk2(o[14], o[15]);
        *(u32x4*)(H + (size_t)row * 1024 + lane * 8) = w0; *(u32x4*)(H + (size_t)row * 1024 + 512 + lane * 8) = w1;
    }
}
__device__ __forceinline__ void phase_cmp_finish(const Params& p, LAS unsigned char* lds) {
    int tid_ = threadIdx.x; asm volatile("" : "+v"(tid_));
    const int lane = tid_ & 63, wave = tid_ >> 6;
    const int gw = blockIdx.x * NWAVES + wave, NGW = gridDim.x * NWAVES;
    LAS float* hs = (LAS float*)(lds + wave * 2048);
    for (int item0 = gw; item0 < 2 * 8192; item0 += 4 * NGW) {
        float a0[4], a1[4]; bool live[4]; const float* w2 = nullptr;
#pragma unroll
        for (int k = 0; k < 4; ++k) { const int item = item0 + k * NGW; live[k] = item < 2 * 8192; a0[k] = 0.f; a1[k] = 0.f;
            if (live[k]) { const int kv = item >> 13, r = item & 8191, n = (r >> 2) & 255;
                const float* P = (const float*)(p.ws + (kv ? S_PV : S_PK)); const float* pe = (const float*)(p.ws + WS_PE) + kv * 128;
                if (n != 255) { a0[k] = P[(size_t)r * 256 + lane] + P[(size_t)(r + 4) * 256 + 128 + lane] + pe[lane]; a1[k] = P[(size_t)r * 256 + 64 + lane] + P[(size_t)(r + 4) * 256 + 192 + lane] + pe[64 + lane]; } } }
        LDS_FENCE();
#pragma unroll
        for (int k = 0; k < 4; ++k) { hs[k * 128 + lane] = gelu_tanh(a0[k]); hs[k * 128 + 64 + lane] = gelu_tanh(a1[k]); }
        LDS_FENCE();
        const int kv0 = item0 >> 13, kv3 = (item0 + 3 * NGW) >> 13;
        if (kv0 == kv3 || item0 + 3 * NGW >= 2 * 8192) {
            w2 = p.in[kv0 ? I_CV_W2 : I_CK_W2];
            float s[4] = {0.f, 0.f, 0.f, 0.f};
            const bool same = (kv0 == kv3);
            if (same) {
#pragma unroll 8
                for (int h = 0; h < 128; ++h) { const float w = w2[h * 64 + lane]; s[0] += hs[h] * w; s[1] += hs[128 + h] * w; s[2] += hs[256 + h] * w; s[3] += hs[384 + h] * w; }
            } else {
#pragma unroll
                for (int k = 0; k < 4; ++k) { const int item = item0 + k * NGW; if (item < 2 * 8192) { const float* wk = p.in[(item >> 13) ? I_CV_W2 : I_CK_W2];
#pragma unroll 8
                    for (int h = 0; h < 128; ++h) s[k] += hs[k * 128 + h] * wk[h * 64 + lane]; } }
            }
#pragma unroll
            for (int k = 0; k < 4; ++k) { const int item = item0 + k * NGW; if (item < 2 * 8192) { const int kv = item >> 13, r = item & 8191, n = (r >> 2) & 255;
                bf16_t* out = (bf16_t*)(p.ws + (kv ? S_VCMP : S_KCMP)) + (size_t)r * 64; out[lane] = (n == 255) ? (bf16_t)0 : f2bf(s[k]); } }
        } else {
#pragma unroll
            for (int k = 0; k < 4; ++k) { const int item = item0 + k * NGW; if (item < 2 * 8192) { const int kv = item >> 13, r = item & 8191, n = (r >> 2) & 255; const float* wk = p.in[kv ? I_CV_W2 : I_CK_W2];
                float sk = 0.f;
#pragma unroll 8
                for (int h = 0; h < 128; ++h) sk += hs[k * 128 + h] * wk[h * 64 + lane];
                bf16_t* out = (bf16_t*)(p.ws + (kv ? S_VCMP : S_KCMP)) + (size_t)r * 64; out[lane] = (n == 255) ? (bf16_t)0 : f2bf(sk); } }
        }
    }
}
__device__ __forceinline__ void phase_mla_rowstats(const Params& p) {
    int tid_ = threadIdx.x; asm volatile("" : "+v"(tid_));
    const int lane = tid_ & 63, wave = tid_ >> 6;
    const int gw = blockIdx.x * NWAVES + wave, NGW = gridDim.x * NWAVES;
    bf16_t* DQ = (bf16_t*)(p.ws + S_DQ);
    const float* rc = (const float*)(p.ws + WS_ROPE_COS); const float* rs = (const float*)(p.ws + WS_ROPE_SIN);
    if (gw >= NTOK) return;
    u32x2 vn[4]; unsigned short x1n = 0, x2n = 0; float cn = 0.f, sn = 0.f;
    { const bf16_t* r0 = DQ + (size_t)gw * MLA_DOWN_PAD;
#pragma unroll
      for (int j = 0; j < 4; ++j) vn[j] = *(const u32x2*)(r0 + j * 256 + lane * 4);
      if (lane < 16) { x1n = r0[1024 + lane]; x2n = r0[1040 + lane]; cn = rc[(gw & 4095) * 16 + lane]; sn = rs[(gw & 4095) * 16 + lane]; } }
    for (int row = gw; row < NTOK; row += NGW) {
        bf16_t* r = DQ + (size_t)row * MLA_DOWN_PAD;
        u32x2 v[4]; float sq = 0.f, skv = 0.f;
#pragma unroll
        for (int j = 0; j < 4; ++j) v[j] = vn[j];
        const float x1 = bf2f(x1n), x2 = bf2f(x2n), c = cn, s = sn;
        { const int rn = row + NGW; if (rn < NTOK) { const bf16_t* r1 = DQ + (size_t)rn * MLA_DOWN_PAD;
#pragma unroll
            for (int j = 0; j < 4; ++j) vn[j] = *(const u32x2*)(r1 + j * 256 + lane * 4);
            if (lane < 16) { x1n = r1[1024 + lane]; x2n = r1[1040 + lane]; cn = rc[(rn & 4095) * 16 + lane]; sn = rs[(rn & 4095) * 16 + lane]; } } }
#pragma unroll
        for (int j = 0; j < 4; ++j) { const float a = bf_lo(v[j].x), b = bf_hi(v[j].x), cc = bf_lo(v[j].y), d = bf_hi(v[j].y); const float ss = (a * a + b * b) + (cc * cc + d * d); if (j < 3) sq += ss; else skv += ss; }
        sq = wave_sum_fast(sq); skv = wave_sum_fast(skv);
        const float rq = rsqrtf(sq * (1.f / 768.f) + RMS_EPS), rkv = rsqrtf(skv * (1.f / 256.f) + RMS_EPS);
#pragma unroll
        for (int j = 0; j < 4; ++j) { const float f = (j < 3) ? rq : rkv; u32x2 o; o.x = pk2(bf_lo(v[j].x) * f, bf_hi(v[j].x) * f); o.y = pk2(bf_lo(v[j].y) * f, bf_hi(v[j].y) * f); *(u32x2*)(r + j * 256 + lane * 4) = o; }
        if (lane < 16) { bf16_t* kr = (bf16_t*)(p.ws + S_KROPE) + (size_t)row * 32; kr[lane] = f2bf(x1 * c - x2 * s); kr[16 + lane] = f2bf(x2 * c + x1 * s); }
    }
}

struct OnlineSt { float m[4], l[4], o[4][2]; };
__device__ __forceinline__ void nsa_attend_block(OnlineSt& st, const bf16_t* Kb, const bf16_t* Vb, int pos0, int t, const float (&slope)[4], LAS float* qs, LAS float* ps, int lane) {
    const int pos = pos0 + lane; const bool valid = pos <= t;
    const bf16_t* krow = Kb + (size_t)(valid ? pos : t) * 256;
    float acc[4] = {0.f, 0.f, 0.f, 0.f};
#pragma unroll 2
    for (int d8 = 0; d8 < 8; ++d8) { const u32x4 kv = *(const u32x4*)(krow + d8 * 8);
        const float kf[8] = {bf_lo(kv.x), bf_hi(kv.x), bf_lo(kv.y), bf_hi(kv.y), bf_lo(kv.z), bf_hi(kv.z), bf_lo(kv.w), bf_hi(kv.w)};
#pragma unroll
        for (int e = 0; e < 8; ++e) { const f32x4 qv = *(const LAS f32x4*)(qs + (d8 * 8 + e) * 4);
#pragma unroll
            for (int r = 0; r < 4; ++r) acc[r] += qv[r] * kf[e]; } }
    const float dist = (float)(t - pos);
    f32x4 pe;
#pragma unroll
    for (int r = 0; r < 4; ++r) {
        const float s = valid ? acc[r] - slope[r] * dist : -1e30f;
        const float mb = wave_max(s), mn = fmaxf(st.m[r], mb);
        const float alpha = __expf(st.m[r] - mn);
        const float e = valid ? __expf(s - mn) : 0.f;
        st.l[r] = st.l[r] * alpha + wave_sum(e); st.o[r][0] *= alpha; st.o[r][1] *= alpha; st.m[r] = mn; pe[r] = e;
    }
    LDS_FENCE();
    *(LAS f32x4*)(ps + lane * 4) = pe;
    LDS_FENCE();
    const int hf = lane >> 5, dp = lane & 31;
    const int nk = (t - pos0 + 1 < 64) ? t - pos0 + 1 : 64;
#pragma unroll 4
    for (int kk = hf; kk < nk; kk += 2) {
        const unsigned vv = *(const unsigned*)(Vb + (size_t)(pos0 + kk) * 256 + 2 * dp); const f32x4 pp = *(const LAS f32x4*)(ps + kk * 4);
        const float lo = bf_lo(vv), hi = bf_hi(vv);
#pragma unroll
        for (int r = 0; r < 4; ++r) { st.o[r][0] += pp[r] * lo; st.o[r][1] += pp[r] * hi; }
    }
}
__device__ __forceinline__ void phase_nsa_attn_ref(const Params& p, LAS unsigned char* lds) {
    int tid_ = threadIdx.x; asm volatile("" : "+v"(tid_));
    const int lane = tid_ & 63, wave = tid_ >> 6;
    const int gw = blockIdx.x * NWAVES + wave, NGW = gridDim.x * NWAVES;
    LAS float* qs = (LAS float*)(lds + wave * 6144);
    LAS float* pc = qs + 256;
    LAS float* ptot = pc + 1024;
    const bf16_t* Q = (const bf16_t*)(p.ws + S_Q); const bf16_t* KV6 = (const bf16_t*)(p.ws + S_KV6);
    const bf16_t* KS = KV6 + (size_t)2 * NTOK * 256; const bf16_t* VS = KV6 + (size_t)3 * NTOK * 256; const bf16_t* KW = KV6 + (size_t)4 * NTOK * 256; const bf16_t* VW = KV6 + (size_t)5 * NTOK * 256;
    const bf16_t* KC = (const bf16_t*)(p.ws + S_KCMP); const bf16_t* VC = (const bf16_t*)(p.ws + S_VCMP);
    const float* GATES = (const float*)(p.ws + S_GATES); bf16_t* AO = (bf16_t*)(p.ws + S_AO);
    const int hf = lane >> 5, dp = lane & 31;
    for (int item = gw; item < NTOK * 4; item += NGW) {
        const int g = item & 3, row = item >> 2, b = row >> 12, t = row & 4095;
        float slope[4];
#pragma unroll
        for (int r = 0; r < 4; ++r) slope[r] = exp2f(-0.5f * (float)(g * 4 + r + 1));
        LDS_FENCE();
        { f32x4 qv;
#pragma unroll
          for (int r = 0; r < 4; ++r) qv[r] = bf2f(Q[(size_t)row * 1024 + (g * 4 + r) * 64 + lane]) * 0.125f;
          *(LAS f32x4*)(qs + lane * 4) = qv; }
        LDS_FENCE();
        const int nv = (t >= 31) ? (((t - 31) >> 4) + 1 < 255 ? ((t - 31) >> 4) + 1 : 255) : 0;
        float mloc[4] = {-1e30f, -1e30f, -1e30f, -1e30f};
#pragma unroll 1
        for (int c = 0; c < 4; ++c) {
            const int i = 64 * c + lane;
            f32x4 sv = (f32x4){-1e30f, -1e30f, -1e30f, -1e30f};
            if (64 * c < nv) {
                const bf16_t* krow = KC + ((size_t)(b * 256 + i) * 4 + g) * 64;
                float acc[4] = {0.f, 0.f, 0.f, 0.f};
#pragma unroll 2
                for (int d8 = 0; d8 < 8; ++d8) { const u32x4 kv = *(const u32x4*)(krow + d8 * 8);
                    const float kf[8] = {bf_lo(kv.x), bf_hi(kv.x), bf_lo(kv.y), bf_hi(kv.y), bf_lo(kv.z), bf_hi(kv.z), bf_lo(kv.w), bf_hi(kv.w)};
#pragma unroll
                    for (int e = 0; e < 8; ++e) { const f32x4 qv = *(const LAS f32x4*)(qs + (d8 * 8 + e) * 4);
#pragma unroll
                        for (int r = 0; r < 4; ++r) acc[r] += qv[r] * kf[e]; } }
                const float dist = (float)(t - (16 * i + 31));
                if (i < nv) {
#pragma unroll
                    for (int r = 0; r < 4; ++r) { sv[r] = acc[r] - slope[r] * dist; mloc[r] = fmaxf(mloc[r], sv[r]); } }
            }
            *(LAS f32x4*)(pc + i * 4) = sv;
        }
        float ssum[4] = {0.f, 0.f, 0.f, 0.f};
#pragma unroll
        for (int r = 0; r < 4; ++r) mloc[r] = wave_max(mloc[r]);
        LDS_FENCE();
#pragma unroll 1
        for (int c = 0; c < 4; ++c) {
            const int i = 64 * c + lane; f32x4 sv = *(const LAS f32x4*)(pc + i * 4);
#pragma unroll
            for (int r = 0; r < 4; ++r) { sv[r] = (sv[r] > -1e29f) ? __expf(sv[r] - mloc[r]) : 0.f; ssum[r] += sv[r]; }
            *(LAS f32x4*)(pc + i * 4) = sv;
        }
#pragma unroll
        for (int r = 0; r < 4; ++r) { const float sm = wave_sum(ssum[r]); ssum[r] = (sm > 0.f) ? 1.f / sm : 0.f; }
        LDS_FENCE();
#pragma unroll 1
        for (int c = 0; c < 4; ++c) {
            const int i = 64 * c + lane; f32x4 sv = *(const LAS f32x4*)(pc + i * 4);
#pragma unroll
            for (int r = 0; r < 4; ++r) sv[r] *= ssum[r];
            *(LAS f32x4*)(pc + i * 4) = sv; ptot[i] = (sv[0] + sv[1]) + (sv[2] + sv[3]);
        }
        LDS_FENCE();
        const int j = lane, blk = t >> 6;
        const float imp = ptot[4 * j] + ptot[4 * j + 1] + ptot[4 * j + 2] + 0.5f * ptot[4 * j + 3] + (j > 0 ? 0.5f * ptot[4 * j - 1] : 0.f);
        const bool elig = j <= blk, forced = (j == 0) || (j == blk) || (j == blk - 1);
        const float val = elig ? imp + (forced ? 1e4f : 0.f) : -1e30f;
        int rank = 0;
#pragma unroll 8
        for (int k = 0; k < 64; ++k) { const float vk = __shfl(val, k); rank += (vk > val || (vk == val && k < j)) ? 1 : 0; }
        const unsigned long long selmask = __ballot(elig && rank < 16);
        float oc[4][2] = {{0.f, 0.f}, {0.f, 0.f}, {0.f, 0.f}, {0.f, 0.f}};
        for (int i = hf; i < nv; i += 2) {
            const unsigned vv = *(const unsigned*)(VC + ((size_t)(b * 256 + i) * 4 + g) * 64 + 2 * dp); const f32x4 pp = *(const LAS f32x4*)(pc + i * 4);
            const float lo = bf_lo(vv), hi = bf_hi(vv);
#pragma unroll
            for (int r = 0; r < 4; ++r) { oc[r][0] += pp[r] * lo; oc[r][1] += pp[r] * hi; }
        }
#pragma unroll
        for (int r = 0; r < 4; ++r) { oc[r][0] += __shfl_xor(oc[r][0], 32); oc[r][1] += __shfl_xor(oc[r][1], 32); }
        OnlineSt st;
#pragma unroll
        for (int r = 0; r < 4; ++r) { st.m[r] = -1e30f; st.l[r] = 0.f; st.o[r][0] = 0.f; st.o[r][1] = 0.f; }
        const bf16_t* ksb = KS + (size_t)b * SEQ * 256 + g * 64; const bf16_t* vsb = VS + (size_t)b * SEQ * 256 + g * 64;
        for (unsigned long long mm = selmask; mm; mm &= mm - 1) { const int jj = __builtin_ctzll(mm); nsa_attend_block(st, ksb, vsb, 64 * jj, t, slope, qs, pc, lane); }
        float os[4][2];
#pragma unroll
        for (int r = 0; r < 4; ++r) { const float il = 1.f / st.l[r]; os[r][0] = (st.o[r][0] + __shfl_xor(st.o[r][0], 32)) * il; os[r][1] = (st.o[r][1] + __shfl_xor(st.o[r][1], 32)) * il; }
#pragma unroll
        for (int r = 0; r < 4; ++r) { st.m[r] = -1e30f; st.l[r] = 0.f; st.o[r][0] = 0.f; st.o[r][1] = 0.f; }
        const bf16_t* kwb = KW + (size_t)b * SEQ * 256 + g * 64; const bf16_t* vwb = VW + (size_t)b * SEQ * 256 + g * 64;
        const int lo = (t - 511 > 0) ? t - 511 : 0;
        for (int p0 = lo; p0 <= t; p0 += 64) nsa_attend_block(st, kwb, vwb, p0, t, slope, qs, pc, lane);
        const float* gp = GATES + (size_t)row * 48 + g * 12;
#pragma unroll
        for (int r = 0; r < 4; ++r) {
            const float il = 1.f / st.l[r]; const float ow0 = (st.o[r][0] + __shfl_xor(st.o[r][0], 32)) * il, ow1 = (st.o[r][1] + __shfl_xor(st.o[r][1], 32)) * il;
            const float gc = gp[r * 3 + 0], gs = gp[r * 3 + 1], gwv = gp[r * 3 + 2];
            const float o0 = gc * oc[r][0] + gs * os[r][0] + gwv * ow0, o1 = gc * oc[r][1] + gs * os[r][1] + gwv * ow1;
            if (hf == 0) *(unsigned*)(AO + (size_t)row * 1024 + (g * 4 + r) * 64 + 2 * dp) = pk2(o0, o1);
        }
    }
}

__device__ __forceinline__ void phase_mla_attn_ref(const Params& p, LAS unsigned char* lds) {
    int tid_ = threadIdx.x; asm volatile("" : "+v"(tid_));
    const int lane = tid_ & 63, wave = tid_ >> 6;
    const int gw = blockIdx.x * NWAVES + wave, NGW = gridDim.x * NWAVES;
    LAS float* qs = (LAS float*)(lds + wave * 1024);
    LAS float* ps = qs + 128;
    const bf16_t* QF = (const bf16_t*)(p.ws + S_QF); const bf16_t* KN = (const bf16_t*)(p.ws + S_KNOPE); const bf16_t* KR = (const bf16_t*)(p.ws + S_KROPE); const bf16_t* V = (const bf16_t*)(p.ws + S_V);
    const float* rc = (const float*)(p.ws + WS_ROPE_COS); const float* rs = (const float*)(p.ws + WS_ROPE_SIN);
    bf16_t* AO = (bf16_t*)(p.ws + S_AO2);
    const float scale = 0.10206207261596577f;
    const int hf = lane >> 5, dp = lane & 31;
    for (int item = gw; item < NTOK * 16; item += NGW) {
        const int h = item & 15, row = item >> 4, b = row >> 12, t = row & 4095;
        const bf16_t* qrow = QF + (size_t)row * 1536 + h * 96; const float rq = scale;
        LDS_FENCE();
        qs[lane] = bf2f(qrow[lane]) * rq;
        if (lane < 16) { const float x1 = bf2f(qrow[64 + lane]), x2 = bf2f(qrow[80 + lane]), c = rc[t * 16 + lane], s = rs[t * 16 + lane]; qs[64 + lane] = (x1 * c - x2 * s) * rq; qs[80 + lane] = (x2 * c + x1 * s) * rq; }
        LDS_FENCE();
        float m = -1e30f, l = 0.f, o0 = 0.f, o1 = 0.f;
        for (int p0 = 0; p0 <= t; p0 += 64) {
            const int pos = p0 + lane; const bool valid = pos <= t;
            const int posc = valid ? pos : t;
            const bf16_t* kn = KN + ((size_t)(b * SEQ + posc)) * 1024 + h * 64; const bf16_t* kr = KR + ((size_t)(b * SEQ + posc)) * 32;
            float acc = 0.f;
#pragma unroll 4
            for (int d8 = 0; d8 < 12; ++d8) { const u32x4 kv = (d8 < 8) ? *(const u32x4*)(kn + d8 * 8) : *(const u32x4*)(kr + (d8 - 8) * 8);
                const f32x4 q0 = *(const LAS f32x4*)(qs + d8 * 8), q1 = *(const LAS f32x4*)(qs + d8 * 8 + 4);
                acc += q0.x * bf_lo(kv.x) + q0.y * bf_hi(kv.x) + q0.z * bf_lo(kv.y) + q0.w * bf_hi(kv.y) + q1.x * bf_lo(kv.z) + q1.y * bf_hi(kv.z) + q1.z * bf_lo(kv.w) + q1.w * bf_hi(kv.w); }
            const float s = valid ? acc : -1e30f;
            const float mn = fmaxf(m, wave_max(s)), alpha = __expf(m - mn), e = valid ? __expf(s - mn) : 0.f;
            l = l * alpha + wave_sum(e); o0 *= alpha; o1 *= alpha; m = mn;
            LDS_FENCE();
            ps[lane] = e;
            LDS_FENCE();
            const int nk = (t - p0 + 1 < 64) ? t - p0 + 1 : 64;
            for (int kk = hf; kk < nk; kk += 2) { const unsigned vv = *(const unsigned*)(V + ((size_t)(b * SEQ + p0 + kk)) * 1024 + h * 64 + 2 * dp); const float pp = ps[kk]; o0 += pp * bf_lo(vv); o1 += pp * bf_hi(vv); }
        }
        const float il = 1.f / l; o0 = (o0 + __shfl_xor(o0, 32)) * il; o1 = (o1 + __shfl_xor(o1, 32)) * il;
        if (hf == 0) *(unsigned*)(AO + (size_t)row * 1024 + h * 64 + 2 * dp) = pk2(o0, o1);
    }
}

namespace att {
typedef float f32x16 __attribute__((ext_vector_type(16)));
typedef short s16x4 __attribute__((ext_vector_type(4)));
constexpr int KSTR64 = 144, KSTR96 = 208;
constexpr int KBUF = 64 * KSTR96, VBUF = 8192;
constexpr int OFF_K = 0, OFF_V = 2 * KBUF, OFF_IMPM = OFF_V + 2 * VBUF, OFF_IMPS = OFF_IMPM + 8 * 8 * 64 * 4, OFF_SELB = OFF_IMPS + 8 * 8 * 72 * 4, OFF_UNION = OFF_SELB + 8 * 8 * 8, OFF_FIN = OFF_UNION + 16, LDS_END = OFF_FIN + 8 * 32 * 64 * 4;
static_assert(LDS_END <= 147456, "attention LDS map");
constexpr float LOG2E = 1.4426950408889634f;
__device__ __forceinline__ int crow(int r, int hi) { return (r & 3) + 8 * (r >> 2) + 4 * hi; }
__device__ __forceinline__ float xhalf(float v) { return __shfl_xor(v, 32); }
__device__ __forceinline__ float xmax(float v) { const auto rr = __builtin_amdgcn_permlane32_swap(__float_as_uint(v), __float_as_uint(v), false, false); return fmaxf(__uint_as_float(rr[0]), __uint_as_float(rr[1])); }
__device__ __forceinline__ float xsum(float v) { const auto rr = __builtin_amdgcn_permlane32_swap(__float_as_uint(v), __float_as_uint(v), false, false); return __uint_as_float(rr[0]) + __uint_as_float(rr[1]); }

struct TileRegs { u32x4 k0, k1, v; };
typedef const __attribute__((address_space(1))) char* gcptr;
__device__ __forceinline__ gcptr uni_ptr(const void* p) {
    const unsigned long long v = (unsigned long long)p; const unsigned lo = __builtin_amdgcn_readfirstlane((unsigned)v), hh = __builtin_amdgcn_readfirstlane((unsigned)(v >> 32));
    return (gcptr)(((unsigned long long)hh << 32) | lo);
}
template <bool MLA>
__device__ __forceinline__ void tile_load(TileRegs& R, const bf16_t* Kg, const bf16_t* KRg, const bf16_t* Vg, unsigned koff, unsigned voff, unsigned roff, int tid) {
    R.k0 = *(const __attribute__((address_space(1))) u32x4*)(uni_ptr(Kg) + koff);
    R.v = *(const __attribute__((address_space(1))) u32x4*)(uni_ptr(Vg) + voff);
    if (MLA) { if (tid < 256) R.k1 = *(const __attribute__((address_space(1))) u32x4*)(uni_ptr(KRg) + roff); }
}
template <bool MLA, int KSTR>
__device__ __forceinline__ void tile_store(const TileRegs& R, LAS unsigned char* Kb, LAS unsigned char* Vb, int tid) {
    const int key = tid >> 3, c = tid & 7;
    *(LAS u32x4*)(Kb + key * KSTR + c * 16) = R.k0;
    if (MLA) { if (tid < 256) *(LAS u32x4*)(Kb + (tid >> 2) * KSTR + 128 + (tid & 3) * 16) = R.k1; }
    *(LAS u32x4*)(Vb + (c >> 2) * 4096 + key * 64 + (c & 3) * 16) = R.v;
}
template <int NKS, int KSTR>
__device__ __forceinline__ void qk(f32x16& p0, f32x16& p1, const LAS unsigned char* Kb, const bf16x8 (&qf)[NKS], int lane) {
    const LAS unsigned char* kp = Kb + (lane & 31) * KSTR + (lane >> 5) * 16;
#pragma unroll
    for (int r = 0; r < 16; ++r) { p0[r] = 0.f; p1[r] = 0.f; }
#pragma unroll
    for (int ks = 0; ks < NKS; ++ks) {
        const bf16x8 a0 = *(const LAS bf16x8*)(kp + ks * 32), a1 = *(const LAS bf16x8*)(kp + 32 * KSTR + ks * 32);
        p0 = __builtin_amdgcn_mfma_f32_32x32x16_bf16(a0, qf[ks], p0, 0, 0, 0);
        p1 = __builtin_amdgcn_mfma_f32_32x32x16_bf16(a1, qf[ks], p1, 0, 0, 0);
    }
}
__device__ __forceinline__ s16x4 vtr(const LAS unsigned char* p) { return __builtin_bit_cast(s16x4, __builtin_amdgcn_ds_read_tr16_b64_v4i16((LAS s16x4*)p)); }
__device__ __forceinline__ void pv(f32x16& o0, f32x16& o1, const f32x16& p0, const f32x16& p1, const LAS unsigned char* Vb, int lane) {
    const int hi = lane >> 5;
    const LAS unsigned char* vp = Vb + ((lane >> 4) & 1) * 32 + (lane & 3) * 8 + (4 * hi + ((lane & 15) >> 2)) * 64;
#pragma unroll
    for (int S = 0; S < 4; ++S) {
        u32x4 pw;
#pragma unroll
        for (int jj = 0; jj < 4; ++jj) { const int r = 8 * (S & 1) + 2 * jj; pw[jj] = (S < 2) ? pk2(p0[r], p0[r + 1]) : pk2(p1[r], p1[r + 1]); }
        const bf16x8 pf = __builtin_bit_cast(bf16x8, pw);
#pragma unroll
        for (int dh = 0; dh < 2; ++dh) {
            const s16x4 lo = vtr(vp + dh * 4096 + S * 1024), hh = vtr(vp + dh * 4096 + S * 1024 + 512);
            const bf16x8 vf = (bf16x8){lo[0], lo[1], lo[2], lo[3], hh[0], hh[1], hh[2], hh[3]};
            if (dh == 0) o0 = __builtin_amdgcn_mfma_f32_32x32x16_bf16(vf, pf, o0, 0, 0, 0); else o1 = __builtin_amdgcn_mfma_f32_32x32x16_bf16(vf, pf, o1, 0, 0, 0);
        }
    }
}
template <int PS, bool ALIBI, bool CAUS, bool WLOW, bool ROWEN, bool SCALE = true>
__device__ __forceinline__ void transform(f32x16& p0, f32x16& p1, float c1, float c2, float tbf, bool en) {
    const float base = -c2 * tbf;
#pragma unroll
    for (int r = 0; r < 16; ++r) {
        const float k0 = (float)(PS * ((r & 3) + 8 * (r >> 2))), k1 = (float)(PS * (32 + (r & 3) + 8 * (r >> 2)));
        float s0, s1;
        if (ALIBI) { s0 = fmaf(p0[r], c1, fmaf(c2, k0, base)); s1 = fmaf(p1[r], c1, fmaf(c2, k1, base)); }
        else { s0 = SCALE ? p0[r] * c1 : p0[r]; s1 = SCALE ? p1[r] * c1 : p1[r]; }
        bool v0 = true, v1 = true;
        if (CAUS) { v0 = v0 && (k0 <= tbf); v1 = v1 && (k1 <= tbf); }
        if (WLOW) { v0 = v0 && (tbf - k0 < 512.f); v1 = v1 && (tbf - k1 < 512.f); }
        if (ROWEN) { v0 = v0 && en; v1 = v1 && en; }
        p0[r] = v0 ? s0 : -1e30f; p1[r] = v1 ? s1 : -1e30f;
    }
}
__device__ __forceinline__ float max3f(float a, float b, float c) { float r; asm("v_max3_f32 %0, %1, %2, %3" : "=v"(r) : "v"(a), "v"(b), "v"(c)); return r; }
__device__ __forceinline__ float tile_max(const f32x16& p0, const f32x16& p1) {
    float a = max3f(p0[0], p0[1], p1[0]), b = max3f(p0[2], p0[3], p1[1]); a = max3f(a, p1[2], p1[3]);
#pragma unroll
    for (int r = 4; r < 16; r += 4) { a = max3f(a, p0[r], p0[r + 1]); b = max3f(b, p0[r + 2], p0[r + 3]); a = max3f(a, p1[r], p1[r + 1]); b = max3f(b, p1[r + 2], p1[r + 3]); }
    a = max3f(a, b, a);
    return xmax(a);
}
__device__ __forceinline__ void softmax_pv(f32x16& p0, f32x16& p1, float& m, float& l, f32x16& o0, f32x16& o1, const LAS unsigned char* Vb, int lane, float sc = 1.f) {
    const float mt = fmaxf(tile_max(p0, p1) * sc, -1e30f);
    if (__any(mt > m + 8.f)) { const float mn = fmaxf(m, mt); const float alpha = __builtin_amdgcn_exp2f(m - mn); l *= alpha; o0 *= alpha; o1 *= alpha; m = mn; }
    const float nmu = -fmaxf(m, -1e20f);
    float s = 0.f;
#pragma unroll
    for (int r = 0; r < 16; ++r) { p0[r] = __builtin_amdgcn_exp2f(fmaf(p0[r], sc, nmu)); p1[r] = __builtin_amdgcn_exp2f(fmaf(p1[r], sc, nmu)); s += p0[r] + p1[r]; }
    l += s;
    pv(o0, o1, p0, p1, Vb, lane);
}
template <bool FIRST> __device__ __forceinline__ void fold(LAS float* fb, const f32x16& o0, const f32x16& o1, float sc, int lane) {
#pragma unroll
    for (int r = 0; r < 16; ++r) { const float a = o0[r] * sc, b = o1[r] * sc; if (FIRST) { fb[r * 64 + lane] = a; fb[(16 + r) * 64 + lane] = b; } else { fb[r * 64 + lane] += a; fb[(16 + r) * 64 + lane] += b; } }
}
__device__ __forceinline__ void store_o(bf16_t* dst  , const f32x16& f0, const f32x16& f1, int hi) {
#pragma unroll
    for (int dh = 0; dh < 2; ++dh)
#pragma unroll
        for (int a = 0; a < 4; ++a) { const f32x16& f = dh ? f1 : f0; u32x2 w; w.x = pk2(f[4 * a], f[4 * a + 1]); w.y = pk2(f[4 * a + 2], f[4 * a + 3]); *(u32x2*)(dst + 32 * dh + 8 * a + 4 * hi) = w; }
}
}

__device__ __forceinline__ void phase_nsa_attn(const Params& p, LAS unsigned char* lds) {
    using namespace att;
    const int tid0 = threadIdx.x, wave = __builtin_amdgcn_readfirstlane(tid0 >> 6);
    const bf16_t* Q = (const bf16_t*)(p.ws + S_Q); const bf16_t* KV6 = (const bf16_t*)(p.ws + S_KV6);
    const bf16_t* KS = KV6 + (size_t)2 * NTOK * 256; const bf16_t* VS = KV6 + (size_t)3 * NTOK * 256; const bf16_t* KW = KV6 + (size_t)4 * NTOK * 256; const bf16_t* VW = KV6 + (size_t)5 * NTOK * 256;
    const bf16_t* KC = (const bf16_t*)(p.ws + S_KCMP); const bf16_t* VC = (const bf16_t*)(p.ws + S_VCMP);
    const float* GATES = (const float*)(p.ws + S_GATES); bf16_t* AO = (bf16_t*)(p.ws + S_AO);
    LAS unsigned char* Kb0 = lds + OFF_K; LAS unsigned char* Vb0 = lds + OFF_V;
    LAS float* impM = (LAS float*)(lds + OFF_IMPM) + wave * 512; LAS float* impS = (LAS float*)(lds + OFF_IMPS) + wave * 576;
    LAS unsigned char* selb = lds + OFF_SELB + wave * 64; LAS unsigned long long* uni = (LAS unsigned long long*)(lds + OFF_UNION);
    const float c1 = 0.125f * LOG2E;
    TileRegs R; bool have = false;
#pragma unroll 1
    for (int vcu = blockIdx.x; vcu < 256; vcu += gridDim.x)
#pragma unroll 1
    for (int ui = 0; ui < 8; ++ui) {
        int tid = tid0; asm volatile("" : "+v"(tid));
        const int lane = tid & 63, q = lane & 31, hi = lane >> 5, tl = q & 7, rh = q >> 3;
        const unsigned koff = (unsigned)((tid >> 3) * 256 + (tid & 7) * 8) * 2u;
        const int pair = vcu >> 3, kk = vcu & 7, b = pair >> 2, g = pair & 3;
        const int tile = (ui >> 1) * 16 + ((ui & 1) ? 15 - kk : kk);
        const int q0 = tile * 64, t = q0 + 8 * wave + tl, head = 4 * g + rh;
        const size_t row = (size_t)b * SEQ + t;
        const float c2 = exp2f(-0.5f * (float)(head + 1)) * LOG2E;
        bf16x8 qf[4];
#pragma unroll
        for (int ks = 0; ks < 4; ++ks) qf[ks] = *(const bf16x8*)(Q + row * 1024 + head * 64 + ks * 16 + hi * 8);
        const float gc = GATES[row * 48 + head * 3 + 0], gs = GATES[row * 48 + head * 3 + 1], gwd = GATES[row * 48 + head * 3 + 2];
        LAS float* fb = (LAS float*)(lds + OFF_FIN) + wave * 2048;
        for (int i = lane; i < 512; i += 64) impM[i] = 0.f;
        for (int i = lane; i < 576; i += 64) impS[i] = 0.f;
        if (tid0 == 0) *uni = 0ull;
        const int nc = (4 * tile + 3 < 255) ? 4 * tile + 3 : 255, ntc = (nc + 63) >> 6;
        const bf16_t* kcb = KC + ((size_t)b * 256 * 4 + g) * 64; const bf16_t* vcb = VC + ((size_t)b * 256 * 4 + g) * 64;
        float m = -1e30f, l = 0.f;
#pragma unroll 1
        for (int pass = 0; pass < 2; ++pass) {
            f32x16 o0, o1;
#pragma unroll
            for (int r = 0; r < 16; ++r) { o0[r] = 0.f; o1[r] = 0.f; }
            const float ltc = xsum(l); const float invl = (ltc > 0.f) ? 1.f / ltc : 0.f;
            if (!have) tile_load<false>(R, kcb, nullptr, vcb, koff, koff, 0u, tid);
            have = false;
#pragma unroll 1
            for (int T = 0; T < ntc; ++T) {
                LAS unsigned char* Kb = Kb0 + (T & 1) * KBUF; LAS unsigned char* Vb = Vb0 + (T & 1) * VBUF;
                tile_store<false, KSTR64>(R, Kb, Vb, tid);
                __syncthreads();
                if (T + 1 < ntc) tile_load<false>(R, kcb + (size_t)(T + 1) * 64 * 256, nullptr, vcb + (size_t)(T + 1) * 64 * 256, koff, koff, 0u, tid);
                else if (pass == 0) { tile_load<false>(R, kcb, nullptr, vcb, koff, koff, 0u, tid); have = true; }
                else { tile_load<false>(R, KS + ((size_t)b * SEQ) * 256 + g * 64 + (size_t)tile * 64 * 256, nullptr, VS + ((size_t)b * SEQ) * 256 + g * 64 + (size_t)tile * 64 * 256, koff, koff, 0u, tid); have = true; }
                f32x16 p0, p1;
                qk<4, KSTR64>(p0, p1, Kb, qf, lane);
                const float tbf = (float)(t - (16 * 64 * T + 31) - 64 * hi);
                transform<16, true, true, false, false>(p0, p1, c1, c2, tbf, true);
                if (pass == 0) {
                    const float mn = fmaxf(m, tile_max(p0, p1)); const float alpha = __builtin_amdgcn_exp2f(m - mn); const float mu = fmaxf(mn, -1e20f);
                    float s = 0.f;
#pragma unroll
                    for (int r = 0; r < 16; ++r) s += __builtin_amdgcn_exp2f(p0[r] - mu) + __builtin_amdgcn_exp2f(p1[r] - mu);
                    l = l * alpha + s; m = mn;
                } else {
                    const float mu = fmaxf(m, -1e20f);
#pragma unroll
                    for (int r = 0; r < 16; ++r) { p0[r] = __builtin_amdgcn_exp2f(p0[r] - mu); p1[r] = __builtin_amdgcn_exp2f(p1[r] - mu); }
#pragma unroll
                    for (int kbk = 0; kbk < 2; ++kbk)
#pragma unroll
                        for (int a = 0; a < 4; ++a) {
                            const f32x16& pp = kbk ? p1 : p0;
                            float mainv = (pp[4 * a] + pp[4 * a + 1] + pp[4 * a + 2] + 0.5f * pp[4 * a + 3]) * invl, spill = 0.5f * pp[4 * a + 3] * invl;
                            mainv += __shfl_xor(mainv, 8); mainv += __shfl_xor(mainv, 16); spill += __shfl_xor(spill, 8); spill += __shfl_xor(spill, 16);
                            const int jb = 16 * T + 8 * kbk + 2 * a + hi;
                            if (rh == 0) { impM[tl * 64 + jb] = mainv; impS[tl * 72 + jb + 1] = spill; }
                            __builtin_amdgcn_sched_barrier(0);
                        }
                    pv(o0, o1, p0, p1, Vb, lane);
                }
            }
            if (pass == 1) fold<true>(fb, o0, o1, gc * invl, lane);
            __syncthreads();
        }
        const int blk = tile;
        unsigned long long mymask;
        if (blk < 16) { mymask = (2ull << blk) - 1ull; }
        else {
            LDS_FENCE();
            const int stl = lane >> 3, sub = lane & 7;
            float mv[8]; int rk[8];
#pragma unroll
            for (int i = 0; i < 8; ++i) { const int j = sub * 8 + i; mv[i] = impM[stl * 64 + j] + impS[stl * 72 + j]; rk[i] = 0; }
#pragma unroll 1
            for (int j2 = 1; j2 < blk - 1; ++j2) {
                const float v2 = impM[stl * 64 + j2] + impS[stl * 72 + j2];
#pragma unroll
                for (int i = 0; i < 8; ++i) { const int j = sub * 8 + i; rk[i] += (v2 > mv[i] || (v2 == mv[i] && j2 < j)) ? 1 : 0; }
            }
            unsigned bits = 0;
#pragma unroll
            for (int i = 0; i < 8; ++i) { const int j = sub * 8 + i; const bool forced = (j == 0) || (j == blk) || (j == blk - 1); const bool sel = (j <= blk) && (forced || rk[i] < 13); bits |= sel ? (1u << i) : 0u; }
            selb[stl * 8 + sub] = (unsigned char)bits;
            LDS_FENCE();
            mymask = *(const LAS unsigned long long*)(selb + tl * 8);
        }
        { unsigned long long um = mymask;
#pragma unroll
          for (int o = 1; o < 8; o <<= 1) { const unsigned lo = __shfl_xor((unsigned)um, o), hh = __shfl_xor((unsigned)(um >> 32), o); um |= ((unsigned long long)hh << 32) | lo; }
          if (lane == 0) atomicOr((unsigned long long*)uni, um); }
        __syncthreads();
        const unsigned long long umask = *uni;
        {
            f32x16 o0, o1;
#pragma unroll
            for (int r = 0; r < 16; ++r) { o0[r] = 0.f; o1[r] = 0.f; }
            m = -1e30f; l = 0.f;
            const bf16_t* kb_ = KS + ((size_t)b * SEQ) * 256 + g * 64; const bf16_t* vb_ = VS + ((size_t)b * SEQ) * 256 + g * 64;
            unsigned long long rem = umask; int it = 0;
            int j = 63 - __builtin_clzll(rem); rem &= ~(1ull << j);
            if (!have) tile_load<false>(R, kb_ + (size_t)j * 64 * 256, nullptr, vb_ + (size_t)j * 64 * 256, koff, koff, 0u, tid);
            have = false;
#pragma unroll 1
            for (;;) {
                LAS unsigned char* Kb = Kb0 + (it & 1) * KBUF; LAS unsigned char* Vb = Vb0 + (it & 1) * VBUF;
                tile_store<false, KSTR64>(R, Kb, Vb, tid);
                __syncthreads();
                const int jn = rem ? 63 - __builtin_clzll(rem) : -1;
                if (jn >= 0) { rem &= ~(1ull << jn); tile_load<false>(R, kb_ + (size_t)jn * 64 * 256, nullptr, vb_ + (size_t)jn * 64 * 256, koff, koff, 0u, tid); }
                else { tile_load<false>(R, KW + ((size_t)b * SEQ) * 256 + g * 64 + (size_t)blk * 64 * 256, nullptr, VW + ((size_t)b * SEQ) * 256 + g * 64 + (size_t)blk * 64 * 256, koff, koff, 0u, tid); have = true; }
                const bool en = (mymask >> j) & 1ull;
                if (__any(en)) {
                    f32x16 p0, p1;
                    qk<4, KSTR64>(p0, p1, Kb, qf, lane);
                    const float tbf = (float)(t - 64 * j - 4 * hi);
                    if (j == blk) transform<1, true, true, false, true>(p0, p1, c1, c2, tbf, en); else transform<1, true, false, false, true>(p0, p1, c1, c2, tbf, en);
                    softmax_pv(p0, p1, m, l, o0, o1, Vb, lane);
                }
                if (jn < 0) break;
                j = jn; ++it;
            }
            const float lt = xsum(l);
            fold<false>(fb, o0, o1, (lt > 0.f) ? gs / lt : 0.f, lane);
            __syncthreads();
        }
        {
            f32x16 o0, o1;
#pragma unroll
            for (int r = 0; r < 16; ++r) { o0[r] = 0.f; o1[r] = 0.f; }
            m = -1e30f; l = 0.f;
            const bf16_t* kb_ = KW + ((size_t)b * SEQ) * 256 + g * 64; const bf16_t* vb_ = VW + ((size_t)b * SEQ) * 256 + g * 64;
            const int jlo = (blk - 8 > 0) ? blk - 8 : 0;
            if (!have) tile_load<false>(R, kb_ + (size_t)blk * 64 * 256, nullptr, vb_ + (size_t)blk * 64 * 256, koff, koff, 0u, tid);
            have = false;
#pragma unroll 1
            for (int j = blk, it = 0; j >= jlo; --j, ++it) {
                LAS unsigned char* Kb = Kb0 + (it & 1) * KBUF; LAS unsigned char* Vb = Vb0 + (it & 1) * VBUF;
                tile_store<false, KSTR64>(R, Kb, Vb, tid);
                __syncthreads();
                if (j > jlo) tile_load<false>(R, kb_ + (size_t)(j - 1) * 64 * 256, nullptr, vb_ + (size_t)(j - 1) * 64 * 256, koff, koff, 0u, tid);
                else if (ui < 7) { tile_load<false>(R, kcb, nullptr, vcb, koff, koff, 0u, tid); have = true; }
                f32x16 p0, p1;
                qk<4, KSTR64>(p0, p1, Kb, qf, lane);
                const float tbf = (float)(t - 64 * j - 4 * hi);
                if (j == blk) transform<1, true, true, false, false>(p0, p1, c1, c2, tbf, true);
                else if (j == blk - 8) transform<1, true, false, true, false>(p0, p1, c1, c2, tbf, true);
                else transform<1, true, false, false, false>(p0, p1, c1, c2, tbf, true);
                softmax_pv(p0, p1, m, l, o0, o1, Vb, lane);
            }
            const float lt = xsum(l);
            const float scw = (lt > 0.f) ? gwd / lt : 0.f;
#pragma unroll
            for (int r = 0; r < 16; ++r) { o0[r] = o0[r] * scw + fb[r * 64 + lane]; o1[r] = o1[r] * scw + fb[(16 + r) * 64 + lane]; }
            store_o(AO + row * 1024 + head * 64, o0, o1, hi);
            __syncthreads();
        }
    }
}

template <int VAR>
__device__ __forceinline__ void phase_mla_attn(const Params& p, LAS unsigned char* lds) {
    using namespace att;
    const int tid0 = threadIdx.x, wave = __builtin_amdgcn_readfirstlane(tid0 >> 6);
    const bf16_t* QF = (const bf16_t*)(p.ws + S_QF); const bf16_t* KN = (const bf16_t*)(p.ws + S_KNOPE); const bf16_t* KR = (const bf16_t*)(p.ws + S_KROPE); const bf16_t* V = (const bf16_t*)(p.ws + S_V);
    const float* rc = (const float*)(p.ws + WS_ROPE_COS); const float* rs = (const float*)(p.ws + WS_ROPE_SIN);
    bf16_t* AO = (bf16_t*)(p.ws + S_AO2);
    LAS unsigned char* Kb0 = lds + OFF_K; LAS unsigned char* Vb0 = lds + OFF_V;
    const float c1 = 0.10206207261596577f * LOG2E;
    TileRegs R; bool have_tile0 = false;
#pragma unroll 1
    for (int vcu = blockIdx.x; vcu < 256; vcu += gridDim.x)
#pragma unroll 1
    for (int ui = 0; ui < 8; ++ui) {
        int tid = tid0; asm volatile("" : "+v"(tid));
        const int lane = tid & 63, q = lane & 31, hi = lane >> 5;
        const unsigned koff = (unsigned)((tid >> 3) * 1024 + (tid & 7) * 8) * 2u, roff = (unsigned)((tid >> 2) * 32 + (tid & 3) * 8) * 2u;
        const int bh = vcu >> 1, b = bh >> 4, h = bh & 15, par = vcu & 1;
        const int qb = (ui & 1) ? 15 - (ui - 1) - par : ui + par;
        const int t = 256 * qb + 32 * wave + q; const size_t row = (size_t)b * SEQ + t;
        bf16x8 qf[6];
        { const bf16_t* qrow = QF + row * 1536 + h * 96;
#pragma unroll
          for (int ks = 0; ks < 4; ++ks) qf[ks] = *(const bf16x8*)(qrow + ks * 16 + hi * 8);
          const u32x4 x1 = *(const u32x4*)(qrow + 64 + hi * 8), x2 = *(const u32x4*)(qrow + 80 + hi * 8);
          const f32x4 ca = *(const f32x4*)(rc + t * 16 + hi * 8), cb = *(const f32x4*)(rc + t * 16 + hi * 8 + 4), sa = *(const f32x4*)(rs + t * 16 + hi * 8), sb = *(const f32x4*)(rs + t * 16 + hi * 8 + 4);
          const float a1[8] = {bf_lo(x1.x), bf_hi(x1.x), bf_lo(x1.y), bf_hi(x1.y), bf_lo(x1.z), bf_hi(x1.z), bf_lo(x1.w), bf_hi(x1.w)};
          const float a2[8] = {bf_lo(x2.x), bf_hi(x2.x), bf_lo(x2.y), bf_hi(x2.y), bf_lo(x2.z), bf_hi(x2.z), bf_lo(x2.w), bf_hi(x2.w)};
          const float cc[8] = {ca.x, ca.y, ca.z, ca.w, cb.x, cb.y, cb.z, cb.w}, ss[8] = {sa.x, sa.y, sa.z, sa.w, sb.x, sb.y, sb.z, sb.w};
          u32x4 w1, w2;
#pragma unroll
          for (int jj = 0; jj < 4; ++jj) { const int e = 2 * jj;
              w1[jj] = pk2(a1[e] * cc[e] - a2[e] * ss[e], a1[e + 1] * cc[e + 1] - a2[e + 1] * ss[e + 1]);
              w2[jj] = pk2(a2[e] * cc[e] + a1[e] * ss[e], a2[e + 1] * cc[e + 1] + a1[e + 1] * ss[e + 1]); }
          qf[4] = __builtin_bit_cast(bf16x8, w1); qf[5] = __builtin_bit_cast(bf16x8, w2); }
        f32x16 o0, o1;
#pragma unroll
        for (int r = 0; r < 16; ++r) { o0[r] = 0.f; o1[r] = 0.f; }
        float m = -1e30f, l = 0.f;
        const bf16_t* knb = KN + ((size_t)b * SEQ) * 1024 + h * 64; const bf16_t* krb = KR + ((size_t)b * SEQ) * 32; const bf16_t* vb_ = V + ((size_t)b * SEQ) * 1024 + h * 64;
        const int nt = 4 * qb + 4; const int tmin = 256 * qb + 32 * wave;
        if (!have_tile0) tile_load<true>(R, knb, krb, vb_, koff, koff, roff, tid);
        have_tile0 = false;
#pragma unroll 1
        for (int j = 0; j < nt; ++j) {
            LAS unsigned char* Kb = Kb0 + (j & 1) * KBUF; LAS unsigned char* Vb = Vb0 + (j & 1) * VBUF;
            tile_store<true, KSTR96>(R, Kb, Vb, tid);
            __syncthreads();
            if (j + 1 < nt) tile_load<true>(R, knb + (size_t)(j + 1) * 64 * 1024, krb + (size_t)(j + 1) * 64 * 32, vb_ + (size_t)(j + 1) * 64 * 1024, koff, koff, roff, tid);
            else if (ui < 7) {
                tile_load<true>(R, knb, krb, vb_, koff, koff, roff, tid); have_tile0 = true; }
            if (64 * j <= tmin + 31) {
                f32x16 p0, p1;
                if (VAR != 3) qk<6, KSTR96>(p0, p1, Kb, qf, lane); else {
#pragma unroll
                    for (int r = 0; r < 16; ++r) { p0[r] = (float)(r + j); p1[r] = (float)(r - j); } }
                const float tbf = (float)(t - 64 * j - 4 * hi);
                if (VAR == 1) {
                    l += p0[0] + p1[15]; pv(o0, o1, p0, p1, Vb, lane);
                } else if (VAR == 2) {
                    if (64 * j + 63 > tmin) transform<1, false, true, false, false>(p0, p1, c1, 0.f, tbf, true); else transform<1, false, false, false, false>(p0, p1, c1, 0.f, tbf, true);
                    const float mn = fmaxf(m, tile_max(p0, p1)); const float mu = fmaxf(mn, -1e20f); float sacc = 0.f;
#pragma unroll
                    for (int r = 0; r < 16; ++r) { p0[r] = __builtin_amdgcn_exp2f(p0[r] - mu); p1[r] = __builtin_amdgcn_exp2f(p1[r] - mu); sacc += p0[r] + p1[r]; }
                    l += sacc; m = mn; o0[0] += pk2(p0[0], p0[1]) * 1e-30f; o1[3] += pk2(p1[2], p1[5]) * 1e-30f;
                } else {
                if (64 * j + 63 > tmin) transform<1, false, true, false, false, false>(p0, p1, c1, 0.f, tbf, true);
                softmax_pv(p0, p1, m, l, o0, o1, Vb, lane, c1);
                }
            }
        }
        const float lt = xsum(l); const float il = 1.f / lt;
        o0 *= il; o1 *= il;
        store_o(AO + row * 1024 + h * 64, o0, o1, hi);
        __syncthreads();
    }
}

__device__ __forceinline__ float pack_idx(float v, unsigned bits, unsigned mask) { return __uint_as_float((__float_as_uint(v) & ~mask) | bits); }
__device__ __forceinline__ void phase_peer_route_ref(const Params& p, LAS unsigned char* lds, int layer, const bf16_t* QP, int* EIDX, float* GW) {
    int tid_ = threadIdx.x; asm volatile("" : "+v"(tid_));
    const int lane = tid_ & 63, wave = tid_ >> 6;
    const int gw = blockIdx.x * NWAVES + wave, NGW = gridDim.x * NWAVES;
    LAS float* qs = (LAS float*)(lds + wave * 1024);
    const bf16_t* SK = (const bf16_t*)(p.ws + WS_SUBK) + (size_t)layer * 8 * 2 * 128 * 128;
    for (int item = gw; item < NTOK * 8; item += NGW) {
        const int h = item & 7, t = item >> 3;
        LDS_FENCE();
        { const u32x2 qv = *(const u32x2*)(QP + (size_t)t * 2048 + h * 256 + lane * 4); *(LAS f32x4*)(qs + lane * 4) = (f32x4){bf_lo(qv.x), bf_hi(qv.x), bf_lo(qv.y), bf_hi(qv.y)}; }
        LDS_FENCE();
        float sv[2];
#pragma unroll
        for (int c = 0; c < 2; ++c) {
            float v[2];
#pragma unroll
            for (int kk = 0; kk < 2; ++kk) {
                const int key = lane + 64 * kk; const bf16_t* krow = SK + ((size_t)(h * 2 + c) * 128 + key) * 128;
                float acc = 0.f;
#pragma unroll 4
                for (int d8 = 0; d8 < 16; ++d8) { const u32x4 kv = *(const u32x4*)(krow + d8 * 8); const f32x4 q0 = *(const LAS f32x4*)(qs + c * 128 + d8 * 8), q1 = *(const LAS f32x4*)(qs + c * 128 + d8 * 8 + 4);
                    acc += q0.x * bf_lo(kv.x) + q0.y * bf_hi(kv.x) + q0.z * bf_lo(kv.y) + q0.w * bf_hi(kv.y) + q1.x * bf_lo(kv.z) + q1.y * bf_hi(kv.z) + q1.z * bf_lo(kv.w) + q1.w * bf_hi(kv.w); }
                v[kk] = pack_idx(acc, 127u - (unsigned)key, 127u);
            }
            float mine = 0.f;
#pragma unroll 1
            for (int n = 0; n < 16; ++n) { const float w = wave_max(fmaxf(v[0], v[1])); if (v[0] == w) v[0] = -INFINITY; if (v[1] == w) v[1] = -INFINITY; if (lane == n) mine = w; }
            sv[c] = mine;
        }
        const int a = lane & 15, bq = lane >> 4;
        const float s0 = __shfl(sv[0], a);
        float cv[4];
#pragma unroll
        for (int i = 0; i < 4; ++i) { const float s1 = __shfl(sv[1], 4 * bq + i); cv[i] = pack_idx(s0 + s1, 255u - (unsigned)(a * 16 + 4 * bq + i), 255u); }
        float cs = 0.f;
#pragma unroll 1
        for (int n = 0; n < 16; ++n) { const float w = wave_max(fmaxf(fmaxf(cv[0], cv[1]), fmaxf(cv[2], cv[3])));
#pragma unroll
            for (int i = 0; i < 4; ++i) if (cv[i] == w) cv[i] = -INFINITY;
            if (lane == n) cs = w; }
        const unsigned flat = 255u - (__float_as_uint(cs) & 255u);
        const int wa = (int)(flat >> 4) & 15, wb = (int)flat & 15;
        const unsigned i0 = 127u - (__float_as_uint(__shfl(sv[0], wa)) & 127u), i1 = 127u - (__float_as_uint(__shfl(sv[1], wb)) & 127u);
        const float mx = __shfl(cs, 0);
        const float ex = (lane < 16) ? __expf(cs - mx) : 0.f;
        const float sum = wave_sum(ex);
        if (lane < 16) { EIDX[(size_t)t * 128 + h * 16 + lane] = (int)(i0 * 128u + i1); GW[(size_t)t * 128 + h * 16 + lane] = ex / sum; }
    }
}

namespace rt {
typedef float f32x16 __attribute__((ext_vector_type(16)));
constexpr int SKSTR = 272;
constexpr int OFF_SK = 0, OFF_IDX = 2 * 128 * SKSTR, LDS_END = OFF_IDX + 8 * 64 * 32;
__device__ __forceinline__ void ce_desc(float& a, float& b) { const float hi = fmaxf(a, b), lo = fminf(a, b); a = hi; b = lo; }
__device__ __forceinline__ void sort16_desc(float (&v)[16]) {
    ce_desc(v[0], v[13]); ce_desc(v[1], v[12]); ce_desc(v[2], v[15]); ce_desc(v[3], v[14]); ce_desc(v[4], v[8]); ce_desc(v[5], v[6]); ce_desc(v[7], v[11]); ce_desc(v[9], v[10]);
    ce_desc(v[0], v[5]); ce_desc(v[1], v[7]); ce_desc(v[2], v[9]); ce_desc(v[3], v[4]); ce_desc(v[6], v[13]); ce_desc(v[8], v[14]); ce_desc(v[10], v[15]); ce_desc(v[11], v[12]);
    ce_desc(v[0], v[1]); ce_desc(v[2], v[3]); ce_desc(v[4], v[5]); ce_desc(v[6], v[8]); ce_desc(v[7], v[9]); ce_desc(v[10], v[11]); ce_desc(v[12], v[13]); ce_desc(v[14], v[15]);
    ce_desc(v[0], v[2]); ce_desc(v[1], v[3]); ce_desc(v[4], v[10]); ce_desc(v[5], v[11]); ce_desc(v[6], v[7]); ce_desc(v[8], v[9]); ce_desc(v[12], v[14]); ce_desc(v[13], v[15]);
    ce_desc(v[1], v[2]); ce_desc(v[3], v[12]); ce_desc(v[4], v[6]); ce_desc(v[5], v[7]); ce_desc(v[8], v[10]); ce_desc(v[9], v[11]); ce_desc(v[13], v[14]);
    ce_desc(v[1], v[4]); ce_desc(v[2], v[6]); ce_desc(v[5], v[8]); ce_desc(v[7], v[10]); ce_desc(v[9], v[13]); ce_desc(v[11], v[14]);
    ce_desc(v[2], v[4]); ce_desc(v[3], v[6]); ce_desc(v[9], v[12]); ce_desc(v[11], v[13]);
    ce_desc(v[3], v[5]); ce_desc(v[6], v[8]); ce_desc(v[7], v[9]); ce_desc(v[10], v[12]);
    ce_desc(v[3], v[4]); ce_desc(v[5], v[6]); ce_desc(v[7], v[8]); ce_desc(v[9], v[10]); ce_desc(v[11], v[12]);
    ce_desc(v[6], v[7]); ce_desc(v[8], v[9]);
}
__device__ __forceinline__ void merge16_desc(float (&v)[16]) {
#pragma unroll
    for (int j = 8; j > 0; j >>= 1)
#pragma unroll
        for (int i = 0; i < 16; ++i) { const int l = i ^ j; if (l > i) ce_desc(v[i], v[l]); }
}
__device__ __forceinline__ void top16_merge(float (&a)[16], const float (&b)[16]) {
#pragma unroll
    for (int i = 0; i < 16; ++i) a[i] = fmaxf(a[i], b[15 - i]);
    merge16_desc(a);
}
}
__device__ __forceinline__ void phase_peer_route(const Params& p, LAS unsigned char* lds, int layer, const bf16_t* QP, int* EIDX, float* GW) {
    using namespace rt;
    int tid = threadIdx.x; asm volatile("" : "+v"(tid));
    const int lane = tid & 63, wave = __builtin_amdgcn_readfirstlane(tid >> 6), tok = lane & 31, hi = lane >> 5;
    const bf16_t* SK = (const bf16_t*)(p.ws + WS_SUBK) + (size_t)layer * 8 * 2 * 128 * 128;
    LAS unsigned char* idxs = lds + OFF_IDX + wave * 2048 + lane * 32;
    const int nbpi = NTOK / 1024;
    for (int bi = blockIdx.x; bi < 8 * nbpi; bi += gridDim.x) {
        const int h = bi & 7, tb = bi >> 3;
        __syncthreads();
        for (int i = tid; i < 256 * 16; i += NTHREADS) { const int r = i >> 4, c = i & 15; *(LAS u32x4*)(lds + OFF_SK + r * SKSTR + c * 16) = *(const u32x4*)(SK + ((size_t)h * 256 + r) * 128 + c * 8); }
        __syncthreads();
        bf16x8 qn[8];
        { const int t0 = tb * 1024 + wave * 128 + tok;
#pragma unroll
          for (int ks = 0; ks < 8; ++ks) qn[ks] = *(const bf16x8*)(QP + (size_t)t0 * 2048 + h * 256 + ks * 16 + hi * 8); }
#pragma unroll 1
        for (int gi = 0; gi < 4; ++gi) {
            const int t = tb * 1024 + wave * 128 + gi * 32 + tok;
            float top[2][16];
#pragma unroll
            for (int c = 0; c < 2; ++c) {
                bf16x8 qf[8];
#pragma unroll
                for (int ks = 0; ks < 8; ++ks) qf[ks] = qn[ks];
                { const int tnx = (c == 0) ? t : t + 32; const int cn = c ^ 1;
                  if (c == 0 || gi < 3) {
#pragma unroll
                      for (int ks = 0; ks < 8; ++ks) qn[ks] = *(const bf16x8*)(QP + (size_t)tnx * 2048 + h * 256 + cn * 128 + ks * 16 + hi * 8); } }
                float cur[16];
#pragma unroll
                for (int kb = 0; kb < 4; ++kb) {
                    f32x16 acc;
#pragma unroll
                    for (int r = 0; r < 16; ++r) acc[r] = 0.f;
                    const LAS unsigned char* kp = lds + OFF_SK + (c * 128 + kb * 32 + tok) * SKSTR + hi * 16;
#pragma unroll
                    for (int ks = 0; ks < 8; ++ks) acc = __builtin_amdgcn_mfma_f32_32x32x16_bf16(*(const LAS bf16x8*)(kp + ks * 32), qf[ks], acc, 0, 0, 0);
                    float v[16];
#pragma unroll
                    for (int r = 0; r < 16; ++r) { const unsigned key = (unsigned)(32 * kb + (r & 3) + 8 * (r >> 2)) + 4u * (unsigned)hi; v[r] = __uint_as_float((__float_as_uint(acc[r]) & ~127u) | (127u - key)); }
                    sort16_desc(v);
                    if (kb == 0) {
#pragma unroll
                        for (int r = 0; r < 16; ++r) cur[r] = v[r];
                    } else top16_merge(cur, v);
                }
                float oth[16];
#pragma unroll
                for (int r = 0; r < 16; ++r) oth[r] = __shfl_xor(cur[r], 32);
                top16_merge(cur, oth);
#pragma unroll
                for (int r = 0; r < 16; ++r) top[c][r] = cur[r];
            }
            { u32x4 w0, w1;
#pragma unroll
              for (int c = 0; c < 2; ++c) {
                  u32x4 w;
#pragma unroll
                  for (int jj = 0; jj < 4; ++jj) { unsigned x = 0;
#pragma unroll
                      for (int e = 0; e < 4; ++e) x |= (127u - (__float_as_uint(top[c][4 * jj + e]) & 127u)) << (8 * e);
                      w[jj] = x; }
                  if (c == 0) w0 = w; else w1 = w; }
              *(LAS u32x4*)idxs = w0; *(LAS u32x4*)(idxs + 16) = w1; }
#define CAND(a, b) __uint_as_float((__float_as_uint(top[0][a] + top[1][b]) & ~255u) | (255u - (unsigned)(16 * (a) + (b))))
            float A[16], B[16], X[16], Y[16];
#pragma unroll
            for (int b = 0; b < 16; ++b) A[b] = CAND(0, b);
#pragma unroll
            for (int b = 0; b < 8; ++b) B[b] = CAND(1, b);
#pragma unroll
            for (int b = 8; b < 16; ++b) B[b] = -INFINITY;
            top16_merge(A, B);
            X[0] = CAND(2, 0); X[1] = CAND(2, 1); X[2] = CAND(2, 2); X[3] = CAND(2, 3); X[4] = CAND(2, 4); X[5] = CAND(3, 0); X[6] = CAND(3, 1); X[7] = CAND(3, 2); X[8] = CAND(3, 3);
            X[9] = CAND(4, 0); X[10] = CAND(4, 1); X[11] = CAND(4, 2); X[12] = CAND(5, 0); X[13] = CAND(5, 1); X[14] = CAND(6, 0); X[15] = CAND(6, 1);
            { const float L[9] = {CAND(7, 0), CAND(8, 0), CAND(9, 0), CAND(10, 0), CAND(11, 0), CAND(12, 0), CAND(13, 0), CAND(14, 0), CAND(15, 0)}; const float e = CAND(7, 1);
              Y[0] = L[0];
#pragma unroll
              for (int i = 1; i < 9; ++i) Y[i] = fmaxf(L[i], fminf(L[i - 1], e));
              Y[9] = fminf(L[8], e); }
#pragma unroll
            for (int i = 10; i < 16; ++i) Y[i] = -INFINITY;
#undef CAND
            sort16_desc(X);
            top16_merge(A, X); top16_merge(A, Y);
            float ex[16], sum = 0.f;
#pragma unroll
            for (int n = 0; n < 16; ++n) { ex[n] = __expf(A[n] - A[0]); sum += ex[n]; }
            const float inv = 1.f / sum;
            LDS_FENCE();
            if (hi == 0) {
                int* ep = EIDX + (size_t)t * 128 + h * 16;
#pragma unroll
                for (int jj = 0; jj < 4; ++jj) { u32x4 w;
#pragma unroll
                    for (int e = 0; e < 4; ++e) { const unsigned flat = 255u - (__float_as_uint(A[4 * jj + e]) & 255u); const unsigned i0 = idxs[flat >> 4], i1 = idxs[16 + (flat & 15u)]; w[e] = i0 * 128u + i1; }
                    *(u32x4*)(ep + 4 * jj) = w; }
            } else {
                float* gp = GW + (size_t)t * 128 + h * 16;
#pragma unroll
                for (int jj = 0; jj < 4; ++jj) *(f32x4*)(gp + 4 * jj) = (f32x4){ex[4 * jj] * inv, ex[4 * jj + 1] * inv, ex[4 * jj + 2] * inv, ex[4 * jj + 3] * inv};
            }
            LDS_FENCE();
        }
    }
}

__device__ __forceinline__ float dot2bf(unsigned a, unsigned b, float acc) {
    float r; asm("v_dot2c_f32_bf16 %0, %1, %2" : "=v"(r) : "v"(a), "v"(b), "0"(acc)); return r;
}
__device__ __forceinline__ float dot8(const u32x4& a, const u32x4& b, float acc) {
    acc = dot2bf(a.x, b.x, acc); acc = dot2bf(a.y, b.y, acc); acc = dot2bf(a.z, b.z, acc); acc = dot2bf(a.w, b.w, acc);
    return acc;
}
__device__ __forceinline__ void axpy8(float* o, const u32x4& v, float w) {
    o[0] += w * bf_lo(v.x); o[1] += w * bf_hi(v.x); o[2] += w * bf_lo(v.y); o[3] += w * bf_hi(v.y); o[4] += w * bf_lo(v.z); o[5] += w * bf_hi(v.z); o[6] += w * bf_lo(v.w); o[7] += w * bf_hi(v.w);
}
#if TAB_FP4
typedef u32x2 tabw_t;
__device__ __forceinline__ void dec16(float (&f)[16], const tabw_t& w) {
#pragma unroll
    for (int j = 0; j < 2; ++j) { const f32x2 a = __builtin_amdgcn_cvt_scalef32_pk_f32_fp4(w[j], 1.0f, 0), b = __builtin_amdgcn_cvt_scalef32_pk_f32_fp4(w[j], 1.0f, 1), c = __builtin_amdgcn_cvt_scalef32_pk_f32_fp4(w[j], 1.0f, 2), d = __builtin_amdgcn_cvt_scalef32_pk_f32_fp4(w[j], 1.0f, 3);
        f[8 * j] = a.x; f[8 * j + 1] = a.y; f[8 * j + 2] = b.x; f[8 * j + 3] = b.y; f[8 * j + 4] = c.x; f[8 * j + 5] = c.y; f[8 * j + 6] = d.x; f[8 * j + 7] = d.y; }
}
#else
typedef u32x4 tabw_t;
__device__ __forceinline__ void dec16(float (&f)[16], const tabw_t& w) {
#pragma unroll
    for (int j = 0; j < 4; ++j) { const f32x2 lo = __builtin_amdgcn_cvt_pk_f32_fp8((int)w[j], false), hh = __builtin_amdgcn_cvt_pk_f32_fp8((int)w[j], true); f[4 * j] = lo.x; f[4 * j + 1] = lo.y; f[4 * j + 2] = hh.x; f[4 * j + 3] = hh.y; }
}
#endif
__device__ __forceinline__ void phase_peer_gather(const Params& p, int layer, const int* EIDX, const float* GW, const bf16_t* HB, bf16_t* HBO, float* OUT, float fs) {
    int tid_ = threadIdx.x; asm volatile("" : "+v"(tid_));
    const int lane = tid_ & 63, wave = tid_ >> 6;
    const int gw = blockIdx.x * NWAVES + wave, NGW = gridDim.x * NWAVES;
    const unsigned char* U8 = p.ws + WS_TAB + (size_t)layer * 2 * TAB_BYTES; const unsigned char* V8 = U8 + TAB_BYTES;
    const float* lg = p.in[I_PEER_LNG] + layer * 1024; const float* lb = p.in[I_PEER_LNB] + layer * 1024;
    for (int t = gw; t < NTOK; t += NGW) {
        const u32x4 x0 = *(const u32x4*)(HB + (size_t)t * 1024 + lane * 16), x1 = *(const u32x4*)(HB + (size_t)t * 1024 + lane * 16 + 8);
        const float xf[16] = {bf_lo(x0.x), bf_hi(x0.x), bf_lo(x0.y), bf_hi(x0.y), bf_lo(x0.z), bf_hi(x0.z), bf_lo(x0.w), bf_hi(x0.w), bf_lo(x1.x), bf_hi(x1.x), bf_lo(x1.y), bf_hi(x1.y), bf_lo(x1.z), bf_hi(x1.z), bf_lo(x1.w), bf_hi(x1.w)};
        const int e0 = EIDX[(size_t)t * 128 + lane], e1 = EIDX[(size_t)t * 128 + 64 + lane];
        const float g0 = GW[(size_t)t * 128 + lane], g1 = GW[(size_t)t * 128 + 64 + lane];
        float o[16];
#pragma unroll
        for (int i = 0; i < 16; ++i) o[i] = 0.f;
#pragma unroll 1
        for (int half = 0; half < 2; ++half) {
            const int eh = half ? e1 : e0; const float gh = half ? g1 : g0;
#pragma unroll 1
            for (int kb = 0; kb < 64; kb += 8) {
                tabw_t uw[8], vw[8]; float gg[8];
#pragma unroll
                for (int i = 0; i < 8; ++i) { const int e = __shfl(eh, kb + i); gg[i] = __shfl(gh, kb + i);
                    uw[i] = *(const tabw_t*)(U8 + (size_t)e * TAB_ROW + lane * (TAB_ROW / 64)); vw[i] = *(const tabw_t*)(V8 + (size_t)e * TAB_ROW + lane * (TAB_ROW / 64)); }
#pragma unroll
                for (int i = 0; i < 8; ++i) {
                    float uf[16]; dec16(uf, uw[i]);
                    float d0 = 0.f, d1 = 0.f;
#pragma unroll
                    for (int j = 0; j < 8; ++j) { d0 += xf[2 * j] * uf[2 * j]; d1 += xf[2 * j + 1] * uf[2 * j + 1]; }
                    const float d = wave_sum(d0 + d1) * (1.f / U_SCALE);
                    const float w = gg[i] * gelu_tanh(d);
                    float vf[16]; dec16(vf, vw[i]);
#pragma unroll
                    for (int j = 0; j < 16; ++j) o[j] += w * vf[j];
                }
            }
        }
        float z[16]; float s = 0.f;
#pragma unroll
        for (int i = 0; i < 16; ++i) { z[i] = DN_ALPHA * xf[i] + fs * (1.f / V_SCALE) * o[i]; s += z[i]; }
        const float mean = wave_sum(s) * (1.f / 1024.f); float q = 0.f;
#pragma unroll
        for (int i = 0; i < 16; ++i) { z[i] -= mean; q += z[i] * z[i]; }
        const float rstd = rsqrtf(wave_sum(q) * (1.f / 1024.f) + LN_EPS);
#pragma unroll
        for (int j = 0; j < 4; ++j) { const f32x4 ga = *(const f32x4*)(lg + lane * 16 + 4 * j), ba = *(const f32x4*)(lb + lane * 16 + 4 * j);
#pragma unroll
            for (int i = 0; i < 4; ++i) z[4 * j + i] = z[4 * j + i] * rstd * ga[i] + ba[i]; }
        if (OUT) {
#pragma unroll
            for (int j = 0; j < 4; ++j) *(f32x4*)(OUT + (size_t)t * 1024 + lane * 16 + 4 * j) = (f32x4){z[4 * j], z[4 * j + 1], z[4 * j + 2], z[4 * j + 3]};
        } else {
            u32x4 w0, w1; w0.x = pk2(z[0], z[1]); w0.y = pk2(z[2], z[3]); w0.z = pk2(z[4], z[5]); w0.w = pk2(z[6], z[7]); w1.x = pk2(z[8], z[9]); w1.y = pk2(z[10], z[11]); w1.z = pk2(z[12], z[13]); w1.w = pk2(z[14], z[15]);
            *(u32x4*)(HBO + (size_t)t * 1024 + lane * 16) = w0; *(u32x4*)(HBO + (size_t)t * 1024 + lane * 16 + 8) = w1;
        }
    }
}

__device__ __forceinline__ void phase_peer_gather6(const Params& p, int layer, const int* EIDX, const float* GW, const bf16_t* HB, bf16_t* HBO, float* OUT, float fs) {
    int tid_ = threadIdx.x; asm volatile("" : "+v"(tid_));
    const int lane = tid_ & 63, wave = tid_ >> 6, hl = lane & 31, half = lane >> 5;
    const int gw = blockIdx.x * NWAVES + wave, NGW = gridDim.x * NWAVES;
    const unsigned char* U6 = p.ws + WS_TAB + (size_t)layer * 2 * TAB_BYTES; const unsigned char* V6 = U6 + TAB_BYTES;
    const float* lg = p.in[I_PEER_LNG] + layer * 1024; const float* lb = p.in[I_PEER_LNB] + layer * 1024;
    for (int t = gw; t < NTOK; t += NGW) {
        float xf[32];
#pragma unroll
        for (int j = 0; j < 4; ++j) { const u32x4 xv = *(const u32x4*)(HB + (size_t)t * 1024 + hl * 32 + j * 8);
            xf[8 * j] = bf_lo(xv.x); xf[8 * j + 1] = bf_hi(xv.x); xf[8 * j + 2] = bf_lo(xv.y); xf[8 * j + 3] = bf_hi(xv.y); xf[8 * j + 4] = bf_lo(xv.z); xf[8 * j + 5] = bf_hi(xv.z); xf[8 * j + 6] = bf_lo(xv.w); xf[8 * j + 7] = bf_hi(xv.w); }
        const int e0 = EIDX[(size_t)t * 128 + lane], e1 = EIDX[(size_t)t * 128 + 64 + lane];
        const float g0 = GW[(size_t)t * 128 + lane], g1 = GW[(size_t)t * 128 + 64 + lane];
        float o[32];
#pragma unroll
        for (int i = 0; i < 32; ++i) o[i] = 0.f;
#pragma unroll 1
        for (int hs = 0; hs < 2; ++hs) {
            const int eh = hs ? e1 : e0; const float gh = hs ? g1 : g0;
#pragma unroll 1
            for (int kb = 0; kb < 64; kb += 8) {
                u32x4 ua[4], va[4]; u32x2 ub[4], vb[4]; float gg[4];
#pragma unroll
                for (int i = 0; i < 4; ++i) { const int k = kb + 2 * i + half; const int e = __shfl(eh, k); gg[i] = __shfl(gh, k);
                    const unsigned char* ur = U6 + (size_t)e * 768 + hl * 24; const unsigned char* vr = V6 + (size_t)e * 768 + hl * 24;
                    ua[i] = *(const u32x4*)ur; ub[i] = *(const u32x2*)(ur + 16); va[i] = *(const u32x4*)vr; vb[i] = *(const u32x2*)(vr + 16); }
#pragma unroll
                for (int i = 0; i < 4; ++i) {
                    const v32f_t uf = __builtin_amdgcn_cvt_scalef32_pk32_f32_fp6((v6u_t){ua[i].x, ua[i].y, ua[i].z, ua[i].w, ub[i].x, ub[i].y}, 1.0f);
                    float d0 = 0.f, d1 = 0.f;
#pragma unroll
                    for (int j = 0; j < 16; ++j) { d0 += xf[2 * j] * uf[2 * j]; d1 += xf[2 * j + 1] * uf[2 * j + 1]; }
                    float d = d0 + d1;
#pragma unroll
                    for (int ofs = 16; ofs >= 1; ofs >>= 1) d += __shfl_xor(d, ofs);
                    const float w = gg[i] * gelu_tanh(d * (1.f / U_SCALE));
                    const v32f_t vf = __builtin_amdgcn_cvt_scalef32_pk32_f32_fp6((v6u_t){va[i].x, va[i].y, va[i].z, va[i].w, vb[i].x, vb[i].y}, 1.0f);
#pragma unroll
                    for (int j = 0; j < 32; ++j) o[j] += w * vf[j];
                }
            }
        }
        float z[32]; float s = 0.f;
#pragma unroll
        for (int i = 0; i < 32; ++i) { const float ot = o[i] + __shfl_xor(o[i], 32); z[i] = DN_ALPHA * xf[i] + fs * (1.f / V_SCALE) * ot; s += z[i]; }
#pragma unroll
        for (int ofs = 16; ofs >= 1; ofs >>= 1) s += __shfl_xor(s, ofs);
        const float mean = s * (1.f / 1024.f); float q = 0.f;
#pragma unroll
        for (int i = 0; i < 32; ++i) { z[i] -= mean; q += z[i] * z[i]; }
#pragma unroll
        for (int ofs = 16; ofs >= 1; ofs >>= 1) q += __shfl_xor(q, ofs);
        const float rstd = rsqrtf(q * (1.f / 1024.f) + LN_EPS);
        float y[16]; const int c0 = hl * 32 + half * 16;
#pragma unroll
        for (int j = 0; j < 4; ++j) { const f32x4 ga = *(const f32x4*)(lg + c0 + 4 * j), ba = *(const f32x4*)(lb + c0 + 4 * j);
#pragma unroll
            for (int i = 0; i < 4; ++i) { float za = z[4 * j + i], zb = z[16 + 4 * j + i]; asm volatile("" : "+v"(za), "+v"(zb));
                const float zz = half ? zb : za; y[4 * j + i] = zz * rstd * ga[i] + ba[i]; } }
        if (OUT) {
#pragma unroll
            for (int j = 0; j < 4; ++j) *(f32x4*)(OUT + (size_t)t * 1024 + c0 + 4 * j) = (f32x4){y[4 * j], y[4 * j + 1], y[4 * j + 2], y[4 * j + 3]};
        } else {
            u32x4 w0, w1; w0.x = pk2(y[0], y[1]); w0.y = pk2(y[2], y[3]); w0.z = pk2(y[4], y[5]); w0.w = pk2(y[6], y[7]); w1.x = pk2(y[8], y[9]); w1.y = pk2(y[10], y[11]); w1.z = pk2(y[12], y[13]); w1.w = pk2(y[14], y[15]);
            *(u32x4*)(HBO + (size_t)t * 1024 + c0) = w0; *(u32x4*)(HBO + (size_t)t * 1024 + c0 + 8) = w1;
        }
    }
}

template <int CTRL> __device__ __forceinline__ float dpp_get(float v) { return __builtin_bit_cast(float, __builtin_amdgcn_update_dpp(0, __builtin_bit_cast(int, v), CTRL, 0xF, 0xF, true)); }
__device__ __forceinline__ float half_sum32(float d) {
    d += dpp_get<0xB1>(d);
    d += dpp_get<0x4E>(d);
    d += dpp_get<0x141>(d);
    d += dpp_get<0x140>(d);
    d += __shfl_xor(d, 16);
    return d;
}
__device__ __forceinline__ float wave_sum_dpp(float v) {
    v += dpp_get<0xB1>(v); v += dpp_get<0x4E>(v); v += dpp_get<0x141>(v); v += dpp_get<0x140>(v);
    v += __builtin_bit_cast(float, __builtin_amdgcn_update_dpp(0, __builtin_bit_cast(int, v), 0x142, 0xA, 0xF, false));
    v += __builtin_bit_cast(float, __builtin_amdgcn_update_dpp(0, __builtin_bit_cast(int, v), 0x143, 0xC, 0xF, false));
    return __builtin_bit_cast(float, __builtin_amdgcn_readlane(__builtin_bit_cast(int, v), 63));
}
__device__ __forceinline__ void phase_peer_upass(const Params& p, int layer, const int* EIDX, float* GW, const bf16_t* HB) {
    int tid_ = threadIdx.x; asm volatile("" : "+v"(tid_));
    const int lane = tid_ & 63, wave = tid_ >> 6, hl = lane & 31, half = lane >> 5;
    const int gw = blockIdx.x * NWAVES + wave, NGW = gridDim.x * NWAVES;
    const unsigned char* U6 = p.ws + WS_TAB + (size_t)layer * 2 * TAB_BYTES;
    u32x4 xn[4]; int e0n = 0, e1n = 0; float g0n = 0.f, g1n = 0.f;
    if (gw < NTOK) {
#pragma unroll
        for (int j = 0; j < 4; ++j) xn[j] = *(const u32x4*)(HB + (size_t)gw * 1024 + hl * 32 + j * 8);
        e0n = EIDX[(size_t)gw * 128 + lane]; e1n = EIDX[(size_t)gw * 128 + 64 + lane]; g0n = GW[(size_t)gw * 128 + lane]; g1n = GW[(size_t)gw * 128 + 64 + lane]; }
    for (int t = gw; t < NTOK; t += NGW) {
        float xf[32];
#pragma unroll
        for (int j = 0; j < 4; ++j) { const u32x4 xv = xn[j];
            xf[8 * j] = bf_lo(xv.x); xf[8 * j + 1] = bf_hi(xv.x); xf[8 * j + 2] = bf_lo(xv.y); xf[8 * j + 3] = bf_hi(xv.y); xf[8 * j + 4] = bf_lo(xv.z); xf[8 * j + 5] = bf_hi(xv.z); xf[8 * j + 6] = bf_lo(xv.w); xf[8 * j + 7] = bf_hi(xv.w); }
        const int e0 = e0n, e1 = e1n; const float g0 = g0n, g1 = g1n;
        { const int tn = t + NGW; if (tn < NTOK) {
#pragma unroll
            for (int j = 0; j < 4; ++j) xn[j] = *(const u32x4*)(HB + (size_t)tn * 1024 + hl * 32 + j * 8);
            e0n = EIDX[(size_t)tn * 128 + lane]; e1n = EIDX[(size_t)tn * 128 + 64 + lane]; g0n = GW[(size_t)tn * 128 + lane]; g1n = GW[(size_t)tn * 128 + 64 + lane]; } }
        float w0 = 0.f, w1 = 0.f;
#pragma unroll 1
        for (int hs = 0; hs < 2; ++hs) {
            const int eh = hs ? e1 : e0;
            float wacc = 0.f;
            int en[4];
#pragma unroll
            for (int i = 0; i < 4; ++i) en[i] = __shfl(eh, 2 * i + half);
#pragma unroll 1
            for (int kb = 0; kb < 64; kb += 8) {
                u32x4 ua[4]; u32x2 ub[4];
#pragma unroll
                for (int i = 0; i < 4; ++i) { const int e = en[i];
                    const unsigned char* ur = U6 + (size_t)e * 768 + hl * 24; ua[i] = *(const u32x4*)ur; ub[i] = *(const u32x2*)(ur + 16); }
#pragma unroll
                for (int i = 0; i < 4; ++i) en[i] = __shfl(eh, (kb + 8 + 2 * i + half) & 63);
#pragma unroll
                for (int i = 0; i < 4; ++i) {
                    const v32f_t uf = __builtin_amdgcn_cvt_scalef32_pk32_f32_fp6((v6u_t){ua[i].x, ua[i].y, ua[i].z, ua[i].w, ub[i].x, ub[i].y}, 1.0f);
                    float d0 = 0.f, d1 = 0.f;
#pragma unroll
                    for (int j = 0; j < 16; ++j) { d0 += xf[2 * j] * uf[2 * j]; d1 += xf[2 * j + 1] * uf[2 * j + 1]; }
                    const float d = half_sum32(d0 + d1);
                    const float dother = __shfl_xor(d, 32);
                    const int k0 = kb + 2 * i;
                    if (lane == k0) wacc = half ? dother : d;
                    if (lane == k0 + 1) wacc = half ? d : dother;
                }
            }
            const float gg = hs ? g1 : g0;
            const float wv = gg * gelu_tanh(wacc * (1.f / U_SCALE));
            if (hs) w1 = wv; else w0 = wv;
        }
        GW[(size_t)t * 128 + lane] = w0; GW[(size_t)t * 128 + 64 + lane] = w1;
    }
}
__device__ __forceinline__ void phase_peer_vpass(const Params& p, int layer, const int* EIDX, const float* GW, const bf16_t* HB, bf16_t* HBO, float* OUT, float fs) {
    int tid_ = threadIdx.x; asm volatile("" : "+v"(tid_));
    const int lane = tid_ & 63, wave = tid_ >> 6, hl = lane & 31, half = lane >> 5;
    const int gw = blockIdx.x * NWAVES + wave, NGW = gridDim.x * NWAVES;
    const unsigned char* V6 = p.ws + WS_TAB + (size_t)layer * 2 * TAB_BYTES + TAB_BYTES;
    const float* lg = p.in[I_PEER_LNG] + layer * 1024; const float* lb = p.in[I_PEER_LNB] + layer * 1024;
    int e0n = 0, e1n = 0; float g0n = 0.f, g1n = 0.f;
    if (gw < NTOK) { e0n = EIDX[(size_t)gw * 128 + lane]; e1n = EIDX[(size_t)gw * 128 + 64 + lane]; g0n = GW[(size_t)gw * 128 + lane]; g1n = GW[(size_t)gw * 128 + 64 + lane]; }
    for (int t = gw; t < NTOK; t += NGW) {
        const int e0 = e0n, e1 = e1n; const float g0 = g0n, g1 = g1n;
        { const int tn = t + NGW; if (tn < NTOK) { e0n = EIDX[(size_t)tn * 128 + lane]; e1n = EIDX[(size_t)tn * 128 + 64 + lane]; g0n = GW[(size_t)tn * 128 + lane]; g1n = GW[(size_t)tn * 128 + 64 + lane]; } }
        float o[32];
#pragma unroll
        for (int i = 0; i < 32; ++i) o[i] = 0.f;
#pragma unroll 1
        for (int hs = 0; hs < 2; ++hs) {
            const int eh = hs ? e1 : e0; const float gh = hs ? g1 : g0;
            int en[4];
#pragma unroll
            for (int i = 0; i < 4; ++i) en[i] = __shfl(eh, 2 * i + half);
#pragma unroll 1
            for (int kb = 0; kb < 64; kb += 8) {
                u32x4 va[4]; u32x2 vb[4]; float gg[4];
#pragma unroll
                for (int i = 0; i < 4; ++i) { const int k = kb + 2 * i + half; const int e = en[i]; gg[i] = __shfl(gh, k);
                    const unsigned char* vr = V6 + (size_t)e * 768 + hl * 24; va[i] = *(const u32x4*)vr; vb[i] = *(const u32x2*)(vr + 16); }
#pragma unroll
                for (int i = 0; i < 4; ++i) en[i] = __shfl(eh, (kb + 8 + 2 * i + half) & 63);
#pragma unroll
                for (int i = 0; i < 4; ++i) {
                    const v32f_t vf = __builtin_amdgcn_cvt_scalef32_pk32_f32_fp6((v6u_t){va[i].x, va[i].y, va[i].z, va[i].w, vb[i].x, vb[i].y}, 1.0f);
#pragma unroll
                    for (int j = 0; j < 32; ++j) o[j] += gg[i] * vf[j];
                }
            }
        }
        float z[32]; float s = 0.f;
#pragma unroll
        for (int j = 0; j < 4; ++j) { const u32x4 xv = *(const u32x4*)(HB + (size_t)t * 1024 + hl * 32 + j * 8);
            z[8 * j] = bf_lo(xv.x); z[8 * j + 1] = bf_hi(xv.x); z[8 * j + 2] = bf_lo(xv.y); z[8 * j + 3] = bf_hi(xv.y); z[8 * j + 4] = bf_lo(xv.z); z[8 * j + 5] = bf_hi(xv.z); z[8 * j + 6] = bf_lo(xv.w); z[8 * j + 7] = bf_hi(xv.w); }
#pragma unroll
        for (int i = 0; i < 32; ++i) { const float ot = o[i] + __shfl_xor(o[i], 32); z[i] = DN_ALPHA * z[i] + fs * (1.f / V_SCALE) * ot; s += z[i]; }
#pragma unroll
        for (int ofs = 16; ofs >= 1; ofs >>= 1) s += __shfl_xor(s, ofs);
        const float mean = s * (1.f / 1024.f); float q = 0.f;
#pragma unroll
        for (int i = 0; i < 32; ++i) { z[i] -= mean; q += z[i] * z[i]; }
#pragma unroll
        for (int ofs = 16; ofs >= 1; ofs >>= 1) q += __shfl_xor(q, ofs);
        const float rstd = rsqrtf(q * (1.f / 1024.f) + LN_EPS);
        float y[16]; const int c0 = hl * 32 + half * 16;
#pragma unroll
        for (int j = 0; j < 4; ++j) { const f32x4 ga = *(const f32x4*)(lg + c0 + 4 * j), ba = *(const f32x4*)(lb + c0 + 4 * j);
#pragma unroll
            for (int i = 0; i < 4; ++i) { float za = z[4 * j + i], zb = z[16 + 4 * j + i]; asm volatile("" : "+v"(za), "+v"(zb));
                const float zz = half ? zb : za; y[4 * j + i] = zz * rstd * ga[i] + ba[i]; } }
        if (OUT) {
#pragma unroll
            for (int j = 0; j < 4; ++j) *(f32x4*)(OUT + (size_t)t * 1024 + c0 + 4 * j) = (f32x4){y[4 * j], y[4 * j + 1], y[4 * j + 2], y[4 * j + 3]};
        } else {
            u32x4 w0, w1; w0.x = pk2(y[0], y[1]); w0.y = pk2(y[2], y[3]); w0.z = pk2(y[4], y[5]); w0.w = pk2(y[6], y[7]); w1.x = pk2(y[8], y[9]); w1.y = pk2(y[10], y[11]); w1.z = pk2(y[12], y[13]); w1.w = pk2(y[14], y[15]);
            *(u32x4*)(HBO + (size_t)t * 1024 + c0) = w0; *(u32x4*)(HBO + (size_t)t * 1024 + c0 + 8) = w1;
        }
    }
}

typedef int v8i_t __attribute__((ext_vector_type(8)));
constexpr float W8_SCALE = 16.f;
__device__ __forceinline__ unsigned w_fp8_splat(float w) {
    const float v = fminf(fmaxf(w * W8_SCALE, -448.f), 448.f);
    return ((unsigned)__builtin_amdgcn_cvt_pk_fp8_f32(v, 0.f, 0, false) & 0xFFu) * 0x01010101u;
}
typedef int v8i_t __attribute__((ext_vector_type(8)));
constexpr float X8_SCALE = 16.f;
__device__ __forceinline__ void phase_peer_upass_mm(const Params& p, LAS unsigned char* lds, int layer, const int* EIDX, float* GW, const bf16_t* HB) {
    int tid_ = threadIdx.x; asm volatile("" : "+v"(tid_));
    const int lane = tid_ & 63, wave = tid_ >> 6, n = lane & 15, kg = lane >> 4, j = n >> 2, nb = n & 3;
    const int gw = blockIdx.x * NWAVES + wave, NGW = gridDim.x * NWAVES;
    const unsigned char* U4 = p.ws + WS_TAB + (size_t)layer * 2 * TAB_BYTES + kg * 64 + nb * 16;
    LAS unsigned char* xl = lds + wave * 2048;
    const LAS unsigned char* xa = xl + ((n >> 2) & 1) * 1024 + (kg >> 1) * 128 + nb * 32 + 16 * (kg & 1);
    const int kbase = 64 * (kg & 1) + 4 * nb + j;
    if (gw >= NTOK) return;
    u32x4 xn[2]; int e0n, e1n; float gn[4];
    xn[0] = *(const u32x4*)(HB + (size_t)gw * 1024 + lane * 16); xn[1] = *(const u32x4*)(HB + (size_t)gw * 1024 + lane * 16 + 8);
    e0n = EIDX[(size_t)gw * 128 + lane]; e1n = EIDX[(size_t)gw * 128 + 64 + lane];
#pragma unroll
    for (int i = 0; i < 4; ++i) gn[i] = GW[(size_t)gw * 128 + kbase + 16 * i];
    u32x4 bq[8][2];
#pragma unroll
    for (int gi = 0; gi < 8; ++gi) { const int e = __shfl(e0n, 4 * gi + j); const unsigned char* r = U4 + (size_t)e * 512; bq[gi][0] = *(const u32x4*)r; bq[gi][1] = *(const u32x4*)(r + 256); }
    for (int t = gw; t < NTOK; t += NGW) {
        { float xf[16];
          xf[0] = bf_lo(xn[0].x); xf[1] = bf_hi(xn[0].x); xf[2] = bf_lo(xn[0].y); xf[3] = bf_hi(xn[0].y); xf[4] = bf_lo(xn[0].z); xf[5] = bf_hi(xn[0].z); xf[6] = bf_lo(xn[0].w); xf[7] = bf_hi(xn[0].w);
          xf[8] = bf_lo(xn[1].x); xf[9] = bf_hi(xn[1].x); xf[10] = bf_lo(xn[1].y); xf[11] = bf_hi(xn[1].y); xf[12] = bf_lo(xn[1].z); xf[13] = bf_hi(xn[1].z); xf[14] = bf_lo(xn[1].w); xf[15] = bf_hi(xn[1].w);
          u32x4 hi, lo;
#pragma unroll
          for (int jj = 0; jj < 4; ++jj) {
              const float v0 = fminf(fmaxf(xf[4 * jj] * X8_SCALE, -448.f), 448.f), v1 = fminf(fmaxf(xf[4 * jj + 1] * X8_SCALE, -448.f), 448.f);
              const float v2 = fminf(fmaxf(xf[4 * jj + 2] * X8_SCALE, -448.f), 448.f), v3 = fminf(fmaxf(xf[4 * jj + 3] * X8_SCALE, -448.f), 448.f);
              int h = __builtin_amdgcn_cvt_pk_fp8_f32(v0, v1, 0, false); h = __builtin_amdgcn_cvt_pk_fp8_f32(v2, v3, h, true);
              const auto d01 = __builtin_amdgcn_cvt_pk_f32_fp8(h, false); const auto d23 = __builtin_amdgcn_cvt_pk_f32_fp8(h, true);
              int l = __builtin_amdgcn_cvt_pk_fp8_f32(v0 - d01[0], v1 - d01[1], 0, false); l = __builtin_amdgcn_cvt_pk_fp8_f32(v2 - d23[0], v3 - d23[1], l, true);
              hi[jj] = (unsigned)h; lo[jj] = (unsigned)l; }
          *(LAS u32x4*)(xl + lane * 16) = hi; *(LAS u32x4*)(xl + 1024 + lane * 16) = lo; }
        __builtin_amdgcn_fence(__ATOMIC_RELEASE, "wavefront"); __builtin_amdgcn_wave_barrier(); __builtin_amdgcn_fence(__ATOMIC_ACQUIRE, "wavefront");
        v8i_t ax[2];
#pragma unroll
        for (int hf = 0; hf < 2; ++hf) { const u32x4 a0 = *(const LAS u32x4*)(xa + hf * 512), a1 = *(const LAS u32x4*)(xa + hf * 512 + 256);
            ax[hf] = (v8i_t){(int)a0.x, (int)a0.y, (int)a0.z, (int)a0.w, (int)a1.x, (int)a1.y, (int)a1.z, (int)a1.w}; }
        __builtin_amdgcn_fence(__ATOMIC_RELEASE, "wavefront"); __builtin_amdgcn_wave_barrier();
        const int e0 = e0n, e1 = e1n; float gcur[4];
#pragma unroll
        for (int i = 0; i < 4; ++i) gcur[i] = gn[i];
        { const int tn = t + NGW; if (tn < NTOK) {
            xn[0] = *(const u32x4*)(HB + (size_t)tn * 1024 + lane * 16); xn[1] = *(const u32x4*)(HB + (size_t)tn * 1024 + lane * 16 + 8);
            e0n = EIDX[(size_t)tn * 128 + lane]; e1n = EIDX[(size_t)tn * 128 + 64 + lane];
#pragma unroll
            for (int i = 0; i < 4; ++i) gn[i] = GW[(size_t)tn * 128 + kbase + 16 * i]; } }
        float hreg[8];
#pragma unroll
        for (int i = 0; i < 8; ++i) hreg[i] = 0.f;
#pragma unroll
        for (int bi = 0; bi < 4; ++bi) {
            const int bn = bi + 1;
            const int ehn = (bn < 2) ? e0 : ((bn < 4) ? e1 : e0n);
            int en[8];
#pragma unroll
            for (int gi = 0; gi < 8; ++gi) en[gi] = __shfl(ehn, (bn & 1) * 32 + 4 * gi + j);
#pragma unroll
            for (int gi = 0; gi < 8; ++gi) {
                const v8i_t b0 = {(int)bq[gi][0].x, (int)bq[gi][0].y, (int)bq[gi][0].z, (int)bq[gi][0].w, 0, 0, 0, 0};
                const v8i_t b1 = {(int)bq[gi][1].x, (int)bq[gi][1].y, (int)bq[gi][1].z, (int)bq[gi][1].w, 0, 0, 0, 0};
                f32x4 c = {0.f, 0.f, 0.f, 0.f};
                c = __builtin_amdgcn_mfma_scale_f32_16x16x128_f8f6f4(ax[0], b0, c, 0  , 4  , 0, 0, 0, 0);
                c = __builtin_amdgcn_mfma_scale_f32_16x16x128_f8f6f4(ax[1], b1, c, 0, 4, 0, 0, 0, 0);
                { const unsigned char* r = U4 + (size_t)en[gi] * 512; bq[gi][0] = *(const u32x4*)r; bq[gi][1] = *(const u32x4*)(r + 256); }
                __builtin_amdgcn_sched_barrier(0);
                float c0 = c[0], c1 = c[1], c2 = c[2], c3 = c[3]; asm volatile("" : "+v"(c0), "+v"(c1), "+v"(c2), "+v"(c3));
                float sel = (nb == 0) ? c0 : ((nb == 1) ? c1 : ((nb == 2) ? c2 : c3));
                sel += dpp_get<0xB1>(sel); sel += dpp_get<0x4E>(sel);
                if (nb == (gi & 3)) hreg[bi * 2 + (gi >> 2)] = sel;
            }
        }
#pragma unroll
        for (int i = 0; i < 8; ++i) hreg[i] += __shfl_xor(hreg[i], 16);
#pragma unroll
        for (int i = 0; i < 4; ++i) { float ha = hreg[i], hb = hreg[4 + i]; asm volatile("" : "+v"(ha), "+v"(hb)); const float h = (kg & 1) ? hb : ha;
            const float wv = gcur[i] * gelu_tanh(h * (1.f / (U_SCALE * X8_SCALE)));
            if (kg < 2) GW[(size_t)t * 128 + kbase + 16 * i] = wv; }
    }
}
__device__ __forceinline__ void phase_peer_upass_mm_split(const Params& p, LAS unsigned char* lds, int layer, const int* EIDX, float* PH, const bf16_t* HB) {
    int tid_ = threadIdx.x; asm volatile("" : "+v"(tid_));
    const int lane = tid_ & 63, wave = tid_ >> 6, n = lane & 15, kg = lane >> 4, j = n >> 2, nb = n & 3;
    const int hf = ((int)blockIdx.x >> 2) & 1;
    const int gw = ((((int)blockIdx.x >> 3) << 2) | ((int)blockIdx.x & 3)) * NWAVES + wave, NGW = (gridDim.x >> 1) * NWAVES;
    const unsigned char* U4 = p.ws + WS_TAB + (size_t)layer * 2 * TAB_BYTES;
    const unsigned uoff = (unsigned)(hf * 256 + kg * 64 + nb * 16);
    float* PHh = PH + (size_t)hf * NTOK * 128;
    LAS unsigned char* xl = lds + wave * 2048;
    const LAS unsigned char* xa = xl + ((n >> 2) & 1) * 1024 + hf * 512 + (kg >> 1) * 128 + nb * 32 + 16 * (kg & 1);
    const int kbase = 64 * (kg & 1) + 4 * nb + j;
    if (gw >= NTOK) return;
    u32x4 xn; int e0n, e1n;
    xn = *(const u32x4*)(HB + (size_t)gw * 1024 + hf * 512 + lane * 8);
    e0n = EIDX[(size_t)gw * 128 + lane]; e1n = EIDX[(size_t)gw * 128 + 64 + lane];
    constexpr int UB = 16;
    u32x4 bq[UB];
#pragma unroll
    for (int gi = 0; gi < UB; ++gi) { const int e = __shfl(e0n, 4 * gi + j); bq[gi] = *(const u32x4*)(U4 + (size_t)((unsigned)e * 512u + uoff)); }
    for (int t = gw; t < NTOK; t += NGW) {
        { float xf[8];
          xf[0] = bf_lo(xn.x); xf[1] = bf_hi(xn.x); xf[2] = bf_lo(xn.y); xf[3] = bf_hi(xn.y); xf[4] = bf_lo(xn.z); xf[5] = bf_hi(xn.z); xf[6] = bf_lo(xn.w); xf[7] = bf_hi(xn.w);
          u32x2 hi, lo;
#pragma unroll
          for (int jj = 0; jj < 2; ++jj) {
              const float v0 = fminf(fmaxf(xf[4 * jj] * X8_SCALE, -448.f), 448.f), v1 = fminf(fmaxf(xf[4 * jj + 1] * X8_SCALE, -448.f), 448.f);
              const float v2 = fminf(fmaxf(xf[4 * jj + 2] * X8_SCALE, -448.f), 448.f), v3 = fminf(fmaxf(xf[4 * jj + 3] * X8_SCALE, -448.f), 448.f);
              int h = __builtin_amdgcn_cvt_pk_fp8_f32(v0, v1, 0, false); h = __builtin_amdgcn_cvt_pk_fp8_f32(v2, v3, h, true);
              const auto d01 = __builtin_amdgcn_cvt_pk_f32_fp8(h, false); const auto d23 = __builtin_amdgcn_cvt_pk_f32_fp8(h, true);
              int l = __builtin_amdgcn_cvt_pk_fp8_f32(v0 - d01[0], v1 - d01[1], 0, false); l = __builtin_amdgcn_cvt_pk_fp8_f32(v2 - d23[0], v3 - d23[1], l, true);
              hi[jj] = (unsigned)h; lo[jj] = (unsigned)l; }
          *(LAS u32x2*)(xl + hf * 512 + lane * 8) = hi; *(LAS u32x2*)(xl + 1024 + hf * 512 + lane * 8) = lo; }
        __builtin_amdgcn_fence(__ATOMIC_RELEASE, "wavefront"); __builtin_amdgcn_wave_barrier(); __builtin_amdgcn_fence(__ATOMIC_ACQUIRE, "wavefront");
        v8i_t ax;
        { const u32x4 a0 = *(const LAS u32x4*)xa, a1 = *(const LAS u32x4*)(xa + 256);
          ax = (v8i_t){(int)a0.x, (int)a0.y, (int)a0.z, (int)a0.w, (int)a1.x, (int)a1.y, (int)a1.z, (int)a1.w}; }
        __builtin_amdgcn_fence(__ATOMIC_RELEASE, "wavefront"); __builtin_amdgcn_wave_barrier();
        const int e0 = e0n, e1 = e1n;
        { const int tn = t + NGW; if (tn < NTOK) {
            xn = *(const u32x4*)(HB + (size_t)tn * 1024 + hf * 512 + lane * 8);
            e0n = EIDX[(size_t)tn * 128 + lane]; e1n = EIDX[(size_t)tn * 128 + 64 + lane]; } }
        float hreg[8];
#pragma unroll
        for (int i = 0; i < 8; ++i) hreg[i] = 0.f;
#pragma unroll
        for (int bi = 0; bi < 32 / UB; ++bi) {
            const int bn = bi + 1;
            const int ehn = (bn * UB < 16) ? e0 : ((bn * UB < 32) ? e1 : e0n);
            int en[UB];
#pragma unroll
            for (int gi = 0; gi < UB; ++gi) en[gi] = __shfl(ehn, ((4 * (bn * UB + gi)) & 63) + j);
#pragma unroll
            for (int gi = 0; gi < UB; ++gi) {
                const v8i_t b0 = {(int)bq[gi].x, (int)bq[gi].y, (int)bq[gi].z, (int)bq[gi].w, 0, 0, 0, 0};
                f32x4 c = {0.f, 0.f, 0.f, 0.f};
                c = __builtin_amdgcn_mfma_scale_f32_16x16x128_f8f6f4(ax, b0, c, 0  , 4  , 0, 0, 0, 0);
                bq[gi] = *(const u32x4*)(U4 + (size_t)((unsigned)en[gi] * 512u + uoff));
                __builtin_amdgcn_sched_barrier(0);
                float c0 = c[0], c1 = c[1], c2 = c[2], c3 = c[3]; asm volatile("" : "+v"(c0), "+v"(c1), "+v"(c2), "+v"(c3));
                float sel = (nb == 0) ? c0 : ((nb == 1) ? c1 : ((nb == 2) ? c2 : c3));
                sel += dpp_get<0xB1>(sel); sel += dpp_get<0x4E>(sel);
                if (nb == (gi & 3)) hreg[(bi * UB + gi) >> 2] = sel;
            }
        }
#pragma unroll
        for (int i = 0; i < 8; ++i) hreg[i] += __shfl_xor(hreg[i], 16);
#pragma unroll
        for (int i = 0; i < 4; ++i) { float ha = hreg[i], hb = hreg[4 + i]; asm volatile("" : "+v"(ha), "+v"(hb)); const float h = (kg & 1) ? hb : ha;
            if (kg < 2) PHh[(size_t)t * 128 + kbase + 16 * i] = h; }
    }
}
__device__ __forceinline__ void phase_peer_vpass_mm(const Params& p, int layer, const int* EIDX, const float* GW, const bf16_t* HB, bf16_t* HBO, float* OUT, float fs, const float* PH = nullptr) {
    int tid_ = threadIdx.x; asm volatile("" : "+v"(tid_));
    const int lane = tid_ & 63, wave = tid_ >> 6, n = lane & 31, kgb = lane >> 5;
    const int gw = blockIdx.x * NWAVES + wave, NGW = gridDim.x * NWAVES;
    constexpr int VROW = V_FP4 ? 512 : 768, VLANE = V_FP4 ? 16 : 24;
    const unsigned char* V6 = p.ws + WS_TAB + (size_t)layer * 2 * TAB_BYTES + TAB_BYTES;
    const unsigned voff = (unsigned)(n * VLANE);
    const float* lg = p.in[I_PEER_LNG] + layer * 1024; const float* lb = p.in[I_PEER_LNB] + layer * 1024;
    const int r = lane & 15; const bool act = (lane < 16) || (lane >= 48);
    unsigned msk[4];
#pragma unroll
    for (int d = 0; d < 4; ++d) msk[d] = (act && d == (r >> 2)) ? (0xFFu << (8 * (r & 3))) : 0u;
    if (gw >= NTOK) return;
    auto load_w = [&](int tt, float& w0, float& w1) {
        w0 = GW[(size_t)tt * 128 + lane]; w1 = GW[(size_t)tt * 128 + 64 + lane];
        if (PH) { const float* P1 = PH + (size_t)NTOK * 128;
            const float h0 = PH[(size_t)tt * 128 + lane] + P1[(size_t)tt * 128 + lane], h1 = PH[(size_t)tt * 128 + 64 + lane] + P1[(size_t)tt * 128 + 64 + lane];
            w0 *= gelu_tanh(h0 * (1.f / (U_SCALE * X8_SCALE))); w1 *= gelu_tanh(h1 * (1.f / (U_SCALE * X8_SCALE))); } };
    int e0n = EIDX[(size_t)gw * 128 + lane], e1n = EIDX[(size_t)gw * 128 + 64 + lane]; float g0n, g1n; load_w(gw, g0n, g1n);
    u32x4 b4[8]; u32x2 b2[8];
#pragma unroll
    for (int i = 0; i < 8; ++i) { const int e = __shfl(e0n, 2 * i + kgb); const unsigned char* vr = V6 + (size_t)((unsigned)e * (unsigned)VROW + voff); b4[i] = *(const u32x4*)vr; if (!V_FP4) b2[i] = *(const u32x2*)(vr + 16); else b2[i] = (u32x2){0u, 0u}; }
    for (int t = gw; t < NTOK; t += NGW) {
        const int e0 = e0n, e1 = e1n; const unsigned ws0 = w_fp8_splat(g0n), ws1 = w_fp8_splat(g1n);
        { const int tn = t + NGW; if (tn < NTOK) { e0n = EIDX[(size_t)tn * 128 + lane]; e1n = EIDX[(size_t)tn * 128 + 64 + lane]; load_w(tn, g0n, g1n); } }
        const int q = kgb;
        u32x2 xr[4];
#pragma unroll
        for (int I = 0; I < 4; ++I) xr[I] = *(const u32x2*)(HB + (size_t)t * 1024 + n * 32 + 8 * I + 4 * q);
        v16f_t acc;
#pragma unroll
        for (int i = 0; i < 16; ++i) acc[i] = 0.f;
#pragma unroll 1
        for (int bi = 0; bi < 8; ++bi) {
            const int bn = bi + 1;
            const int ehn = (bn < 4) ? e0 : ((bn < 8) ? e1 : e0n);
            const unsigned wsh = (bi & 4) ? ws1 : ws0;
            const int base = (bi & 3) * 16, basen = (bn & 3) * 16;
            int en[8];
#pragma unroll
            for (int i = 0; i < 8; ++i) en[i] = __shfl(ehn, basen + 2 * i + kgb);
#pragma unroll
            for (int i = 0; i < 8; ++i) {
                const unsigned w0s = (unsigned)__builtin_amdgcn_readlane((int)wsh, base + 2 * i), w1s = (unsigned)__builtin_amdgcn_readlane((int)wsh, base + 2 * i + 1);
                const v8i_t A = {(int)(msk[0] & w0s), (int)(msk[1] & w0s), (int)(msk[2] & w0s), (int)(msk[3] & w0s), (int)(msk[0] & w1s), (int)(msk[1] & w1s), (int)(msk[2] & w1s), (int)(msk[3] & w1s)};
                const v8i_t B = {(int)b4[i].x, (int)b4[i].y, (int)b4[i].z, (int)b4[i].w, (int)b2[i].x, (int)b2[i].y, 0, 0};
                acc = __builtin_amdgcn_mfma_scale_f32_32x32x64_f8f6f4(A, B, acc, 0  , V_FP4 ? 4 : 2  , 0, 0, 0, 0);
                const unsigned char* vr = V6 + (size_t)((unsigned)en[i] * (unsigned)VROW + voff); b4[i] = *(const u32x4*)vr; if (!V_FP4) b2[i] = *(const u32x2*)(vr + 16);
                __builtin_amdgcn_sched_barrier(0);
            }
        }
        float z[16]; float s = 0.f;
#pragma unroll
        for (int I = 0; I < 4; ++I) { const float x0 = bf_lo(xr[I].x), x1 = bf_hi(xr[I].x), x2 = bf_lo(xr[I].y), x3 = bf_hi(xr[I].y);
            z[4 * I] = DN_ALPHA * x0 + fs * (1.f / (V_SCALE * W8_SCALE)) * acc[4 * I]; z[4 * I + 1] = DN_ALPHA * x1 + fs * (1.f / (V_SCALE * W8_SCALE)) * acc[4 * I + 1];
            z[4 * I + 2] = DN_ALPHA * x2 + fs * (1.f / (V_SCALE * W8_SCALE)) * acc[4 * I + 2]; z[4 * I + 3] = DN_ALPHA * x3 + fs * (1.f / (V_SCALE * W8_SCALE)) * acc[4 * I + 3]; }
#pragma unroll
        for (int i = 0; i < 16; ++i) s += z[i];
        const float mean = wave_sum(s) * (1.f / 1024.f); float qq = 0.f;
#pragma unroll
        for (int i = 0; i < 16; ++i) { z[i] -= mean; qq += z[i] * z[i]; }
        const float rstd = rsqrtf(wave_sum(qq) * (1.f / 1024.f) + LN_EPS);
#pragma unroll
        for (int I = 0; I < 4; ++I) { const int c0 = n * 32 + 8 * I + 4 * q; const f32x4 ga = *(const f32x4*)(lg + c0), ba = *(const f32x4*)(lb + c0);
            const float y0 = z[4 * I] * rstd * ga.x + ba.x, y1 = z[4 * I + 1] * rstd * ga.y + ba.y, y2 = z[4 * I + 2] * rstd * ga.z + ba.z, y3 = z[4 * I + 3] * rstd * ga.w + ba.w;
            if (OUT) *(f32x4*)(OUT + (size_t)t * 1024 + c0) = (f32x4){y0, y1, y2, y3};
            else *(u32x2*)(HBO + (size_t)t * 1024 + c0) = (u32x2){pk2(y0, y1), pk2(y2, y3)}; }
    }
}

__device__ __forceinline__ void phase_peer_vpass_mm_sweep(const Params& p, LAS unsigned char* lds, int layer, const int* EIDX, const float* GW, const float* PH, const bf16_t* HB, bf16_t* HBO, float* OUT, float fs) {
    int tid_ = threadIdx.x; asm volatile("" : "+v"(tid_));
    const int lane = tid_ & 63, wave = tid_ >> 6, n = lane & 15, kg = lane >> 4, q = kg;
    const int gw = blockIdx.x * NWAVES + wave, NGW = gridDim.x * NWAVES;
    const unsigned char* V4 = p.ws + WS_TAB + (size_t)layer * 2 * TAB_BYTES + TAB_BYTES;
    const unsigned voff0 = (unsigned)(n * 8);
    LAS unsigned char* zl = lds + wave * 16384;
    LAS float* sl = (LAS float*)(lds + 8 * 16384) + wave * 32;
    const int colb = 16 * n + 4 * q;
    unsigned sel[4];
#pragma unroll
    for (int d = 0; d < 4; ++d) sel[d] = (d == (n >> 2)) ? ((0x0C0C0C0Cu & ~(0xFFu << (8 * (n & 3)))) | ((unsigned)kg << (8 * (n & 3)))) : 0x0C0C0C0Cu;
    if (gw >= NTOK) return;
    const int ntok = (NTOK - gw + NGW - 1) / NGW;
    auto load_w = [&](int tt, unsigned& p0, unsigned& p1) {
        float w0, w1;
        if (PH) { const float* P1 = PH + (size_t)NTOK * 128;
            const float h0 = PH[(size_t)tt * 128 + lane] + P1[(size_t)tt * 128 + lane], h1 = PH[(size_t)tt * 128 + 64 + lane] + P1[(size_t)tt * 128 + 64 + lane];
            w0 = GW[(size_t)tt * 128 + lane] * gelu_tanh(h0 * (1.f / (U_SCALE * X8_SCALE))); w1 = GW[(size_t)tt * 128 + 64 + lane] * gelu_tanh(h1 * (1.f / (U_SCALE * X8_SCALE))); }
        else { w0 = GW[(size_t)tt * 128 + lane]; w1 = GW[(size_t)tt * 128 + 64 + lane]; }
        const float v0 = fminf(fmaxf(w0 * W8_SCALE, -448.f), 448.f), v1 = fminf(fmaxf(w1 * W8_SCALE, -448.f), 448.f);
        const unsigned pk = (unsigned)__builtin_amdgcn_cvt_pk_fp8_f32(v0, v1, 0, false);
        unsigned a0 = pk & 0xFFu, a1 = (pk >> 8) & 0xFFu;
        a0 |= (unsigned)__builtin_amdgcn_update_dpp(0, (int)a0, 0x101, 0xF, 0xF, true) << 8;  a1 |= (unsigned)__builtin_amdgcn_update_dpp(0, (int)a1, 0x101, 0xF, 0xF, true) << 8;
        a0 |= (unsigned)__builtin_amdgcn_update_dpp(0, (int)a0, 0x102, 0xF, 0xF, true) << 16; a1 |= (unsigned)__builtin_amdgcn_update_dpp(0, (int)a1, 0x102, 0xF, 0xF, true) << 16;
        p0 = a0; p1 = a1; };
    constexpr int VB = 8;
    int eo0n = EIDX[(size_t)gw * 128 + lane] << 9, eo1n = EIDX[(size_t)gw * 128 + 64 + lane] << 9; unsigned p0n, p1n; load_w(gw, p0n, p1n);
    u32x2 ba0[VB], ba1[VB], bb0[VB], bb1[VB];
#pragma unroll
    for (int i = 0; i < VB; ++i) { const unsigned oa = (unsigned)__shfl(eo0n, 8 * i + 2 * kg) + voff0, ob = (unsigned)__shfl(eo0n, 8 * i + 2 * kg + 1) + voff0;
        ba0[i] = *(const u32x2*)(V4 + (size_t)oa); ba1[i] = *(const u32x2*)(V4 + (size_t)oa + 128); bb0[i] = *(const u32x2*)(V4 + (size_t)ob); bb1[i] = *(const u32x2*)(V4 + (size_t)ob + 128); }
    f32x4 ga[2], ba[2], gb[2], bb[2];
#pragma unroll
    for (int Q = 0; Q < 2; ++Q) { ga[Q] = *(const f32x4*)(p.in[I_PEER_LNG] + layer * 1024 + colb + 256 * Q); ba[Q] = *(const f32x4*)(p.in[I_PEER_LNB] + layer * 1024 + colb + 256 * Q);
        gb[Q] = *(const f32x4*)(p.in[I_PEER_LNG] + layer * 1024 + 512 + colb + 256 * Q); bb[Q] = *(const f32x4*)(p.in[I_PEER_LNB] + layer * 1024 + 512 + colb + 256 * Q); }
#pragma unroll 1
    for (int hf = 0; hf < 2; ++hf) {
        const unsigned voff = voff0 + (unsigned)(hf * 256), voffn_last = voff0 + (unsigned)((hf ^ 1) * 256);
#pragma unroll 1
        for (int k = 0; k < ntok; ++k) {
            const int t = gw + k * NGW;
            const int eo1 = eo1n; const unsigned p0 = p0n, p1 = p1n;
            const bool lastk = (k + 1 == ntok); const int tn = lastk ? gw : t + NGW; const bool more = !(lastk && hf == 1);
            if (more) { eo0n = EIDX[(size_t)tn * 128 + lane] << 9; eo1n = EIDX[(size_t)tn * 128 + 64 + lane] << 9; load_w(tn, p0n, p1n); }
            const unsigned voffn = lastk ? voffn_last : voff;
            u32x2 xr[2];
#pragma unroll
            for (int Q = 0; Q < 2; ++Q) xr[Q] = *(const u32x2*)(HB + (size_t)t * 1024 + hf * 512 + colb + 256 * Q);
            f32x4 acc0 = {0.f, 0.f, 0.f, 0.f}, acc1 = {0.f, 0.f, 0.f, 0.f};
#pragma unroll
            for (int bi = 0; bi < 2; ++bi) {
                const int ehn = (bi == 0) ? eo1 : eo0n;
                const unsigned vo = (bi == 0) ? voff : voffn;
                const unsigned ph = (bi == 0) ? p0 : p1;
                unsigned oa[VB], ob[VB];
#pragma unroll
                for (int i = 0; i < VB; ++i) { oa[i] = (unsigned)__shfl(ehn, 8 * i + 2 * kg) + vo; ob[i] = (unsigned)__shfl(ehn, 8 * i + 2 * kg + 1) + vo; }
#pragma unroll
                for (int i = 0; i < VB; ++i) {
                    const unsigned s0 = (unsigned)__builtin_amdgcn_readlane((int)ph, 8 * i), s1 = (unsigned)__builtin_amdgcn_readlane((int)ph, 8 * i + 4);
                    const v8i_t A = {(int)__builtin_amdgcn_perm(s0, s0, sel[0]), (int)__builtin_amdgcn_perm(s0, s0, sel[1]), (int)__builtin_amdgcn_perm(s0, s0, sel[2]), (int)__builtin_amdgcn_perm(s0, s0, sel[3]),
                                     (int)__builtin_amdgcn_perm(s1, s1, sel[0]), (int)__builtin_amdgcn_perm(s1, s1, sel[1]), (int)__builtin_amdgcn_perm(s1, s1, sel[2]), (int)__builtin_amdgcn_perm(s1, s1, sel[3])};
                    const v8i_t B0 = {(int)ba0[i].x, (int)ba0[i].y, (int)bb0[i].x, (int)bb0[i].y, 0, 0, 0, 0};
                    const v8i_t B1 = {(int)ba1[i].x, (int)ba1[i].y, (int)bb1[i].x, (int)bb1[i].y, 0, 0, 0, 0};
                    acc0 = __builtin_amdgcn_mfma_scale_f32_16x16x128_f8f6f4(A, B0, acc0, 0  , 4  , 0, 0, 0, 0);
                    acc1 = __builtin_amdgcn_mfma_scale_f32_16x16x128_f8f6f4(A, B1, acc1, 0, 4, 0, 0, 0, 0);
                    ba0[i] = *(const u32x2*)(V4 + (size_t)oa[i]); ba1[i] = *(const u32x2*)(V4 + (size_t)oa[i] + 128); bb0[i] = *(const u32x2*)(V4 + (size_t)ob[i]); bb1[i] = *(const u32x2*)(V4 + (size_t)ob[i] + 128);
                    __builtin_amdgcn_sched_barrier(0);
                }
            }
            float z[8]; float s1 = 0.f, s2 = 0.f;
            { const float x0 = bf_lo(xr[0].x), x1 = bf_hi(xr[0].x), x2 = bf_lo(xr[0].y), x3 = bf_hi(xr[0].y);
              z[0] = DN_ALPHA * x0 + fs * (1.f / (V_SCALE * W8_SCALE)) * acc0[0]; z[1] = DN_ALPHA * x1 + fs * (1.f / (V_SCALE * W8_SCALE)) * acc0[1];
              z[2] = DN_ALPHA * x2 + fs * (1.f / (V_SCALE * W8_SCALE)) * acc0[2]; z[3] = DN_ALPHA * x3 + fs * (1.f / (V_SCALE * W8_SCALE)) * acc0[3]; }
            { const float x0 = bf_lo(xr[1].x), x1 = bf_hi(xr[1].x), x2 = bf_lo(xr[1].y), x3 = bf_hi(xr[1].y);
              z[4] = DN_ALPHA * x0 + fs * (1.f / (V_SCALE * W8_SCALE)) * acc1[0]; z[5] = DN_ALPHA * x1 + fs * (1.f / (V_SCALE * W8_SCALE)) * acc1[1];
              z[6] = DN_ALPHA * x2 + fs * (1.f / (V_SCALE * W8_SCALE)) * acc1[2]; z[7] = DN_ALPHA * x3 + fs * (1.f / (V_SCALE * W8_SCALE)) * acc1[3]; }
            if (hf == 0) {
                const u32x4 zz = {pk2(z[0], z[1]), pk2(z[2], z[3]), pk2(z[4], z[5]), pk2(z[6], z[7])};
                *(LAS u32x4*)(zl + k * 1024 + lane * 16) = zz;
                const float r0 = bf_lo(zz.x), r1 = bf_hi(zz.x), r2 = bf_lo(zz.y), r3 = bf_hi(zz.y), r4 = bf_lo(zz.z), r5 = bf_hi(zz.z), r6 = bf_lo(zz.w), r7 = bf_hi(zz.w);
                s1 = ((r0 + r1) + (r2 + r3)) + ((r4 + r5) + (r6 + r7)); s2 = ((r0 * r0 + r1 * r1) + (r2 * r2 + r3 * r3)) + ((r4 * r4 + r5 * r5) + (r6 * r6 + r7 * r7));
                const float S1 = wave_sum_dpp(s1), S2 = wave_sum_dpp(s2);
                if (lane == 0) { sl[2 * k] = S1; sl[2 * k + 1] = S2; }
            } else {
#pragma unroll
                for (int i = 0; i < 8; ++i) { s1 += z[i]; s2 += z[i] * z[i]; }
                const u32x4 zz = *(const LAS u32x4*)(zl + k * 1024 + lane * 16);
                const float S1 = wave_sum_dpp(s1) + sl[2 * k], S2 = wave_sum_dpp(s2) + sl[2 * k + 1];
                const float mean = S1 * (1.f / 1024.f); const float var = fmaxf(S2 * (1.f / 1024.f) - mean * mean, 0.f);
                const float rstd = rsqrtf(var + LN_EPS);
                const float za[8] = {bf_lo(zz.x), bf_hi(zz.x), bf_lo(zz.y), bf_hi(zz.y), bf_lo(zz.z), bf_hi(zz.z), bf_lo(zz.w), bf_hi(zz.w)};
#pragma unroll
                for (int Q = 0; Q < 2; ++Q) {
                    const float a0 = (za[4 * Q] - mean) * rstd * ga[Q].x + ba[Q].x, a1 = (za[4 * Q + 1] - mean) * rstd * ga[Q].y + ba[Q].y, a2 = (za[4 * Q + 2] - mean) * rstd * ga[Q].z + ba[Q].z, a3 = (za[4 * Q + 3] - mean) * rstd * ga[Q].w + ba[Q].w;
                    const float y0 = (z[4 * Q] - mean) * rstd * gb[Q].x + bb[Q].x, y1 = (z[4 * Q + 1] - mean) * rstd * gb[Q].y + bb[Q].y, y2 = (z[4 * Q + 2] - mean) * rstd * gb[Q].z + bb[Q].z, y3 = (z[4 * Q + 3] - mean) * rstd * gb[Q].w + bb[Q].w;
                    if (OUT) { __builtin_nontemporal_store((f32x4){a0, a1, a2, a3}, (f32x4*)(OUT + (size_t)t * 1024 + colb + 256 * Q)); __builtin_nontemporal_store((f32x4){y0, y1, y2, y3}, (f32x4*)(OUT + (size_t)t * 1024 + 512 + colb + 256 * Q)); }
                    else { __builtin_nontemporal_store((u32x2){pk2(a0, a1), pk2(a2, a3)}, (u32x2*)(HBO + (size_t)t * 1024 + colb + 256 * Q)); __builtin_nontemporal_store((u32x2){pk2(y0, y1), pk2(y2, y3)}, (u32x2*)(HBO + (size_t)t * 1024 + 512 + colb + 256 * Q)); }
                }
            }
        }
    }
}

#define XB_TMO      128
#define XB_XCNT(j)  (256  + 64 * (j))
#define XB_XSUB(j)  (1280 + 64 * (j))
#define XB_XGEN(j)  (2304 + 64 * (j))
#define XB_TOP      3328
#define XB_TOPGEN   3392
#define XCD_BAR_WORDS 3456
#define XB_SPIN_CAP (1u << 18)
__device__ __forceinline__ unsigned xb_ld(unsigned* p)              { return __hip_atomic_load(p, __ATOMIC_RELAXED, __HIP_MEMORY_SCOPE_AGENT); }
__device__ __forceinline__ unsigned xb_add(unsigned* p, unsigned v) { return __hip_atomic_fetch_add(p, v, __ATOMIC_RELAXED, __HIP_MEMORY_SCOPE_AGENT); }
__device__ __forceinline__ unsigned xb_xcc_id() { return (unsigned)__builtin_amdgcn_s_getreg((3 << 11) | 20) & 0xFu; }
#define XB_SPIN(cond, bar) do { unsigned _sp = 0; while (cond) { __builtin_amdgcn_s_sleep(1); \
    if ((++_sp & 255u) == 0u) { if (xb_ld(&(bar)[XB_TMO])) break; if (_sp > XB_SPIN_CAP) { atomicAdd(&(bar)[XB_TMO], 1u); break; } } } } while (0)
struct XcdBarrier { unsigned* bar; unsigned x; volatile LAS unsigned* st; };
__device__ __forceinline__ XcdBarrier xcd_barrier_post(unsigned* bar, volatile LAS unsigned* st) {
    XcdBarrier b; b.bar = bar; b.x = xb_xcc_id(); b.st = st;
    if (threadIdx.x == 0) (void)xb_add(&bar[XB_XCNT(b.x)], 1u);
    return b;
}
__device__ __forceinline__ void xcd_barrier_complete(unsigned* bar, unsigned x, unsigned& nloc, unsigned& nx) {
    const unsigned G = gridDim.x * gridDim.y * gridDim.z;
    unsigned sum, cnt, mine, sp = 0u;
    for (;;) {
        sum = 0u; cnt = 0u; mine = 0u;
#pragma unroll
        for (unsigned j = 0; j < 16; ++j) { const unsigned c = xb_ld(&bar[XB_XCNT(j)]); sum += c; cnt += (c > 0u) ? 1u : 0u; mine = (j == x) ? c : mine; }
        if (sum == G) break;
        __builtin_amdgcn_s_sleep(1);
        if ((++sp & 255u) == 0u) { if (xb_ld(&bar[XB_TMO])) break; if (sp > XB_SPIN_CAP) { atomicAdd(&bar[XB_TMO], 1u); break; } }
    }
    nloc = mine > 0u ? mine : 1u; nx = cnt > 0u ? cnt : 1u;
}
__device__ __forceinline__ void xcd_barrier(const XcdBarrier& b) {
    asm volatile("s_waitcnt vmcnt(0)" ::: "memory");
    __syncthreads();
    if (threadIdx.x == 0) {
        unsigned* bar = b.bar;
        __builtin_amdgcn_s_waitcnt(0);
        unsigned nloc = b.st[0], nx = b.st[1];
        if (nloc == 0u) { xcd_barrier_complete(bar, b.x, nloc, nx); b.st[0] = nloc; b.st[1] = nx; }
        const unsigned old = xb_add(&bar[XB_XSUB(b.x)], 1u);
        const unsigned gen = old / nloc;
        if (old + 1u == (gen + 1u) * nloc) {
            __builtin_amdgcn_fence(__ATOMIC_RELEASE, "agent");
            asm volatile("s_waitcnt vmcnt(0)" ::: "memory");
            const unsigned og = xb_add(&bar[XB_TOP], 1u);
            const unsigned tg = og / nx;
            if (og + 1u == (tg + 1u) * nx) xb_add(&bar[XB_TOPGEN], 1u);
            else XB_SPIN(xb_ld(&bar[XB_TOPGEN]) == tg, bar);
            __builtin_amdgcn_fence(__ATOMIC_ACQUIRE, "agent");
            xb_add(&bar[XB_XGEN(b.x)], 1u);
            asm volatile("s_waitcnt vmcnt(0)" ::: "memory");
        } else {
            XB_SPIN(xb_ld(&bar[XB_XGEN(b.x)]) == gen, bar);
            __builtin_amdgcn_fence(__ATOMIC_ACQUIRE, "agent");
            asm volatile("s_waitcnt vmcnt(0)" ::: "memory");
        }
    }
    __syncthreads();
}

constexpr int NPHASES = 19;
#if TAB_MODE == 6
#define PEER_GATHER phase_peer_gather6
#else
#define PEER_GATHER phase_peer_gather
#endif
__global__ void __launch_bounds__(NTHREADS, 2) fwd_kernel(Params p) {
    extern __shared__ __attribute__((aligned(16))) unsigned char lds_raw[];
    LAS unsigned char* lds = (LAS unsigned char*)lds_raw;
    unsigned char* ws = p.ws;
    bf16_t* HB = (bf16_t*)(ws + WS_HB);
    const int lo = p.ph_lo, hi = p.ph_hi;
    volatile LAS unsigned* bst = (volatile LAS unsigned*)(lds + LDS_BYTES - 64);
    if (threadIdx.x < 16) bst[threadIdx.x] = 0u;
    __syncthreads();
    XcdBarrier gbar; gbar.bar = (unsigned*)(ws + WS_CTL) + 4096; gbar.x = 0; gbar.st = bst;
    if (hi - lo > 1) {
        gbar = xcd_barrier_post((unsigned*)(ws + WS_CTL) + 4096, bst); }
#ifndef PH_MASK
#define PH_MASK 0xFFFFFFFFu
#endif
#define IN(k) (((PH_MASK >> (k)) & 1u) && lo <= (k) && (k) < hi)
#if DBG_TIME
    unsigned long long t_prev = __builtin_amdgcn_s_memrealtime(), t_acc = 0ull;
#define SEAM(k) do { if (IN(k) && IN((k) + 1)) { xcd_barrier(gbar); } { const unsigned long long t_now = __builtin_amdgcn_s_memrealtime(); if ((DBG_TIME >> (k)) & 1u) t_acc += t_now - t_prev; t_prev = t_now; } } while (0)
#else
#define SEAM(k) do { if (IN(k) && IN((k) + 1)) { xcd_barrier(gbar); } } while (0)
#endif
    if (IN(0)) for (int rep_ = 0; rep_ < ((PROBE_REP == 0) ? 1 + PROBE_N : 1); ++rep_) { phase_prologue(p, lds); } SEAM(0);
    if (IN(1) && PROBE_REP2 == 1) { EpiNsaProj E{(bf16_t*)(ws + S_Q), (bf16_t*)(ws + S_KV6), (float*)(ws + S_GATES)};
        run_gemm(lds, HB, 1024, (const bf16_t*)(ws + WS_W_IN_T), 1024, NTOK, NSA_IN_PAD, 1024, (int)blockIdx.x, E); }
    if (IN(1)) for (int rep_ = 0; rep_ < ((PROBE_REP == 1) ? 1 + PROBE_N : 1); ++rep_) { EpiNsaProj E{(bf16_t*)(ws + S_Q), (bf16_t*)(ws + S_KV6), (float*)(ws + S_GATES)};
        run_gemm(lds, HB, 1024, (const bf16_t*)(ws + WS_W_IN_T), 1024, NTOK, NSA_IN_PAD, 1024, (int)blockIdx.x, E);
        if (rep_ == 0) late_weight_transposes(p, lds); } SEAM(1);
    if (IN(2)) for (int rep_ = 0; rep_ < ((PROBE_REP == 2) ? 1 + PROBE_N : 1); ++rep_) { EpiF32 Ek{(float*)(ws + S_PK), 256}, Ev{(float*)(ws + S_PV), 256};
        run_gemm(lds, (const bf16_t*)(ws + S_KV6), 1024, (const bf16_t*)(ws + WS_W_CK1_T), 1024, 8192, 256, 1024, (int)blockIdx.x, Ek);
        run_gemm(lds, (const bf16_t*)(ws + S_KV6) + (size_t)NTOK * 256, 1024, (const bf16_t*)(ws + WS_W_CV1_T), 1024, 8192, 256, 1024, (int)((blockIdx.x + gridDim.x / 2) % gridDim.x), Ev);
        if (rep_ == 0) convert_tables_idle(p); } SEAM(2);
    if (IN(3)) for (int rep_ = 0; rep_ < ((PROBE_REP == 3) ? 1 + PROBE_N : 1); ++rep_) { phase_cmp_finish(p, lds); } SEAM(3);
    if (IN(4)) for (int rep_ = 0; rep_ < ((PROBE_REP == 4) ? 1 + PROBE_N : 1); ++rep_) { if (USE_MFMA_NSA) phase_nsa_attn(p, lds); else phase_nsa_attn_ref(p, lds); } SEAM(4);
    if (IN(5) && PROBE_REP2 == 5) { EpiResid E{HB, (bf16_t*)(ws + S_Z), (ABL & 1) ? 0.f : 1.f};
        run_gemm(lds, (const bf16_t*)(ws + S_AO), 1024, (const bf16_t*)(ws + WS_W_NSAOUT_T), 1024, NTOK, 1024, 1024, (int)blockIdx.x, E); }
    if (IN(5)) for (int rep_ = 0; rep_ < ((PROBE_REP == 5) ? 1 + PROBE_N : 1); ++rep_) { EpiResid E{HB, (bf16_t*)(ws + S_Z), (ABL & 1) ? 0.f : 1.f};
        run_gemm(lds, (const bf16_t*)(ws + S_AO), 1024, (const bf16_t*)(ws + WS_W_NSAOUT_T), 1024, NTOK, 1024, 1024, (int)blockIdx.x, E); } SEAM(5);
    if (IN(6)) for (int rep_ = 0; rep_ < ((PROBE_REP == 6) ? 1 + PROBE_N : 1); ++rep_) { phase_ln((const bf16_t*)(ws + S_Z), HB, p.in[I_NSA_LNG], p.in[I_NSA_LNB]); } SEAM(6);
    if (IN(7) && PROBE_REP2 == 7) { EpiBf16 E{(bf16_t*)(ws + S_QP0), 2048};
        run_gemm(lds, HB, 1024, (const bf16_t*)(ws + WS_W_PQ_T), 1024, NTOK, 2048, 1024, (int)blockIdx.x, E); }
    if (IN(7)) for (int rep_ = 0; rep_ < ((PROBE_REP == 7) ? 1 + PROBE_N : 1); ++rep_) { EpiBf16 E{(bf16_t*)(ws + S_QP0), 2048};
        run_gemm(lds, HB, 1024, (const bf16_t*)(ws + WS_W_PQ_T), 1024, NTOK, 2048, 1024, (int)blockIdx.x, E); } SEAM(7);
    if (IN(8) && ((PROBE_DUP & 1) || PROBE_REP == 8)) for (int rep_ = 0; rep_ < PROBE_N; ++rep_) { phase_peer_route(p, lds, 0, (const bf16_t*)(ws + S_QP0), (int*)(ws + S_Z), (float*)(ws + S_Z + 16 * MiB)); }
    if (IN(8)) { if (USE_MFMA_ROUTE) phase_peer_route(p, lds, 0, (const bf16_t*)(ws + S_QP0), (int*)(ws + S_EIDX0), (float*)(ws + S_GW0)); else phase_peer_route_ref(p, lds, 0, (const bf16_t*)(ws + S_QP0), (int*)(ws + S_EIDX0), (float*)(ws + S_GW0)); } SEAM(8);
    if (IN(9) && ((PROBE_DUP & 2) || PROBE_REP == 9)) for (int rep_ = 0; rep_ < PROBE_N; ++rep_) { PEER_GATHER(p, 0, (const int*)(ws + S_EIDX0), (const float*)(ws + S_GW0), HB, (bf16_t*)(ws + S_Z), nullptr, 1.f); }
#if SPLIT_UV && TAB_MODE == 6
    if (IN(9)) { if (U_MM && U_SPLIT && gridDim.x == 256) { phase_peer_upass_mm_split(p, lds, 0, (const int*)(ws + S_EIDX0), (float*)(ws + S_Z), HB); xcd_barrier(gbar);
            if (V_SPLIT && V_FP4) phase_peer_vpass_mm_sweep(p, lds, 0, (const int*)(ws + S_EIDX0), (const float*)(ws + S_GW0), (const float*)(ws + S_Z), HB, HB, nullptr, 1.f);
            else phase_peer_vpass_mm(p, 0, (const int*)(ws + S_EIDX0), (const float*)(ws + S_GW0), HB, HB, nullptr, 1.f, (const float*)(ws + S_Z)); }
        else { if (U_MM) phase_peer_upass_mm(p, lds, 0, (const int*)(ws + S_EIDX0), (float*)(ws + S_GW0), HB); else phase_peer_upass(p, 0, (const int*)(ws + S_EIDX0), (float*)(ws + S_GW0), HB);
            phase_peer_vpass_mm(p, 0, (const int*)(ws + S_EIDX0), (const float*)(ws + S_GW0), HB, HB, nullptr, 1.f); } } SEAM(9);
#else
    if (IN(9)) { PEER_GATHER(p, 0, (const int*)(ws + S_EIDX0), (const float*)(ws + S_GW0), HB, HB, nullptr, (ABL & 2) ? 0.f : 1.f); } SEAM(9);
#endif
    if (IN(10) && PROBE_REP2 == 10) { EpiBf16 E{(bf16_t*)(ws + S_DQ), MLA_DOWN_PAD};
        run_gemm(lds, HB, 1024, (const bf16_t*)(ws + WS_W_MLADOWN_T), 1024, NTOK, MLA_DOWN_PAD, 1024, (int)blockIdx.x, E); }
    if (IN(10)) for (int rep_ = 0; rep_ < ((PROBE_REP == 10) ? 1 + PROBE_N : 1); ++rep_) { EpiBf16 E{(bf16_t*)(ws + S_DQ), MLA_DOWN_PAD};
        run_gemm(lds, HB, 1024, (const bf16_t*)(ws + WS_W_MLADOWN_T), 1024, NTOK, MLA_DOWN_PAD, 1024, (int)blockIdx.x, E); } SEAM(10);
    if (IN(11)) for (int rep_ = 0; rep_ < ((PROBE_REP == 11) ? 1 + PROBE_N : 1); ++rep_) { phase_mla_rowstats(p); } SEAM(11);
    if (IN(12)) for (int rep_ = 0; rep_ < ((PROBE_REP == 12) ? 1 + PROBE_N : 1); ++rep_) { EpiBf16 Eq{(bf16_t*)(ws + S_QF), 1536}; EpiKV Ekv{(bf16_t*)(ws + S_KNOPE), (bf16_t*)(ws + S_V)};
        run_gemm(lds, (const bf16_t*)(ws + S_DQ), MLA_DOWN_PAD, (const bf16_t*)(ws + WS_W_UQ_T), 768, NTOK, 1536, 768, (int)blockIdx.x, Eq);
        run_gemm(lds, (const bf16_t*)(ws + S_DQ) + 768, MLA_DOWN_PAD, (const bf16_t*)(ws + WS_W_UKV_T), 256, NTOK, 2048, 256, (int)blockIdx.x, Ekv); } SEAM(12);
    if (IN(13) && MLA_VAR >= 0) { phase_mla_attn<(MLA_VAR >= 0 ? MLA_VAR : 0)>(p, lds); xcd_barrier(gbar); }
    if (IN(13)) { phase_mla_attn<0>(p, lds); } SEAM(13);
    if (IN(14) && PROBE_REP2 == 14) { EpiResid E{HB, (bf16_t*)(ws + S_Z2), (ABL & 4) ? 0.f : 1.f};
        run_gemm(lds, (const bf16_t*)(ws + S_AO2), 1024, (const bf16_t*)(ws + WS_W_MLAOUT_T), 1024, NTOK, 1024, 1024, (int)blockIdx.x, E); }
    if (IN(14)) for (int rep_ = 0; rep_ < ((PROBE_REP == 14) ? 1 + PROBE_N : 1); ++rep_) { EpiResid E{HB, (bf16_t*)(ws + S_Z2), (ABL & 4) ? 0.f : 1.f};
        run_gemm(lds, (const bf16_t*)(ws + S_AO2), 1024, (const bf16_t*)(ws + WS_W_MLAOUT_T), 1024, NTOK, 1024, 1024, (int)blockIdx.x, E); } SEAM(14);
    if (IN(15)) for (int rep_ = 0; rep_ < ((PROBE_REP == 15) ? 1 + PROBE_N : 1); ++rep_) { phase_ln((const bf16_t*)(ws + S_Z2), HB, p.in[I_MLA_LNG], p.in[I_MLA_LNB]); } SEAM(15);
    if (IN(16) && PROBE_REP2 == 16) { EpiBf16 E{(bf16_t*)(ws + S_QP1), 2048};
        run_gemm(lds, HB, 1024, (const bf16_t*)(ws + WS_W_PQ_T) + (size_t)2048 * 1024, 1024, NTOK, 2048, 1024, (int)blockIdx.x, E); }
    if (IN(16)) for (int rep_ = 0; rep_ < ((PROBE_REP == 16) ? 1 + PROBE_N : 1); ++rep_) { EpiBf16 E{(bf16_t*)(ws + S_QP1), 2048};
        run_gemm(lds, HB, 1024, (const bf16_t*)(ws + WS_W_PQ_T) + (size_t)2048 * 1024, 1024, NTOK, 2048, 1024, (int)blockIdx.x, E); } SEAM(16);
    if (IN(17) && ((PROBE_DUP & 1) || PROBE_REP == 17)) for (int rep_ = 0; rep_ < PROBE_N; ++rep_) { phase_peer_route_ref(p, lds, 1, (const bf16_t*)(ws + S_QP1), (int*)(ws + S_EIDX1), (float*)(ws + S_GW1)); }
    if (IN(17)) { if (USE_MFMA_ROUTE) phase_peer_route(p, lds, 1, (const bf16_t*)(ws + S_QP1), (int*)(ws + S_EIDX1), (float*)(ws + S_GW1)); else phase_peer_route_ref(p, lds, 1, (const bf16_t*)(ws + S_QP1), (int*)(ws + S_EIDX1), (float*)(ws + S_GW1)); } SEAM(17);
    if (IN(18) && ((PROBE_DUP & 2) || PROBE_REP == 18)) for (int rep_ = 0; rep_ < PROBE_N; ++rep_) { PEER_GATHER(p, 1, (const int*)(ws + S_EIDX1), (const float*)(ws + S_GW1), HB, (bf16_t*)(ws + S_Z2), nullptr, 1.f); }
#if SPLIT_UV && TAB_MODE == 6
    if (IN(18)) { if (U_MM && U_SPLIT && gridDim.x == 256) { phase_peer_upass_mm_split(p, lds, 1, (const int*)(ws + S_EIDX1), (float*)(ws + S_Z2), HB); xcd_barrier(gbar);
            if (V_SPLIT && V_FP4) phase_peer_vpass_mm_sweep(p, lds, 1, (const int*)(ws + S_EIDX1), (const float*)(ws + S_GW1), (const float*)(ws + S_Z2), HB, HB, p.out, 1.f);
            else phase_peer_vpass_mm(p, 1, (const int*)(ws + S_EIDX1), (const float*)(ws + S_GW1), HB, HB, p.out, 1.f, (const float*)(ws + S_Z2)); }
        else { if (U_MM) phase_peer_upass_mm(p, lds, 1, (const int*)(ws + S_EIDX1), (float*)(ws + S_GW1), HB); else phase_peer_upass(p, 1, (const int*)(ws + S_EIDX1), (float*)(ws + S_GW1), HB);
            phase_peer_vpass_mm(p, 1, (const int*)(ws + S_EIDX1), (const float*)(ws + S_GW1), HB, HB, p.out, 1.f); } }
#else
    if (IN(18)) { PEER_GATHER(p, 1, (const int*)(ws + S_EIDX1), (const float*)(ws + S_GW1), HB, HB, p.out, (ABL & 8) ? 0.f : 1.f); }
#endif
#if DBG_TIME
    if (IN(18)) { { const unsigned long long t_now = __builtin_amdgcn_s_memrealtime(); if ((DBG_TIME >> 18) & 1u) t_acc += t_now - t_prev; }
        xcd_barrier(gbar);
        const float c = 1.f + (float)t_acc * (0.01f / 100.f);
        if (blockIdx.x == 0) for (size_t i = threadIdx.x; i < (size_t)NTOK * DM; i += NTHREADS) p.out[i] = c;
        else { const float c0 = 1.f; (void)c0; } }
#elif DBG_STAT == 7
    if (IN(18)) { xcd_barrier(gbar);
        typedef float v16f_ __attribute__((ext_vector_type(16))); typedef float v32f_ __attribute__((ext_vector_type(32))); typedef unsigned v6u_ __attribute__((ext_vector_type(6)));
        v16f_ a, b;
#pragma unroll
        for (int i = 0; i < 16; ++i) { a[i] = 0.125f * (float)i; b[i] = (i < 8) ? 2.f + 0.25f * (float)i : 4.f + 0.5f * (float)(i - 8); }
        asm volatile("" : "+v"(a), "+v"(b));
        const v6u_ pk = __builtin_amdgcn_cvt_scalef32_2xpk16_fp6_f32(a, b, 1.0f);
        const v32f_ r = __builtin_amdgcn_cvt_scalef32_pk32_f32_fp6(pk, 1.0f);
        bool seq = true, itl = true;
#pragma unroll
        for (int i = 0; i < 16; ++i) { seq = seq && (r[i] == a[i]) && (r[16 + i] == b[i]); itl = itl && (r[2 * i] == a[i]) && (r[2 * i + 1] == b[i]); }
        const float c = seq ? 1.f : (itl ? 2.f : 3.f);
        for (size_t i = (size_t)blockIdx.x * NTHREADS + threadIdx.x; i < (size_t)NTOK * DM; i += (size_t)gridDim.x * NTHREADS) p.out[i] = c; }
#elif DBG_STAT
    if (IN(18)) { asm volatile("s_waitcnt vmcnt(0) lgkmcnt(0)" ::: "memory"); __builtin_amdgcn_fence(__ATOMIC_RELEASE, "agent"); cg::this_grid().sync(); __builtin_amdgcn_fence(__ATOMIC_ACQUIRE, "agent");
        const float c = 1.f + __hip_atomic_load((float*)(ws + WS_CTL) + 16, __ATOMIC_RELAXED, __HIP_MEMORY_SCOPE_AGENT);
        for (size_t i = (size_t)blockIdx.x * NTHREADS + threadIdx.x; i < (size_t)NTOK * DM; i += (size_t)gridDim.x * NTHREADS) p.out[i] = c; }
#endif
#undef IN
#undef SEAM
}

extern "C" void kernel_launch(void* const* d_in, const int* in_sizes, int n_in, void* d_out, int out_size, void* d_ws, size_t ws_size, hipStream_t stream) {
    static int grid = 0;
    if (grid == 0) {
        if (n_in != 28 || out_size != NTOK * DM || ws_size < WS_NEED) { fprintf(stderr, "kernel_launch: unexpected problem (n_in %d, out %d, ws %zu)\n", n_in, out_size, ws_size); grid = -1; return; }
        int dev = 0, cus = 0, per_cu = 0;
        (void)hipGetDevice(&dev); (void)hipDeviceGetAttribute(&cus, hipDeviceAttributeMultiprocessorCount, dev);
        if (hipFuncSetAttribute((const void*)fwd_kernel, hipFuncAttributeMaxDynamicSharedMemorySize, LDS_BYTES) != hipSuccess) { fprintf(stderr, "kernel_launch: hipFuncSetAttribute failed\n"); grid = -1; return; }
        if (hipOccupancyMaxActiveBlocksPerMultiprocessor(&per_cu, (const void*)fwd_kernel, NTHREADS, LDS_BYTES) != hipSuccess || per_cu < 1) { fprintf(stderr, "kernel_launch: occupancy query says %d blocks per CU\n", per_cu); grid = -1; return; }
        grid = cus;
    }
    if (grid < 0) return;
    if (hipMemsetAsync((char*)d_ws + WS_CTL, 0, CTL_BYTES, stream) != hipSuccess) { fprintf(stderr, "kernel_launch: memset of the control words failed\n"); return; }
    Params p{};
    for (int i = 0; i < 28; ++i) p.in[i] = (const float*)d_in[i];
    p.out = (float*)d_out; p.ws = (unsigned char*)d_ws;
#if MK_ONE_LAUNCH
    p.ph_lo = 0; p.ph_hi = NPHASES;
    void* args[] = {&p};
    hipError_t e = hipLaunchCooperativeKernel((const void*)fwd_kernel, dim3(grid), dim3(NTHREADS), args, LDS_BYTES, stream);
    if (e != hipSuccess) fprintf(stderr, "kernel_launch: cooperative launch failed: %s\n", hipGetErrorString(e));
#else
    for (int k = 0; k < NPHASES; ++k) { p.ph_lo = k; p.ph_hi = k + 1; hipLaunchKernelGGL(fwd_kernel, dim3(grid), dim3(NTHREADS), LDS_BYTES, stream, p); }
#endif
}
#ifdef REGTEST
__global__ void __launch_bounds__(256) regtest_nsa(Params p) { extern __shared__ __attribute__((aligned(16))) unsigned char l2[]; phase_nsa_attn(p, (LAS unsigned char*)l2); }
__global__ void __launch_bounds__(256) regtest_mla(Params p) { extern __shared__ __attribute__((aligned(16))) unsigned char l2[]; phase_mla_attn<0>(p, (LAS unsigned char*)l2); }
#endif
```

```cpp
#include <hip/hip_runtime.h>
#include <hip/hip_cooperative_groups.h>
#include <cstdio>
#include <cstdint>
namespace cg = cooperative_groups;

#ifndef ABL
#define ABL 0
#endif
#ifndef PROBE_DUP
#define PROBE_DUP 0
#endif
#ifndef MLA_VAR
#define MLA_VAR -1
#endif
#ifndef V_FP4
#define V_FP4 1
#endif
#ifndef U_MM
#define U_MM 1
#endif
#ifndef U_SPLIT
#define U_SPLIT 1
#endif
#ifndef V_SPLIT
#define V_SPLIT 1
#endif
#ifndef PROBE_REP2
#define PROBE_REP2 -1
#endif
#ifndef PROBE_REP
#define PROBE_REP -1
#endif
#ifndef PROBE_N
#define PROBE_N 2
#endif
#ifndef TAB_MODE
#define TAB_MODE 6
#endif
#define TAB_FP4 (TAB_MODE == 4)
#ifndef SPLIT_UV
#define SPLIT_UV 1
#endif
#ifndef USE_MFMA_ROUTE
#define USE_MFMA_ROUTE 1
#endif
#ifndef USE_MFMA_NSA
#define USE_MFMA_NSA 1
#endif
#ifndef USE_MFMA_MLA
#define USE_MFMA_MLA 1
#endif
#ifndef DBG_TIME
#define DBG_TIME 0u
#endif
#ifndef DBG_STAT
#define DBG_STAT 0
#endif
#ifndef MK_ONE_LAUNCH
#define MK_ONE_LAUNCH 1
#endif

#define LAS __attribute__((address_space(3)))
typedef unsigned short bf16_t;
typedef short bf16x8 __attribute__((ext_vector_type(8)));
typedef float f32x4 __attribute__((ext_vector_type(4)));
typedef float f32x2 __attribute__((ext_vector_type(2)));
typedef unsigned u32x4 __attribute__((ext_vector_type(4)));
typedef unsigned u32x2 __attribute__((ext_vector_type(2)));
typedef __bf16 bf16x2_t __attribute__((ext_vector_type(2)));

constexpr int BATCH = 8, SEQ = 4096, DM = 1024, NTOK = BATCH * SEQ;
constexpr int NSA_IN = 2608, NSA_IN_PAD = 2816;
constexpr int MLA_DOWN = 1056, MLA_DOWN_PAD = 1280;
constexpr int NEXP = 16384;
constexpr float DN_ALPHA = 1.4142135623730951f;
constexpr float LN_EPS = 1e-5f, RMS_EPS = 1e-6f;
#if TAB_FP4
constexpr float U_SCALE = 64.f, V_SCALE = 4.f;
constexpr size_t TAB_ROW = 512, TAB_BYTES = 8u << 20;
#elif TAB_MODE == 6
constexpr float U_SCALE = 64.f, V_SCALE = 4.f;
constexpr size_t TAB_ROW = 768, TAB_BYTES = 12u << 20;
#else
constexpr float U_SCALE = 1024.f, V_SCALE = 64.f;
constexpr size_t TAB_ROW = 1024, TAB_BYTES = 16u << 20;
#endif
constexpr int NWAVES = 8, NTHREADS = 512;
constexpr int LDS_BYTES = 147456;

constexpr size_t KiB = 1024, MiB = 1024 * 1024;
constexpr size_t WS_CTL = 0, CTL_BYTES = 64 * KiB;
constexpr size_t WS_W_IN_T = 1 * MiB;
constexpr size_t WS_W_NSAOUT_T = 6 * MiB + 512 * KiB;
constexpr size_t WS_W_CK1_T = 8 * MiB + 512 * KiB;
constexpr size_t WS_W_CV1_T = 9 * MiB;
constexpr size_t WS_W_MLADOWN_T = 9 * MiB + 512 * KiB;
constexpr size_t WS_W_UQ_T = 12 * MiB;
constexpr size_t WS_W_UKV_T = 14 * MiB + 256 * KiB;
constexpr size_t WS_W_MLAOUT_T = 15 * MiB + 256 * KiB;
constexpr size_t WS_W_PQ_T = 17 * MiB + 256 * KiB;
constexpr size_t WS_SUBK = 25 * MiB + 256 * KiB;
constexpr size_t WS_MISC = 27 * MiB;
constexpr size_t WS_PE = WS_MISC;
constexpr size_t WS_ROPE_COS = WS_MISC + 4 * KiB;
constexpr size_t WS_ROPE_SIN = WS_ROPE_COS + 256 * KiB;
constexpr size_t WS_RSTD_Q = WS_ROPE_SIN + 256 * KiB;
constexpr size_t WS_RSTD_KV = WS_RSTD_Q + 128 * KiB;
constexpr size_t WS_STATS = 28 * MiB;
constexpr size_t WS_TAB = 32 * MiB;
constexpr size_t WS_HB = 160 * MiB;
constexpr size_t WS_S = 224 * MiB;
constexpr size_t S_Q = WS_S;
constexpr size_t S_KV6 = WS_S + 64 * MiB;
constexpr size_t S_AO = WS_S + 160 * MiB;
constexpr size_t S_GATES = WS_S + 224 * MiB;
constexpr size_t S_PK = WS_S + 230 * MiB;
constexpr size_t S_PV = WS_S + 238 * MiB;
constexpr size_t S_KCMP = WS_S + 246 * MiB;
constexpr size_t S_VCMP = S_KCMP + 512 * KiB;
constexpr size_t S_Z = WS_S;
constexpr size_t S_QP0 = WS_S + 64 * MiB;
constexpr size_t S_EIDX0 = WS_S + 192 * MiB;
constexpr size_t S_GW0 = WS_S + 208 * MiB;
constexpr size_t S_DQ = WS_S;
constexpr size_t S_QF = WS_S + 80 * MiB;
constexpr size_t S_V = WS_S + 176 * MiB;
constexpr size_t S_KROPE = WS_S + 240 * MiB;
constexpr size_t S_KNOPE = WS_TAB + 64 * MiB;
constexpr size_t S_AO2 = WS_S;
constexpr size_t S_Z2 = WS_S + 80 * MiB;
constexpr size_t S_QP1 = WS_S + 144 * MiB;
constexpr size_t S_EIDX1 = WS_S;
constexpr size_t S_GW1 = WS_S + 16 * MiB;
constexpr size_t WS_NEED = 512 * MiB;
static_assert(S_QP1 + 128 * MiB <= WS_NEED && S_VCMP + 512 * KiB <= WS_NEED, "workspace map");

__device__ __forceinline__ float bf_lo(unsigned u) { return __uint_as_float(u << 16); }
__device__ __forceinline__ float bf_hi(unsigned u) { return __uint_as_float(u & 0xffff0000u); }
__device__ __forceinline__ float bf2f(bf16_t v) { return __uint_as_float((unsigned)v << 16); }
__device__ __forceinline__ unsigned pk2(float lo, float hi) { f32x2 v = {lo, hi}; bf16x2_t b = __builtin_convertvector(v, bf16x2_t); return __builtin_bit_cast(unsigned, b); }
__device__ __forceinline__ bf16_t f2bf(float f) { return (bf16_t)(pk2(f, 0.f) & 0xffffu); }
__device__ __forceinline__ float wave_sum(float v) {
#pragma unroll
    for (int o = 32; o >= 1; o >>= 1) v += __shfl_xor(v, o);
    return v;
}
__device__ __forceinline__ float wave_sum_fast(float v) {
#define WSF_DPP(ctrl) __builtin_bit_cast(float, __builtin_amdgcn_update_dpp(0, __builtin_bit_cast(int, v), ctrl, 0xF, 0xF, true))
    v += WSF_DPP(0xB1); v += WSF_DPP(0x4E); v += WSF_DPP(0x141); v += WSF_DPP(0x140);
#undef WSF_DPP
    v += __builtin_bit_cast(float, __builtin_amdgcn_update_dpp(0, __builtin_bit_cast(int, v), 0x142, 0xA, 0xF, false));
    v += __builtin_bit_cast(float, __builtin_amdgcn_update_dpp(0, __builtin_bit_cast(int, v), 0x143, 0xC, 0xF, false));
    return __builtin_bit_cast(float, __builtin_amdgcn_readlane(__builtin_bit_cast(int, v), 63));
}
__device__ __forceinline__ float wave_max(float v) {
#pragma unroll
    for (int o = 32; o >= 1; o >>= 1) v = fmaxf(v, __shfl_xor(v, o));
    return v;
}
__device__ __forceinline__ float gelu_tanh(float x) {
    const float y = 0.7978845608028654f * (x + 0.044715f * x * x * x);
    const float e = __expf(2.f * y);
    const float th = 1.f - 2.f / (1.f + e);
    return 0.5f * x * (1.f + th);
}
#define LDS_FENCE() asm volatile("s_waitcnt lgkmcnt(0)" ::: "memory")

namespace pg8 {
constexpr int BM = 256, BK = 64, HALF = 128, HTB = HALF * BK * 2, STAGE_BYTES = 8 * HTB, NXCD = 8, WGM = 8;
__host__ __device__ __forceinline__ int lds_byte(int r, int c) { const int st = (r >> 4) * 2 + (c >> 5), rr = r & 15, cc = c & 31, ob = rr * 64 + cc * 2; return st * 1024 + (ob ^ (((ob >> 9) & 1) << 5)); }
__host__ __device__ __forceinline__ void stage_rc(int b, int& R, int& C) { const int st = b / 1024, sb = b % 1024, swz = sb ^ (((sb >> 9) & 1) << 5); R = (st >> 1) * 16 + swz / 64; C = (st & 1) * 32 + (swz % 64) / 2; }
__host__ __device__ __forceinline__ int perm32(int rho) { const int n = rho >> 4, i = rho & 15; return 8 * (i >> 2) + 4 * n + (i & 3); }
struct Unit { int pm, pn; };
struct Gemm { const bf16_t* A; const bf16_t* Bt; int M, N, K, lda, ldb; };
struct StaticOrder {
    int nM, nN, nwg, G, c;
    __device__ void init(int M, int N, int G_, int c_) { nM = M / BM; nN = N / BM; nwg = nM * nN; G = G_; c = c_; }
    __device__ bool next(int i, Unit& u) const {
        const long L = (long)i * G + c; if (L >= nwg) return false;
        int wgid = (int)L; { const int q = nwg / NXCD, r = nwg % NXCD, xcd = wgid % NXCD, off = wgid / NXCD; wgid = (xcd < r ? xcd * (q + 1) : r * (q + 1) + (xcd - r) * q) + off; }
        const int nig = WGM * nN, gid = wgid / nig, fm = gid * WGM, gsz = (nM - fm) < WGM ? (nM - fm) : WGM;
        u.pm = fm + ((wgid % nig) % gsz); u.pn = (wgid % nig) / gsz; return true;
    }
};
template <class F> struct EpiFn {
    static constexpr bool PERM = true;
    F f;
    __device__ __forceinline__ void operator()(const f32x4 (&acc)[2][2][4][2], const Unit& u, int wr, int wc, int fr, int fq) const {
        const int row0 = u.pm * BM + wr * 64 + fr, col0 = u.pn * BM + wc * 32 + 8 * fq;
#pragma unroll
        for (int ai = 0; ai < 2; ++ai)
#pragma unroll
            for (int m = 0; m < 4; ++m)
#pragma unroll
                for (int bj = 0; bj < 2; ++bj) f(row0 + ai * HALF + m * 16, col0 + bj * HALF, acc[ai][bj][m][0], acc[ai][bj][m][1]);
    }
};

template <class Epi, class Sched>
__device__ __forceinline__ void gemm_phase(LAS unsigned char* lds, const Gemm g, const Sched& S, const Epi& E) {
    int tid = threadIdx.x; asm volatile("" : "+v"(tid));
    const int wid = __builtin_amdgcn_readfirstlane(tid >> 6), lane = tid & 63, wr = wid >> 2, wc = wid & 3, fr = lane & 15, fq = lane >> 4;
    const int K = g.K, nt = K / BK;
    unsigned voffA[2], voffB[2];
#pragma unroll
    for (int i = 0; i < 2; ++i) { int R, C; stage_rc(tid * 16 + i * 8192, R, C); const int Rb = Epi::PERM ? ((R & ~31) + perm32(R & 31)) : R;
        voffA[i] = (unsigned)(R * g.lda + C) * 2u; voffB[i] = (unsigned)(Rb * g.ldb + C) * 2u; }
    const size_t kstep = (size_t)(BK * 2);
    const size_t hstepA = (size_t)HALF * g.lda * 2, hstepB = (size_t)HALF * g.ldb * 2;
    const size_t tstepA = 2 * hstepA, tstepB = 2 * hstepB;
    const unsigned ldsw = (unsigned)wid * 1024u;
    const int aoff = lds_byte(wr * 64 + fr, fq * 8), boff = lds_byte(wc * 32 + fr, fq * 8);
#define PG8_SA(b, h) (((b) * 2 + (h)) * HTB)
#define PG8_SB(b, h) ((4 + (b) * 2 + (h)) * HTB)
#define PG8_STAGE(bufoff, gbase, voff) do { _Pragma("unroll") for (int _i = 0; _i < 2; ++_i) \
        __builtin_amdgcn_global_load_lds((const unsigned*)((const char*)(gbase) + (voff)[_i]), (LAS unsigned*)(lds + (bufoff) + ldsw + _i * 8192), 16, 0, 0); } while (0)
#define PG8_LDA(dst, b, h) do { _Pragma("unroll") for (int m = 0; m < 4; ++m) _Pragma("unroll") for (int k = 0; k < 2; ++k) dst[m][k] = *(const LAS bf16x8*)(lds + PG8_SA(b, h) + aoff + m * 2048 + k * 1024); } while (0)
#define PG8_LDB(dst, b, h) do { _Pragma("unroll") for (int n = 0; n < 2; ++n) _Pragma("unroll") for (int k = 0; k < 2; ++k) dst[n][k] = *(const LAS bf16x8*)(lds + PG8_SB(b, h) + boff + n * 2048 + k * 1024); } while (0)
#define PG8_MMA(ai, bj, At, Bt) do { __builtin_amdgcn_s_setprio(1); _Pragma("unroll") for (int m = 0; m < 4; ++m) _Pragma("unroll") for (int n = 0; n < 2; ++n) _Pragma("unroll") for (int k = 0; k < 2; ++k) \
        acc[ai][bj][m][n] = __builtin_amdgcn_mfma_f32_16x16x32_bf16(Bt[n][k], At[m][k], acc[ai][bj][m][n], 0, 0, 0); __builtin_amdgcn_s_setprio(0); } while (0)
#define PG8_WAIT_V(n) asm volatile("s_waitcnt vmcnt(" #n ")" ::: "memory")
#define PG8_WAIT_L(n) asm volatile("s_waitcnt lgkmcnt(" #n ")" ::: "memory")
#define PG8_BAR __builtin_amdgcn_s_barrier()
#define PG8_SCHED __builtin_amdgcn_sched_barrier(0)
    Unit cur, nxt; int ui = 0;
    if (!S.next(0, cur)) return;
    f32x4 acc[2][2][4][2];
#pragma unroll
    for (int a = 0; a < 2; ++a)
#pragma unroll
        for (int b = 0; b < 2; ++b)
#pragma unroll
            for (int m = 0; m < 4; ++m)
#pragma unroll
                for (int n = 0; n < 2; ++n) acc[a][b][m][n] = (f32x4){0.f, 0.f, 0.f, 0.f};
    bf16x8 At[4][2], B0[2][2], B1[2][2];
    const char* cA = (const char*)g.A + (size_t)cur.pm * tstepA; const char* cB = (const char*)g.Bt + (size_t)cur.pn * tstepB;
    PG8_STAGE(PG8_SB(0, 0), cB, voffB); PG8_STAGE(PG8_SB(0, 1), cB + hstepB, voffB); PG8_STAGE(PG8_SA(0, 0), cA, voffA); PG8_STAGE(PG8_SA(0, 1), cA + hstepA, voffA);
    if (wr == 1) PG8_BAR;
    PG8_WAIT_V(2); PG8_BAR;
    PG8_STAGE(PG8_SB(1, 0), cB + kstep, voffB); PG8_STAGE(PG8_SA(1, 0), cA + kstep, voffA); PG8_STAGE(PG8_SB(1, 1), cB + hstepB + kstep, voffB);
    PG8_WAIT_V(6); PG8_BAR;
    for (;;) {
        const bool has_next = S.next(ui + 1, nxt);
        const char* nA = has_next ? (const char*)g.A + (size_t)nxt.pm * tstepA : cA; const char* nB = has_next ? (const char*)g.Bt + (size_t)nxt.pn * tstepB : cB;
        for (int t = 0; t < nt; t += 2) {
            const bool last = (t == nt - 2);
            const char* a1 = cA + (size_t)(t + 1) * kstep;
            const char* a2 = last ? nA : cA + (size_t)(t + 2) * kstep; const char* b2 = last ? nB : cB + (size_t)(t + 2) * kstep;
            const char* a3 = a2 + kstep; const char* b3 = b2 + kstep;
            PG8_LDB(B0, 0, 0); PG8_LDB(B1, 0, 1); PG8_SCHED; PG8_LDA(At, 0, 0); PG8_STAGE(PG8_SA(1, 1), a1 + hstepA, voffA);
            PG8_WAIT_V(8); PG8_WAIT_L(0); PG8_BAR; PG8_MMA(0, 0, At, B0); PG8_MMA(0, 1, At, B1); PG8_BAR; PG8_SCHED;
            PG8_LDA(At, 0, 1); PG8_STAGE(PG8_SB(0, 0), b2, voffB); PG8_STAGE(PG8_SB(0, 1), b2 + hstepB, voffB); PG8_STAGE(PG8_SA(0, 0), a2, voffA);
            PG8_WAIT_V(8); PG8_WAIT_L(0); PG8_BAR; PG8_MMA(1, 0, At, B0); PG8_MMA(1, 1, At, B1); PG8_BAR; PG8_SCHED;
            PG8_LDB(B0, 1, 0); PG8_LDB(B1, 1, 1); PG8_SCHED; PG8_LDA(At, 1, 0); PG8_STAGE(PG8_SA(0, 1), a2 + hstepA, voffA);
            PG8_WAIT_V(8); PG8_WAIT_L(0); PG8_BAR; PG8_MMA(0, 0, At, B0); PG8_MMA(0, 1, At, B1); PG8_BAR; PG8_SCHED;
            PG8_LDA(At, 1, 1); PG8_STAGE(PG8_SB(1, 0), b3, voffB); PG8_STAGE(PG8_SB(1, 1), b3 + hstepB, voffB); PG8_STAGE(PG8_SA(1, 0), a3, voffA);
            PG8_WAIT_V(8); PG8_WAIT_L(0); PG8_BAR; PG8_MMA(1, 0, At, B0); PG8_MMA(1, 1, At, B1); PG8_BAR; PG8_SCHED;
        }
        if (wr == 0) PG8_BAR;
        E(acc, cur, wr, wc, fr, fq);
        if (!has_next) break;
#pragma unroll
        for (int a = 0; a < 2; ++a)
#pragma unroll
            for (int b = 0; b < 2; ++b)
#pragma unroll
                for (int m = 0; m < 4; ++m)
#pragma unroll
                    for (int n = 0; n < 2; ++n) acc[a][b][m][n] = (f32x4){0.f, 0.f, 0.f, 0.f};
        cur = nxt; cA = nA; cB = nB; ++ui;
        if (wr == 1) PG8_BAR;
    }
    PG8_WAIT_V(0);
    PG8_BAR;
#undef PG8_SA
#undef PG8_SB
#undef PG8_STAGE
#undef PG8_LDA
#undef PG8_LDB
#undef PG8_MMA
#undef PG8_WAIT_V
#undef PG8_WAIT_L
#undef PG8_BAR
#undef PG8_SCHED
}
}

template <class F>
__device__ __forceinline__ void run_gemm(LAS unsigned char* lds, const bf16_t* A, int lda, const bf16_t* Bt, int ldb, int M, int N, int K, int vblock, const F& f) {
    pg8::Gemm g{A, Bt, M, N, K, lda, ldb}; pg8::StaticOrder S; S.init(M, N, (int)gridDim.x, vblock);
    pg8::EpiFn<F> E{f};
    pg8::gemm_phase<pg8::EpiFn<F>, pg8::StaticOrder>(lds, g, S, E);
}

struct Params {
    const float* in[28];
    float* out;
    unsigned char* ws;
    int ph_lo, ph_hi;
};
enum { I_X = 0, I_NSA_WIN, I_CK_W1, I_CK_W2, I_CK_PE, I_CV_W1, I_CV_W2, I_CV_PE, I_NSA_WOUT, I_NSA_LNG, I_NSA_LNB, I_MLA_WDKV, I_MLA_KVG, I_MLA_WKR, I_MLA_WUK, I_MLA_WUV,
       I_MLA_WDQ, I_MLA_QG, I_MLA_WUQ, I_MLA_WOUT, I_MLA_LNG, I_MLA_LNB, I_PEER_WQ, I_PEER_SUBK, I_PEER_U, I_PEER_V, I_PEER_LNG, I_PEER_LNB };

__device__ __forceinline__ void p0_transpose_item(const float* W, int ldw, int n_valid, int K, bf16_t* WT, int row_off, const float* kscale, LAS float* scr, int nblk, int item, int lane) {
    const int kb = item / nblk, nb = item % nblk, k0 = 64 * kb, n0 = 32 * nb;
    const int n = n0 + (lane & 31);
#pragma unroll 8
    for (int i = 0; i < 32; ++i) { const int kk = 2 * i + (lane >> 5); float v = 0.f; if (n < n_valid) { v = W[(size_t)(k0 + kk) * ldw + n]; if (kscale) v *= kscale[k0 + kk]; } scr[kk * 33 + (lane & 31)] = v; }
    LDS_FENCE();
    const int c = lane & 7;
#pragma unroll
    for (int j = 0; j < 4; ++j) { const int nn = (lane >> 3) + 8 * j; const LAS float* s = scr + (8 * c) * 33 + nn;
        u32x4 o; o.x = pk2(s[0 * 33], s[1 * 33]); o.y = pk2(s[2 * 33], s[3 * 33]); o.z = pk2(s[4 * 33], s[5 * 33]); o.w = pk2(s[6 * 33], s[7 * 33]);
        *(u32x4*)(WT + (size_t)(row_off + n0 + nn) * K + k0 + 8 * c) = o; }
    LDS_FENCE();
}
__device__ __forceinline__ void cvt_f32_bf16(const float* src, bf16_t* dst, size_t n, size_t gtid, size_t gsz) {
    for (size_t i = gtid * 8; i < n; i += gsz * 8) { const f32x4 a = *(const f32x4*)(src + i), b = *(const f32x4*)(src + i + 4);
        u32x4 o; o.x = pk2(a.x, a.y); o.y = pk2(a.z, a.w); o.z = pk2(b.x, b.y); o.w = pk2(b.z, b.w); *(u32x4*)(dst + i) = o; }
}
__device__ __forceinline__ void cvt_f32_fp8(const float* src, unsigned char* dst, size_t n, float scale, size_t gtid, size_t gsz) {
    for (size_t i = gtid * 16; i < n; i += gsz * 16) {
        u32x4 o;
#pragma unroll
        for (int j = 0; j < 4; ++j) { f32x4 a = *(const f32x4*)(src + i + 4 * j) * scale;
#pragma unroll
            for (int e = 0; e < 4; ++e) a[e] = fminf(fmaxf(a[e], -448.f), 448.f);
            int pk = 0; pk = __builtin_amdgcn_cvt_pk_fp8_f32(a.x, a.y, pk, false); pk = __builtin_amdgcn_cvt_pk_fp8_f32(a.z, a.w, pk, true); o[j] = (unsigned)pk; }
        *(u32x4*)(dst + i) = o;
    }
}
__device__ __forceinline__ void cvt_f32_fp4(const float* src, unsigned char* dst, size_t n, float scale, size_t gtid, size_t gsz) {
    for (size_t i = gtid * 32; i < n; i += gsz * 32) {
        u32x4 o;
#pragma unroll
        for (int j = 0; j < 4; ++j) { const f32x4 a = *(const f32x4*)(src + i + 8 * j) * scale, b = *(const f32x4*)(src + i + 8 * j + 4) * scale;
            unsigned pk = 0u;
            pk = __builtin_amdgcn_cvt_scalef32_pk_fp4_f32(pk, a.x, a.y, 1.0f, 0); pk = __builtin_amdgcn_cvt_scalef32_pk_fp4_f32(pk, a.z, a.w, 1.0f, 1);
            pk = __builtin_amdgcn_cvt_scalef32_pk_fp4_f32(pk, b.x, b.y, 1.0f, 2); pk = __builtin_amdgcn_cvt_scalef32_pk_fp4_f32(pk, b.z, b.w, 1.0f, 3); o[j] = pk; }
        *(u32x4*)(dst + (i >> 1)) = o;
    }
}
typedef float v16f_t __attribute__((ext_vector_type(16)));
typedef float v32f_t __attribute__((ext_vector_type(32)));
typedef unsigned v6u_t __attribute__((ext_vector_type(6)));
__device__ __forceinline__ void cvt_f32_fp6(const float* src, unsigned char* dst, size_t n, float scale, size_t gtid, size_t gsz) {
    for (size_t i = gtid * 32; i < n; i += gsz * 32) {
        v16f_t a, b;
#pragma unroll
        for (int j = 0; j < 8; ++j) { f32x4 v = *(const f32x4*)(src + i + 4 * j) * scale;
#pragma unroll
            for (int e = 0; e < 4; ++e) v[e] = fminf(fmaxf(v[e], -7.5f), 7.5f);
            a[2 * j] = v.x; b[2 * j] = v.y; a[2 * j + 1] = v.z; b[2 * j + 1] = v.w; }
        const v6u_t pk = __builtin_amdgcn_cvt_scalef32_2xpk16_fp6_f32(a, b, 1.0f);
        unsigned char* d = dst + (i >> 5) * 24;
        *(u32x2*)d = (u32x2){pk[0], pk[1]}; *(u32x2*)(d + 8) = (u32x2){pk[2], pk[3]}; *(u32x2*)(d + 16) = (u32x2){pk[4], pk[5]};
    }
}
__device__ __forceinline__ void phase_prologue(const Params& p, LAS unsigned char* lds) {
    int tid = threadIdx.x; asm volatile("" : "+v"(tid));
    const int lane = tid & 63, wave = tid >> 6;
    LAS float* scr = (LAS float*)(lds + wave * 16384);
    const int gw = blockIdx.x * NWAVES + wave, NGW = gridDim.x * NWAVES;
    unsigned char* ws = p.ws;
    int base = 0;
#define TJOB(W_, ldw_, nvalid_, K_, npad_, WT_, rowoff_, ks_) do { const int nblk = (npad_) / 32, nit = ((K_) / 64) * nblk; \
        for (int it = gw - base; it < nit; it += NGW) { if (it >= 0) p0_transpose_item((W_), (ldw_), (nvalid_), (K_), (WT_), (rowoff_), (ks_), scr, nblk, it, lane); } \
        base = (base + nit) % NGW; } while (0)
#define TJOBS_EARLY() do {   \
    TJOB(p.in[I_NSA_WIN], NSA_IN, NSA_IN, 1024, NSA_IN_PAD, (bf16_t*)(ws + WS_W_IN_T), 0, (const float*)nullptr); \
    TJOB(p.in[I_CK_W1], 128, 128, 1024, 128, (bf16_t*)(ws + WS_W_CK1_T), 0, (const float*)nullptr); \
    TJOB(p.in[I_CK_W1] + 1024 * 128, 128, 128, 1024, 128, (bf16_t*)(ws + WS_W_CK1_T), 128, (const float*)nullptr); \
    TJOB(p.in[I_CV_W1], 128, 128, 1024, 128, (bf16_t*)(ws + WS_W_CV1_T), 0, (const float*)nullptr); \
    TJOB(p.in[I_CV_W1] + 1024 * 128, 128, 128, 1024, 128, (bf16_t*)(ws + WS_W_CV1_T), 128, (const float*)nullptr); } while (0)
#define TJOBS_LATE() do {   \
    TJOB(p.in[I_NSA_WOUT], 1024, 1024, 1024, 1024, (bf16_t*)(ws + WS_W_NSAOUT_T), 0, (const float*)nullptr); \
    TJOB(p.in[I_MLA_WDQ], 768, 768, 1024, 768, (bf16_t*)(ws + WS_W_MLADOWN_T), 0, (const float*)nullptr); \
    TJOB(p.in[I_MLA_WDKV], 256, 256, 1024, 256, (bf16_t*)(ws + WS_W_MLADOWN_T), 768, (const float*)nullptr); \
    TJOB(p.in[I_MLA_WKR], 32, 32, 1024, 256, (bf16_t*)(ws + WS_W_MLADOWN_T), 1024, (const float*)nullptr);   \
    TJOB(p.in[I_MLA_WUQ], 1536, 1536, 768, 1536, (bf16_t*)(ws + WS_W_UQ_T), 0, p.in[I_MLA_QG]); \
    TJOB(p.in[I_MLA_WUK], 1024, 1024, 256, 1024, (bf16_t*)(ws + WS_W_UKV_T), 0, p.in[I_MLA_KVG]); \
    TJOB(p.in[I_MLA_WUV], 1024, 1024, 256, 1024, (bf16_t*)(ws + WS_W_UKV_T), 1024, p.in[I_MLA_KVG]); \
    TJOB(p.in[I_MLA_WOUT], 1024, 1024, 1024, 1024, (bf16_t*)(ws + WS_W_MLAOUT_T), 0, (const float*)nullptr); \
    TJOB(p.in[I_PEER_WQ], 2048, 2048, 1024, 2048, (bf16_t*)(ws + WS_W_PQ_T), 0, (const float*)nullptr); \
    TJOB(p.in[I_PEER_WQ] + (size_t)1024 * 2048, 2048, 2048, 1024, 2048, (bf16_t*)(ws + WS_W_PQ_T) + (size_t)2048 * 1024, 0, (const float*)nullptr); } while (0)
    TJOBS_EARLY();
    if (gridDim.x != 256) TJOBS_LATE();
#if DBG_STAT
    if (blockIdx.x == 0 && tid == 0) ((float*)(ws + WS_CTL))[16] = 0.f;
#endif
    const size_t gtid = (size_t)blockIdx.x * NTHREADS + tid, gsz = (size_t)gridDim.x * NTHREADS;
    cvt_f32_bf16(p.in[I_X], (bf16_t*)(ws + WS_HB), (size_t)NTOK * DM, gtid, gsz);
    cvt_f32_bf16(p.in[I_PEER_SUBK], (bf16_t*)(ws + WS_SUBK), (size_t)2 * 8 * 2 * 128 * 128, gtid, gsz);
#if TAB_MODE == 4
#define CVT_TAB cvt_f32_fp4
#define CVT_TAB_U cvt_f32_fp4
#define CVT_TAB_V cvt_f32_fp4
#elif TAB_MODE == 6
#define CVT_TAB cvt_f32_fp6
#if U_MM
#define CVT_TAB_U cvt_f32_fp4
#else
#define CVT_TAB_U cvt_f32_fp6
#endif
#if V_FP4
#define CVT_TAB_V cvt_f32_fp4
#else
#define CVT_TAB_V cvt_f32_fp6
#endif
#else
#define CVT_TAB cvt_f32_fp8
#define CVT_TAB_U cvt_f32_fp8
#define CVT_TAB_V cvt_f32_fp8
#endif
    if (gridDim.x != 256) {
        CVT_TAB_U(p.in[I_PEER_U], ws + WS_TAB, (size_t)NEXP * DM, U_SCALE, gtid, gsz);
        CVT_TAB_V(p.in[I_PEER_V], ws + WS_TAB + TAB_BYTES, (size_t)NEXP * DM, V_SCALE, gtid, gsz);
        CVT_TAB_U(p.in[I_PEER_U] + (size_t)NEXP * DM, ws + WS_TAB + 2 * TAB_BYTES, (size_t)NEXP * DM, U_SCALE, gtid, gsz);
        CVT_TAB_V(p.in[I_PEER_V] + (size_t)NEXP * DM, ws + WS_TAB + 3 * TAB_BYTES, (size_t)NEXP * DM, V_SCALE, gtid, gsz);
    }
    for (int o = gw; o < 256; o += NGW) {
        const float* pe = (o < 128) ? p.in[I_CK_PE] : p.in[I_CV_PE]; const float* w1 = (o < 128) ? p.in[I_CK_W1] : p.in[I_CV_W1]; const int h = o & 127;
        float s = 0.f; for (int i = lane; i < 2048; i += 64) s += pe[i] * w1[(size_t)i * 128 + h];
        s = wave_sum(s); if (lane == 0) ((float*)(ws + WS_PE))[o] = s;
    }
    for (size_t i = gtid; i < (size_t)SEQ * 16; i += gsz) {
        const int pos = (int)(i >> 4), fi = (int)(i & 15);
        const float inv = 1.0f / powf(10000.0f, (float)(2 * fi) / 32.0f);
        const float ang = (float)pos * inv;
        const double rev = (double)ang * 0.15915494309189535; const double fr = rev - rint(rev);
        ((float*)(ws + WS_ROPE_COS))[i] = __builtin_amdgcn_cosf((float)fr); ((float*)(ws + WS_ROPE_SIN))[i] = __builtin_amdgcn_sinf((float)fr);
    }
}

__device__ __forceinline__ void late_weight_transposes(const Params& p, LAS unsigned char* lds) {
    if (gridDim.x != 256 || blockIdx.x < 128) return;
    int tid = threadIdx.x; asm volatile("" : "+v"(tid));
    const int lane = tid & 63, wave = tid >> 6;
    LAS float* scr = (LAS float*)(lds + wave * 16384);
    const int gw = ((int)blockIdx.x - 128) * NWAVES + wave, NGW = 128 * NWAVES;
    unsigned char* ws = p.ws;
    int base = 0;
    TJOBS_LATE();
}
#undef TJOBS_EARLY
#undef TJOBS_LATE
#undef TJOB
__device__ __forceinline__ void convert_tables_idle(const Params& p) {
    const int bid = (int)blockIdx.x;
    if (gridDim.x != 256 || bid < 32 || (bid >= 128 && bid < 160)) return;
    const int rank = (bid < 128) ? bid - 32 : bid - 64;
    const size_t gtid = (size_t)rank * NTHREADS + threadIdx.x, gsz = (size_t)192 * NTHREADS;
    unsigned char* ws = p.ws;
    CVT_TAB_U(p.in[I_PEER_U], ws + WS_TAB, (size_t)NEXP * DM, U_SCALE, gtid, gsz);
    CVT_TAB_V(p.in[I_PEER_V], ws + WS_TAB + TAB_BYTES, (size_t)NEXP * DM, V_SCALE, gtid, gsz);
    CVT_TAB_U(p.in[I_PEER_U] + (size_t)NEXP * DM, ws + WS_TAB + 2 * TAB_BYTES, (size_t)NEXP * DM, U_SCALE, gtid, gsz);
    CVT_TAB_V(p.in[I_PEER_V] + (size_t)NEXP * DM, ws + WS_TAB + 3 * TAB_BYTES, (size_t)NEXP * DM, V_SCALE, gtid, gsz);
}
#undef CVT_TAB
#undef CVT_TAB_U
#undef CVT_TAB_V
__device__ __forceinline__ u32x4 pack8(const f32x4& a, const f32x4& b) { u32x4 o; o.x = pk2(a.x, a.y); o.y = pk2(a.z, a.w); o.z = pk2(b.x, b.y); o.w = pk2(b.z, b.w); return o; }
__device__ __forceinline__ void store16_wt(void* p, const u32x4& v) { asm volatile("global_store_dwordx4 %0, %1, off sc0 sc1\n\ts_nop 1" :: "v"(p), "v"(v) : "memory"); }
struct EpiNsaProj {
    bf16_t* q; bf16_t* kv6; float* gates;
    __device__ __forceinline__ void operator()(int row, int col, const f32x4& a, const f32x4& b) const {
        if (col < 1024) { store16_wt(q + (size_t)row * 1024 + col, pack8(a, b)); }
        else if (col < 2560) {
            const int which = (col - 1024) >> 8, cc = (col - 1024) & 255;
            bf16_t* base = kv6 + (size_t)which * NTOK * 256;
            if (which < 2) { const int g = cc >> 6, d = cc & 63, bb = row >> 12, t = row & 4095, n = t >> 4, l = t & 15;
                store16_wt(base + ((((size_t)(bb * 256 + n) * 4 + g) * 16 + l) * 64 + d), pack8(a, b)); }
            else store16_wt(base + (size_t)row * 256 + cc, pack8(a, b));
        } else if (col < NSA_IN) {
            float* gp = gates + (size_t)row * 48 + (col - 2560);
            f32x4 s0, s1;
#pragma unroll
            for (int i = 0; i < 4; ++i) { s0[i] = 1.f / (1.f + __expf(-a[i])); s1[i] = 1.f / (1.f + __expf(-b[i])); }
            *(f32x4*)gp = s0; *(f32x4*)(gp + 4) = s1;
        }
    }
};
struct EpiF32 { float* O; int ldc; __device__ __forceinline__ void operator()(int row, int col, const f32x4& a, const f32x4& b) const { float* o = O + (size_t)row * ldc + col; *(f32x4*)o = a; *(f32x4*)(o + 4) = b; } };
struct EpiBf16 { bf16_t* O; int ldc; __device__ __forceinline__ void operator()(int row, int col, const f32x4& a, const f32x4& b) const { store16_wt(O + (size_t)row * ldc + col, pack8(a, b)); } };
struct EpiResid {
    const bf16_t* H; bf16_t* Z; float ms;
    __device__ __forceinline__ void operator()(int row, int col, const f32x4& a_, const f32x4& b_) const {
        const f32x4 a = a_ * ms, b = b_ * ms;
        const u32x4 h = *(const u32x4*)(H + (size_t)row * 1024 + col);
        f32x4 x, y;
        x.x = DN_ALPHA * bf_lo(h.x) + a.x; x.y = DN_ALPHA * bf_hi(h.x) + a.y; x.z = DN_ALPHA * bf_lo(h.y) + a.z; x.w = DN_ALPHA * bf_hi(h.y) + a.w;
        y.x = DN_ALPHA * bf_lo(h.z) + b.x; y.y = DN_ALPHA * bf_hi(h.z) + b.y; y.z = DN_ALPHA * bf_lo(h.w) + b.z; y.w = DN_ALPHA * bf_hi(h.w) + b.w;
        store16_wt(Z + (size_t)row * 1024 + col, pack8(x, y));
    }
};
struct EpiKV {
    bf16_t* KN; bf16_t* V;
    __device__ __forceinline__ void operator()(int row, int col, const f32x4& a, const f32x4& b) const {
        bf16_t* dst = (col < 1024) ? KN + (size_t)row * 1024 + col : V + (size_t)row * 1024 + (col - 1024);
        store16_wt(dst, pack8(a, b));
    }
};

__device__ __forceinline__ void phase_ln(const bf16_t* Z, bf16_t* H, const float* g, const float* b) {
    int tid_ = threadIdx.x; asm volatile("" : "+v"(tid_));
    const int lane = tid_ & 63, wave = tid_ >> 6;
    const int gw = blockIdx.x * NWAVES + wave, NGW = gridDim.x * NWAVES;
    if (gw >= NTOK) return;
    f32x4 gg[4], bb[4];
#pragma unroll
    for (int hh = 0; hh < 2; ++hh) { const int c0 = hh * 512 + lane * 8; gg[2 * hh] = *(const f32x4*)(g + c0); gg[2 * hh + 1] = *(const f32x4*)(g + c0 + 4); bb[2 * hh] = *(const f32x4*)(b + c0); bb[2 * hh + 1] = *(const f32x4*)(b + c0 + 4); }
    u32x4 an = *(const u32x4*)(Z + (size_t)gw * 1024 + lane * 8), cn = *(const u32x4*)(Z + (size_t)gw * 1024 + 512 + lane * 8);
    for (int row = gw; row < NTOK; row += NGW) {
        const u32x4 a = an, c = cn;
        { const int rn = row + NGW; if (rn < NTOK) { an = *(const u32x4*)(Z + (size_t)rn * 1024 + lane * 8); cn = *(const u32x4*)(Z + (size_t)rn * 1024 + 512 + lane * 8); } }
        float v[16] = {bf_lo(a.x), bf_hi(a.x), bf_lo(a.y), bf_hi(a.y), bf_lo(a.z), bf_hi(a.z), bf_lo(a.w), bf_hi(a.w), bf_lo(c.x), bf_hi(c.x), bf_lo(c.y), bf_hi(c.y), bf_lo(c.z), bf_hi(c.z), bf_lo(c.w), bf_hi(c.w)};
        float s = 0.f;
#pragma unroll
        for (int i = 0; i < 16; ++i) s += v[i];
        const float mean = wave_sum_fast(s) * (1.f / 1024.f); float q = 0.f;
#pragma unroll
        for (int i = 0; i < 16; ++i) { v[i] -= mean; q += v[i] * v[i]; }
        const float rstd = rsqrtf(wave_sum_fast(q) * (1.f / 1024.f) + LN_EPS);
        float o[16];
#pragma unroll
        for (int j = 0; j < 4; ++j)
#pragma unroll
            for (int i = 0; i < 4; ++i) o[4 * j + i] = v[4 * j + i] * rstd * gg[j][i] + bb[j][i];
        u32x4 w0, w1; w0.x = pk2(o[0], o[1]); w0.y = pk2(o[2], o[3]); w0.z = pk2(o[4], o[5]); w0.w = pk2(o[6], o[7]); w1.x = pk2(o[8], o[9]); w1.y = pk2(o[10], o[11]); w1.z = pk2(o[12], o[13]); w1.w = pk2(o[14], o[15]);
        *(u32x4*)(H + (size_t)row * 1024 + lane * 8) = w0; *(u32x4*)(H + (size_t)row * 1024 + 512 + lane * 8) = w1;
    }
}
__device__ __forceinline__ void phase_cmp_finish(const Params& p, LAS unsigned char* lds) {
    int tid_ = threadIdx.x; asm volatile("" : "+v"(tid_));
    const int lane = tid_ & 63, wave = tid_ >> 6;
    const int gw = blockIdx.x * NWAVES + wave, NGW = gridDim.x * NWAVES;
    LAS float* hs = (LAS float*)(lds + wave * 2048);
    for (int item0 = gw; item0 < 2 * 8192; item0 += 4 * NGW) {
        float a0[4], a1[4]; bool live[4]; const float* w2 = nullptr;
#pragma unroll
        for (int k = 0; k < 4; ++k) { const int item = item0 + k * NGW; live[k] = item < 2 * 8192; a0[k] = 0.f; a1[k] = 0.f;
            if (live[k]) { const int kv = item >> 13, r = item & 8191, n = (r >> 2) & 255;
                const float* P = (const float*)(p.ws + (kv ? S_PV : S_PK)); const float* pe = (const float*)(p.ws + WS_PE) + kv * 128;
                if (n != 255) { a0[k] = P[(size_t)r * 256 + lane] + P[(size_t)(r + 4) * 256 + 128 + lane] + pe[lane]; a1[k] = P[(size_t)r * 256 + 64 + lane] + P[(size_t)(r + 4) * 256 + 192 + lane] + pe[64 + lane]; } } }
        LDS_FENCE();
#pragma unroll
        for (int k = 0; k < 4; ++k) { hs[k * 128 + lane] = gelu_tanh(a0[k]); hs[k * 128 + 64 + lane] = gelu_tanh(a1[k]); }
        LDS_FENCE();
        const int kv0 = item0 >> 13, kv3 = (item0 + 3 * NGW) >> 13;
        if (kv0 == kv3 || item0 + 3 * NGW >= 2 * 8192) {
            w2 = p.in[kv0 ? I_CV_W2 : I_CK_W2];
            float s[4] = {0.f, 0.f, 0.f, 0.f};
            const bool same = (kv0 == kv3);
            if (same) {
#pragma unroll 8
                for (int h = 0; h < 128; ++h) { const float w = w2[h * 64 + lane]; s[0] += hs[h] * w; s[1] += hs[128 + h] * w; s[2] += hs[256 + h] * w; s[3] += hs[384 + h] * w; }
            } else {
#pragma unroll
                for (int k = 0; k < 4; ++k) { const int item = item0 + k * NGW; if (item < 2 * 8192) { const float* wk = p.in[(item >> 13) ? I_CV_W2 : I_CK_W2];
#pragma unroll 8
                    for (int h = 0; h < 128; ++h) s[k] += hs[k * 128 + h] * wk[h * 64 + lane]; } }
            }
#pragma unroll
            for (int k = 0; k < 4; ++k) { const int item = item0 + k * NGW; if (item < 2 * 8192) { const int kv = item >> 13, r = item & 8191, n = (r >> 2) & 255;
                bf16_t* out = (bf16_t*)(p.ws + (kv ? S_VCMP : S_KCMP)) + (size_t)r * 64; out[lane] = (n == 255) ? (bf16_t)0 : f2bf(s[k]); } }
        } else {
#pragma unroll
            for (int k = 0; k < 4; ++k) { const int item = item0 + k * NGW; if (item < 2 * 8192) { const int kv = item >> 13, r = item & 8191, n = (r >> 2) & 255; const float* wk = p.in[kv ? I_CV_W2 : I_CK_W2];
                float sk = 0.f;
#pragma unroll 8
                for (int h = 0; h < 128; ++h) sk += hs[k * 128 + h] * wk[h * 64 + lane];
                bf16_t* out = (bf16_t*)(p.ws + (kv ? S_VCMP : S_KCMP)) + (size_t)r * 64; out[lane] = (n == 255) ? (bf16_t)0 : f2bf(sk); } }
        }
    }
}
__device__ __forceinline__ void phase_mla_rowstats(const Params& p) {
    int tid_ = threadIdx.x; asm volatile("" : "+v"(tid_));
    const int lane = tid_ & 63, wave = tid_ >> 6;
    const int gw = blockIdx.x * NWAVES + wave, NGW = gridDim.x * NWAVES;
    bf16_t* DQ = (bf16_t*)(p.ws + S_DQ);
    const float* rc = (const float*)(p.ws + WS_ROPE_COS); const float* rs = (const float*)(p.ws + WS_ROPE_SIN);
    for (int row = gw; row < NTOK; row += NGW) {
        bf16_t* r = DQ + (size_t)row * MLA_DOWN_PAD;
        u32x2 v[4]; float sq = 0.f, skv = 0.f;
#pragma unroll
        for (int j = 0; j < 4; ++j) { v[j] = *(const u32x2*)(r + j * 256 + lane * 4); const float a = bf_lo(v[j].x), b = bf_hi(v[j].x), c = bf_lo(v[j].y), d = bf_hi(v[j].y); const float ss = (a * a + b * b) + (c * c + d * d); if (j < 3) sq += ss; else skv += ss; }
        sq = wave_sum_fast(sq); skv = wave_sum_fast(skv);
        const float rq = rsqrtf(sq * (1.f / 768.f) + RMS_EPS), rkv = rsqrtf(skv * (1.f / 256.f) + RMS_EPS);
#pragma unroll
        for (int j = 0; j < 4; ++j) { const float f = (j < 3) ? rq : rkv; u32x2 o; o.x = pk2(bf_lo(v[j].x) * f, bf_hi(v[j].x) * f); o.y = pk2(bf_lo(v[j].y) * f, bf_hi(v[j].y) * f); *(u32x2*)(r + j * 256 + lane * 4) = o; }
        if (lane < 16) { const int pos = row & 4095; const float x1 = bf2f(r[1024 + lane]), x2 = bf2f(r[1040 + lane]), c = rc[pos * 16 + lane], s = rs[pos * 16 + lane];
            bf16_t* kr = (bf16_t*)(p.ws + S_KROPE) + (size_t)row * 32; kr[lane] = f2bf(x1 * c - x2 * s); kr[16 + lane] = f2bf(x2 * c + x1 * s); }
    }
}

struct OnlineSt { float m[4], l[4], o[4][2]; };
__device__ __forceinline__ void nsa_attend_block(OnlineSt& st, const bf16_t* Kb, const bf16_t* Vb, int pos0, int t, const float (&slope)[4], LAS float* qs, LAS float* ps, int lane) {
    const int pos = pos0 + lane; const bool valid = pos <= t;
    const bf16_t* krow = Kb + (size_t)(valid ? pos : t) * 256;
    float acc[4] = {0.f, 0.f, 0.f, 0.f};
#pragma unroll 2
    for (int d8 = 0; d8 < 8; ++d8) { const u32x4 kv = *(const u32x4*)(krow + d8 * 8);
        const float kf[8] = {bf_lo(kv.x), bf_hi(kv.x), bf_lo(kv.y), bf_hi(kv.y), bf_lo(kv.z), bf_hi(kv.z), bf_lo(kv.w), bf_hi(kv.w)};
#pragma unroll
        for (int e = 0; e < 8; ++e) { const f32x4 qv = *(const LAS f32x4*)(qs + (d8 * 8 + e) * 4);
#pragma unroll
            for (int r = 0; r < 4; ++r) acc[r] += qv[r] * kf[e]; } }
    const float dist = (float)(t - pos);
    f32x4 pe;
#pragma unroll
    for (int r = 0; r < 4; ++r) {
        const float s = valid ? acc[r] - slope[r] * dist : -1e30f;
        const float mb = wave_max(s), mn = fmaxf(st.m[r], mb);
        const float alpha = __expf(st.m[r] - mn);
        const float e = valid ? __expf(s - mn) : 0.f;
        st.l[r] = st.l[r] * alpha + wave_sum(e); st.o[r][0] *= alpha; st.o[r][1] *= alpha; st.m[r] = mn; pe[r] = e;
    }
    LDS_FENCE();
    *(LAS f32x4*)(ps + lane * 4) = pe;
    LDS_FENCE();
    const int hf = lane >> 5, dp = lane & 31;
    const int nk = (t - pos0 + 1 < 64) ? t - pos0 + 1 : 64;
#pragma unroll 4
    for (int kk = hf; kk < nk; kk += 2) {
        const unsigned vv = *(const unsigned*)(Vb + (size_t)(pos0 + kk) * 256 + 2 * dp); const f32x4 pp = *(const LAS f32x4*)(ps + kk * 4);
        const float lo = bf_lo(vv), hi = bf_hi(vv);
#pragma unroll
        for (int r = 0; r < 4; ++r) { st.o[r][0] += pp[r] * lo; st.o[r][1] += pp[r] * hi; }
    }
}
__device__ __forceinline__ void phase_nsa_attn_ref(const Params& p, LAS unsigned char* lds) {
    int tid_ = threadIdx.x; asm volatile("" : "+v"(tid_));
    const int lane = tid_ & 63, wave = tid_ >> 6;
    const int gw = blockIdx.x * NWAVES + wave, NGW = gridDim.x * NWAVES;
    LAS float* qs = (LAS float*)(lds + wave * 6144);
    LAS float* pc = qs + 256;
    LAS float* ptot = pc + 1024;
    const bf16_t* Q = (const bf16_t*)(p.ws + S_Q); const bf16_t* KV6 = (const bf16_t*)(p.ws + S_KV6);
    const bf16_t* KS = KV6 + (size_t)2 * NTOK * 256; const bf16_t* VS = KV6 + (size_t)3 * NTOK * 256; const bf16_t* KW = KV6 + (size_t)4 * NTOK * 256; const bf16_t* VW = KV6 + (size_t)5 * NTOK * 256;
    const bf16_t* KC = (const bf16_t*)(p.ws + S_KCMP); const bf16_t* VC = (const bf16_t*)(p.ws + S_VCMP);
    const float* GATES = (const float*)(p.ws + S_GATES); bf16_t* AO = (bf16_t*)(p.ws + S_AO);
    const int hf = lane >> 5, dp = lane & 31;
    for (int item = gw; item < NTOK * 4; item += NGW) {
        const int g = item & 3, row = item >> 2, b = row >> 12, t = row & 4095;
        float slope[4];
#pragma unroll
        for (int r = 0; r < 4; ++r) slope[r] = exp2f(-0.5f * (float)(g * 4 + r + 1));
        LDS_FENCE();
        { f32x4 qv;
#pragma unroll
          for (int r = 0; r < 4; ++r) qv[r] = bf2f(Q[(size_t)row * 1024 + (g * 4 + r) * 64 + lane]) * 0.125f;
          *(LAS f32x4*)(qs + lane * 4) = qv; }
        LDS_FENCE();
        const int nv = (t >= 31) ? (((t - 31) >> 4) + 1 < 255 ? ((t - 31) >> 4) + 1 : 255) : 0;
        float mloc[4] = {-1e30f, -1e30f, -1e30f, -1e30f};
#pragma unroll 1
        for (int c = 0; c < 4; ++c) {
            const int i = 64 * c + lane;
            f32x4 sv = (f32x4){-1e30f, -1e30f, -1e30f, -1e30f};
            if (64 * c < nv) {
                const bf16_t* krow = KC + ((size_t)(b * 256 + i) * 4 + g) * 64;
                float acc[4] = {0.f, 0.f, 0.f, 0.f};
#pragma unroll 2
                for (int d8 = 0; d8 < 8; ++d8) { const u32x4 kv = *(const u32x4*)(krow + d8 * 8);
                    const float kf[8] = {bf_lo(kv.x), bf_hi(kv.x), bf_lo(kv.y), bf_hi(kv.y), bf_lo(kv.z), bf_hi(kv.z), bf_lo(kv.w), bf_hi(kv.w)};
#pragma unroll
                    for (int e = 0; e < 8; ++e) { const f32x4 qv = *(const LAS f32x4*)(qs + (d8 * 8 + e) * 4);
#pragma unroll
                        for (int r = 0; r < 4; ++r) acc[r] += qv[r] * kf[e]; } }
                const float dist = (float)(t - (16 * i + 31));
                if (i < nv) {
#pragma unroll
                    for (int r = 0; r < 4; ++r) { sv[r] = acc[r] - slope[r] * dist; mloc[r] = fmaxf(mloc[r], sv[r]); } }
            }
            *(LAS f32x4*)(pc + i * 4) = sv;
        }
        float ssum[4] = {0.f, 0.f, 0.f, 0.f};
#pragma unroll
        for (int r = 0; r < 4; ++r) mloc[r] = wave_max(mloc[r]);
        LDS_FENCE();
#pragma unroll 1
        for (int c = 0; c < 4; ++c) {
            const int i = 64 * c + lane; f32x4 sv = *(const LAS f32x4*)(pc + i * 4);
#pragma unroll
            for (int r = 0; r < 4; ++r) { sv[r] = (sv[r] > -1e29f) ? __expf(sv[r] - mloc[r]) : 0.f; ssum[r] += sv[r]; }
            *(LAS f32x4*)(pc + i * 4) = sv;
        }
#pragma unroll
        for (int r = 0; r < 4; ++r) { const float sm = wave_sum(ssum[r]); ssum[r] = (sm > 0.f) ? 1.f / sm : 0.f; }
        LDS_FENCE();
#pragma unroll 1
        for (int c = 0; c < 4; ++c) {
            const int i = 64 * c + lane; f32x4 sv = *(const LAS f32x4*)(pc + i * 4);
#pragma unroll
            for (int r = 0; r < 4; ++r) sv[r] *= ssum[r];
            *(LAS f32x4*)(pc + i * 4) = sv; ptot[i] = (sv[0] + sv[1]) + (sv[2] + sv[3]);
        }
        LDS_FENCE();
        const int j = lane, blk = t >> 6;
        const float imp = ptot[4 * j] + ptot[4 * j + 1] + ptot[4 * j + 2] + 0.5f * ptot[4 * j + 3] + (j > 0 ? 0.5f * ptot[4 * j - 1] : 0.f);
        const bool elig = j <= blk, forced = (j == 0) || (j == blk) || (j == blk - 1);
        const float val = elig ? imp + (forced ? 1e4f : 0.f) : -1e30f;
        int rank = 0;
#pragma unroll 8
        for (int k = 0; k < 64; ++k) { const float vk = __shfl(val, k); rank += (vk > val || (vk == val && k < j)) ? 1 : 0; }
        const unsigned long long selmask = __ballot(elig && rank < 16);
        float oc[4][2] = {{0.f, 0.f}, {0.f, 0.f}, {0.f, 0.f}, {0.f, 0.f}};
        for (int i = hf; i < nv; i += 2) {
            const unsigned vv = *(const unsigned*)(VC + ((size_t)(b * 256 + i) * 4 + g) * 64 + 2 * dp); const f32x4 pp = *(const LAS f32x4*)(pc + i * 4);
            const float lo = bf_lo(vv), hi = bf_hi(vv);
#pragma unroll
            for (int r = 0; r < 4; ++r) { oc[r][0] += pp[r] * lo; oc[r][1] += pp[r] * hi; }
        }
#pragma unroll
        for (int r = 0; r < 4; ++r) { oc[r][0] += __shfl_xor(oc[r][0], 32); oc[r][1] += __shfl_xor(oc[r][1], 32); }
        OnlineSt st;
#pragma unroll
        for (int r = 0; r < 4; ++r) { st.m[r] = -1e30f; st.l[r] = 0.f; st.o[r][0] = 0.f; st.o[r][1] = 0.f; }
        const bf16_t* ksb = KS + (size_t)b * SEQ * 256 + g * 64; const bf16_t* vsb = VS + (size_t)b * SEQ * 256 + g * 64;
        for (unsigned long long mm = selmask; mm; mm &= mm - 1) { const int jj = __builtin_ctzll(mm); nsa_attend_block(st, ksb, vsb, 64 * jj, t, slope, qs, pc, lane); }
        float os[4][2];
#pragma unroll
        for (int r = 0; r < 4; ++r) { const float il = 1.f / st.l[r]; os[r][0] = (st.o[r][0] + __shfl_xor(st.o[r][0], 32)) * il; os[r][1] = (st.o[r][1] + __shfl_xor(st.o[r][1], 32)) * il; }
#pragma unroll
        for (int r = 0; r < 4; ++r) { st.m[r] = -1e30f; st.l[r] = 0.f; st.o[r][0] = 0.f; st.o[r][1] = 0.f; }
        const bf16_t* kwb = KW + (size_t)b * SEQ * 256 + g * 64; const bf16_t* vwb = VW + (size_t)b * SEQ * 256 + g * 64;
        const int lo = (t - 511 > 0) ? t - 511 : 0;
        for (int p0 = lo; p0 <= t; p0 += 64) nsa_attend_block(st, kwb, vwb, p0, t, slope, qs, pc, lane);
        const float* gp = GATES + (size_t)row * 48 + g * 12;
#pragma unroll
        for (int r = 0; r < 4; ++r) {
            const float il = 1.f / st.l[r]; const float ow0 = (st.o[r][0] + __shfl_xor(st.o[r][0], 32)) * il, ow1 = (st.o[r][1] + __shfl_xor(st.o[r][1], 32)) * il;
            const float gc = gp[r * 3 + 0], gs = gp[r * 3 + 1], gwv = gp[r * 3 + 2];
            const float o0 = gc * oc[r][0] + gs * os[r][0] + gwv * ow0, o1 = gc * oc[r][1] + gs * os[r][1] + gwv * ow1;
            if (hf == 0) *(unsigned*)(AO + (size_t)row * 1024 + (g * 4 + r) * 64 + 2 * dp) = pk2(o0, o1);
        }
    }
}

__device__ __forceinline__ void phase_mla_attn_ref(const Params& p, LAS unsigned char* lds) {
    int tid_ = threadIdx.x; asm volatile("" : "+v"(tid_));
    const int lane = tid_ & 63, wave = tid_ >> 6;
    const int gw = blockIdx.x * NWAVES + wave, NGW = gridDim.x * NWAVES;
    LAS float* qs = (LAS float*)(lds + wave * 1024);
    LAS float* ps = qs + 128;
    const bf16_t* QF = (const bf16_t*)(p.ws + S_QF); const bf16_t* KN = (const bf16_t*)(p.ws + S_KNOPE); const bf16_t* KR = (const bf16_t*)(p.ws + S_KROPE); const bf16_t* V = (const bf16_t*)(p.ws + S_V);
    const float* rc = (const float*)(p.ws + WS_ROPE_COS); const float* rs = (const float*)(p.ws + WS_ROPE_SIN);
    bf16_t* AO = (bf16_t*)(p.ws + S_AO2);
    const float scale = 0.10206207261596577f;
    const int hf = lane >> 5, dp = lane & 31;
    for (int item = gw; item < NTOK * 16; item += NGW) {
        const int h = item & 15, row = item >> 4, b = row >> 12, t = row & 4095;
        const bf16_t* qrow = QF + (size_t)row * 1536 + h * 96; const float rq = scale;
        LDS_FENCE();
        qs[lane] = bf2f(qrow[lane]) * rq;
        if (lane < 16) { const float x1 = bf2f(qrow[64 + lane]), x2 = bf2f(qrow[80 + lane]), c = rc[t * 16 + lane], s = rs[t * 16 + lane]; qs[64 + lane] = (x1 * c - x2 * s) * rq; qs[80 + lane] = (x2 * c + x1 * s) * rq; }
        LDS_FENCE();
        float m = -1e30f, l = 0.f, o0 = 0.f, o1 = 0.f;
        for (int p0 = 0; p0 <= t; p0 += 64) {
            const int pos = p0 + lane; const bool valid = pos <= t;
            const int posc = valid ? pos : t;
            const bf16_t* kn = KN + ((size_t)(b * SEQ + posc)) * 1024 + h * 64; const bf16_t* kr = KR + ((size_t)(b * SEQ + posc)) * 32;
            float acc = 0.f;
#pragma unroll 4
            for (int d8 = 0; d8 < 12; ++d8) { const u32x4 kv = (d8 < 8) ? *(const u32x4*)(kn + d8 * 8) : *(const u32x4*)(kr + (d8 - 8) * 8);
                const f32x4 q0 = *(const LAS f32x4*)(qs + d8 * 8), q1 = *(const LAS f32x4*)(qs + d8 * 8 + 4);
                acc += q0.x * bf_lo(kv.x) + q0.y * bf_hi(kv.x) + q0.z * bf_lo(kv.y) + q0.w * bf_hi(kv.y) + q1.x * bf_lo(kv.z) + q1.y * bf_hi(kv.z) + q1.z * bf_lo(kv.w) + q1.w * bf_hi(kv.w); }
            const float s = valid ? acc : -1e30f;
            const float mn = fmaxf(m, wave_max(s)), alpha = __expf(m - mn), e = valid ? __expf(s - mn) : 0.f;
            l = l * alpha + wave_sum(e); o0 *= alpha; o1 *= alpha; m = mn;
            LDS_FENCE();
            ps[lane] = e;
            LDS_FENCE();
            const int nk = (t - p0 + 1 < 64) ? t - p0 + 1 : 64;
            for (int kk = hf; kk < nk; kk += 2) { const unsigned vv = *(const unsigned*)(V + ((size_t)(b * SEQ + p0 + kk)) * 1024 + h * 64 + 2 * dp); const float pp = ps[kk]; o0 += pp * bf_lo(vv); o1 += pp * bf_hi(vv); }
        }
        const float il = 1.f / l; o0 = (o0 + __shfl_xor(o0, 32)) * il; o1 = (o1 + __shfl_xor(o1, 32)) * il;
        if (hf == 0) *(unsigned*)(AO + (size_t)row * 1024 + h * 64 + 2 * dp) = pk2(o0, o1);
    }
}

namespace att {
typedef float f32x16 __attribute__((ext_vector_type(16)));
typedef short s16x4 __attribute__((ext_vector_type(4)));
constexpr int KSTR64 = 144, KSTR96 = 208;
constexpr int KBUF = 64 * KSTR96, VBUF = 8192;
constexpr int OFF_K = 0, OFF_V = 2 * KBUF, OFF_IMPM = OFF_V + 2 * VBUF, OFF_IMPS = OFF_IMPM + 8 * 8 * 64 * 4, OFF_SELB = OFF_IMPS + 8 * 8 * 72 * 4, OFF_UNION = OFF_SELB + 8 * 8 * 8, OFF_FIN = OFF_UNION + 16, LDS_END = OFF_FIN + 8 * 32 * 64 * 4;
static_assert(LDS_END <= 147456, "attention LDS map");
constexpr float LOG2E = 1.4426950408889634f;
__device__ __forceinline__ int crow(int r, int hi) { return (r & 3) + 8 * (r >> 2) + 4 * hi; }
__device__ __forceinline__ float xhalf(float v) { return __shfl_xor(v, 32); }
__device__ __forceinline__ float xmax(float v) { const auto rr = __builtin_amdgcn_permlane32_swap(__float_as_uint(v), __float_as_uint(v), false, false); return fmaxf(__uint_as_float(rr[0]), __uint_as_float(rr[1])); }
__device__ __forceinline__ float xsum(float v) { const auto rr = __builtin_amdgcn_permlane32_swap(__float_as_uint(v), __float_as_uint(v), false, false); return __uint_as_float(rr[0]) + __uint_as_float(rr[1]); }

struct TileRegs { u32x4 k0, k1, v; };
typedef const __attribute__((address_space(1))) char* gcptr;
__device__ __forceinline__ gcptr uni_ptr(const void* p) {
    const unsigned long long v = (unsigned long long)p; const unsigned lo = __builtin_amdgcn_readfirstlane((unsigned)v), hh = __builtin_amdgcn_readfirstlane((unsigned)(v >> 32));
    return (gcptr)(((unsigned long long)hh << 32) | lo);
}
template <bool MLA>
__device__ __forceinline__ void tile_load(TileRegs& R, const bf16_t* Kg, const bf16_t* KRg, const bf16_t* Vg, unsigned koff, unsigned voff, unsigned roff, int tid) {
    R.k0 = *(const __attribute__((address_space(1))) u32x4*)(uni_ptr(Kg) + koff);
    R.v = *(const __attribute__((address_space(1))) u32x4*)(uni_ptr(Vg) + voff);
    if (MLA) { if (tid < 256) R.k1 = *(const __attribute__((address_space(1))) u32x4*)(uni_ptr(KRg) + roff); }
}
template <bool MLA, int KSTR>
__device__ __forceinline__ void tile_store(const TileRegs& R, LAS unsigned char* Kb, LAS unsigned char* Vb, int tid) {
    const int key = tid >> 3, c = tid & 7;
    *(LAS u32x4*)(Kb + key * KSTR + c * 16) = R.k0;
    if (MLA) { if (tid < 256) *(LAS u32x4*)(Kb + (tid >> 2) * KSTR + 128 + (tid & 3) * 16) = R.k1; }
    *(LAS u32x4*)(Vb + (c >> 2) * 4096 + key * 64 + (c & 3) * 16) = R.v;
}
template <int NKS, int KSTR>
__device__ __forceinline__ void qk(f32x16& p0, f32x16& p1, const LAS unsigned char* Kb, const bf16x8 (&qf)[NKS], int lane) {
    const LAS unsigned char* kp = Kb + (lane & 31) * KSTR + (lane >> 5) * 16;
#pragma unroll
    for (int r = 0; r < 16; ++r) { p0[r] = 0.f; p1[r] = 0.f; }
#pragma unroll
    for (int ks = 0; ks < NKS; ++ks) {
        const bf16x8 a0 = *(const LAS bf16x8*)(kp + ks * 32), a1 = *(const LAS bf16x8*)(kp + 32 * KSTR + ks * 32);
        p0 = __builtin_amdgcn_mfma_f32_32x32x16_bf16(a0, qf[ks], p0, 0, 0, 0);
        p1 = __builtin_amdgcn_mfma_f32_32x32x16_bf16(a1, qf[ks], p1, 0, 0, 0);
    }
}
__device__ __forceinline__ s16x4 vtr(const LAS unsigned char* p) { return __builtin_bit_cast(s16x4, __builtin_amdgcn_ds_read_tr16_b64_v4i16((LAS s16x4*)p)); }
__device__ __forceinline__ void pv(f32x16& o0, f32x16& o1, const f32x16& p0, const f32x16& p1, const LAS unsigned char* Vb, int lane) {
    const int hi = lane >> 5;
    const LAS unsigned char* vp = Vb + ((lane >> 4) & 1) * 32 + (lane & 3) * 8 + (4 * hi + ((lane & 15) >> 2)) * 64;
#pragma unroll
    for (int S = 0; S < 4; ++S) {
        u32x4 pw;
#pragma unroll
        for (int jj = 0; jj < 4; ++jj) { const int r = 8 * (S & 1) + 2 * jj; pw[jj] = (S < 2) ? pk2(p0[r], p0[r + 1]) : pk2(p1[r], p1[r + 1]); }
        const bf16x8 pf = __builtin_bit_cast(bf16x8, pw);
#pragma unroll
        for (int dh = 0; dh < 2; ++dh) {
            const s16x4 lo = vtr(vp + dh * 4096 + S * 1024), hh = vtr(vp + dh * 4096 + S * 1024 + 512);
            const bf16x8 vf = (bf16x8){lo[0], lo[1], lo[2], lo[3], hh[0], hh[1], hh[2], hh[3]};
            if (dh == 0) o0 = __builtin_amdgcn_mfma_f32_32x32x16_bf16(vf, pf, o0, 0, 0, 0); else o1 = __builtin_amdgcn_mfma_f32_32x32x16_bf16(vf, pf, o1, 0, 0, 0);
        }
    }
}
template <int PS, bool ALIBI, bool CAUS, bool WLOW, bool ROWEN, bool SCALE = true>
__device__ __forceinline__ void transform(f32x16& p0, f32x16& p1, float c1, float c2, float tbf, bool en) {
    const float base = -c2 * tbf;
#pragma unroll
    for (int r = 0; r < 16; ++r) {
        const float k0 = (float)(PS * ((r & 3) + 8 * (r >> 2))), k1 = (float)(PS * (32 + (r & 3) + 8 * (r >> 2)));
        float s0, s1;
        if (ALIBI) { s0 = fmaf(p0[r], c1, fmaf(c2, k0, base)); s1 = fmaf(p1[r], c1, fmaf(c2, k1, base)); }
        else { s0 = SCALE ? p0[r] * c1 : p0[r]; s1 = SCALE ? p1[r] * c1 : p1[r]; }
        bool v0 = true, v1 = true;
        if (CAUS) { v0 = v0 && (k0 <= tbf); v1 = v1 && (k1 <= tbf); }
        if (WLOW) { v0 = v0 && (tbf - k0 < 512.f); v1 = v1 && (tbf - k1 < 512.f); }
        if (ROWEN) { v0 = v0 && en; v1 = v1 && en; }
        p0[r] = v0 ? s0 : -1e30f; p1[r] = v1 ? s1 : -1e30f;
    }
}
__device__ __forceinline__ float max3f(float a, float b, float c) { float r; asm("v_max3_f32 %0, %1, %2, %3" : "=v"(r) : "v"(a), "v"(b), "v"(c)); return r; }
__device__ __forceinline__ float tile_max(const f32x16& p0, const f32x16& p1) {
    float a = max3f(p0[0], p0[1], p1[0]), b = max3f(p0[2], p0[3], p1[1]); a = max3f(a, p1[2], p1[3]);
#pragma unroll
    for (int r = 4; r < 16; r += 4) { a = max3f(a, p0[r], p0[r + 1]); b = max3f(b, p0[r + 2], p0[r + 3]); a = max3f(a, p1[r], p1[r + 1]); b = max3f(b, p1[r + 2], p1[r + 3]); }
    a = max3f(a, b, a);
    return xmax(a);
}
__device__ __forceinline__ void softmax_pv(f32x16& p0, f32x16& p1, float& m, float& l, f32x16& o0, f32x16& o1, const LAS unsigned char* Vb, int lane, float sc = 1.f) {
    const float mt = fmaxf(tile_max(p0, p1) * sc, -1e30f);
    if (__any(mt > m + 8.f)) { const float mn = fmaxf(m, mt); const float alpha = __builtin_amdgcn_exp2f(m - mn); l *= alpha; o0 *= alpha; o1 *= alpha; m = mn; }
    const float nmu = -fmaxf(m, -1e20f);
    float s = 0.f;
#pragma unroll
    for (int r = 0; r < 16; ++r) { p0[r] = __builtin_amdgcn_exp2f(fmaf(p0[r], sc, nmu)); p1[r] = __builtin_amdgcn_exp2f(fmaf(p1[r], sc, nmu)); s += p0[r] + p1[r]; }
    l += s;
    pv(o0, o1, p0, p1, Vb, lane);
}
template <bool FIRST> __device__ __forceinline__ void fold(LAS float* fb, const f32x16& o0, const f32x16& o1, float sc, int lane) {
#pragma unroll
    for (int r = 0; r < 16; ++r) { const float a = o0[r] * sc, b = o1[r] * sc; if (FIRST) { fb[r * 64 + lane] = a; fb[(16 + r) * 64 + lane] = b; } else { fb[r * 64 + lane] += a; fb[(16 + r) * 64 + lane] += b; } }
}
__device__ __forceinline__ void store_o(bf16_t* dst  , const f32x16& f0, const f32x16& f1, int hi) {
#pragma unroll
    for (int dh = 0; dh < 2; ++dh)
#pragma unroll
        for (int a = 0; a < 4; ++a) { const f32x16& f = dh ? f1 : f0; u32x2 w; w.x = pk2(f[4 * a], f[4 * a + 1]); w.y = pk2(f[4 * a + 2], f[4 * a + 3]); *(u32x2*)(dst + 32 * dh + 8 * a + 4 * hi) = w; }
}
}

__device__ __forceinline__ void phase_nsa_attn(const Params& p, LAS unsigned char* lds) {
    using namespace att;
    const int tid0 = threadIdx.x, wave = __builtin_amdgcn_readfirstlane(tid0 >> 6);
    const bf16_t* Q = (const bf16_t*)(p.ws + S_Q); const bf16_t* KV6 = (const bf16_t*)(p.ws + S_KV6);
    const bf16_t* KS = KV6 + (size_t)2 * NTOK * 256; const bf16_t* VS = KV6 + (size_t)3 * NTOK * 256; const bf16_t* KW = KV6 + (size_t)4 * NTOK * 256; const bf16_t* VW = KV6 + (size_t)5 * NTOK * 256;
    const bf16_t* KC = (const bf16_t*)(p.ws + S_KCMP); const bf16_t* VC = (const bf16_t*)(p.ws + S_VCMP);
    const float* GATES = (const float*)(p.ws + S_GATES); bf16_t* AO = (bf16_t*)(p.ws + S_AO);
    LAS unsigned char* Kb0 = lds + OFF_K; LAS unsigned char* Vb0 = lds + OFF_V;
    LAS float* impM = (LAS float*)(lds + OFF_IMPM) + wave * 512; LAS float* impS = (LAS float*)(lds + OFF_IMPS) + wave * 576;
    LAS unsigned char* selb = lds + OFF_SELB + wave * 64; LAS unsigned long long* uni = (LAS unsigned long long*)(lds + OFF_UNION);
    const float c1 = 0.125f * LOG2E;
    TileRegs R; bool have = false;
#pragma unroll 1
    for (int vcu = blockIdx.x; vcu < 256; vcu += gridDim.x)
#pragma unroll 1
    for (int ui = 0; ui < 8; ++ui) {
        int tid = tid0; asm volatile("" : "+v"(tid));
        const int lane = tid & 63, q = lane & 31, hi = lane >> 5, tl = q & 7, rh = q >> 3;
        const unsigned koff = (unsigned)((tid >> 3) * 256 + (tid & 7) * 8) * 2u;
        const int pair = (gridDim.x == 256) ? ((vcu & 7) * 4 + (vcu >> 6)) : (vcu >> 3), kk = (gridDim.x == 256) ? ((vcu >> 3) & 7) : (vcu & 7), b = pair >> 2, g = pair & 3;
        const int tile = (ui >> 1) * 16 + ((ui & 1) ? 15 - kk : kk);
        const int q0 = tile * 64, t = q0 + 8 * wave + tl, head = 4 * g + rh;
        const size_t row = (size_t)b * SEQ + t;
        const float c2 = exp2f(-0.5f * (float)(head + 1)) * LOG2E;
        bf16x8 qf[4];
#pragma unroll
        for (int ks = 0; ks < 4; ++ks) qf[ks] = *(const bf16x8*)(Q + row * 1024 + head * 64 + ks * 16 + hi * 8);
        const float gc = GATES[row * 48 + head * 3 + 0], gs = GATES[row * 48 + head * 3 + 1], gwd = GATES[row * 48 + head * 3 + 2];
        LAS float* fb = (LAS float*)(lds + OFF_FIN) + wave * 2048;
        for (int i = lane; i < 512; i += 64) impM[i] = 0.f;
        for (int i = lane; i < 576; i += 64) impS[i] = 0.f;
        if (tid0 == 0) *uni = 0ull;
        const int nc = (4 * tile + 3 < 255) ? 4 * tile + 3 : 255, ntc = (nc + 63) >> 6;
        const bf16_t* kcb = KC + ((size_t)b * 256 * 4 + g) * 64; const bf16_t* vcb = VC + ((size_t)b * 256 * 4 + g) * 64;
        float m = -1e30f, l = 0.f;
#pragma unroll 1
        for (int pass = 0; pass < 2; ++pass) {
            f32x16 o0, o1;
#pragma unroll
            for (int r = 0; r < 16; ++r) { o0[r] = 0.f; o1[r] = 0.f; }
            const float ltc = xsum(l); const float invl = (ltc > 0.f) ? 1.f / ltc : 0.f;
            if (!have) tile_load<false>(R, kcb, nullptr, vcb, koff, koff, 0u, tid);
            have = false;
#pragma unroll 1
            for (int T = 0; T < ntc; ++T) {
                LAS unsigned char* Kb = Kb0 + (T & 1) * KBUF; LAS unsigned char* Vb = Vb0 + (T & 1) * VBUF;
                tile_store<false, KSTR64>(R, Kb, Vb, tid);
                __syncthreads();
                if (T + 1 < ntc) tile_load<false>(R, kcb + (size_t)(T + 1) * 64 * 256, nullptr, vcb + (size_t)(T + 1) * 64 * 256, koff, koff, 0u, tid);
                else if (pass == 0) { tile_load<false>(R, kcb, nullptr, vcb, koff, koff, 0u, tid); have = true; }
                else { tile_load<false>(R, KS + ((size_t)b * SEQ) * 256 + g * 64 + (size_t)tile * 64 * 256, nullptr, VS + ((size_t)b * SEQ) * 256 + g * 64 + (size_t)tile * 64 * 256, koff, koff, 0u, tid); have = true; }
                f32x16 p0, p1;
                qk<4, KSTR64>(p0, p1, Kb, qf, lane);
                const float tbf = (float)(t - (16 * 64 * T + 31) - 64 * hi);
                transform<16, true, true, false, false>(p0, p1, c1, c2, tbf, true);
                if (pass == 0) {
                    const float mn = fmaxf(m, tile_max(p0, p1)); const float alpha = __builtin_amdgcn_exp2f(m - mn); const float mu = fmaxf(mn, -1e20f);
                    float s = 0.f;
#pragma unroll
                    for (int r = 0; r < 16; ++r) s += __builtin_amdgcn_exp2f(p0[r] - mu) + __builtin_amdgcn_exp2f(p1[r] - mu);
                    l = l * alpha + s; m = mn;
                } else {
                    const float mu = fmaxf(m, -1e20f);
#pragma unroll
                    for (int r = 0; r < 16; ++r) { p0[r] = __builtin_amdgcn_exp2f(p0[r] - mu); p1[r] = __builtin_amdgcn_exp2f(p1[r] - mu); }
#pragma unroll
                    for (int kbk = 0; kbk < 2; ++kbk)
#pragma unroll
                        for (int a = 0; a < 4; ++a) {
                            const f32x16& pp = kbk ? p1 : p0;
                            float mainv = (pp[4 * a] + pp[4 * a + 1] + pp[4 * a + 2] + 0.5f * pp[4 * a + 3]) * invl, spill = 0.5f * pp[4 * a + 3] * invl;
                            mainv += __shfl_xor(mainv, 8); mainv += __shfl_xor(mainv, 16); spill += __shfl_xor(spill, 8); spill += __shfl_xor(spill, 16);
                            const int jb = 16 * T + 8 * kbk + 2 * a + hi;
                            if (rh == 0) { impM[tl * 64 + jb] = mainv; impS[tl * 72 + jb + 1] = spill; }
                            __builtin_amdgcn_sched_barrier(0);
                        }
                    pv(o0, o1, p0, p1, Vb, lane);
                }
            }
            if (pass == 1) fold<true>(fb, o0, o1, gc * invl, lane);
            __syncthreads();
        }
        const int blk = tile;
        unsigned long long mymask;
        if (blk < 16) { mymask = (2ull << blk) - 1ull; }
        else {
            LDS_FENCE();
            const int stl = lane >> 3, sub = lane & 7;
            float mv[8]; int rk[8];
#pragma unroll
            for (int i = 0; i < 8; ++i) { const int j = sub * 8 + i; mv[i] = impM[stl * 64 + j] + impS[stl * 72 + j]; rk[i] = 0; }
#pragma unroll 1
            for (int j2 = 1; j2 < blk - 1; ++j2) {
                const float v2 = impM[stl * 64 + j2] + impS[stl * 72 + j2];
#pragma unroll
                for (int i = 0; i < 8; ++i) { const int j = sub * 8 + i; rk[i] += (v2 > mv[i] || (v2 == mv[i] && j2 < j)) ? 1 : 0; }
            }
            unsigned bits = 0;
#pragma unroll
            for (int i = 0; i < 8; ++i) { const int j = sub * 8 + i; const bool forced = (j == 0) || (j == blk) || (j == blk - 1); const bool sel = (j <= blk) && (forced || rk[i] < 13); bits |= sel ? (1u << i) : 0u; }
            selb[stl * 8 + sub] = (unsigned char)bits;
            LDS_FENCE();
            mymask = *(const LAS unsigned long long*)(selb + tl * 8);
        }
        { unsigned long long um = mymask;
#pragma unroll
          for (int o = 1; o < 8; o <<= 1) { const unsigned lo = __shfl_xor((unsigned)um, o), hh = __shfl_xor((unsigned)(um >> 32), o); um |= ((unsigned long long)hh << 32) | lo; }
          if (lane == 0) atomicOr((unsigned long long*)uni, um); }
        __syncthreads();
        const unsigned long long umask = *uni;
        {
            f32x16 o0, o1;
#pragma unroll
            for (int r = 0; r < 16; ++r) { o0[r] = 0.f; o1[r] = 0.f; }
            m = -1e30f; l = 0.f;
            const bf16_t* kb_ = KS + ((size_t)b * SEQ) * 256 + g * 64; const bf16_t* vb_ = VS + ((size_t)b * SEQ) * 256 + g * 64;
            unsigned long long rem = umask; int it = 0;
            int j = 63 - __builtin_clzll(rem); rem &= ~(1ull << j);
            if (!have) tile_load<false>(R, kb_ + (size_t)j * 64 * 256, nullptr, vb_ + (size_t)j * 64 * 256, koff, koff, 0u, tid);
            have = false;
#pragma unroll 1
            for (;;) {
                LAS unsigned char* Kb = Kb0 + (it & 1) * KBUF; LAS unsigned char* Vb = Vb0 + (it & 1) * VBUF;
                tile_store<false, KSTR64>(R, Kb, Vb, tid);
                __syncthreads();
                const int jn = rem ? 63 - __builtin_clzll(rem) : -1;
                if (jn >= 0) { rem &= ~(1ull << jn); tile_load<false>(R, kb_ + (size_t)jn * 64 * 256, nullptr, vb_ + (size_t)jn * 64 * 256, koff, koff, 0u, tid); }
                else { tile_load<false>(R, KW + ((size_t)b * SEQ) * 256 + g * 64 + (size_t)blk * 64 * 256, nullptr, VW + ((size_t)b * SEQ) * 256 + g * 64 + (size_t)blk * 64 * 256, koff, koff, 0u, tid); have = true; }
                const bool en = (mymask >> j) & 1ull;
                if (__any(en)) {
                    f32x16 p0, p1;
                    qk<4, KSTR64>(p0, p1, Kb, qf, lane);
                    const float tbf = (float)(t - 64 * j - 4 * hi);
                    if (j == blk) transform<1, true, true, false, true>(p0, p1, c1, c2, tbf, en); else transform<1, true, false, false, true>(p0, p1, c1, c2, tbf, en);
                    softmax_pv(p0, p1, m, l, o0, o1, Vb, lane);
                }
                if (jn < 0) break;
                j = jn; ++it;
            }
            const float lt = xsum(l);
            fold<false>(fb, o0, o1, (lt > 0.f) ? gs / lt : 0.f, lane);
            __syncthreads();
        }
        {
            f32x16 o0, o1;
#pragma unroll
            for (int r = 0; r < 16; ++r) { o0[r] = 0.f; o1[r] = 0.f; }
            m = -1e30f; l = 0.f;
            const bf16_t* kb_ = KW + ((size_t)b * SEQ) * 256 + g * 64; const bf16_t* vb_ = VW + ((size_t)b * SEQ) * 256 + g * 64;
            const int jlo = (blk - 8 > 0) ? blk - 8 : 0;
            if (!have) tile_load<false>(R, kb_ + (size_t)blk * 64 * 256, nullptr, vb_ + (size_t)blk * 64 * 256, koff, koff, 0u, tid);
            have = false;
#pragma unroll 1
            for (int j = blk, it = 0; j >= jlo; --j, ++it) {
                LAS unsigned char* Kb = Kb0 + (it & 1) * KBUF; LAS unsigned char* Vb = Vb0 + (it & 1) * VBUF;
                tile_store<false, KSTR64>(R, Kb, Vb, tid);
                __syncthreads();
                if (j > jlo) tile_load<false>(R, kb_ + (size_t)(j - 1) * 64 * 256, nullptr, vb_ + (size_t)(j - 1) * 64 * 256, koff, koff, 0u, tid);
                else if (ui < 7) { tile_load<false>(R, kcb, nullptr, vcb, koff, koff, 0u, tid); have = true; }
                f32x16 p0, p1;
                qk<4, KSTR64>(p0, p1, Kb, qf, lane);
                const float tbf = (float)(t - 64 * j - 4 * hi);
                if (j == blk) transform<1, true, true, false, false>(p0, p1, c1, c2, tbf, true);
                else if (j == blk - 8) transform<1, true, false, true, false>(p0, p1, c1, c2, tbf, true);
                else transform<1, true, false, false, false>(p0, p1, c1, c2, tbf, true);
                softmax_pv(p0, p1, m, l, o0, o1, Vb, lane);
            }
            const float lt = xsum(l);
            const float scw = (lt > 0.f) ? gwd / lt : 0.f;
#pragma unroll
            for (int r = 0; r < 16; ++r) { o0[r] = o0[r] * scw + fb[r * 64 + lane]; o1[r] = o1[r] * scw + fb[(16 + r) * 64 + lane]; }
            store_o(AO + row * 1024 + head * 64, o0, o1, hi);
            __syncthreads();
        }
    }
}

template <int VAR>
__device__ __forceinline__ void phase_mla_attn(const Params& p, LAS unsigned char* lds) {
    using namespace att;
    const int tid0 = threadIdx.x, wave = __builtin_amdgcn_readfirstlane(tid0 >> 6);
    const bf16_t* QF = (const bf16_t*)(p.ws + S_QF); const bf16_t* KN = (const bf16_t*)(p.ws + S_KNOPE); const bf16_t* KR = (const bf16_t*)(p.ws + S_KROPE); const bf16_t* V = (const bf16_t*)(p.ws + S_V);
    const float* rc = (const float*)(p.ws + WS_ROPE_COS); const float* rs = (const float*)(p.ws + WS_ROPE_SIN);
    bf16_t* AO = (bf16_t*)(p.ws + S_AO2);
    LAS unsigned char* Kb0 = lds + OFF_K; LAS unsigned char* Vb0 = lds + OFF_V;
    const float c1 = 0.10206207261596577f * LOG2E;
    TileRegs R; bool have_tile0 = false;
#pragma unroll 1
    for (int vcu = blockIdx.x; vcu < 256; vcu += gridDim.x)
#pragma unroll 1
    for (int ui = 0; ui < 8; ++ui) {
        int tid = tid0; asm volatile("" : "+v"(tid));
        const int lane = tid & 63, q = lane & 31, hi = lane >> 5;
        const unsigned koff = (unsigned)((tid >> 3) * 1024 + (tid & 7) * 8) * 2u, roff = (unsigned)((tid >> 2) * 32 + (tid & 3) * 8) * 2u;
        const int bh = vcu >> 1, b = bh >> 4, h = bh & 15, par = vcu & 1;
        const int qb = (ui & 1) ? 15 - (ui - 1) - par : ui + par;
        const int t = 256 * qb + 32 * wave + q; const size_t row = (size_t)b * SEQ + t;
        bf16x8 qf[6];
        { const bf16_t* qrow = QF + row * 1536 + h * 96;
#pragma unroll
          for (int ks = 0; ks < 4; ++ks) qf[ks] = *(const bf16x8*)(qrow + ks * 16 + hi * 8);
          const u32x4 x1 = *(const u32x4*)(qrow + 64 + hi * 8), x2 = *(const u32x4*)(qrow + 80 + hi * 8);
          const f32x4 ca = *(const f32x4*)(rc + t * 16 + hi * 8), cb = *(const f32x4*)(rc + t * 16 + hi * 8 + 4), sa = *(const f32x4*)(rs + t * 16 + hi * 8), sb = *(const f32x4*)(rs + t * 16 + hi * 8 + 4);
          const float a1[8] = {bf_lo(x1.x), bf_hi(x1.x), bf_lo(x1.y), bf_hi(x1.y), bf_lo(x1.z), bf_hi(x1.z), bf_lo(x1.w), bf_hi(x1.w)};
          const float a2[8] = {bf_lo(x2.x), bf_hi(x2.x), bf_lo(x2.y), bf_hi(x2.y), bf_lo(x2.z), bf_hi(x2.z), bf_lo(x2.w), bf_hi(x2.w)};
          const float cc[8] = {ca.x, ca.y, ca.z, ca.w, cb.x, cb.y, cb.z, cb.w}, ss[8] = {sa.x, sa.y, sa.z, sa.w, sb.x, sb.y, sb.z, sb.w};
          u32x4 w1, w2;
#pragma unroll
          for (int jj = 0; jj < 4; ++jj) { const int e = 2 * jj;
              w1[jj] = pk2(a1[e] * cc[e] - a2[e] * ss[e], a1[e + 1] * cc[e + 1] - a2[e + 1] * ss[e + 1]);
              w2[jj] = pk2(a2[e] * cc[e] + a1[e] * ss[e], a2[e + 1] * cc[e + 1] + a1[e + 1] * ss[e + 1]); }
          qf[4] = __builtin_bit_cast(bf16x8, w1); qf[5] = __builtin_bit_cast(bf16x8, w2); }
        f32x16 o0, o1;
#pragma unroll
        for (int r = 0; r < 16; ++r) { o0[r] = 0.f; o1[r] = 0.f; }
        float m = -1e30f, l = 0.f;
        const bf16_t* knb = KN + ((size_t)b * SEQ) * 1024 + h * 64; const bf16_t* krb = KR + ((size_t)b * SEQ) * 32; const bf16_t* vb_ = V + ((size_t)b * SEQ) * 1024 + h * 64;
        const int nt = 4 * qb + 4; const int tmin = 256 * qb + 32 * wave;
        if (!have_tile0) tile_load<true>(R, knb, krb, vb_, koff, koff, roff, tid);
        have_tile0 = false;
#pragma unroll 1
        for (int j = 0; j < nt; ++j) {
            LAS unsigned char* Kb = Kb0 + (j & 1) * KBUF; LAS unsigned char* Vb = Vb0 + (j & 1) * VBUF;
            tile_store<true, KSTR96>(R, Kb, Vb, tid);
            __syncthreads();
            if (j + 1 < nt) tile_load<true>(R, knb + (size_t)(j + 1) * 64 * 1024, krb + (size_t)(j + 1) * 64 * 32, vb_ + (size_t)(j + 1) * 64 * 1024, koff, koff, roff, tid);
            else if (ui < 7) {
                tile_load<true>(R, knb, krb, vb_, koff, koff, roff, tid); have_tile0 = true; }
            if (64 * j <= tmin + 31) {
                f32x16 p0, p1;
                if (VAR != 3) qk<6, KSTR96>(p0, p1, Kb, qf, lane); else {
#pragma unroll
                    for (int r = 0; r < 16; ++r) { p0[r] = (float)(r + j); p1[r] = (float)(r - j); } }
                const float tbf = (float)(t - 64 * j - 4 * hi);
                if (VAR == 1) {
                    l += p0[0] + p1[15]; pv(o0, o1, p0, p1, Vb, lane);
                } else if (VAR == 2) {
                    if (64 * j + 63 > tmin) transform<1, false, true, false, false>(p0, p1, c1, 0.f, tbf, true); else transform<1, false, false, false, false>(p0, p1, c1, 0.f, tbf, true);
                    const float mn = fmaxf(m, tile_max(p0, p1)); const float mu = fmaxf(mn, -1e20f); float sacc = 0.f;
#pragma unroll
                    for (int r = 0; r < 16; ++r) { p0[r] = __builtin_amdgcn_exp2f(p0[r] - mu); p1[r] = __builtin_amdgcn_exp2f(p1[r] - mu); sacc += p0[r] + p1[r]; }
                    l += sacc; m = mn; o0[0] += pk2(p0[0], p0[1]) * 1e-30f; o1[3] += pk2(p1[2], p1[5]) * 1e-30f;
                } else {
                if (64 * j + 63 > tmin) transform<1, false, true, false, false, false>(p0, p1, c1, 0.f, tbf, true);
                softmax_pv(p0, p1, m, l, o0, o1, Vb, lane, c1);
                }
            }
        }
        const float lt = xsum(l); const float il = 1.f / lt;
        o0 *= il; o1 *= il;
        store_o(AO + row * 1024 + h * 64, o0, o1, hi);
        __syncthreads();
    }
}

__device__ __forceinline__ float pack_idx(float v, unsigned bits, unsigned mask) { return __uint_as_float((__float_as_uint(v) & ~mask) | bits); }
__device__ __forceinline__ void phase_peer_route_ref(const Params& p, LAS unsigned char* lds, int layer, const bf16_t* QP, int* EIDX, float* GW) {
    int tid_ = threadIdx.x; asm volatile("" : "+v"(tid_));
    const int lane = tid_ & 63, wave = tid_ >> 6;
    const int gw = blockIdx.x * NWAVES + wave, NGW = gridDim.x * NWAVES;
    LAS float* qs = (LAS float*)(lds + wave * 1024);
    const bf16_t* SK = (const bf16_t*)(p.ws + WS_SUBK) + (size_t)layer * 8 * 2 * 128 * 128;
    for (int item = gw; item < NTOK * 8; item += NGW) {
        const int h = item & 7, t = item >> 3;
        LDS_FENCE();
        { const u32x2 qv = *(const u32x2*)(QP + (size_t)t * 2048 + h * 256 + lane * 4); *(LAS f32x4*)(qs + lane * 4) = (f32x4){bf_lo(qv.x), bf_hi(qv.x), bf_lo(qv.y), bf_hi(qv.y)}; }
        LDS_FENCE();
        float sv[2];
#pragma unroll
        for (int c = 0; c < 2; ++c) {
            float v[2];
#pragma unroll
            for (int kk = 0; kk < 2; ++kk) {
                const int key = lane + 64 * kk; const bf16_t* krow = SK + ((size_t)(h * 2 + c) * 128 + key) * 128;
                float acc = 0.f;
#pragma unroll 4
                for (int d8 = 0; d8 < 16; ++d8) { const u32x4 kv = *(const u32x4*)(krow + d8 * 8); const f32x4 q0 = *(const LAS f32x4*)(qs + c * 128 + d8 * 8), q1 = *(const LAS f32x4*)(qs + c * 128 + d8 * 8 + 4);
                    acc += q0.x * bf_lo(kv.x) + q0.y * bf_hi(kv.x) + q0.z * bf_lo(kv.y) + q0.w * bf_hi(kv.y) + q1.x * bf_lo(kv.z) + q1.y * bf_hi(kv.z) + q1.z * bf_lo(kv.w) + q1.w * bf_hi(kv.w); }
                v[kk] = pack_idx(acc, 127u - (unsigned)key, 127u);
            }
            float mine = 0.f;
#pragma unroll 1
            for (int n = 0; n < 16; ++n) { const float w = wave_max(fmaxf(v[0], v[1])); if (v[0] == w) v[0] = -INFINITY; if (v[1] == w) v[1] = -INFINITY; if (lane == n) mine = w; }
            sv[c] = mine;
        }
        const int a = lane & 15, bq = lane >> 4;
        const float s0 = __shfl(sv[0], a);
        float cv[4];
#pragma unroll
        for (int i = 0; i < 4; ++i) { const float s1 = __shfl(sv[1], 4 * bq + i); cv[i] = pack_idx(s0 + s1, 255u - (unsigned)(a * 16 + 4 * bq + i), 255u); }
        float cs = 0.f;
#pragma unroll 1
        for (int n = 0; n < 16; ++n) { const float w = wave_max(fmaxf(fmaxf(cv[0], cv[1]), fmaxf(cv[2], cv[3])));
#pragma unroll
            for (int i = 0; i < 4; ++i) if (cv[i] == w) cv[i] = -INFINITY;
            if (lane == n) cs = w; }
        const unsigned flat = 255u - (__float_as_uint(cs) & 255u);
        const int wa = (int)(flat >> 4) & 15, wb = (int)flat & 15;
        const unsigned i0 = 127u - (__float_as_uint(__shfl(sv[0], wa)) & 127u), i1 = 127u - (__float_as_uint(__shfl(sv[1], wb)) & 127u);
        const float mx = __shfl(cs, 0);
        const float ex = (lane < 16) ? __expf(cs - mx) : 0.f;
        const float sum = wave_sum(ex);
        if (lane < 16) { EIDX[(size_t)t * 128 + h * 16 + lane] = (int)(i0 * 128u + i1); GW[(size_t)t * 128 + h * 16 + lane] = ex / sum; }
    }
}

namespace rt {
typedef float f32x16 __attribute__((ext_vector_type(16)));
constexpr int SKSTR = 272;
constexpr int OFF_SK = 0, OFF_IDX = 2 * 128 * SKSTR, LDS_END = OFF_IDX + 8 * 64 * 32;
__device__ __forceinline__ void ce_desc(float& a, float& b) { const float hi = fmaxf(a, b), lo = fminf(a, b); a = hi; b = lo; }
__device__ __forceinline__ void sort16_desc(float (&v)[16]) {
    ce_desc(v[0], v[13]); ce_desc(v[1], v[12]); ce_desc(v[2], v[15]); ce_desc(v[3], v[14]); ce_desc(v[4], v[8]); ce_desc(v[5], v[6]); ce_desc(v[7], v[11]); ce_desc(v[9], v[10]);
    ce_desc(v[0], v[5]); ce_desc(v[1], v[7]); ce_desc(v[2], v[9]); ce_desc(v[3], v[4]); ce_desc(v[6], v[13]); ce_desc(v[8], v[14]); ce_desc(v[10], v[15]); ce_desc(v[11], v[12]);
    ce_desc(v[0], v[1]); ce_desc(v[2], v[3]); ce_desc(v[4], v[5]); ce_desc(v[6], v[8]); ce_desc(v[7], v[9]); ce_desc(v[10], v[11]); ce_desc(v[12], v[13]); ce_desc(v[14], v[15]);
    ce_desc(v[0], v[2]); ce_desc(v[1], v[3]); ce_desc(v[4], v[10]); ce_desc(v[5], v[11]); ce_desc(v[6], v[7]); ce_desc(v[8], v[9]); ce_desc(v[12], v[14]); ce_desc(v[13], v[15]);
    ce_desc(v[1], v[2]); ce_desc(v[3], v[12]); ce_desc(v[4], v[6]); ce_desc(v[5], v[7]); ce_desc(v[8], v[10]); ce_desc(v[9], v[11]); ce_desc(v[13], v[14]);
    ce_desc(v[1], v[4]); ce_desc(v[2], v[6]); ce_desc(v[5], v[8]); ce_desc(v[7], v[10]); ce_desc(v[9], v[13]); ce_desc(v[11], v[14]);
    ce_desc(v[2], v[4]); ce_desc(v[3], v[6]); ce_desc(v[9], v[12]); ce_desc(v[11], v[13]);
    ce_desc(v[3], v[5]); ce_desc(v[6], v[8]); ce_desc(v[7], v[9]); ce_desc(v[10], v[12]);
    ce_desc(v[3], v[4]); ce_desc(v[5], v[6]); ce_desc(v[7], v[8]); ce_desc(v[9], v[10]); ce_desc(v[11], v[12]);
    ce_desc(v[6], v[7]); ce_desc(v[8], v[9]);
}
__device__ __forceinline__ void merge16_desc(float (&v)[16]) {
#pragma unroll
    for (int j = 8; j > 0; j >>= 1)
#pragma unroll
        for (int i = 0; i < 16; ++i) { const int l = i ^ j; if (l > i) ce_desc(v[i], v[l]); }
}
__device__ __forceinline__ void top16_merge(float (&a)[16], const float (&b)[16]) {
#pragma unroll
    for (int i = 0; i < 16; ++i) a[i] = fmaxf(a[i], b[15 - i]);
    merge16_desc(a);
}
}
__device__ __forceinline__ void phase_peer_route(const Params& p, LAS unsigned char* lds, int layer, const bf16_t* QP, int* EIDX, float* GW) {
    using namespace rt;
    int tid = threadIdx.x; asm volatile("" : "+v"(tid));
    const int lane = tid & 63, wave = __builtin_amdgcn_readfirstlane(tid >> 6), tok = lane & 31, hi = lane >> 5;
    const bf16_t* SK = (const bf16_t*)(p.ws + WS_SUBK) + (size_t)layer * 8 * 2 * 128 * 128;
    LAS unsigned char* idxs = lds + OFF_IDX + wave * 2048 + lane * 32;
    const int nbpi = NTOK / 1024;
    for (int bi = blockIdx.x; bi < 8 * nbpi; bi += gridDim.x) {
        const int h = bi & 7, tb = bi >> 3;
        __syncthreads();
        for (int i = tid; i < 256 * 16; i += NTHREADS) { const int r = i >> 4, c = i & 15; *(LAS u32x4*)(lds + OFF_SK + r * SKSTR + c * 16) = *(const u32x4*)(SK + ((size_t)h * 256 + r) * 128 + c * 8); }
        __syncthreads();
        bf16x8 qn[8];
        { const int t0 = tb * 1024 + wave * 128 + tok;
#pragma unroll
          for (int ks = 0; ks < 8; ++ks) qn[ks] = *(const bf16x8*)(QP + (size_t)t0 * 2048 + h * 256 + ks * 16 + hi * 8); }
#pragma unroll 1
        for (int gi = 0; gi < 4; ++gi) {
            const int t = tb * 1024 + wave * 128 + gi * 32 + tok;
            float top[2][16];
#pragma unroll
            for (int c = 0; c < 2; ++c) {
                bf16x8 qf[8];
#pragma unroll
                for (int ks = 0; ks < 8; ++ks) qf[ks] = qn[ks];
                { const int tnx = (c == 0) ? t : t + 32; const int cn = c ^ 1;
                  if (c == 0 || gi < 3) {
#pragma unroll
                      for (int ks = 0; ks < 8; ++ks) qn[ks] = *(const bf16x8*)(QP + (size_t)tnx * 2048 + h * 256 + cn * 128 + ks * 16 + hi * 8); } }
                float cur[16];
#pragma unroll
                for (int kb = 0; kb < 4; ++kb) {
                    f32x16 acc;
#pragma unroll
                    for (int r = 0; r < 16; ++r) acc[r] = 0.f;
                    const LAS unsigned char* kp = lds + OFF_SK + (c * 128 + kb * 32 + tok) * SKSTR + hi * 16;
#pragma unroll
                    for (int ks = 0; ks < 8; ++ks) acc = __builtin_amdgcn_mfma_f32_32x32x16_bf16(*(const LAS bf16x8*)(kp + ks * 32), qf[ks], acc, 0, 0, 0);
                    float v[16];
#pragma unroll
                    for (int r = 0; r < 16; ++r) { const unsigned key = (unsigned)(32 * kb + (r & 3) + 8 * (r >> 2)) + 4u * (unsigned)hi; v[r] = __uint_as_float((__float_as_uint(acc[r]) & ~127u) | (127u - key)); }
                    sort16_desc(v);
                    if (kb == 0) {
#pragma unroll
                        for (int r = 0; r < 16; ++r) cur[r] = v[r];
                    } else top16_merge(cur, v);
                }
                float oth[16];
#pragma unroll
                for (int r = 0; r < 16; ++r) oth[r] = __shfl_xor(cur[r], 32);
                top16_merge(cur, oth);
#pragma unroll
                for (int r = 0; r < 16; ++r) top[c][r] = cur[r];
            }
            { u32x4 w0, w1;
#pragma unroll
              for (int c = 0; c < 2; ++c) {
                  u32x4 w;
#pragma unroll
                  for (int jj = 0; jj < 4; ++jj) { unsigned x = 0;
#pragma unroll
                      for (int e = 0; e < 4; ++e) x |= (127u - (__float_as_uint(top[c][4 * jj + e]) & 127u)) << (8 * e);
                      w[jj] = x; }
                  if (c == 0) w0 = w; else w1 = w; }
              *(LAS u32x4*)idxs = w0; *(LAS u32x4*)(idxs + 16) = w1; }
#define CAND(a, b) __uint_as_float((__float_as_uint(top[0][a] + top[1][b]) & ~255u) | (255u - (unsigned)(16 * (a) + (b))))
            float A[16], B[16], X[16], Y[16];
#pragma unroll
            for (int b = 0; b < 16; ++b) A[b] = CAND(0, b);
#pragma unroll
            for (int b = 0; b < 8; ++b) B[b] = CAND(1, b);
#pragma unroll
            for (int b = 8; b < 16; ++b) B[b] = -INFINITY;
            top16_merge(A, B);
            X[0] = CAND(2, 0); X[1] = CAND(2, 1); X[2] = CAND(2, 2); X[3] = CAND(2, 3); X[4] = CAND(2, 4); X[5] = CAND(3, 0); X[6] = CAND(3, 1); X[7] = CAND(3, 2); X[8] = CAND(3, 3);
            X[9] = CAND(4, 0); X[10] = CAND(4, 1); X[11] = CAND(4, 2); X[12] = CAND(5, 0); X[13] = CAND(5, 1); X[14] = CAND(6, 0); X[15] = CAND(6, 1);
            { const float L[9] = {CAND(7, 0), CAND(8, 0), CAND(9, 0), CAND(10, 0), CAND(11, 0), CAND(12, 0), CAND(13, 0), CAND(14, 0), CAND(15, 0)}; const float e = CAND(7, 1);
              Y[0] = L[0];
#pragma unroll
              for (int i = 1; i < 9; ++i) Y[i] = fmaxf(L[i], fminf(L[i - 1], e));
              Y[9] = fminf(L[8], e); }
#pragma unroll
            for (int i = 10; i < 16; ++i) Y[i] = -INFINITY;
#undef CAND
            sort16_desc(X);
            top16_merge(A, X); top16_merge(A, Y);
            float ex[16], sum = 0.f;
#pragma unroll
            for (int n = 0; n < 16; ++n) { ex[n] = __expf(A[n] - A[0]); sum += ex[n]; }
            const float inv = 1.f / sum;
            LDS_FENCE();
            if (hi == 0) {
                int* ep = EIDX + (size_t)t * 128 + h * 16;
#pragma unroll
                for (int jj = 0; jj < 4; ++jj) { u32x4 w;
#pragma unroll
                    for (int e = 0; e < 4; ++e) { const unsigned flat = 255u - (__float_as_uint(A[4 * jj + e]) & 255u); const unsigned i0 = idxs[flat >> 4], i1 = idxs[16 + (flat & 15u)]; w[e] = i0 * 128u + i1; }
                    *(u32x4*)(ep + 4 * jj) = w; }
            } else {
                float* gp = GW + (size_t)t * 128 + h * 16;
#pragma unroll
                for (int jj = 0; jj < 4; ++jj) *(f32x4*)(gp + 4 * jj) = (f32x4){ex[4 * jj] * inv, ex[4 * jj + 1] * inv, ex[4 * jj + 2] * inv, ex[4 * jj + 3] * inv};
            }
            LDS_FENCE();
        }
    }
}

__device__ __forceinline__ float dot2bf(unsigned a, unsigned b, float acc) {
    float r; asm("v_dot2c_f32_bf16 %0, %1, %2" : "=v"(r) : "v"(a), "v"(b), "0"(acc)); return r;
}
__device__ __forceinline__ float dot8(const u32x4& a, const u32x4& b, float acc) {
    acc = dot2bf(a.x, b.x, acc); acc = dot2bf(a.y, b.y, acc); acc = dot2bf(a.z, b.z, acc); acc = dot2bf(a.w, b.w, acc);
    return acc;
}
__device__ __forceinline__ void axpy8(float* o, const u32x4& v, float w) {
    o[0] += w * bf_lo(v.x); o[1] += w * bf_hi(v.x); o[2] += w * bf_lo(v.y); o[3] += w * bf_hi(v.y); o[4] += w * bf_lo(v.z); o[5] += w * bf_hi(v.z); o[6] += w * bf_lo(v.w); o[7] += w * bf_hi(v.w);
}
#if TAB_FP4
typedef u32x2 tabw_t;
__device__ __forceinline__ void dec16(float (&f)[16], const tabw_t& w) {
#pragma unroll
    for (int j = 0; j < 2; ++j) { const f32x2 a = __builtin_amdgcn_cvt_scalef32_pk_f32_fp4(w[j], 1.0f, 0), b = __builtin_amdgcn_cvt_scalef32_pk_f32_fp4(w[j], 1.0f, 1), c = __builtin_amdgcn_cvt_scalef32_pk_f32_fp4(w[j], 1.0f, 2), d = __builtin_amdgcn_cvt_scalef32_pk_f32_fp4(w[j], 1.0f, 3);
        f[8 * j] = a.x; f[8 * j + 1] = a.y; f[8 * j + 2] = b.x; f[8 * j + 3] = b.y; f[8 * j + 4] = c.x; f[8 * j + 5] = c.y; f[8 * j + 6] = d.x; f[8 * j + 7] = d.y; }
}
#else
typedef u32x4 tabw_t;
__device__ __forceinline__ void dec16(float (&f)[16], const tabw_t& w) {
#pragma unroll
    for (int j = 0; j < 4; ++j) { const f32x2 lo = __builtin_amdgcn_cvt_pk_f32_fp8((int)w[j], false), hh = __builtin_amdgcn_cvt_pk_f32_fp8((int)w[j], true); f[4 * j] = lo.x; f[4 * j + 1] = lo.y; f[4 * j + 2] = hh.x; f[4 * j + 3] = hh.y; }
}
#endif
__device__ __forceinline__ void phase_peer_gather(const Params& p, int layer, const int* EIDX, const float* GW, const bf16_t* HB, bf16_t* HBO, float* OUT, float fs) {
    int tid_ = threadIdx.x; asm volatile("" : "+v"(tid_));
    const int lane = tid_ & 63, wave = tid_ >> 6;
    const int gw = blockIdx.x * NWAVES + wave, NGW = gridDim.x * NWAVES;
    const unsigned char* U8 = p.ws + WS_TAB + (size_t)layer * 2 * TAB_BYTES; const unsigned char* V8 = U8 + TAB_BYTES;
    const float* lg = p.in[I_PEER_LNG] + layer * 1024; const float* lb = p.in[I_PEER_LNB] + layer * 1024;
    for (int t = gw; t < NTOK; t += NGW) {
        const u32x4 x0 = *(const u32x4*)(HB + (size_t)t * 1024 + lane * 16), x1 = *(const u32x4*)(HB + (size_t)t * 1024 + lane * 16 + 8);
        const float xf[16] = {bf_lo(x0.x), bf_hi(x0.x), bf_lo(x0.y), bf_hi(x0.y), bf_lo(x0.z), bf_hi(x0.z), bf_lo(x0.w), bf_hi(x0.w), bf_lo(x1.x), bf_hi(x1.x), bf_lo(x1.y), bf_hi(x1.y), bf_lo(x1.z), bf_hi(x1.z), bf_lo(x1.w), bf_hi(x1.w)};
        const int e0 = EIDX[(size_t)t * 128 + lane], e1 = EIDX[(size_t)t * 128 + 64 + lane];
        const float g0 = GW[(size_t)t * 128 + lane], g1 = GW[(size_t)t * 128 + 64 + lane];
        float o[16];
#pragma unroll
        for (int i = 0; i < 16; ++i) o[i] = 0.f;
#pragma unroll 1
        for (int half = 0; half < 2; ++half) {
            const int eh = half ? e1 : e0; const float gh = half ? g1 : g0;
#pragma unroll 1
            for (int kb = 0; kb < 64; kb += 8) {
                tabw_t uw[8], vw[8]; float gg[8];
#pragma unroll
                for (int i = 0; i < 8; ++i) { const int e = __shfl(eh, kb + i); gg[i] = __shfl(gh, kb + i);
                    uw[i] = *(const tabw_t*)(U8 + (size_t)e * TAB_ROW + lane * (TAB_ROW / 64)); vw[i] = *(const tabw_t*)(V8 + (size_t)e * TAB_ROW + lane * (TAB_ROW / 64)); }
#pragma unroll
                for (int i = 0; i < 8; ++i) {
                    float uf[16]; dec16(uf, uw[i]);
                    float d0 = 0.f, d1 = 0.f;
#pragma unroll
                    for (int j = 0; j < 8; ++j) { d0 += xf[2 * j] * uf[2 * j]; d1 += xf[2 * j + 1] * uf[2 * j + 1]; }
                    const float d = wave_sum(d0 + d1) * (1.f / U_SCALE);
                    const float w = gg[i] * gelu_tanh(d);
                    float vf[16]; dec16(vf, vw[i]);
#pragma unroll
                    for (int j = 0; j < 16; ++j) o[j] += w * vf[j];
                }
            }
        }
        float z[16]; float s = 0.f;
#pragma unroll
        for (int i = 0; i < 16; ++i) { z[i] = DN_ALPHA * xf[i] + fs * (1.f / V_SCALE) * o[i]; s += z[i]; }
        const float mean = wave_sum(s) * (1.f / 1024.f); float q = 0.f;
#pragma unroll
        for (int i = 0; i < 16; ++i) { z[i] -= mean; q += z[i] * z[i]; }
        const float rstd = rsqrtf(wave_sum(q) * (1.f / 1024.f) + LN_EPS);
#pragma unroll
        for (int j = 0; j < 4; ++j) { const f32x4 ga = *(const f32x4*)(lg + lane * 16 + 4 * j), ba = *(const f32x4*)(lb + lane * 16 + 4 * j);
#pragma unroll
            for (int i = 0; i < 4; ++i) z[4 * j + i] = z[4 * j + i] * rstd * ga[i] + ba[i]; }
        if (OUT) {
#pragma unroll
            for (int j = 0; j < 4; ++j) *(f32x4*)(OUT + (size_t)t * 1024 + lane * 16 + 4 * j) = (f32x4){z[4 * j], z[4 * j + 1], z[4 * j + 2], z[4 * j + 3]};
        } else {
            u32x4 w0, w1; w0.x = pk2(z[0], z[1]); w0.y = pk2(z[2], z[3]); w0.z = pk2(z[4], z[5]); w0.w = pk2(z[6], z[7]); w1.x = pk2(z[8], z[9]); w1.y = pk2(z[10], z[11]); w1.z = pk2(z[12], z[13]); w1.w = pk2(z[14], z[15]);
            *(u32x4*)(HBO + (size_t)t * 1024 + lane * 16) = w0; *(u32x4*)(HBO + (size_t)t * 1024 + lane * 16 + 8) = w1;
        }
    }
}

__device__ __forceinline__ void phase_peer_gather6(const Params& p, int layer, const int* EIDX, const float* GW, const bf16_t* HB, bf16_t* HBO, float* OUT, float fs) {
    int tid_ = threadIdx.x; asm volatile("" : "+v"(tid_));
    const int lane = tid_ & 63, wave = tid_ >> 6, hl = lane & 31, half = lane >> 5;
    const int gw = blockIdx.x * NWAVES + wave, NGW = gridDim.x * NWAVES;
    const unsigned char* U6 = p.ws + WS_TAB + (size_t)layer * 2 * TAB_BYTES; const unsigned char* V6 = U6 + TAB_BYTES;
    const float* lg = p.in[I_PEER_LNG] + layer * 1024; const float* lb = p.in[I_PEER_LNB] + layer * 1024;
    for (int t = gw; t < NTOK; t += NGW) {
        float xf[32];
#pragma unroll
        for (int j = 0; j < 4; ++j) { const u32x4 xv = *(const u32x4*)(HB + (size_t)t * 1024 + hl * 32 + j * 8);
            xf[8 * j] = bf_lo(xv.x); xf[8 * j + 1] = bf_hi(xv.x); xf[8 * j + 2] = bf_lo(xv.y); xf[8 * j + 3] = bf_hi(xv.y); xf[8 * j + 4] = bf_lo(xv.z); xf[8 * j + 5] = bf_hi(xv.z); xf[8 * j + 6] = bf_lo(xv.w); xf[8 * j + 7] = bf_hi(xv.w); }
        const int e0 = EIDX[(size_t)t * 128 + lane], e1 = EIDX[(size_t)t * 128 + 64 + lane];
        const float g0 = GW[(size_t)t * 128 + lane], g1 = GW[(size_t)t * 128 + 64 + lane];
        float o[32];
#pragma unroll
        for (int i = 0; i < 32; ++i) o[i] = 0.f;
#pragma unroll 1
        for (int hs = 0; hs < 2; ++hs) {
            const int eh = hs ? e1 : e0; const float gh = hs ? g1 : g0;
#pragma unroll 1
            for (int kb = 0; kb < 64; kb += 8) {
                u32x4 ua[4], va[4]; u32x2 ub[4], vb[4]; float gg[4];
#pragma unroll
                for (int i = 0; i < 4; ++i) { const int k = kb + 2 * i + half; const int e = __shfl(eh, k); gg[i] = __shfl(gh, k);
                    const unsigned char* ur = U6 + (size_t)e * 768 + hl * 24; const unsigned char* vr = V6 + (size_t)e * 768 + hl * 24;
                    ua[i] = *(const u32x4*)ur; ub[i] = *(const u32x2*)(ur + 16); va[i] = *(const u32x4*)vr; vb[i] = *(const u32x2*)(vr + 16); }
#pragma unroll
                for (int i = 0; i < 4; ++i) {
                    const v32f_t uf = __builtin_amdgcn_cvt_scalef32_pk32_f32_fp6((v6u_t){ua[i].x, ua[i].y, ua[i].z, ua[i].w, ub[i].x, ub[i].y}, 1.0f);
                    float d0 = 0.f, d1 = 0.f;
#pragma unroll
                    for (int j = 0; j < 16; ++j) { d0 += xf[2 * j] * uf[2 * j]; d1 += xf[2 * j + 1] * uf[2 * j + 1]; }
                    float d = d0 + d1;
#pragma unroll
                    for (int ofs = 16; ofs >= 1; ofs >>= 1) d += __shfl_xor(d, ofs);
                    const float w = gg[i] * gelu_tanh(d * (1.f / U_SCALE));
                    const v32f_t vf = __builtin_amdgcn_cvt_scalef32_pk32_f32_fp6((v6u_t){va[i].x, va[i].y, va[i].z, va[i].w, vb[i].x, vb[i].y}, 1.0f);
#pragma unroll
                    for (int j = 0; j < 32; ++j) o[j] += w * vf[j];
                }
            }
        }
        float z[32]; float s = 0.f;
#pragma unroll
        for (int i = 0; i < 32; ++i) { const float ot = o[i] + __shfl_xor(o[i], 32); z[i] = DN_ALPHA * xf[i] + fs * (1.f / V_SCALE) * ot; s += z[i]; }
#pragma unroll
        for (int ofs = 16; ofs >= 1; ofs >>= 1) s += __shfl_xor(s, ofs);
        const float mean = s * (1.f / 1024.f); float q = 0.f;
#pragma unroll
        for (int i = 0; i < 32; ++i) { z[i] -= mean; q += z[i] * z[i]; }
#pragma unroll
        for (int ofs = 16; ofs >= 1; ofs >>= 1) q += __shfl_xor(q, ofs);
        const float rstd = rsqrtf(q * (1.f / 1024.f) + LN_EPS);
        float y[16]; const int c0 = hl * 32 + half * 16;
#pragma unroll
        for (int j = 0; j < 4; ++j) { const f32x4 ga = *(const f32x4*)(lg + c0 + 4 * j), ba = *(const f32x4*)(lb + c0 + 4 * j);
#pragma unroll
            for (int i = 0; i < 4; ++i) { float za = z[4 * j + i], zb = z[16 + 4 * j + i]; asm volatile("" : "+v"(za), "+v"(zb));
                const float zz = half ? zb : za; y[4 * j + i] = zz * rstd * ga[i] + ba[i]; } }
        if (OUT) {
#pragma unroll
            for (int j = 0; j < 4; ++j) *(f32x4*)(OUT + (size_t)t * 1024 + c0 + 4 * j) = (f32x4){y[4 * j], y[4 * j + 1], y[4 * j + 2], y[4 * j + 3]};
        } else {
            u32x4 w0, w1; w0.x = pk2(y[0], y[1]); w0.y = pk2(y[2], y[3]); w0.z = pk2(y[4], y[5]); w0.w = pk2(y[6], y[7]); w1.x = pk2(y[8], y[9]); w1.y = pk2(y[10], y[11]); w1.z = pk2(y[12], y[13]); w1.w = pk2(y[14], y[15]);
            *(u32x4*)(HBO + (size_t)t * 1024 + c0) = w0; *(u32x4*)(HBO + (size_t)t * 1024 + c0 + 8) = w1;
        }
    }
}

template <int CTRL> __device__ __forceinline__ float dpp_get(float v) { return __builtin_bit_cast(float, __builtin_amdgcn_update_dpp(0, __builtin_bit_cast(int, v), CTRL, 0xF, 0xF, true)); }
__device__ __forceinline__ float half_sum32(float d) {
    d += dpp_get<0xB1>(d);
    d += dpp_get<0x4E>(d);
    d += dpp_get<0x141>(d);
    d += dpp_get<0x140>(d);
    d += __shfl_xor(d, 16);
    return d;
}
__device__ __forceinline__ float wave_sum_dpp(float v) {
    v += dpp_get<0xB1>(v); v += dpp_get<0x4E>(v); v += dpp_get<0x141>(v); v += dpp_get<0x140>(v);
    v += __builtin_bit_cast(float, __builtin_amdgcn_update_dpp(0, __builtin_bit_cast(int, v), 0x142, 0xA, 0xF, false));
    v += __builtin_bit_cast(float, __builtin_amdgcn_update_dpp(0, __builtin_bit_cast(int, v), 0x143, 0xC, 0xF, false));
    return __builtin_bit_cast(float, __builtin_amdgcn_readlane(__builtin_bit_cast(int, v), 63));
}
__device__ __forceinline__ void phase_peer_upass(const Params& p, int layer, const int* EIDX, float* GW, const bf16_t* HB) {
    int tid_ = threadIdx.x; asm volatile("" : "+v"(tid_));
    const int lane = tid_ & 63, wave = tid_ >> 6, hl = lane & 31, half = lane >> 5;
    const int gw = blockIdx.x * NWAVES + wave, NGW = gridDim.x * NWAVES;
    const unsigned char* U6 = p.ws + WS_TAB + (size_t)layer * 2 * TAB_BYTES;
    u32x4 xn[4]; int e0n = 0, e1n = 0; float g0n = 0.f, g1n = 0.f;
    if (gw < NTOK) {
#pragma unroll
        for (int j = 0; j < 4; ++j) xn[j] = *(const u32x4*)(HB + (size_t)gw * 1024 + hl * 32 + j * 8);
        e0n = EIDX[(size_t)gw * 128 + lane]; e1n = EIDX[(size_t)gw * 128 + 64 + lane]; g0n = GW[(size_t)gw * 128 + lane]; g1n = GW[(size_t)gw * 128 + 64 + lane]; }
    for (int t = gw; t < NTOK; t += NGW) {
        float xf[32];
#pragma unroll
        for (int j = 0; j < 4; ++j) { const u32x4 xv = xn[j];
            xf[8 * j] = bf_lo(xv.x); xf[8 * j + 1] = bf_hi(xv.x); xf[8 * j + 2] = bf_lo(xv.y); xf[8 * j + 3] = bf_hi(xv.y); xf[8 * j + 4] = bf_lo(xv.z); xf[8 * j + 5] = bf_hi(xv.z); xf[8 * j + 6] = bf_lo(xv.w); xf[8 * j + 7] = bf_hi(xv.w); }
        const int e0 = e0n, e1 = e1n; const float g0 = g0n, g1 = g1n;
        { const int tn = t + NGW; if (tn < NTOK) {
#pragma unroll
            for (int j = 0; j < 4; ++j) xn[j] = *(const u32x4*)(HB + (size_t)tn * 1024 + hl * 32 + j * 8);
            e0n = EIDX[(size_t)tn * 128 + lane]; e1n = EIDX[(size_t)tn * 128 + 64 + lane]; g0n = GW[(size_t)tn * 128 + lane]; g1n = GW[(size_t)tn * 128 + 64 + lane]; } }
        float w0 = 0.f, w1 = 0.f;
#pragma unroll 1
        for (int hs = 0; hs < 2; ++hs) {
            const int eh = hs ? e1 : e0;
            float wacc = 0.f;
            int en[4];
#pragma unroll
            for (int i = 0; i < 4; ++i) en[i] = __shfl(eh, 2 * i + half);
#pragma unroll 1
            for (int kb = 0; kb < 64; kb += 8) {
                u32x4 ua[4]; u32x2 ub[4];
#pragma unroll
                for (int i = 0; i < 4; ++i) { const int e = en[i];
                    const unsigned char* ur = U6 + (size_t)e * 768 + hl * 24; ua[i] = *(const u32x4*)ur; ub[i] = *(const u32x2*)(ur + 16); }
#pragma unroll
                for (int i = 0; i < 4; ++i) en[i] = __shfl(eh, (kb + 8 + 2 * i + half) & 63);
#pragma unroll
                for (int i = 0; i < 4; ++i) {
                    const v32f_t uf = __builtin_amdgcn_cvt_scalef32_pk32_f32_fp6((v6u_t){ua[i].x, ua[i].y, ua[i].z, ua[i].w, ub[i].x, ub[i].y}, 1.0f);
                    float d0 = 0.f, d1 = 0.f;
#pragma unroll
                    for (int j = 0; j < 16; ++j) { d0 += xf[2 * j] * uf[2 * j]; d1 += xf[2 * j + 1] * uf[2 * j + 1]; }
                    const float d = half_sum32(d0 + d1);
                    const float dother = __shfl_xor(d, 32);
                    const int k0 = kb + 2 * i;
                    if (lane == k0) wacc = half ? dother : d;
                    if (lane == k0 + 1) wacc = half ? d : dother;
                }
            }
            const float gg = hs ? g1 : g0;
            const float wv = gg * gelu_tanh(wacc * (1.f / U_SCALE));
            if (hs) w1 = wv; else w0 = wv;
        }
        GW[(size_t)t * 128 + lane] = w0; GW[(size_t)t * 128 + 64 + lane] = w1;
    }
}
__device__ __forceinline__ void phase_peer_vpass(const Params& p, int layer, const int* EIDX, const float* GW, const bf16_t* HB, bf16_t* HBO, float* OUT, float fs) {
    int tid_ = threadIdx.x; asm volatile("" : "+v"(tid_));
    const int lane = tid_ & 63, wave = tid_ >> 6, hl = lane & 31, half = lane >> 5;
    const int gw = blockIdx.x * NWAVES + wave, NGW = gridDim.x * NWAVES;
    const unsigned char* V6 = p.ws + WS_TAB + (size_t)layer * 2 * TAB_BYTES + TAB_BYTES;
    const float* lg = p.in[I_PEER_LNG] + layer * 1024; const float* lb = p.in[I_PEER_LNB] + layer * 1024;
    int e0n = 0, e1n = 0; float g0n = 0.f, g1n = 0.f;
    if (gw < NTOK) { e0n = EIDX[(size_t)gw * 128 + lane]; e1n = EIDX[(size_t)gw * 128 + 64 + lane]; g0n = GW[(size_t)gw * 128 + lane]; g1n = GW[(size_t)gw * 128 + 64 + lane]; }
    for (int t = gw; t < NTOK; t += NGW) {
        const int e0 = e0n, e1 = e1n; const float g0 = g0n, g1 = g1n;
        { const int tn = t + NGW; if (tn < NTOK) { e0n = EIDX[(size_t)tn * 128 + lane]; e1n = EIDX[(size_t)tn * 128 + 64 + lane]; g0n = GW[(size_t)tn * 128 + lane]; g1n = GW[(size_t)tn * 128 + 64 + lane]; } }
        float o[32];
#pragma unroll
        for (int i = 0; i < 32; ++i) o[i] = 0.f;
#pragma unroll 1
        for (int hs = 0; hs < 2; ++hs) {
            const int eh = hs ? e1 : e0; const float gh = hs ? g1 : g0;
            int en[4];
#pragma unroll
            for (int i = 0; i < 4; ++i) en[i] = __shfl(eh, 2 * i + half);
#pragma unroll 1
            for (int kb = 0; kb < 64; kb += 8) {
                u32x4 va[4]; u32x2 vb[4]; float gg[4];
#pragma unroll
                for (int i = 0; i < 4; ++i) { const int k = kb + 2 * i + half; const int e = en[i]; gg[i] = __shfl(gh, k);
                    const unsigned char* vr = V6 + (size_t)e * 768 + hl * 24; va[i] = *(const u32x4*)vr; vb[i] = *(const u32x2*)(vr + 16); }
#pragma unroll
                for (int i = 0; i < 4; ++i) en[i] = __shfl(eh, (kb + 8 + 2 * i + half) & 63);
#pragma unroll
                for (int i = 0; i < 4; ++i) {
                    const v32f_t vf = __builtin_amdgcn_cvt_scalef32_pk32_f32_fp6((v6u_t){va[i].x, va[i].y, va[i].z, va[i].w, vb[i].x, vb[i].y}, 1.0f);
#pragma unroll
                    for (int j = 0; j < 32; ++j) o[j] += gg[i] * vf[j];
                }
            }
        }
        float z[32]; float s = 0.f;
#pragma unroll
        for (int j = 0; j < 4; ++j) { const u32x4 xv = *(const u32x4*)(HB + (size_t)t * 1024 + hl * 32 + j * 8);
            z[8 * j] = bf_lo(xv.x); z[8 * j + 1] = bf_hi(xv.x); z[8 * j + 2] = bf_lo(xv.y); z[8 * j + 3] = bf_hi(xv.y); z[8 * j + 4] = bf_lo(xv.z); z[8 * j + 5] = bf_hi(xv.z); z[8 * j + 6] = bf_lo(xv.w); z[8 * j + 7] = bf_hi(xv.w); }
#pragma unroll
        for (int i = 0; i < 32; ++i) { const float ot = o[i] + __shfl_xor(o[i], 32); z[i] = DN_ALPHA * z[i] + fs * (1.f / V_SCALE) * ot; s += z[i]; }
#pragma unroll
        for (int ofs = 16; ofs >= 1; ofs >>= 1) s += __shfl_xor(s, ofs);
        const float mean = s * (1.f / 1024.f); float q = 0.f;
#pragma unroll
        for (int i = 0; i < 32; ++i) { z[i] -= mean; q += z[i] * z[i]; }
#pragma unroll
        for (int ofs = 16; ofs >= 1; ofs >>= 1) q += __shfl_xor(q, ofs);
        const float rstd = rsqrtf(q * (1.f / 1024.f) + LN_EPS);
        float y[16]; const int c0 = hl * 32 + half * 16;
#pragma unroll
        for (int j = 0; j < 4; ++j) { const f32x4 ga = *(const f32x4*)(lg + c0 + 4 * j), ba = *(const f32x4*)(lb + c0 + 4 * j);
#pragma unroll
            for (int i = 0; i < 4; ++i) { float za = z[4 * j + i], zb = z[16 + 4 * j + i]; asm volatile("" : "+v"(za), "+v"(zb));
                const float zz = half ? zb : za; y[4 * j + i] = zz * rstd * ga[i] + ba[i]; } }
        if (OUT) {
#pragma unroll
            for (int j = 0; j < 4; ++j) *(f32x4*)(OUT + (size_t)t * 1024 + c0 + 4 * j) = (f32x4){y[4 * j], y[4 * j + 1], y[4 * j + 2], y[4 * j + 3]};
        } else {
            u32x4 w0, w1; w0.x = pk2(y[0], y[1]); w0.y = pk2(y[2], y[3]); w0.z = pk2(y[4], y[5]); w0.w = pk2(y[6], y[7]); w1.x = pk2(y[8], y[9]); w1.y = pk2(y[10], y[11]); w1.z = pk2(y[12], y[13]); w1.w = pk2(y[14], y[15]);
            *(u32x4*)(HBO + (size_t)t * 1024 + c0) = w0; *(u32x4*)(HBO + (size_t)t * 1024 + c0 + 8) = w1;
        }
    }
}

typedef int v8i_t __attribute__((ext_vector_type(8)));
constexpr float W8_SCALE = 16.f;
__device__ __forceinline__ unsigned w_fp8_splat(float w) {
    const float v = fminf(fmaxf(w * W8_SCALE, -448.f), 448.f);
    return ((unsigned)__builtin_amdgcn_cvt_pk_fp8_f32(v, 0.f, 0, false) & 0xFFu) * 0x01010101u;
}
typedef int v8i_t __attribute__((ext_vector_type(8)));
constexpr float X8_SCALE = 16.f;
__device__ __forceinline__ void phase_peer_upass_mm(const Params& p, LAS unsigned char* lds, int layer, const int* EIDX, float* GW, const bf16_t* HB) {
    int tid_ = threadIdx.x; asm volatile("" : "+v"(tid_));
    const int lane = tid_ & 63, wave = tid_ >> 6, n = lane & 15, kg = lane >> 4, j = n >> 2, nb = n & 3;
    const int gw = blockIdx.x * NWAVES + wave, NGW = gridDim.x * NWAVES;
    const unsigned char* U4 = p.ws + WS_TAB + (size_t)layer * 2 * TAB_BYTES + kg * 64 + nb * 16;
    LAS unsigned char* xl = lds + wave * 2048;
    const LAS unsigned char* xa = xl + ((n >> 2) & 1) * 1024 + (kg >> 1) * 128 + nb * 32 + 16 * (kg & 1);
    const int kbase = 64 * (kg & 1) + 4 * nb + j;
    if (gw >= NTOK) return;
    u32x4 xn[2]; int e0n, e1n; float gn[4];
    xn[0] = *(const u32x4*)(HB + (size_t)gw * 1024 + lane * 16); xn[1] = *(const u32x4*)(HB + (size_t)gw * 1024 + lane * 16 + 8);
    e0n = EIDX[(size_t)gw * 128 + lane]; e1n = EIDX[(size_t)gw * 128 + 64 + lane];
#pragma unroll
    for (int i = 0; i < 4; ++i) gn[i] = GW[(size_t)gw * 128 + kbase + 16 * i];
    u32x4 bq[8][2];
#pragma unroll
    for (int gi = 0; gi < 8; ++gi) { const int e = __shfl(e0n, 4 * gi + j); const unsigned char* r = U4 + (size_t)e * 512; bq[gi][0] = *(const u32x4*)r; bq[gi][1] = *(const u32x4*)(r + 256); }
    for (int t = gw; t < NTOK; t += NGW) {
        { float xf[16];
          xf[0] = bf_lo(xn[0].x); xf[1] = bf_hi(xn[0].x); xf[2] = bf_lo(xn[0].y); xf[3] = bf_hi(xn[0].y); xf[4] = bf_lo(xn[0].z); xf[5] = bf_hi(xn[0].z); xf[6] = bf_lo(xn[0].w); xf[7] = bf_hi(xn[0].w);
          xf[8] = bf_lo(xn[1].x); xf[9] = bf_hi(xn[1].x); xf[10] = bf_lo(xn[1].y); xf[11] = bf_hi(xn[1].y); xf[12] = bf_lo(xn[1].z); xf[13] = bf_hi(xn[1].z); xf[14] = bf_lo(xn[1].w); xf[15] = bf_hi(xn[1].w);
          u32x4 hi, lo;
#pragma unroll
          for (int jj = 0; jj < 4; ++jj) {
              const float v0 = fminf(fmaxf(xf[4 * jj] * X8_SCALE, -448.f), 448.f), v1 = fminf(fmaxf(xf[4 * jj + 1] * X8_SCALE, -448.f), 448.f);
              const float v2 = fminf(fmaxf(xf[4 * jj + 2] * X8_SCALE, -448.f), 448.f), v3 = fminf(fmaxf(xf[4 * jj + 3] * X8_SCALE, -448.f), 448.f);
              int h = __builtin_amdgcn_cvt_pk_fp8_f32(v0, v1, 0, false); h = __builtin_amdgcn_cvt_pk_fp8_f32(v2, v3, h, true);
              const auto d01 = __builtin_amdgcn_cvt_pk_f32_fp8(h, false); const auto d23 = __builtin_amdgcn_cvt_pk_f32_fp8(h, true);
              int l = __builtin_amdgcn_cvt_pk_fp8_f32(v0 - d01[0], v1 - d01[1], 0, false); l = __builtin_amdgcn_cvt_pk_fp8_f32(v2 - d23[0], v3 - d23[1], l, true);
              hi[jj] = (unsigned)h; lo[jj] = (unsigned)l; }
          *(LAS u32x4*)(xl + lane * 16) = hi; *(LAS u32x4*)(xl + 1024 + lane * 16) = lo; }
        __builtin_amdgcn_fence(__ATOMIC_RELEASE, "wavefront"); __builtin_amdgcn_wave_barrier(); __builtin_amdgcn_fence(__ATOMIC_ACQUIRE, "wavefront");
        v8i_t ax[2];
#pragma unroll
        for (int hf = 0; hf < 2; ++hf) { const u32x4 a0 = *(const LAS u32x4*)(xa + hf * 512), a1 = *(const LAS u32x4*)(xa + hf * 512 + 256);
            ax[hf] = (v8i_t){(int)a0.x, (int)a0.y, (int)a0.z, (int)a0.w, (int)a1.x, (int)a1.y, (int)a1.z, (int)a1.w}; }
        __builtin_amdgcn_fence(__ATOMIC_RELEASE, "wavefront"); __builtin_amdgcn_wave_barrier();
        const int e0 = e0n, e1 = e1n; float gcur[4];
#pragma unroll
        for (int i = 0; i < 4; ++i) gcur[i] = gn[i];
        { const int tn = t + NGW; if (tn < NTOK) {
            xn[0] = *(const u32x4*)(HB + (size_t)tn * 1024 + lane * 16); xn[1] = *(const u32x4*)(HB + (size_t)tn * 1024 + lane * 16 + 8);
            e0n = EIDX[(size_t)tn * 128 + lane]; e1n = EIDX[(size_t)tn * 128 + 64 + lane];
#pragma unroll
            for (int i = 0; i < 4; ++i) gn[i] = GW[(size_t)tn * 128 + kbase + 16 * i]; } }
        float hreg[8];
#pragma unroll
        for (int i = 0; i < 8; ++i) hreg[i] = 0.f;
#pragma unroll
        for (int bi = 0; bi < 4; ++bi) {
            const int bn = bi + 1;
            const int ehn = (bn < 2) ? e0 : ((bn < 4) ? e1 : e0n);
            int en[8];
#pragma unroll
            for (int gi = 0; gi < 8; ++gi) en[gi] = __shfl(ehn, (bn & 1) * 32 + 4 * gi + j);
#pragma unroll
            for (int gi = 0; gi < 8; ++gi) {
                const v8i_t b0 = {(int)bq[gi][0].x, (int)bq[gi][0].y, (int)bq[gi][0].z, (int)bq[gi][0].w, 0, 0, 0, 0};
                const v8i_t b1 = {(int)bq[gi][1].x, (int)bq[gi][1].y, (int)bq[gi][1].z, (int)bq[gi][1].w, 0, 0, 0, 0};
                f32x4 c = {0.f, 0.f, 0.f, 0.f};
                c = __builtin_amdgcn_mfma_scale_f32_16x16x128_f8f6f4(ax[0], b0, c, 0  , 4  , 0, 0, 0, 0);
                c = __builtin_amdgcn_mfma_scale_f32_16x16x128_f8f6f4(ax[1], b1, c, 0, 4, 0, 0, 0, 0);
                { const unsigned char* r = U4 + (size_t)en[gi] * 512; bq[gi][0] = *(const u32x4*)r; bq[gi][1] = *(const u32x4*)(r + 256); }
                __builtin_amdgcn_sched_barrier(0);
                float c0 = c[0], c1 = c[1], c2 = c[2], c3 = c[3]; asm volatile("" : "+v"(c0), "+v"(c1), "+v"(c2), "+v"(c3));
                float sel = (nb == 0) ? c0 : ((nb == 1) ? c1 : ((nb == 2) ? c2 : c3));
                sel += dpp_get<0xB1>(sel); sel += dpp_get<0x4E>(sel);
                if (nb == (gi & 3)) hreg[bi * 2 + (gi >> 2)] = sel;
            }
        }
#pragma unroll
        for (int i = 0; i < 8; ++i) hreg[i] += __shfl_xor(hreg[i], 16);
#pragma unroll
        for (int i = 0; i < 4; ++i) { float ha = hreg[i], hb = hreg[4 + i]; asm volatile("" : "+v"(ha), "+v"(hb)); const float h = (kg & 1) ? hb : ha;
            const float wv = gcur[i] * gelu_tanh(h * (1.f / (U_SCALE * X8_SCALE)));
            if (kg < 2) GW[(size_t)t * 128 + kbase + 16 * i] = wv; }
    }
}
__device__ __forceinline__ void phase_peer_upass_mm_split(const Params& p, LAS unsigned char* lds, int layer, const int* EIDX, float* PH, const bf16_t* HB) {
    int tid_ = threadIdx.x; asm volatile("" : "+v"(tid_));
    const int lane = tid_ & 63, wave = tid_ >> 6, n = lane & 15, kg = lane >> 4, j = n >> 2, nb = n & 3;
    const int hf = ((int)blockIdx.x >> 2) & 1;
    const int gw = ((((int)blockIdx.x >> 3) << 2) | ((int)blockIdx.x & 3)) * NWAVES + wave, NGW = (gridDim.x >> 1) * NWAVES;
    const unsigned char* U4 = p.ws + WS_TAB + (size_t)layer * 2 * TAB_BYTES;
    const unsigned uoff = (unsigned)(hf * 256 + kg * 64 + nb * 16);
    float* PHh = PH + (size_t)hf * NTOK * 128;
    LAS unsigned char* xl = lds + wave * 2048;
    const LAS unsigned char* xa = xl + ((n >> 2) & 1) * 1024 + hf * 512 + (kg >> 1) * 128 + nb * 32 + 16 * (kg & 1);
    const int kbase = 64 * (kg & 1) + 4 * nb + j;
    if (gw >= NTOK) return;
    u32x4 xn; int e0n, e1n;
    xn = *(const u32x4*)(HB + (size_t)gw * 1024 + hf * 512 + lane * 8);
    e0n = EIDX[(size_t)gw * 128 + lane]; e1n = EIDX[(size_t)gw * 128 + 64 + lane];
    constexpr int UB = 16;
    u32x4 bq[UB];
#pragma unroll
    for (int gi = 0; gi < UB; ++gi) { const int e = __shfl(e0n, 4 * gi + j); bq[gi] = *(const u32x4*)(U4 + (size_t)((unsigned)e * 512u + uoff)); }
    for (int t = gw; t < NTOK; t += NGW) {
        { float xf[8];
          xf[0] = bf_lo(xn.x); xf[1] = bf_hi(xn.x); xf[2] = bf_lo(xn.y); xf[3] = bf_hi(xn.y); xf[4] = bf_lo(xn.z); xf[5] = bf_hi(xn.z); xf[6] = bf_lo(xn.w); xf[7] = bf_hi(xn.w);
          u32x2 hi, lo;
#pragma unroll
          for (int jj = 0; jj < 2; ++jj) {
              const float v0 = fminf(fmaxf(xf[4 * jj] * X8_SCALE, -448.f), 448.f), v1 = fminf(fmaxf(xf[4 * jj + 1] * X8_SCALE, -448.f), 448.f);
              const float v2 = fminf(fmaxf(xf[4 * jj + 2] * X8_SCALE, -448.f), 448.f), v3 = fminf(fmaxf(xf[4 * jj + 3] * X8_SCALE, -448.f), 448.f);
              int h = __builtin_amdgcn_cvt_pk_fp8_f32(v0, v1, 0, false); h = __builtin_amdgcn_cvt_pk_fp8_f32(v2, v3, h, true);
              const auto d01 = __builtin_amdgcn_cvt_pk_f32_fp8(h, false); const auto d23 = __builtin_amdgcn_cvt_pk_f32_fp8(h, true);
              int l = __builtin_amdgcn_cvt_pk_fp8_f32(v0 - d01[0], v1 - d01[1], 0, false); l = __builtin_amdgcn_cvt_pk_fp8_f32(v2 - d23[0], v3 - d23[1], l, true);
              hi[jj] = (unsigned)h; lo[jj] = (unsigned)l; }
          *(LAS u32x2*)(xl + hf * 512 + lane * 8) = hi; *(LAS u32x2*)(xl + 1024 + hf * 512 + lane * 8) = lo; }
        __builtin_amdgcn_fence(__ATOMIC_RELEASE, "wavefront"); __builtin_amdgcn_wave_barrier(); __builtin_amdgcn_fence(__ATOMIC_ACQUIRE, "wavefront");
        v8i_t ax;
        { const u32x4 a0 = *(const LAS u32x4*)xa, a1 = *(const LAS u32x4*)(xa + 256);
          ax = (v8i_t){(int)a0.x, (int)a0.y, (int)a0.z, (int)a0.w, (int)a1.x, (int)a1.y, (int)a1.z, (int)a1.w}; }
        __builtin_amdgcn_fence(__ATOMIC_RELEASE, "wavefront"); __builtin_amdgcn_wave_barrier();
        const int e0 = e0n, e1 = e1n;
        { const int tn = t + NGW; if (tn < NTOK) {
            xn = *(const u32x4*)(HB + (size_t)tn * 1024 + hf * 512 + lane * 8);
            e0n = EIDX[(size_t)tn * 128 + lane]; e1n = EIDX[(size_t)tn * 128 + 64 + lane]; } }
        float hreg[8];
#pragma unroll
        for (int i = 0; i < 8; ++i) hreg[i] = 0.f;
#pragma unroll
        for (int bi = 0; bi < 32 / UB; ++bi) {
            const int bn = bi + 1;
            const int ehn = (bn * UB < 16) ? e0 : ((bn * UB < 32) ? e1 : e0n);
            int en[UB];
#pragma unroll
            for (int gi = 0; gi < UB; ++gi) en[gi] = __shfl(ehn, ((4 * (bn * UB + gi)) & 63) + j);
#pragma unroll
            for (int gi = 0; gi < UB; ++gi) {
                const v8i_t b0 = {(int)bq[gi].x, (int)bq[gi].y, (int)bq[gi].z, (int)bq[gi].w, 0, 0, 0, 0};
                f32x4 c = {0.f, 0.f, 0.f, 0.f};
                c = __builtin_amdgcn_mfma_scale_f32_16x16x128_f8f6f4(ax, b0, c, 0  , 4  , 0, 0, 0, 0);
                bq[gi] = *(const u32x4*)(U4 + (size_t)((unsigned)en[gi] * 512u + uoff));
                __builtin_amdgcn_sched_barrier(0);
                float c0 = c[0], c1 = c[1], c2 = c[2], c3 = c[3]; asm volatile("" : "+v"(c0), "+v"(c1), "+v"(c2), "+v"(c3));
                float sel = (nb == 0) ? c0 : ((nb == 1) ? c1 : ((nb == 2) ? c2 : c3));
                sel += dpp_get<0xB1>(sel); sel += dpp_get<0x4E>(sel);
                if (nb == (gi & 3)) hreg[(bi * UB + gi) >> 2] = sel;
            }
        }
#pragma unroll
        for (int i = 0; i < 8; ++i) hreg[i] += __shfl_xor(hreg[i], 16);
#pragma unroll
        for (int i = 0; i < 4; ++i) { float ha = hreg[i], hb = hreg[4 + i]; asm volatile("" : "+v"(ha), "+v"(hb)); const float h = (kg & 1) ? hb : ha;
            if (kg < 2) PHh[(size_t)t * 128 + kbase + 16 * i] = h; }
    }
}
__device__ __forceinline__ void phase_peer_vpass_mm(const Params& p, int layer, const int* EIDX, const float* GW, const bf16_t* HB, bf16_t* HBO, float* OUT, float fs, const float* PH = nullptr) {
    int tid_ = threadIdx.x; asm volatile("" : "+v"(tid_));
    const int lane = tid_ & 63, wave = tid_ >> 6, n = lane & 31, kgb = lane >> 5;
    const int gw = blockIdx.x * NWAVES + wave, NGW = gridDim.x * NWAVES;
    constexpr int VROW = V_FP4 ? 512 : 768, VLANE = V_FP4 ? 16 : 24;
    const unsigned char* V6 = p.ws + WS_TAB + (size_t)layer * 2 * TAB_BYTES + TAB_BYTES;
    const unsigned voff = (unsigned)(n * VLANE);
    const float* lg = p.in[I_PEER_LNG] + layer * 1024; const float* lb = p.in[I_PEER_LNB] + layer * 1024;
    const int r = lane & 15; const bool act = (lane < 16) || (lane >= 48);
    unsigned msk[4];
#pragma unroll
    for (int d = 0; d < 4; ++d) msk[d] = (act && d == (r >> 2)) ? (0xFFu << (8 * (r & 3))) : 0u;
    if (gw >= NTOK) return;
    auto load_w = [&](int tt, float& w0, float& w1) {
        w0 = GW[(size_t)tt * 128 + lane]; w1 = GW[(size_t)tt * 128 + 64 + lane];
        if (PH) { const float* P1 = PH + (size_t)NTOK * 128;
            const float h0 = PH[(size_t)tt * 128 + lane] + P1[(size_t)tt * 128 + lane], h1 = PH[(size_t)tt * 128 + 64 + lane] + P1[(size_t)tt * 128 + 64 + lane];
            w0 *= gelu_tanh(h0 * (1.f / (U_SCALE * X8_SCALE))); w1 *= gelu_tanh(h1 * (1.f / (U_SCALE * X8_SCALE))); } };
    int e0n = EIDX[(size_t)gw * 128 + lane], e1n = EIDX[(size_t)gw * 128 + 64 + lane]; float g0n, g1n; load_w(gw, g0n, g1n);
    u32x4 b4[8]; u32x2 b2[8];
#pragma unroll
    for (int i = 0; i < 8; ++i) { const int e = __shfl(e0n, 2 * i + kgb); const unsigned char* vr = V6 + (size_t)((unsigned)e * (unsigned)VROW + voff); b4[i] = *(const u32x4*)vr; if (!V_FP4) b2[i] = *(const u32x2*)(vr + 16); else b2[i] = (u32x2){0u, 0u}; }
    for (int t = gw; t < NTOK; t += NGW) {
        const int e0 = e0n, e1 = e1n; const unsigned ws0 = w_fp8_splat(g0n), ws1 = w_fp8_splat(g1n);
        { const int tn = t + NGW; if (tn < NTOK) { e0n = EIDX[(size_t)tn * 128 + lane]; e1n = EIDX[(size_t)tn * 128 + 64 + lane]; load_w(tn, g0n, g1n); } }
        const int q = kgb;
        u32x2 xr[4];
#pragma unroll
        for (int I = 0; I < 4; ++I) xr[I] = *(const u32x2*)(HB + (size_t)t * 1024 + n * 32 + 8 * I + 4 * q);
        v16f_t acc;
#pragma unroll
        for (int i = 0; i < 16; ++i) acc[i] = 0.f;
#pragma unroll 1
        for (int bi = 0; bi < 8; ++bi) {
            const int bn = bi + 1;
            const int ehn = (bn < 4) ? e0 : ((bn < 8) ? e1 : e0n);
            const unsigned wsh = (bi & 4) ? ws1 : ws0;
            const int base = (bi & 3) * 16, basen = (bn & 3) * 16;
            int en[8];
#pragma unroll
            for (int i = 0; i < 8; ++i) en[i] = __shfl(ehn, basen + 2 * i + kgb);
#pragma unroll
            for (int i = 0; i < 8; ++i) {
                const unsigned w0s = (unsigned)__builtin_amdgcn_readlane((int)wsh, base + 2 * i), w1s = (unsigned)__builtin_amdgcn_readlane((int)wsh, base + 2 * i + 1);
                const v8i_t A = {(int)(msk[0] & w0s), (int)(msk[1] & w0s), (int)(msk[2] & w0s), (int)(msk[3] & w0s), (int)(msk[0] & w1s), (int)(msk[1] & w1s), (int)(msk[2] & w1s), (int)(msk[3] & w1s)};
                const v8i_t B = {(int)b4[i].x, (int)b4[i].y, (int)b4[i].z, (int)b4[i].w, (int)b2[i].x, (int)b2[i].y, 0, 0};
                acc = __builtin_amdgcn_mfma_scale_f32_32x32x64_f8f6f4(A, B, acc, 0  , V_FP4 ? 4 : 2  , 0, 0, 0, 0);
                const unsigned char* vr = V6 + (size_t)((unsigned)en[i] * (unsigned)VROW + voff); b4[i] = *(const u32x4*)vr; if (!V_FP4) b2[i] = *(const u32x2*)(vr + 16);
                __builtin_amdgcn_sched_barrier(0);
            }
        }
        float z[16]; float s = 0.f;
#pragma unroll
        for (int I = 0; I < 4; ++I) { const float x0 = bf_lo(xr[I].x), x1 = bf_hi(xr[I].x), x2 = bf_lo(xr[I].y), x3 = bf_hi(xr[I].y);
            z[4 * I] = DN_ALPHA * x0 + fs * (1.f / (V_SCALE * W8_SCALE)) * acc[4 * I]; z[4 * I + 1] = DN_ALPHA * x1 + fs * (1.f / (V_SCALE * W8_SCALE)) * acc[4 * I + 1];
            z[4 * I + 2] = DN_ALPHA * x2 + fs * (1.f / (V_SCALE * W8_SCALE)) * acc[4 * I + 2]; z[4 * I + 3] = DN_ALPHA * x3 + fs * (1.f / (V_SCALE * W8_SCALE)) * acc[4 * I + 3]; }
#pragma unroll
        for (int i = 0; i < 16; ++i) s += z[i];
        const float mean = wave_sum(s) * (1.f / 1024.f); float qq = 0.f;
#pragma unroll
        for (int i = 0; i < 16; ++i) { z[i] -= mean; qq += z[i] * z[i]; }
        const float rstd = rsqrtf(wave_sum(qq) * (1.f / 1024.f) + LN_EPS);
#pragma unroll
        for (int I = 0; I < 4; ++I) { const int c0 = n * 32 + 8 * I + 4 * q; const f32x4 ga = *(const f32x4*)(lg + c0), ba = *(const f32x4*)(lb + c0);
            const float y0 = z[4 * I] * rstd * ga.x + ba.x, y1 = z[4 * I + 1] * rstd * ga.y + ba.y, y2 = z[4 * I + 2] * rstd * ga.z + ba.z, y3 = z[4 * I + 3] * rstd * ga.w + ba.w;
            if (OUT) *(f32x4*)(OUT + (size_t)t * 1024 + c0) = (f32x4){y0, y1, y2, y3};
            else *(u32x2*)(HBO + (size_t)t * 1024 + c0) = (u32x2){pk2(y0, y1), pk2(y2, y3)}; }
    }
}

__device__ __forceinline__ void phase_peer_vpass_mm_sweep(const Params& p, LAS unsigned char* lds, int layer, const int* EIDX, const float* GW, const float* PH, const bf16_t* HB, bf16_t* HBO, float* OUT, float fs) {
    int tid_ = threadIdx.x; asm volatile("" : "+v"(tid_));
    const int lane = tid_ & 63, wave = tid_ >> 6, n = lane & 15, kg = lane >> 4, q = kg;
    const int gw = blockIdx.x * NWAVES + wave, NGW = gridDim.x * NWAVES;
    const unsigned char* V4 = p.ws + WS_TAB + (size_t)layer * 2 * TAB_BYTES + TAB_BYTES;
    const unsigned voff0 = (unsigned)(n * 8);
    LAS unsigned char* zl = lds + wave * 16384;
    LAS float* sl = (LAS float*)(lds + 8 * 16384) + wave * 32;
    const int colb = 16 * n + 4 * q;
    unsigned sel[4];
#pragma unroll
    for (int d = 0; d < 4; ++d) sel[d] = (d == (n >> 2)) ? ((0x0C0C0C0Cu & ~(0xFFu << (8 * (n & 3)))) | ((unsigned)kg << (8 * (n & 3)))) : 0x0C0C0C0Cu;
    if (gw >= NTOK) return;
    const int ntok = (NTOK - gw + NGW - 1) / NGW;
    auto load_w = [&](int tt, unsigned& p0, unsigned& p1) {
        float w0, w1;
        if (PH) { const float* P1 = PH + (size_t)NTOK * 128;
            const float h0 = PH[(size_t)tt * 128 + lane] + P1[(size_t)tt * 128 + lane], h1 = PH[(size_t)tt * 128 + 64 + lane] + P1[(size_t)tt * 128 + 64 + lane];
            w0 = GW[(size_t)tt * 128 + lane] * gelu_tanh(h0 * (1.f / (U_SCALE * X8_SCALE))); w1 = GW[(size_t)tt * 128 + 64 + lane] * gelu_tanh(h1 * (1.f / (U_SCALE * X8_SCALE))); }
        else { w0 = GW[(size_t)tt * 128 + lane]; w1 = GW[(size_t)tt * 128 + 64 + lane]; }
        const float v0 = fminf(fmaxf(w0 * W8_SCALE, -448.f), 448.f), v1 = fminf(fmaxf(w1 * W8_SCALE, -448.f), 448.f);
        const unsigned pk = (unsigned)__builtin_amdgcn_cvt_pk_fp8_f32(v0, v1, 0, false);
        unsigned a0 = pk & 0xFFu, a1 = (pk >> 8) & 0xFFu;
        a0 |= (unsigned)__builtin_amdgcn_update_dpp(0, (int)a0, 0x101, 0xF, 0xF, true) << 8;  a1 |= (unsigned)__builtin_amdgcn_update_dpp(0, (int)a1, 0x101, 0xF, 0xF, true) << 8;
        a0 |= (unsigned)__builtin_amdgcn_update_dpp(0, (int)a0, 0x102, 0xF, 0xF, true) << 16; a1 |= (unsigned)__builtin_amdgcn_update_dpp(0, (int)a1, 0x102, 0xF, 0xF, true) << 16;
        p0 = a0; p1 = a1; };
    constexpr int VB = 8;
    int eo0n = EIDX[(size_t)gw * 128 + lane] << 9, eo1n = EIDX[(size_t)gw * 128 + 64 + lane] << 9; unsigned p0n, p1n; load_w(gw, p0n, p1n);
    u32x2 ba0[VB], ba1[VB], bb0[VB], bb1[VB];
#pragma unroll
    for (int i = 0; i < VB; ++i) { const unsigned oa = (unsigned)__shfl(eo0n, 8 * i + 2 * kg) + voff0, ob = (unsigned)__shfl(eo0n, 8 * i + 2 * kg + 1) + voff0;
        ba0[i] = *(const u32x2*)(V4 + (size_t)oa); ba1[i] = *(const u32x2*)(V4 + (size_t)oa + 128); bb0[i] = *(const u32x2*)(V4 + (size_t)ob); bb1[i] = *(const u32x2*)(V4 + (size_t)ob + 128); }
    f32x4 ga[2], ba[2], gb[2], bb[2];
#pragma unroll
    for (int Q = 0; Q < 2; ++Q) { ga[Q] = *(const f32x4*)(p.in[I_PEER_LNG] + layer * 1024 + colb + 256 * Q); ba[Q] = *(const f32x4*)(p.in[I_PEER_LNB] + layer * 1024 + colb + 256 * Q);
        gb[Q] = *(const f32x4*)(p.in[I_PEER_LNG] + layer * 1024 + 512 + colb + 256 * Q); bb[Q] = *(const f32x4*)(p.in[I_PEER_LNB] + layer * 1024 + 512 + colb + 256 * Q); }
#pragma unroll 1
    for (int hf = 0; hf < 2; ++hf) {
        const unsigned voff = voff0 + (unsigned)(hf * 256), voffn_last = voff0 + (unsigned)((hf ^ 1) * 256);
#pragma unroll 1
        for (int k = 0; k < ntok; ++k) {
            const int t = gw + k * NGW;
            const int eo1 = eo1n; const unsigned p0 = p0n, p1 = p1n;
            const bool lastk = (k + 1 == ntok); const int tn = lastk ? gw : t + NGW; const bool more = !(lastk && hf == 1);
            if (more) { eo0n = EIDX[(size_t)tn * 128 + lane] << 9; eo1n = EIDX[(size_t)tn * 128 + 64 + lane] << 9; load_w(tn, p0n, p1n); }
            const unsigned voffn = lastk ? voffn_last : voff;
            u32x2 xr[2];
#pragma unroll
            for (int Q = 0; Q < 2; ++Q) xr[Q] = *(const u32x2*)(HB + (size_t)t * 1024 + hf * 512 + colb + 256 * Q);
            f32x4 acc0 = {0.f, 0.f, 0.f, 0.f}, acc1 = {0.f, 0.f, 0.f, 0.f};
#pragma unroll
            for (int bi = 0; bi < 2; ++bi) {
                const int ehn = (bi == 0) ? eo1 : eo0n;
                const unsigned vo = (bi == 0) ? voff : voffn;
                const unsigned ph = (bi == 0) ? p0 : p1;
                unsigned oa[VB], ob[VB];
#pragma unroll
                for (int i = 0; i < VB; ++i) { oa[i] = (unsigned)__shfl(ehn, 8 * i + 2 * kg) + vo; ob[i] = (unsigned)__shfl(ehn, 8 * i + 2 * kg + 1) + vo; }
#pragma unroll
                for (int i = 0; i < VB; ++i) {
                    const unsigned s0 = (unsigned)__builtin_amdgcn_readlane((int)ph, 8 * i), s1 = (unsigned)__builtin_amdgcn_readlane((int)ph, 8 * i + 4);
                    const v8i_t A = {(int)__builtin_amdgcn_perm(s0, s0, sel[0]), (int)__builtin_amdgcn_perm(s0, s0, sel[1]), (int)__builtin_amdgcn_perm(s0, s0, sel[2]), (int)__builtin_amdgcn_perm(s0, s0, sel[3]),
                                     (int)__builtin_amdgcn_perm(s1, s1, sel[0]), (int)__builtin_amdgcn_perm(s1, s1, sel[1]), (int)__builtin_amdgcn_perm(s1, s1, sel[2]), (int)__builtin_amdgcn_perm(s1, s1, sel[3])};
                    const v8i_t B0 = {(int)ba0[i].x, (int)ba0[i].y, (int)bb0[i].x, (int)bb0[i].y, 0, 0, 0, 0};
                    const v8i_t B1 = {(int)ba1[i].x, (int)ba1[i].y, (int)bb1[i].x, (int)bb1[i].y, 0, 0, 0, 0};
                    acc0 = __builtin_amdgcn_mfma_scale_f32_16x16x128_f8f6f4(A, B0, acc0, 0  , 4  , 0, 0, 0, 0);
                    acc1 = __builtin_amdgcn_mfma_scale_f32_16x16x128_f8f6f4(A, B1, acc1, 0, 4, 0, 0, 0, 0);
                    ba0[i] = *(const u32x2*)(V4 + (size_t)oa[i]); ba1[i] = *(const u32x2*)(V4 + (size_t)oa[i] + 128); bb0[i] = *(const u32x2*)(V4 + (size_t)ob[i]); bb1[i] = *(const u32x2*)(V4 + (size_t)ob[i] + 128);
                    __builtin_amdgcn_sched_barrier(0);
                }
            }
            float z[8]; float s1 = 0.f, s2 = 0.f;
            { const float x0 = bf_lo(xr[0].x), x1 = bf_hi(xr[0].x), x2 = bf_lo(xr[0].y), x3 = bf_hi(xr[0].y);
              z[0] = DN_ALPHA * x0 + fs * (1.f / (V_SCALE * W8_SCALE)) * acc0[0]; z[1] = DN_ALPHA * x1 + fs * (1.f / (V_SCALE * W8_SCALE)) * acc0[1];
              z[2] = DN_ALPHA * x2 + fs * (1.f / (V_SCALE * W8_SCALE)) * acc0[2]; z[3] = DN_ALPHA * x3 + fs * (1.f / (V_SCALE * W8_SCALE)) * acc0[3]; }
            { const float x0 = bf_lo(xr[1].x), x1 = bf_hi(xr[1].x), x2 = bf_lo(xr[1].y), x3 = bf_hi(xr[1].y);
              z[4] = DN_ALPHA * x0 + fs * (1.f / (V_SCALE * W8_SCALE)) * acc1[0]; z[5] = DN_ALPHA * x1 + fs * (1.f / (V_SCALE * W8_SCALE)) * acc1[1];
              z[6] = DN_ALPHA * x2 + fs * (1.f / (V_SCALE * W8_SCALE)) * acc1[2]; z[7] = DN_ALPHA * x3 + fs * (1.f / (V_SCALE * W8_SCALE)) * acc1[3]; }
            if (hf == 0) {
                const u32x4 zz = {pk2(z[0], z[1]), pk2(z[2], z[3]), pk2(z[4], z[5]), pk2(z[6], z[7])};
                *(LAS u32x4*)(zl + k * 1024 + lane * 16) = zz;
                const float r0 = bf_lo(zz.x), r1 = bf_hi(zz.x), r2 = bf_lo(zz.y), r3 = bf_hi(zz.y), r4 = bf_lo(zz.z), r5 = bf_hi(zz.z), r6 = bf_lo(zz.w), r7 = bf_hi(zz.w);
                s1 = ((r0 + r1) + (r2 + r3)) + ((r4 + r5) + (r6 + r7)); s2 = ((r0 * r0 + r1 * r1) + (r2 * r2 + r3 * r3)) + ((r4 * r4 + r5 * r5) + (r6 * r6 + r7 * r7));
                const float S1 = wave_sum_dpp(s1), S2 = wave_sum_dpp(s2);
                if (lane == 0) { sl[2 * k] = S1; sl[2 * k + 1] = S2; }
            } else {
#pragma unroll
                for (int i = 0; i < 8; ++i) { s1 += z[i]; s2 += z[i] * z[i]; }
                const u32x4 zz = *(const LAS u32x4*)(zl + k * 1024 + lane * 16);
                const float S1 = wave_sum_dpp(s1) + sl[2 * k], S2 = wave_sum_dpp(s2) + sl[2 * k + 1];
                const float mean = S1 * (1.f / 1024.f); const float var = fmaxf(S2 * (1.f / 1024.f) - mean * mean, 0.f);
                const float rstd = rsqrtf(var + LN_EPS);
                const float za[8] = {bf_lo(zz.x), bf_hi(zz.x), bf_lo(zz.y), bf_hi(zz.y), bf_lo(zz.z), bf_hi(zz.z), bf_lo(zz.w), bf_hi(zz.w)};
#pragma unroll
                for (int Q = 0; Q < 2; ++Q) {
                    const float a0 = (za[4 * Q] - mean) * rstd * ga[Q].x + ba[Q].x, a1 = (za[4 * Q + 1] - mean) * rstd * ga[Q].y + ba[Q].y, a2 = (za[4 * Q + 2] - mean) * rstd * ga[Q].z + ba[Q].z, a3 = (za[4 * Q + 3] - mean) * rstd * ga[Q].w + ba[Q].w;
                    const float y0 = (z[4 * Q] - mean) * rstd * gb[Q].x + bb[Q].x, y1 = (z[4 * Q + 1] - mean) * rstd * gb[Q].y + bb[Q].y, y2 = (z[4 * Q + 2] - mean) * rstd * gb[Q].z + bb[Q].z, y3 = (z[4 * Q + 3] - mean) * rstd * gb[Q].w + bb[Q].w;
                    if (OUT) { __builtin_nontemporal_store((f32x4){a0, a1, a2, a3}, (f32x4*)(OUT + (size_t)t * 1024 + colb + 256 * Q)); __builtin_nontemporal_store((f32x4){y0, y1, y2, y3}, (f32x4*)(OUT + (size_t)t * 1024 + 512 + colb + 256 * Q)); }
                    else { __builtin_nontemporal_store((u32x2){pk2(a0, a1), pk2(a2, a3)}, (u32x2*)(HBO + (size_t)t * 1024 + colb + 256 * Q)); __builtin_nontemporal_store((u32x2){pk2(y0, y1), pk2(y2, y3)}, (u32x2*)(HBO + (size_t)t * 1024 + 512 + colb + 256 * Q)); }
                }
            }
        }
    }
}

#define XB_TMO      128
#define XB_XCNT(j)  (256  + 64 * (j))
#define XB_XSUB(j)  (1280 + 64 * (j))
#define XB_XGEN(j)  (2304 + 64 * (j))
#define XB_TOP      3328
#define XB_TOPGEN   3392
#define XCD_BAR_WORDS 3456
#define XB_SPIN_CAP (1u << 18)
__device__ __forceinline__ unsigned xb_ld(unsigned* p)              { return __hip_atomic_load(p, __ATOMIC_RELAXED, __HIP_MEMORY_SCOPE_AGENT); }
__device__ __forceinline__ unsigned xb_add(unsigned* p, unsigned v) { return __hip_atomic_fetch_add(p, v, __ATOMIC_RELAXED, __HIP_MEMORY_SCOPE_AGENT); }
__device__ __forceinline__ unsigned xb_xcc_id() { return (unsigned)__builtin_amdgcn_s_getreg((3 << 11) | 20) & 0xFu; }
#define XB_SPIN(cond, bar) do { unsigned _sp = 0; while (cond) { __builtin_amdgcn_s_sleep(1); \
    if ((++_sp & 255u) == 0u) { if (xb_ld(&(bar)[XB_TMO])) break; if (_sp > XB_SPIN_CAP) { atomicAdd(&(bar)[XB_TMO], 1u); break; } } } } while (0)
struct XcdBarrier { unsigned* bar; unsigned x; volatile LAS unsigned* st; };
__device__ __forceinline__ XcdBarrier xcd_barrier_post(unsigned* bar, volatile LAS unsigned* st) {
    XcdBarrier b; b.bar = bar; b.x = xb_xcc_id(); b.st = st;
    if (threadIdx.x == 0) (void)xb_add(&bar[XB_XCNT(b.x)], 1u);
    return b;
}
__device__ __forceinline__ void xcd_barrier_complete(unsigned* bar, unsigned x, unsigned& nloc, unsigned& nx) {
    const unsigned G = gridDim.x * gridDim.y * gridDim.z;
    unsigned sum, cnt, mine, sp = 0u;
    for (;;) {
        sum = 0u; cnt = 0u; mine = 0u;
#pragma unroll
        for (unsigned j = 0; j < 16; ++j) { const unsigned c = xb_ld(&bar[XB_XCNT(j)]); sum += c; cnt += (c > 0u) ? 1u : 0u; mine = (j == x) ? c : mine; }
        if (sum == G) break;
        __builtin_amdgcn_s_sleep(1);
        if ((++sp & 255u) == 0u) { if (xb_ld(&bar[XB_TMO])) break; if (sp > XB_SPIN_CAP) { atomicAdd(&bar[XB_TMO], 1u); break; } }
    }
    nloc = mine > 0u ? mine : 1u; nx = cnt > 0u ? cnt : 1u;
}
__device__ __forceinline__ void xcd_barrier(const XcdBarrier& b) {
    asm volatile("s_waitcnt vmcnt(0)" ::: "memory");
    __syncthreads();
    if (threadIdx.x == 0) {
        unsigned* bar = b.bar;
        __builtin_amdgcn_s_waitcnt(0);
        unsigned nloc = b.st[0], nx = b.st[1];
        if (nloc == 0u) { xcd_barrier_complete(bar, b.x, nloc, nx); b.st[0] = nloc; b.st[1] = nx; }
        const unsigned old = xb_add(&bar[XB_XSUB(b.x)], 1u);
        const unsigned gen = old / nloc;
        if (old + 1u == (gen + 1u) * nloc) {
            __builtin_amdgcn_fence(__ATOMIC_RELEASE, "agent");
            asm volatile("s_waitcnt vmcnt(0)" ::: "memory");
            const unsigned og = xb_add(&bar[XB_TOP], 1u);
            const unsigned tg = og / nx;
            if (og + 1u == (tg + 1u) * nx) xb_add(&bar[XB_TOPGEN], 1u);
            else XB_SPIN(xb_ld(&bar[XB_TOPGEN]) == tg, bar);
            __builtin_amdgcn_fence(__ATOMIC_ACQUIRE, "agent");
            xb_add(&bar[XB_XGEN(b.x)], 1u);
            asm volatile("s_waitcnt vmcnt(0)" ::: "memory");
        } else {
            XB_SPIN(xb_ld(&bar[XB_XGEN(b.x)]) == gen, bar);
            __builtin_amdgcn_fence(__ATOMIC_ACQUIRE, "agent");
            asm volatile("s_waitcnt vmcnt(0)" ::: "memory");
        }
    }
    __syncthreads();
}

constexpr int NPHASES = 19;
#if TAB_MODE == 6
#define PEER_GATHER phase_peer_gather6
#else
#define PEER_GATHER phase_peer_gather
#endif
__global__ void __launch_bounds__(NTHREADS, 2) fwd_kernel(Params p) {
    extern __shared__ __attribute__((aligned(16))) unsigned char lds_raw[];
    LAS unsigned char* lds = (LAS unsigned char*)lds_raw;
    unsigned char* ws = p.ws;
    bf16_t* HB = (bf16_t*)(ws + WS_HB);
    const int lo = p.ph_lo, hi = p.ph_hi;
    volatile LAS unsigned* bst = (volatile LAS unsigned*)(lds + LDS_BYTES - 64);
    if (threadIdx.x < 16) bst[threadIdx.x] = 0u;
    __syncthreads();
    XcdBarrier gbar; gbar.bar = (unsigned*)(ws + WS_CTL) + 4096; gbar.x = 0; gbar.st = bst;
    if (hi - lo > 1) {
        gbar = xcd_barrier_post((unsigned*)(ws + WS_CTL) + 4096, bst); }
#ifndef PH_MASK
#define PH_MASK 0xFFFFFFFFu
#endif
#define IN(k) (((PH_MASK >> (k)) & 1u) && lo <= (k) && (k) < hi)
#if DBG_TIME
    unsigned long long t_prev = __builtin_amdgcn_s_memrealtime(), t_acc = 0ull;
#define SEAM(k) do { if (IN(k) && IN((k) + 1)) { xcd_barrier(gbar); } { const unsigned long long t_now = __builtin_amdgcn_s_memrealtime(); if ((DBG_TIME >> (k)) & 1u) t_acc += t_now - t_prev; t_prev = t_now; } } while (0)
#else
#define SEAM(k) do { if (IN(k) && IN((k) + 1)) { xcd_barrier(gbar); } } while (0)
#endif
    if (IN(0)) for (int rep_ = 0; rep_ < ((PROBE_REP == 0) ? 1 + PROBE_N : 1); ++rep_) { phase_prologue(p, lds); } SEAM(0);
    if (IN(1) && PROBE_REP2 == 1) { EpiNsaProj E{(bf16_t*)(ws + S_Q), (bf16_t*)(ws + S_KV6), (float*)(ws + S_GATES)};
        run_gemm(lds, HB, 1024, (const bf16_t*)(ws + WS_W_IN_T), 1024, NTOK, NSA_IN_PAD, 1024, (int)blockIdx.x, E); }
    if (IN(1)) for (int rep_ = 0; rep_ < ((PROBE_REP == 1) ? 1 + PROBE_N : 1); ++rep_) { EpiNsaProj E{(bf16_t*)(ws + S_Q), (bf16_t*)(ws + S_KV6), (float*)(ws + S_GATES)};
        run_gemm(lds, HB, 1024, (const bf16_t*)(ws + WS_W_IN_T), 1024, NTOK, NSA_IN_PAD, 1024, (int)blockIdx.x, E);
        if (rep_ == 0) late_weight_transposes(p, lds); } SEAM(1);
    if (IN(2)) for (int rep_ = 0; rep_ < ((PROBE_REP == 2) ? 1 + PROBE_N : 1); ++rep_) { EpiF32 Ek{(float*)(ws + S_PK), 256}, Ev{(float*)(ws + S_PV), 256};
        run_gemm(lds, (const bf16_t*)(ws + S_KV6), 1024, (const bf16_t*)(ws + WS_W_CK1_T), 1024, 8192, 256, 1024, (int)blockIdx.x, Ek);
        run_gemm(lds, (const bf16_t*)(ws + S_KV6) + (size_t)NTOK * 256, 1024, (const bf16_t*)(ws + WS_W_CV1_T), 1024, 8192, 256, 1024, (int)((blockIdx.x + gridDim.x / 2) % gridDim.x), Ev);
        if (rep_ == 0) convert_tables_idle(p); } SEAM(2);
    if (IN(3)) for (int rep_ = 0; rep_ < ((PROBE_REP == 3) ? 1 + PROBE_N : 1); ++rep_) { phase_cmp_finish(p, lds); } SEAM(3);
    if (IN(4)) for (int rep_ = 0; rep_ < ((PROBE_REP == 4) ? 1 + PROBE_N : 1); ++rep_) { if (USE_MFMA_NSA) phase_nsa_attn(p, lds); else phase_nsa_attn_ref(p, lds); } SEAM(4);
    if (IN(5) && PROBE_REP2 == 5) { EpiResid E{HB, (bf16_t*)(ws + S_Z), (ABL & 1) ? 0.f : 1.f};
        run_gemm(lds, (const bf16_t*)(ws + S_AO), 1024, (const bf16_t*)(ws + WS_W_NSAOUT_T), 1024, NTOK, 1024, 1024, (int)blockIdx.x, E); }
    if (IN(5)) for (int rep_ = 0; rep_ < ((PROBE_REP == 5) ? 1 + PROBE_N : 1); ++rep_) { EpiResid E{HB, (bf16_t*)(ws + S_Z), (ABL & 1) ? 0.f : 1.f};
        run_gemm(lds, (const bf16_t*)(ws + S_AO), 1024, (const bf16_t*)(ws + WS_W_NSAOUT_T), 1024, NTOK, 1024, 1024, (int)blockIdx.x, E); } SEAM(5);
    if (IN(6)) for (int rep_ = 0; rep_ < ((PROBE_REP == 6) ? 1 + PROBE_N : 1); ++rep_) { phase_ln((const bf16_t*)(ws + S_Z), HB, p.in[I_NSA_LNG], p.in[I_NSA_LNB]); } SEAM(6);
    if (IN(7) && PROBE_REP2 == 7) { EpiBf16 E{(bf16_t*)(ws + S_QP0), 2048};
        run_gemm(lds, HB, 1024, (const bf16_t*)(ws + WS_W_PQ_T), 1024, NTOK, 2048, 1024, (int)blockIdx.x, E); }
    if (IN(7)) for (int rep_ = 0; rep_ < ((PROBE_REP == 7) ? 1 + PROBE_N : 1); ++rep_) { EpiBf16 E{(bf16_t*)(ws + S_QP0), 2048};
        run_gemm(lds, HB, 1024, (const bf16_t*)(ws + WS_W_PQ_T), 1024, NTOK, 2048, 1024, (int)blockIdx.x, E); } SEAM(7);
    if (IN(8) && ((PROBE_DUP & 1) || PROBE_REP == 8)) for (int rep_ = 0; rep_ < PROBE_N; ++rep_) { phase_peer_route(p, lds, 0, (const bf16_t*)(ws + S_QP0), (int*)(ws + S_Z), (float*)(ws + S_Z + 16 * MiB)); }
    if (IN(8)) { if (USE_MFMA_ROUTE) phase_peer_route(p, lds, 0, (const bf16_t*)(ws + S_QP0), (int*)(ws + S_EIDX0), (float*)(ws + S_GW0)); else phase_peer_route_ref(p, lds, 0, (const bf16_t*)(ws + S_QP0), (int*)(ws + S_EIDX0), (float*)(ws + S_GW0)); } SEAM(8);
    if (IN(9) && ((PROBE_DUP & 2) || PROBE_REP == 9)) for (int rep_ = 0; rep_ < PROBE_N; ++rep_) { PEER_GATHER(p, 0, (const int*)(ws + S_EIDX0), (const float*)(ws + S_GW0), HB, (bf16_t*)(ws + S_Z), nullptr, 1.f); }
#if SPLIT_UV && TAB_MODE == 6
    if (IN(9)) { if (U_MM && U_SPLIT && gridDim.x == 256) { phase_peer_upass_mm_split(p, lds, 0, (const int*)(ws + S_EIDX0), (float*)(ws + S_Z), HB); xcd_barrier(gbar);
            if (V_SPLIT && V_FP4) phase_peer_vpass_mm_sweep(p, lds, 0, (const int*)(ws + S_EIDX0), (const float*)(ws + S_GW0), (const float*)(ws + S_Z), HB, HB, nullptr, 1.f);
            else phase_peer_vpass_mm(p, 0, (const int*)(ws + S_EIDX0), (const float*)(ws + S_GW0), HB, HB, nullptr, 1.f, (const float*)(ws + S_Z)); }
        else { if (U_MM) phase_peer_upass_mm(p, lds, 0, (const int*)(ws + S_EIDX0), (float*)(ws + S_GW0), HB); else phase_peer_upass(p, 0, (const int*)(ws + S_EIDX0), (float*)(ws + S_GW0), HB);
            phase_peer_vpass_mm(p, 0, (const int*)(ws + S_EIDX0), (const float*)(ws + S_GW0), HB, HB, nullptr, 1.f); } } SEAM(9);
#else
    if (IN(9)) { PEER_GATHER(p, 0, (const int*)(ws + S_EIDX0), (const float*)(ws + S_GW0), HB, HB, nullptr, (ABL & 2) ? 0.f : 1.f); } SEAM(9);
#endif
    if (IN(10) && PROBE_REP2 == 10) { EpiBf16 E{(bf16_t*)(ws + S_DQ), MLA_DOWN_PAD};
        run_gemm(lds, HB, 1024, (const bf16_t*)(ws + WS_W_MLADOWN_T), 1024, NTOK, MLA_DOWN_PAD, 1024, (int)blockIdx.x, E); }
    if (IN(10)) for (int rep_ = 0; rep_ < ((PROBE_REP == 10) ? 1 + PROBE_N : 1); ++rep_) { EpiBf16 E{(bf16_t*)(ws + S_DQ), MLA_DOWN_PAD};
        run_gemm(lds, HB, 1024, (const bf16_t*)(ws + WS_W_MLADOWN_T), 1024, NTOK, MLA_DOWN_PAD, 1024, (int)blockIdx.x, E); } SEAM(10);
    if (IN(11)) for (int rep_ = 0; rep_ < ((PROBE_REP == 11) ? 1 + PROBE_N : 1); ++rep_) { phase_mla_rowstats(p); } SEAM(11);
    if (IN(12)) for (int rep_ = 0; rep_ < ((PROBE_REP == 12) ? 1 + PROBE_N : 1); ++rep_) { EpiBf16 Eq{(bf16_t*)(ws + S_QF), 1536}; EpiKV Ekv{(bf16_t*)(ws + S_KNOPE), (bf16_t*)(ws + S_V)};
        run_gemm(lds, (const bf16_t*)(ws + S_DQ), MLA_DOWN_PAD, (const bf16_t*)(ws + WS_W_UQ_T), 768, NTOK, 1536, 768, (int)blockIdx.x, Eq);
        run_gemm(lds, (const bf16_t*)(ws + S_DQ) + 768, MLA_DOWN_PAD, (const bf16_t*)(ws + WS_W_UKV_T), 256, NTOK, 2048, 256, (int)blockIdx.x, Ekv); } SEAM(12);
    if (IN(13) && MLA_VAR >= 0) { phase_mla_attn<(MLA_VAR >= 0 ? MLA_VAR : 0)>(p, lds); xcd_barrier(gbar); }
    if (IN(13)) { phase_mla_attn<0>(p, lds); } SEAM(13);
    if (IN(14) && PROBE_REP2 == 14) { EpiResid E{HB, (bf16_t*)(ws + S_Z2), (ABL & 4) ? 0.f : 1.f};
        run_gemm(lds, (const bf16_t*)(ws + S_AO2), 1024, (const bf16_t*)(ws + WS_W_MLAOUT_T), 1024, NTOK, 1024, 1024, (int)blockIdx.x, E); }
    if (IN(14)) for (int rep_ = 0; rep_ < ((PROBE_REP == 14) ? 1 + PROBE_N : 1); ++rep_) { EpiResid E{HB, (bf16_t*)(ws + S_Z2), (ABL & 4) ? 0.f : 1.f};
        run_gemm(lds, (const bf16_t*)(ws + S_AO2), 1024, (const bf16_t*)(ws + WS_W_MLAOUT_T), 1024, NTOK, 1024, 1024, (int)blockIdx.x, E); } SEAM(14);
    if (IN(15)) for (int rep_ = 0; rep_ < ((PROBE_REP == 15) ? 1 + PROBE_N : 1); ++rep_) { phase_ln((const bf16_t*)(ws + S_Z2), HB, p.in[I_MLA_LNG], p.in[I_MLA_LNB]); } SEAM(15);
    if (IN(16) && PROBE_REP2 == 16) { EpiBf16 E{(bf16_t*)(ws + S_QP1), 2048};
        run_gemm(lds, HB, 1024, (const bf16_t*)(ws + WS_W_PQ_T) + (size_t)2048 * 1024, 1024, NTOK, 2048, 1024, (int)blockIdx.x, E); }
    if (IN(16)) for (int rep_ = 0; rep_ < ((PROBE_REP == 16) ? 1 + PROBE_N : 1); ++rep_) { EpiBf16 E{(bf16_t*)(ws + S_QP1), 2048};
        run_gemm(lds, HB, 1024, (const bf16_t*)(ws + WS_W_PQ_T) + (size_t)2048 * 1024, 1024, NTOK, 2048, 1024, (int)blockIdx.x, E); } SEAM(16);
    if (IN(17) && ((PROBE_DUP & 1) || PROBE_REP == 17)) for (int rep_ = 0; rep_ < PROBE_N; ++rep_) { phase_peer_route_ref(p, lds, 1, (const bf16_t*)(ws + S_QP1), (int*)(ws + S_EIDX1), (float*)(ws + S_GW1)); }
    if (IN(17)) { if (USE_MFMA_ROUTE) phase_peer_route(p, lds, 1, (const bf16_t*)(ws + S_QP1), (int*)(ws + S_EIDX1), (float*)(ws + S_GW1)); else phase_peer_route_ref(p, lds, 1, (const bf16_t*)(ws + S_QP1), (int*)(ws + S_EIDX1), (float*)(ws + S_GW1)); } SEAM(17);
    if (IN(18) && ((PROBE_DUP & 2) || PROBE_REP == 18)) for (int rep_ = 0; rep_ < PROBE_N; ++rep_) { PEER_GATHER(p, 1, (const int*)(ws + S_EIDX1), (const float*)(ws + S_GW1), HB, (bf16_t*)(ws + S_Z2), nullptr, 1.f); }
#if SPLIT_UV && TAB_MODE == 6
    if (IN(18)) { if (U_MM && U_SPLIT && gridDim.x == 256) { phase_peer_upass_mm_split(p, lds, 1, (const int*)(ws + S_EIDX1), (float*)(ws + S_Z2), HB); xcd_barrier(gbar);
            if (V_SPLIT && V_FP4) phase_peer_vpass_mm_sweep(p, lds, 1, (const int*)(ws + S_EIDX1), (const float*)(ws + S_GW1), (const float*)(ws + S_Z2), HB, HB, p.out, 1.f);
            else phase_peer_vpass_mm(p, 1, (const int*)(ws + S_EIDX1), (const float*)(ws + S_GW1), HB, HB, p.out, 1.f, (const float*)(ws + S_Z2)); }
        else { if (U_MM) phase_peer_upass_mm(p, lds, 1, (const int*)(ws + S_EIDX1), (float*)(ws + S_GW1), HB); else phase_peer_upass(p, 1, (const int*)(ws + S_EIDX1), (float*)(ws + S_GW1), HB);
            phase_peer_vpass_mm(p, 1, (const int*)(ws + S_EIDX1), (const float*)(ws + S_GW1), HB, HB, p.out, 1.f); } }
#else
    if (IN(18)) { PEER_GATHER(p, 1, (const int*)(ws + S_EIDX1), (const float*)(ws + S_GW1), HB, HB, p.out, (ABL & 8) ? 0.f : 1.f); }
#endif
#if DBG_TIME
    if (IN(18)) { { const unsigned long long t_now = __builtin_amdgcn_s_memrealtime(); if ((DBG_TIME >> 18) & 1u) t_acc += t_now - t_prev; }
        xcd_barrier(gbar);
        const float c = 1.f + (float)t_acc * (0.01f / 100.f);
        if (blockIdx.x == 0) for (size_t i = threadIdx.x; i < (size_t)NTOK * DM; i += NTHREADS) p.out[i] = c;
        else { const float c0 = 1.f; (void)c0; } }
#elif DBG_STAT == 7
    if (IN(18)) { xcd_barrier(gbar);
        typedef float v16f_ __attribute__((ext_vector_type(16))); typedef float v32f_ __attribute__((ext_vector_type(32))); typedef unsigned v6u_ __attribute__((ext_vector_type(6)));
        v16f_ a, b;
#pragma unroll
        for (int i = 0; i < 16; ++i) { a[i] = 0.125f * (float)i; b[i] = (i < 8) ? 2.f + 0.25f * (float)i : 4.f + 0.5f * (float)(i - 8); }
        asm volatile("" : "+v"(a), "+v"(b));
        const v6u_ pk = __builtin_amdgcn_cvt_scalef32_2xpk16_fp6_f32(a, b, 1.0f);
        const v32f_ r = __builtin_amdgcn_cvt_scalef32_pk32_f32_fp6(pk, 1.0f);
        bool seq = true, itl = true;
#pragma unroll
        for (int i = 0; i < 16; ++i) { seq = seq && (r[i] == a[i]) && (r[16 + i] == b[i]); itl = itl && (r[2 * i] == a[i]) && (r[2 * i + 1] == b[i]); }
        const float c = seq ? 1.f : (itl ? 2.f : 3.f);
        for (size_t i = (size_t)blockIdx.x * NTHREADS + threadIdx.x; i < (size_t)NTOK * DM; i += (size_t)gridDim.x * NTHREADS) p.out[i] = c; }
#elif DBG_STAT
    if (IN(18)) { asm volatile("s_waitcnt vmcnt(0) lgkmcnt(0)" ::: "memory"); __builtin_amdgcn_fence(__ATOMIC_RELEASE, "agent"); cg::this_grid().sync(); __builtin_amdgcn_fence(__ATOMIC_ACQUIRE, "agent");
        const float c = 1.f + __hip_atomic_load((float*)(ws + WS_CTL) + 16, __ATOMIC_RELAXED, __HIP_MEMORY_SCOPE_AGENT);
        for (size_t i = (size_t)blockIdx.x * NTHREADS + threadIdx.x; i < (size_t)NTOK * DM; i += (size_t)gridDim.x * NTHREADS) p.out[i] = c; }
#endif
#undef IN
#undef SEAM
}

extern "C" void kernel_launch(void* const* d_in, const int* in_sizes, int n_in, void* d_out, int out_size, void* d_ws, size_t ws_size, hipStream_t stream) {
    static int grid = 0;
    if (grid == 0) {
        if (n_in != 28 || out_size != NTOK * DM || ws_size < WS_NEED) { fprintf(stderr, "kernel_launch: unexpected problem (n_in %d, out %d, ws %zu)\n", n_in, out_size, ws_size); grid = -1; return; }
        int dev = 0, cus = 0, per_cu = 0;
        (void)hipGetDevice(&dev); (void)hipDeviceGetAttribute(&cus, hipDeviceAttributeMultiprocessorCount, dev);
        if (hipFuncSetAttribute((const void*)fwd_kernel, hipFuncAttributeMaxDynamicSharedMemorySize, LDS_BYTES) != hipSuccess) { fprintf(stderr, "kernel_launch: hipFuncSetAttribute failed\n"); grid = -1; return; }
        if (hipOccupancyMaxActiveBlocksPerMultiprocessor(&per_cu, (const void*)fwd_kernel, NTHREADS, LDS_BYTES) != hipSuccess || per_cu < 1) { fprintf(stderr, "kernel_launch: occupancy query says %d blocks per CU\n", per_cu); grid = -1; return; }
        grid = cus;
    }
    if (grid < 0) return;
    if (hipMemsetAsync((char*)d_ws + WS_CTL, 0, CTL_BYTES, stream) != hipSuccess) { fprintf(stderr, "kernel_launch: memset of the control words failed\n"); return; }
    Params p{};
    for (int i = 0; i < 28; ++i) p.in[i] = (const float*)d_in[i];
    p.out = (float*)d_out; p.ws = (unsigned char*)d_ws;
#if MK_ONE_LAUNCH
    p.ph_lo = 0; p.ph_hi = NPHASES;
    void* args[] = {&p};
    hipError_t e = hipLaunchCooperativeKernel((const void*)fwd_kernel, dim3(grid), dim3(NTHREADS), args, LDS_BYTES, stream);
    if (e != hipSuccess) fprintf(stderr, "kernel_launch: cooperative launch failed: %s\n", hipGetErrorString(e));
#else
    for (int k = 0; k < NPHASES; ++k) { p.ph_lo = k; p.ph_hi = k + 1; hipLaunchKernelGGL(fwd_kernel, dim3(grid), dim3(NTHREADS), LDS_BYTES, stream, p); }
#endif
}
#ifdef REGTEST
__global__ void __launch_bounds__(256) regtest_nsa(Params p) { extern __shared__ __attribute__((aligned(16))) unsigned char l2[]; phase_nsa_attn(p, (LAS unsigned char*)l2); }
__global__ void __launch_bounds__(256) regtest_mla(Params p) { extern __shared__ __attribute__((aligned(16))) unsigned char l2[]; phase_mla_attn<0>(p, (LAS unsigned char*)l2); }
#endif
```
